# Optimizing an MI355X kernel written in HIP

```python
import math
import jax, jax.numpy as jnp
from jax import lax
import numpy as np

D_MODEL = 1024
BATCH = 2
SEQ = 8192
DEPTH = 2

D_MIX = D_MODEL
HGRN_WIDTH = D_MIX // 4
HGRN_HEAD_DIM = 64
HGRN_HEADS = HGRN_WIDTH // HGRN_HEAD_DIM
HGRN_CHUNK = 16
LB_FLOOR = 1e-30
S5_WIDTH = D_MIX // 4
S5_GROUP = 16
S5_GROUPS = S5_WIDTH // S5_GROUP
S5_STATE = 64
S5_DT_MIN = 1e-3
S5_DT_MAX = 1e-1
ATTN_WIDTH = D_MIX - HGRN_WIDTH - S5_WIDTH
DIFF_HEAD_DIM = 64
DIFF_V_DIM = 2 * DIFF_HEAD_DIM
DIFF_HEADS = ATTN_WIDTH // DIFF_V_DIM
ROPE_DIM = DIFF_HEAD_DIM // 4
ROPE_THETA = 500000.0
Q_BLOCK = 128
MASK_VALUE = -1e30
EPS = 1e-6
D_IN = 4 * HGRN_WIDTH + 2 * S5_WIDTH + 4 * ATTN_WIDTH

kernel_name = "hymba_style_hgrn2_s5_diffattn"


def _in_splits():
    sizes = [HGRN_WIDTH] * 4 + [S5_WIDTH] * 2 + [ATTN_WIDTH] * 4
    return [int(v) for v in np.cumsum(sizes)[:-1]]


def rmsnorm(x, w):
    xf = x.astype(jnp.float32)
    return xf * lax.rsqrt(jnp.mean(xf * xf, axis=-1, keepdims=True) + EPS) * w.astype(jnp.float32)


def hgrn2_mixer(q, f_raw, v, lb, g_norm_w):
    b, s, _ = q.shape
    n = s // HGRN_CHUNK
    q = jax.nn.silu(q)
    log_f = jnp.logaddexp(jnp.log(jnp.maximum(lb, LB_FLOOR)), jnp.log1p(-lb) + jax.nn.log_sigmoid(f_raw))
    k = -jnp.expm1(log_f)

    def to_chunks(t):
        return t.reshape(b, n, HGRN_CHUNK, HGRN_HEADS, HGRN_HEAD_DIM).transpose(0, 3, 1, 2, 4)

    qc, kc, vc, lfc = to_chunks(q), to_chunks(k), to_chunks(v), to_chunks(log_f)
    cum = jnp.cumsum(lfc, axis=3)
    causal = jnp.tril(jnp.ones((HGRN_CHUNK, HGRN_CHUNK), dtype=bool))[:, :, None]
    rel = cum[..., :, None, :] - cum[..., None, :, :]
    decay = jnp.where(causal, jnp.exp(jnp.where(causal, rel, 0.0)), 0.0)
    scores = jnp.einsum('bhntd,bhnsd,bhntsd->bhnts', qc, kc, decay)
    o_intra = jnp.einsum('bhnts,bhnsv->bhntv', scores, vc)
    last = cum[..., -1:, :]
    chunk_upd = jnp.einsum('bhnsd,bhnsv->bhndv', kc * jnp.exp(last - cum), vc)
    chunk_decay = jnp.exp(last[..., 0, :])

    def step(state, inp):
        dec, upd = inp
        return dec[..., None] * state + upd, state

    init = jnp.zeros((b, HGRN_HEADS, HGRN_HEAD_DIM, HGRN_HEAD_DIM), jnp.float32)
    _, prev = lax.scan(step, init, (jnp.moveaxis(chunk_decay, 2, 0), jnp.moveaxis(chunk_upd, 2, 0)))
    prev = jnp.moveaxis(prev, 0, 2)
    o_inter = jnp.einsum('bhntd,bhndv->bhntv', qc * jnp.exp(cum), prev)
    o = (o_intra + o_inter).transpose(0, 2, 3, 1, 4).reshape(b, s, HGRN_HEADS, HGRN_HEAD_DIM)
    o = rmsnorm(o, g_norm_w)
    return o.reshape(b, s, HGRN_WIDTH)


def s5_mixer(u, a_re, a_im, b_re, b_im, c_re, c_im, log_dt, d_skip, glu_w, glu_b):
    bsz, s, _ = u.shape
    ug = u.reshape(bsz, s, S5_GROUPS, S5_GROUP)
    dt = jnp.exp(log_dt)[:, None]
    mag = jnp.exp(dt * a_re)
    ab_re = mag * jnp.cos(dt * a_im)
    ab_im = mag * jnp.sin(dt * a_im)
    den = a_re * a_re + a_im * a_im
    num_re = ab_re - 1.0
    num_im = ab_im
    z_re = (num_re * a_re + num_im * a_im) / den
    z_im = (num_im * a_re - num_re * a_im) / den
    bb_re = z_re[..., None] * b_re - z_im[..., None] * b_im
    bb_im = z_re[..., None] * b_im + z_im[..., None] * b_re
    bu_re = jnp.einsum('gpc,bsgc->bsgp', bb_re, ug)
    bu_im = jnp.einsum('gpc,bsgc->bsgp', bb_im, ug)
    at_re = jnp.broadcast_to(ab_re, bu_re.shape)
    at_im = jnp.broadcast_to(ab_im, bu_im.shape)

    def combine(left, right):
        a1r, a1i, b1r, b1i = left
        a2r, a2i, b2r, b2i = right
        return (a1r * a2r - a1i * a2i,
                a1r * a2i + a1i * a2r,
                a2r * b1r - a2i * b1i + b2r,
                a2r * b1i + a2i * b1r + b2i)

    _, _, x_re, x_im = lax.associative_scan(combine, (at_re, at_im, bu_re, bu_im), axis=1)
    y = jnp.einsum('gcp,bsgp->bsgc', c_re, x_re) - jnp.einsum('gcp,bsgp->bsgc', c_im, x_im)
    y = y.reshape(bsz, s, S5_WIDTH) + d_skip * u
    y = jax.nn.gelu(y)
    return y * jax.nn.sigmoid(y @ glu_w + glu_b)


def partial_rope(t, cos, sin):
    half = ROPE_DIM // 2
    r1 = t[..., :half]
    r2 = t[..., half:ROPE_DIM]
    rot = jnp.concatenate([r1 * cos - r2 * sin, r2 * cos + r1 * sin], axis=-1)
    return jnp.concatenate([rot, t[..., ROPE_DIM:]], axis=-1)


def diff_attention(q, k, v, lam, lambda_init, subln_w):
    b, s, _ = q.shape
    pos = jnp.arange(s, dtype=jnp.float32)
    inv_freq = ROPE_THETA ** (-jnp.arange(0, ROPE_DIM, 2, dtype=jnp.float32) / ROPE_DIM)
    ang = pos[:, None] * inv_freq[None, :]
    cos, sin = jnp.cos(ang), jnp.sin(ang)
    q = q.reshape(b, s, DIFF_HEADS, 2, DIFF_HEAD_DIM).transpose(0, 2, 3, 1, 4)
    k = k.reshape(b, s, DIFF_HEADS, 2, DIFF_HEAD_DIM).transpose(0, 2, 3, 1, 4)
    v = v.reshape(b, s, DIFF_HEADS, DIFF_V_DIM).transpose(0, 2, 1, 3)
    q = partial_rope(q, cos, sin) * (DIFF_HEAD_DIM ** -0.5)
    k = partial_rope(k, cos, sin)
    outs = []
    for blk in range(s // Q_BLOCK):
        q0 = blk * Q_BLOCK
        kv_len = q0 + Q_BLOCK
        qb = q[:, :, :, q0:kv_len]
        sc = jnp.einsum('bhmqd,bhmkd->bhmqk', qb, k[:, :, :, :kv_len])
        mask = (q0 + jnp.arange(Q_BLOCK))[:, None] >= jnp.arange(kv_len)[None, :]
        p = jax.nn.softmax(jnp.where(mask, sc, MASK_VALUE), axis=-1)
        w = p[:, :, 0] - lam * p[:, :, 1]
        outs.append(jnp.einsum('bhqk,bhkv->bhqv', w, v[:, :, :kv_len]))
    o = jnp.concatenate(outs, axis=2)
    o = rmsnorm(o, subln_w) * (1.0 - lambda_init)
    return o.transpose(0, 2, 1, 3).reshape(b, s, ATTN_WIDTH)


def setup_inputs(seed: int = 0) -> dict:
    key = jax.random.key(seed)
    ks = jax.random.split(key, 22)
    nrm = jax.random.normal
    f32 = jnp.float32
    return {
        "x": nrm(ks[0], (BATCH, SEQ, D_MODEL), f32),
        "norm_w": 1.0 + 0.02 * nrm(ks[1], (DEPTH, D_MODEL), f32),
        "w_in": nrm(ks[2], (DEPTH, D_MODEL, D_IN), f32) * D_MODEL ** -0.5,
        "w_out": nrm(ks[3], (DEPTH, D_MIX, D_MODEL), f32) * D_MIX ** -0.5,
        "hgrn_lb_logits": nrm(ks[4], (DEPTH, HGRN_WIDTH), f32),
        "hgrn_norm_w": 1.0 + 0.02 * nrm(ks[5], (DEPTH, HGRN_HEAD_DIM), f32),
        "s5_a_re": -0.5 + 0.01 * nrm(ks[6], (DEPTH, S5_GROUPS, S5_STATE), f32),
        "s5_a_im": math.pi * jnp.arange(S5_STATE, dtype=f32) + 0.01 * nrm(ks[7], (DEPTH, S5_GROUPS, S5_STATE), f32),
        "s5_b_re": nrm(ks[8], (DEPTH, S5_GROUPS, S5_STATE, S5_GROUP), f32) * (2 * S5_GROUP) ** -0.5,
        "s5_b_im": nrm(ks[9], (DEPTH, S5_GROUPS, S5_STATE, S5_GROUP), f32) * (2 * S5_GROUP) ** -0.5,
        "s5_c_re": nrm(ks[10], (DEPTH, S5_GROUPS, S5_GROUP, S5_STATE), f32) * S5_STATE ** -0.5,
        "s5_c_im": nrm(ks[11], (DEPTH, S5_GROUPS, S5_GROUP, S5_STATE), f32) * S5_STATE ** -0.5,
        "s5_log_dt": jax.random.uniform(ks[12], (DEPTH, S5_GROUPS), f32, math.log(S5_DT_MIN), math.log(S5_DT_MAX)),
        "s5_d": nrm(ks[13], (DEPTH, S5_WIDTH), f32),
        "s5_glu_w": nrm(ks[14], (DEPTH, S5_WIDTH, S5_WIDTH), f32) * S5_WIDTH ** -0.5,
        "s5_glu_b": 0.01 * nrm(ks[15], (DEPTH, S5_WIDTH), f32),
        "diff_lq1": 0.1 * nrm(ks[16], (DEPTH, DIFF_HEAD_DIM), f32),
        "diff_lk1": 0.1 * nrm(ks[17], (DEPTH, DIFF_HEAD_DIM), f32),
        "diff_lq2": 0.1 * nrm(ks[18], (DEPTH, DIFF_HEAD_DIM), f32),
        "diff_lk2": 0.1 * nrm(ks[19], (DEPTH, DIFF_HEAD_DIM), f32),
        "diff_subln_w": 1.0 + 0.02 * nrm(ks[20], (DEPTH, DIFF_V_DIM), f32),
        "final_norm_w": 1.0 + 0.02 * nrm(ks[21], (D_MODEL,), f32),
    }


def reference(x, norm_w, w_in, w_out, hgrn_lb_logits, hgrn_norm_w, s5_a_re, s5_a_im, s5_b_re, s5_b_im,
              s5_c_re, s5_c_im, s5_log_dt, s5_d, s5_glu_w, s5_glu_b, diff_lq1, diff_lk1, diff_lq2, diff_lk2,
              diff_subln_w, final_norm_w):
    f32 = jnp.float32
    in_dtype = x.dtype
    h_res = x.astype(f32)
    lb_p = jax.nn.softmax(hgrn_lb_logits.astype(f32), axis=0)
    lb_all = jnp.cumsum(lb_p, axis=0) - lb_p[0:1]
    splits = _in_splits()
    for l in range(DEPTH):
        h = rmsnorm(h_res, norm_w[l])
        proj = h @ w_in[l].astype(f32)
        hq, hf, hi, hg, su, sg, aq, ak, av, ag = jnp.split(proj, splits, axis=-1)
        o_h = hgrn2_mixer(hq, hf, hi, lb_all[l], hgrn_norm_w[l]) * jax.nn.silu(hg)
        o_s = s5_mixer(su, s5_a_re[l].astype(f32), s5_a_im[l].astype(f32), s5_b_re[l].astype(f32),
                       s5_b_im[l].astype(f32), s5_c_re[l].astype(f32), s5_c_im[l].astype(f32),
                       s5_log_dt[l].astype(f32), s5_d[l].astype(f32), s5_glu_w[l].astype(f32),
                       s5_glu_b[l].astype(f32)) * jax.nn.silu(sg)
        lambda_init = 0.8 - 0.6 * math.exp(-0.3 * l)
        lam = (jnp.exp(jnp.sum(diff_lq1[l].astype(f32) * diff_lk1[l].astype(f32)))
               - jnp.exp(jnp.sum(diff_lq2[l].astype(f32) * diff_lk2[l].astype(f32))) + lambda_init)
        o_a = diff_attention(aq, ak, av, lam, lambda_init, diff_subln_w[l]) * jax.nn.silu(ag)
        mix = jnp.concatenate([o_h, o_s, o_a], axis=-1)
        h_res = h_res + mix @ w_out[l].astype(f32)
    return rmsnorm(h_res, final_norm_w).astype(in_dtype)
```

```cpp
#include <hip/hip_runtime.h>
#include <hip/hip_cooperative_groups.h>
#include <cstdio>
#include <cstdint>
namespace pg8 {
#define PG8_LAS __attribute__((address_space(3)))
typedef unsigned short bf16_t;
typedef short bf16x8 __attribute__((ext_vector_type(8)));
typedef float f32x4 __attribute__((ext_vector_type(4)));
typedef unsigned u32x4 __attribute__((ext_vector_type(4)));
constexpr int BM = 256, BK = 64, HALF = 128, HTB = HALF * BK * 2  , STAGE_BYTES = 8 * HTB, NXCD = 8, WGM = 8;

__host__ __device__ __forceinline__ int lds_byte(int r, int c) { const int st = (r >> 4) * 2 + (c >> 5), rr = r & 15, cc = c & 31, ob = rr * 64 + cc * 2; return st * 1024 + (ob ^ (((ob >> 9) & 1) << 5)); }
__host__ __device__ __forceinline__ void stage_rc(int b, int& R, int& C) { const int st = b / 1024, sb = b % 1024, swz = sb ^ (((sb >> 9) & 1) << 5); R = (st >> 1) * 16 + swz / 64; C = (st & 1) * 32 + (swz % 64) / 2; }
__host__ __device__ __forceinline__ int perm32(int rho) { const int n = rho >> 4, i = rho & 15; return 8 * (i >> 2) + 4 * n + (i & 3); }

struct Unit { int pm, pn; };
struct Gemm { const bf16_t* A; const bf16_t* Bt; int M, N, K; };

struct StaticOrder {
    int nM, nN, nwg, G, c;
    __host__ __device__ void init(int M, int N, int G_, int c_) { nM = M / BM; nN = N / BM; nwg = nM * nN; G = G_; c = c_; }
    __host__ __device__ bool next(int i, Unit& u) const {
        const long L = (long)i * G + c; if (L >= nwg) return false;
        int wgid = (int)L; { const int q = nwg / NXCD, r = nwg % NXCD, xcd = wgid % NXCD, off = wgid / NXCD; wgid = (xcd < r ? xcd * (q + 1) : r * (q + 1) + (xcd - r) * q) + off; }
        const int nig = WGM * nN, gid = wgid / nig, fm = gid * WGM, gsz = (nM - fm) < WGM ? (nM - fm) : WGM;
        u.pm = fm + ((wgid % nig) % gsz); u.pn = (wgid % nig) / gsz; return true;
    }
    __device__ __forceinline__ void a_ready(const Unit&) const {}
    __device__ __forceinline__ void done(const Unit&) const {}
};

__device__ __forceinline__ unsigned cvt_pk_bf16(float lo, float hi) { unsigned r; asm volatile("v_cvt_pk_bf16_f32 %0, %1, %2" : "=v"(r) : "v"(lo), "v"(hi)); return r; }
typedef float f32x2 __attribute__((ext_vector_type(2)));
__device__ __forceinline__ f32x2 gelu_pk(f32x2 v) {
    const f32x2 av = __builtin_elementwise_abs(v), d = av * 0.2316418882f + 1.0f;
    f32x2 t; t.x = __builtin_amdgcn_rcpf(d.x); t.y = __builtin_amdgcn_rcpf(d.y);
    f32x2 q = t * 0.5307027145f + (-0.7265760135f); q = q * t + 0.7107068705f; q = q * t + (-0.142248368f); q = q * t + 0.127414796f; q = q * t;
    const f32x2 s = (v * v) * (-0.72134752044f);
    f32x2 e; e.x = __builtin_amdgcn_exp2f(s.x); e.y = __builtin_amdgcn_exp2f(s.y);
    const f32x2 m = v * (q * e), r = v - m;
    f32x2 o; o.x = v.x < 0.f ? m.x : r.x; o.y = v.y < 0.f ? m.y : r.y; return o;
}

template <int ACT  > struct EpiBf16 {
    static constexpr bool PERM = true, AFTER_DRAIN = false; static_assert(ACT == 0 || ACT == 1, "EpiBf16: ACT is 0 (none) or 1 (gelu_pk)");
    bf16_t* O; int ldc; const float* bias; int split_cols; size_t split_stride; float scale0;
    __device__ __forceinline__ void operator()(const f32x4 (&acc)[2][2][4][2], const Unit& u, int wr, int wc, int fr, int fq) const {
        const int row0 = u.pm * BM + wr * 64 + fr; int colt = u.pn * BM; bf16_t* base = O;
        float sc = 1.f; if (split_cols) { const int t = colt / split_cols; base += (size_t)t * split_stride; colt -= t * split_cols; if (t == 0) sc = scale0; }
        const int col0 = colt + wc * 32 + 8 * fq, bcol0 = u.pn * BM + wc * 32 + 8 * fq;
        f32x4 bv[2][2];
#pragma unroll
        for (int bj = 0; bj < 2; ++bj)
#pragma unroll
            for (int n = 0; n < 2; ++n) bv[bj][n] = bias ? *(const f32x4*)(bias + bcol0 + bj * HALF + 4 * n) : (f32x4){0.f, 0.f, 0.f, 0.f};
#pragma unroll
        for (int ai = 0; ai < 2; ++ai)
#pragma unroll
            for (int m = 0; m < 4; ++m) { bf16_t* rowp = base + (size_t)(row0 + ai * HALF + m * 16) * ldc + col0;
#pragma unroll
                for (int bj = 0; bj < 2; ++bj) { f32x4 v0 = acc[ai][bj][m][0] + bv[bj][0], v1 = acc[ai][bj][m][1] + bv[bj][1];
                    if (ACT == 1) { f32x2 a = gelu_pk((f32x2){v0[0], v0[1]}), b = gelu_pk((f32x2){v0[2], v0[3]}), c = gelu_pk((f32x2){v1[0], v1[1]}), d = gelu_pk((f32x2){v1[2], v1[3]});
                        v0 = (f32x4){a.x, a.y, b.x, b.y}; v1 = (f32x4){c.x, c.y, d.x, d.y}; }
                    v0 = v0 * sc; v1 = v1 * sc; u32x4 w; w.x = cvt_pk_bf16(v0[0], v0[1]); w.y = cvt_pk_bf16(v0[2], v0[3]); w.z = cvt_pk_bf16(v1[0], v1[1]); w.w = cvt_pk_bf16(v1[2], v1[3]);
                    *(u32x4*)(rowp + bj * HALF) = w; } }
    }
};
__device__ __forceinline__ float bf2f(unsigned short h) { return __uint_as_float(((unsigned)h) << 16); }
#define WT_RSRC(base, bytes) __builtin_amdgcn_make_buffer_rsrc((void*)(base), 0, (int)(bytes), 0x00020000)
#define WT_ST16(rsrc, byteoff, v) __builtin_amdgcn_raw_buffer_store_b128((v), (rsrc), (unsigned)(byteoff), 0, 16)
__device__ __forceinline__ float sigm(float v) { return __builtin_amdgcn_rcpf(1.0f + __builtin_amdgcn_exp2f(-1.4426950408889634f * v)); }
struct EpiInProj {
    static constexpr bool PERM = true, AFTER_DRAIN = false;
    bf16_t* O; const float* rope; float qscale; const float* rowss; unsigned* sucnt;
    __device__ __forceinline__ void operator()(const f32x4 (&acc)[2][2][4][2], const Unit& u, int wr, int wc, int fr, int fq) const {
        const int row0 = u.pm * BM + wr * 64 + fr, col0 = u.pn * BM + wc * 32 + 8 * fq;
        const bool ropewave = (u.pn >= 6 && u.pn < 10) && ((wc & 1) == 0);
        const float sc = (u.pn == 6 || u.pn == 7) ? qscale : 1.f;
        const float sgn = (fq == 0) ? -1.f : 1.f;
        const bool pub = (u.pn == 4) || (u.pn == 1) || (u.pn == 2);
        const __amdgpu_buffer_rsrc_t orsrc = WT_RSRC(O, 16384u * 3584u * 2u);
#pragma unroll
        for (int ai = 0; ai < 2; ++ai)
#pragma unroll
            for (int m = 0; m < 4; ++m) {
                const int row = row0 + ai * HALF + m * 16;
                bf16_t* rowp = O + (size_t)row * 3584 + col0;
                const float scr = rowss ? sc * __builtin_amdgcn_rsqf(rowss[row] * (1.0f / 1024.0f) + 1e-6f) : sc;
                f32x4 cs[4];
                if (ropewave) { const float* rp = rope + (size_t)(row & 8191) * 16;
#pragma unroll
                    for (int k = 0; k < 4; ++k) cs[k] = *(const f32x4*)(rp + 4 * k); }
#pragma unroll
                for (int bj = 0; bj < 2; ++bj) {
                    f32x4 v0 = acc[ai][bj][m][0], v1 = acc[ai][bj][m][1];
                    if (ropewave) {
                        float v[8] = {v0[0], v0[1], v0[2], v0[3], v1[0], v1[1], v1[2], v1[3]};
#pragma unroll
                        for (int j = 0; j < 8; ++j) {
                            const float p = __shfl_xor(v[j], 16);
                            const float c = cs[j >> 1][(j & 1) * 2], s = cs[j >> 1][(j & 1) * 2 + 1];
                            const float nv = v[j] * c + sgn * p * s;
                            v[j] = (fq < 2) ? nv : v[j];
                        }
                        v0 = (f32x4){v[0], v[1], v[2], v[3]}; v1 = (f32x4){v[4], v[5], v[6], v[7]};
                    }
                    v0 = v0 * scr; v1 = v1 * scr;
                    u32x4 w; w.x = cvt_pk_bf16(v0[0], v0[1]); w.y = cvt_pk_bf16(v0[2], v0[3]); w.z = cvt_pk_bf16(v1[0], v1[1]); w.w = cvt_pk_bf16(v1[2], v1[3]);
                    if (pub) WT_ST16(orsrc, ((size_t)row * 3584 + col0 + bj * HALF) * 2, w); else *(u32x4*)(rowp + bj * HALF) = w;
                }
                asm volatile("" ::: "memory");
            }
        if (pub) { asm volatile("s_waitcnt vmcnt(0)" ::: "memory"); if (fr == 0 && fq == 0) (void)__hip_atomic_fetch_add(sucnt + (u.pn == 4 ? 0 : 16), 1u, __ATOMIC_RELAXED, __HIP_MEMORY_SCOPE_AGENT); }
    }
};
template <bool NEXT> struct EpiRes {
    static constexpr bool PERM = false, AFTER_DRAIN = false;
    const float* base; float* out; float* rowss; const float* nw; bf16_t* XN;
    __device__ __forceinline__ void operator()(const f32x4 (&acc)[2][2][4][2], const Unit& u, int wr, int wc, int fr, int fq) const {
        typedef unsigned u32x2 __attribute__((ext_vector_type(2)));
        const int col0 = u.pn * BM + wc * 32 + 4 * fq;
        f32x4 wv[2][2];
        if (NEXT) {
#pragma unroll
            for (int bj = 0; bj < 2; ++bj)
#pragma unroll
                for (int n = 0; n < 2; ++n) wv[bj][n] = *(const f32x4*)(nw + col0 + bj * HALF + n * 16);
        }
#pragma unroll
        for (int ai = 0; ai < 2; ++ai)
#pragma unroll
            for (int m = 0; m < 4; ++m) {
                const int row = u.pm * BM + ai * HALF + wr * 64 + m * 16 + fr;
                const size_t off = (size_t)row * 1024 + col0;
                float ss = 0.f;
#pragma unroll
                for (int bj = 0; bj < 2; ++bj)
#pragma unroll
                    for (int n = 0; n < 2; ++n) { const f32x4 bs = *(const f32x4*)(base + off + bj * HALF + n * 16); const f32x4 o = bs + acc[ai][bj][m][n]; *(f32x4*)(out + off + bj * HALF + n * 16) = o;
                        if (NEXT) { ss += (o[0] * o[0] + o[1] * o[1]) + (o[2] * o[2] + o[3] * o[3]); const f32x4 x = o * wv[bj][n];
                            u32x2 w; w.x = cvt_pk_bf16(x[0], x[1]); w.y = cvt_pk_bf16(x[2], x[3]); *(u32x2*)(XN + off + bj * HALF + n * 16) = w; } }
                if (NEXT) { ss += __shfl_xor(ss, 16); ss += __shfl_xor(ss, 32); if (fq == 0) atomicAdd(rowss + row, ss); }
                if (m & 1) asm volatile("" ::: "memory");
            }
    }
};
struct EpiResFinal {
    static constexpr bool PERM = false, AFTER_DRAIN = true;
    const float* base; float* out; float* rowss2; unsigned* cnt; const float* fw;
    __device__ __forceinline__ void operator()(const f32x4 (&)[2][2][4][2], const Unit&, int, int, int, int) const {}
    __device__ __forceinline__ void fused(f32x4 (&acc)[2][2][4][2], const Unit& u, int wr, int wc, int fr, int fq, PG8_LAS unsigned char*, int wid, int lane) const {
        const int col0 = u.pn * BM + wc * 32 + 4 * fq;
#pragma unroll
        for (int ai = 0; ai < 2; ++ai)
#pragma unroll
            for (int m = 0; m < 4; ++m) {
                const int row = u.pm * BM + ai * HALF + wr * 64 + m * 16 + fr;
                const size_t off = (size_t)row * 1024 + col0;
                float ss = 0.f;
#pragma unroll
                for (int bj = 0; bj < 2; ++bj)
#pragma unroll
                    for (int n = 0; n < 2; ++n) { const f32x4 o = *(const f32x4*)(base + off + bj * HALF + n * 16) + acc[ai][bj][m][n]; acc[ai][bj][m][n] = o;
                        ss += (o[0] * o[0] + o[1] * o[1]) + (o[2] * o[2] + o[3] * o[3]); }
                ss += __shfl_xor(ss, 16); ss += __shfl_xor(ss, 32);
                if (fq == 0) (void)__hip_atomic_fetch_add(rowss2 + row, ss, __ATOMIC_RELAXED, __HIP_MEMORY_SCOPE_AGENT);
                if (m & 1) asm volatile("" ::: "memory");
            }
        asm volatile("s_waitcnt vmcnt(0)" ::: "memory");
        __builtin_amdgcn_s_barrier(); asm volatile("" ::: "memory");
        if (wid == 0) {
            if (lane == 0) (void)__hip_atomic_fetch_add(cnt + u.pm, 1u, __ATOMIC_RELAXED, __HIP_MEMORY_SCOPE_AGENT);
            unsigned spins = 0;
            while ((unsigned)__builtin_amdgcn_readfirstlane(__hip_atomic_load(cnt + u.pm, __ATOMIC_RELAXED, __HIP_MEMORY_SCOPE_AGENT)) < 4u) { __builtin_amdgcn_s_sleep(4); if (++spins > (1u << 20)) break; }
            __builtin_amdgcn_fence(__ATOMIC_ACQUIRE, "agent");
            asm volatile("s_waitcnt vmcnt(0)" ::: "memory");
        }
        __builtin_amdgcn_s_barrier(); asm volatile("" ::: "memory");
        f32x4 wv[2][2];
#pragma unroll
        for (int bj = 0; bj < 2; ++bj)
#pragma unroll
            for (int n = 0; n < 2; ++n) wv[bj][n] = *(const f32x4*)(fw + col0 + bj * HALF + n * 16);
#pragma unroll
        for (int ai = 0; ai < 2; ++ai)
#pragma unroll
            for (int m = 0; m < 4; ++m) {
                const int row = u.pm * BM + ai * HALF + wr * 64 + m * 16 + fr;
                const size_t off = (size_t)row * 1024 + col0;
                const float rs = __builtin_amdgcn_rsqf(__hip_atomic_load(rowss2 + row, __ATOMIC_RELAXED, __HIP_MEMORY_SCOPE_AGENT) * (1.0f / 1024.0f) + 1e-6f);
#pragma unroll
                for (int bj = 0; bj < 2; ++bj)
#pragma unroll
                    for (int n = 0; n < 2; ++n) *(f32x4*)(out + off + bj * HALF + n * 16) = acc[ai][bj][m][n] * rs * wv[bj][n];
            }
    }
};
struct EpiGlu {
    static constexpr bool PERM = true, AFTER_DRAIN = false;
    const bf16_t* YGS; const float* bias; bf16_t* MIX;
    __device__ __forceinline__ void operator()(const f32x4 (&acc)[2][2][4][2], const Unit& u, int wr, int wc, int fr, int fq) const {
        typedef unsigned u32x2 __attribute__((ext_vector_type(2)));
        const int row0 = u.pm * BM + wr * 64 + fr, col0 = wc * 32 + 8 * fq;
#pragma unroll
        for (int bj = 0; bj < 2; ++bj)
#pragma unroll
            for (int n = 0; n < 2; ++n) {
                const int c = col0 + bj * HALF + 4 * n;
                const f32x4 bv = *(const f32x4*)(bias + c);
#pragma unroll
                for (int ai = 0; ai < 2; ++ai)
#pragma unroll
                    for (int m = 0; m < 4; ++m) {
                        const size_t row = (size_t)(row0 + ai * HALF + m * 16);
                        const f32x4 v = acc[ai][bj][m][n] + bv;
                        const u32x2 yv = *(const u32x2*)(YGS + row * 256 + c);
                        const float y0 = __uint_as_float(yv.x << 16), y1 = __uint_as_float(yv.x & 0xffff0000u), y2 = __uint_as_float(yv.y << 16), y3 = __uint_as_float(yv.y & 0xffff0000u);
                        u32x2 w; w.x = cvt_pk_bf16(y0 * sigm(v[0]), y1 * sigm(v[1])); w.y = cvt_pk_bf16(y2 * sigm(v[2]), y3 * sigm(v[3]));
                        *(u32x2*)(MIX + row * 1024 + 256 + c) = w;
                        if (m & 1) asm volatile("" ::: "memory");
                    }
            }
    }
};
template <class Epi, class Sched, bool ALIGN_EPI = false, bool SP2 = false>
__device__ __forceinline__ void gemm_phase(PG8_LAS unsigned char* lds, const Gemm g, const Sched& S, const Epi& E) {
    int tid_l = threadIdx.x; asm volatile("" : "+v"(tid_l));
    const int tid = tid_l, wid = __builtin_amdgcn_readfirstlane(tid >> 6), lane = tid & 63, wr = wid >> 2, wc = wid & 3, fr = lane & 15, fq = lane >> 4;
    const int K = g.K, nt = K / BK;
    unsigned voffA[2], voffB[2];
#pragma unroll
    for (int i = 0; i < 2; ++i) { int R, C; stage_rc(tid * 16 + i * 8192, R, C); const int Rb = Epi::PERM ? ((R & ~31) + perm32(R & 31)) : R;
        voffA[i] = (unsigned)(R * K + C) * 2u; voffB[i] = (unsigned)(Rb * K + C) * 2u; }
    const size_t kstep = (size_t)(BK * 2);
    const size_t hstep = (size_t)HALF * K * 2;
    const size_t tstep = 2 * hstep;
    const unsigned ldsw = (unsigned)wid * 1024u;
    const int aoff = lds_byte(wr * 64 + fr, fq * 8), boff = lds_byte(wc * 32 + fr, fq * 8);
#define PG8_SA(b, h) (((b) * 2 + (h)) * HTB)
#define PG8_SB(b, h) ((4 + (b) * 2 + (h)) * HTB)
#define PG8_STAGE(bufoff, gbase, voff) do { _Pragma("unroll") for (int _i = 0; _i < 2; ++_i) \
        __builtin_amdgcn_global_load_lds((const unsigned*)((const char*)(gbase) + (voff)[_i]), (PG8_LAS unsigned*)(lds + (bufoff) + ldsw + _i * 8192), 16, 0, 0); } while (0)
#define PG8_LDA(dst, b, h) do { _Pragma("unroll") for (int m = 0; m < 4; ++m) _Pragma("unroll") for (int k = 0; k < 2; ++k) dst[m][k] = *(const PG8_LAS bf16x8*)(lds + PG8_SA(b, h) + aoff + m * 2048 + k * 1024); } while (0)
#define PG8_LDB(dst, b, h) do { _Pragma("unroll") for (int n = 0; n < 2; ++n) _Pragma("unroll") for (int k = 0; k < 2; ++k) dst[n][k] = *(const PG8_LAS bf16x8*)(lds + PG8_SB(b, h) + boff + n * 2048 + k * 1024); } while (0)
#define PG8_MMA(ai, bj, At, Bt) do { __builtin_amdgcn_s_setprio(1); _Pragma("unroll") for (int m = 0; m < 4; ++m) _Pragma("unroll") for (int n = 0; n < 2; ++n) _Pragma("unroll") for (int k = 0; k < 2; ++k) \
        acc[ai][bj][m][n] = __builtin_amdgcn_mfma_f32_16x16x32_bf16(Bt[n][k], At[m][k], acc[ai][bj][m][n], 0, 0, 0); __builtin_amdgcn_s_setprio(0); } while (0)
#define PG8_WAIT_V(n) asm volatile("s_waitcnt vmcnt(" #n ")" ::: "memory")
#define PG8_WAIT_L(n) asm volatile("s_waitcnt lgkmcnt(" #n ")" ::: "memory")
#define PG8_BAR __builtin_amdgcn_s_barrier()
#define PG8_SCHED __builtin_amdgcn_sched_barrier(0)
    Unit cur, nxt; int ui = 0;
    if (!S.next(0, cur)) return;
    f32x4 acc[2][2][4][2];
#pragma unroll
    for (int a = 0; a < 2; ++a)
#pragma unroll
        for (int b = 0; b < 2; ++b)
#pragma unroll
            for (int m = 0; m < 4; ++m)
#pragma unroll
                for (int n = 0; n < 2; ++n) acc[a][b][m][n] = (f32x4){0.f, 0.f, 0.f, 0.f};
    bf16x8 At[4][2], B0[2][2], B1[2][2];
    const char* cA = (const char*)g.A + (size_t)cur.pm * tstep; const char* cB = (const char*)g.Bt + (size_t)cur.pn * tstep;
    S.a_ready(cur);
    if constexpr (SP2) {
        PG8_STAGE(PG8_SB(0, 0), cB, voffB); PG8_STAGE(PG8_SB(0, 1), cB + hstep, voffB); PG8_STAGE(PG8_SA(0, 0), cA, voffA); PG8_STAGE(PG8_SA(0, 1), cA + hstep, voffA);
        if (wr == 1) PG8_BAR;
        PG8_WAIT_V(2); PG8_BAR;
        PG8_STAGE(PG8_SB(1, 0), cB + kstep, voffB); PG8_STAGE(PG8_SA(1, 0), cA + kstep, voffA); PG8_STAGE(PG8_SB(1, 1), cB + hstep + kstep, voffB);
        PG8_WAIT_V(6); PG8_BAR;
    } else {
        PG8_STAGE(PG8_SB(0, 0), cB, voffB); PG8_STAGE(PG8_SA(0, 0), cA, voffA); PG8_STAGE(PG8_SB(0, 1), cB + hstep, voffB); PG8_STAGE(PG8_SA(0, 1), cA + hstep, voffA);
        if (wr == 1) PG8_BAR;
        PG8_WAIT_V(4); PG8_BAR;
        PG8_STAGE(PG8_SB(1, 0), cB + kstep, voffB); PG8_STAGE(PG8_SA(1, 0), cA + kstep, voffA); PG8_STAGE(PG8_SB(1, 1), cB + hstep + kstep, voffB);
        PG8_WAIT_V(6); PG8_BAR;
    }
    for (;;) {
        const bool has_next = S.next(ui + 1, nxt);
        const char* nA = has_next ? (const char*)g.A + (size_t)nxt.pm * tstep : cA; const char* nB = has_next ? (const char*)g.Bt + (size_t)nxt.pn * tstep : cB;
        for (int t = 0; t < nt; t += 2) {
            const bool last = (t == nt - 2);
            const char* a1 = cA + (size_t)(t + 1) * kstep;
            const char* a2 = last ? nA : cA + (size_t)(t + 2) * kstep; const char* b2 = last ? nB : cB + (size_t)(t + 2) * kstep;
            const char* a3 = a2 + kstep; const char* b3 = b2 + kstep;
            if (last && has_next) S.a_ready(nxt);
            if constexpr (SP2) {
            PG8_LDB(B0, 0, 0); PG8_LDB(B1, 0, 1); PG8_SCHED; PG8_LDA(At, 0, 0); PG8_STAGE(PG8_SA(1, 1), a1 + hstep, voffA);
            PG8_WAIT_V(8); PG8_WAIT_L(0); PG8_BAR; PG8_MMA(0, 0, At, B0); PG8_MMA(0, 1, At, B1); PG8_BAR; PG8_SCHED;
            PG8_LDA(At, 0, 1); PG8_STAGE(PG8_SB(0, 0), b2, voffB); PG8_STAGE(PG8_SB(0, 1), b2 + hstep, voffB); PG8_STAGE(PG8_SA(0, 0), a2, voffA);
            PG8_WAIT_V(8); PG8_WAIT_L(0); PG8_BAR; PG8_MMA(1, 0, At, B0); PG8_MMA(1, 1, At, B1); PG8_BAR; PG8_SCHED;
            PG8_LDB(B0, 1, 0); PG8_LDB(B1, 1, 1); PG8_SCHED; PG8_LDA(At, 1, 0); PG8_STAGE(PG8_SA(0, 1), a2 + hstep, voffA);
            PG8_WAIT_V(8); PG8_WAIT_L(0); PG8_BAR; PG8_MMA(0, 0, At, B0); PG8_MMA(0, 1, At, B1); PG8_BAR; PG8_SCHED;
            PG8_LDA(At, 1, 1); PG8_STAGE(PG8_SB(1, 0), b3, voffB); PG8_STAGE(PG8_SB(1, 1), b3 + hstep, voffB); PG8_STAGE(PG8_SA(1, 0), a3, voffA);
            PG8_WAIT_V(8); PG8_WAIT_L(0); PG8_BAR; PG8_MMA(1, 0, At, B0); PG8_MMA(1, 1, At, B1); PG8_BAR; PG8_SCHED;
            } else {
            PG8_LDB(B0, 0, 0); PG8_SCHED; PG8_LDA(At, 0, 0); PG8_STAGE(PG8_SA(1, 1), a1 + hstep, voffA);
            PG8_WAIT_L(8); PG8_BAR; PG8_WAIT_L(0); PG8_MMA(0, 0, At, B0); PG8_BAR; PG8_SCHED;
            PG8_LDB(B1, 0, 1); PG8_STAGE(PG8_SB(0, 0), b2, voffB);
            PG8_BAR; PG8_WAIT_L(0); PG8_MMA(0, 1, At, B1); PG8_BAR;
            PG8_LDA(At, 0, 1); PG8_STAGE(PG8_SA(0, 0), a2, voffA);
            PG8_BAR; PG8_WAIT_L(0); PG8_MMA(1, 0, At, B0); PG8_BAR; PG8_SCHED;
            PG8_STAGE(PG8_SB(0, 1), b2 + hstep, voffB);
            PG8_WAIT_V(6); PG8_BAR; PG8_MMA(1, 1, At, B1); PG8_BAR;
            PG8_LDB(B0, 1, 0); PG8_SCHED; PG8_LDA(At, 1, 0); PG8_STAGE(PG8_SA(0, 1), a2 + hstep, voffA);
            PG8_WAIT_L(8); PG8_BAR; PG8_WAIT_L(0); PG8_MMA(0, 0, At, B0); PG8_BAR; PG8_SCHED;
            PG8_LDB(B1, 1, 1); PG8_STAGE(PG8_SB(1, 0), b3, voffB);
            PG8_BAR; PG8_WAIT_L(0); PG8_MMA(0, 1, At, B1); PG8_BAR;
            PG8_LDA(At, 1, 1); PG8_STAGE(PG8_SA(1, 0), a3, voffA);
            PG8_BAR; PG8_WAIT_L(0); PG8_MMA(1, 0, At, B0); PG8_BAR; PG8_SCHED;
            PG8_STAGE(PG8_SB(1, 1), b3 + hstep, voffB);
            PG8_WAIT_V(6); PG8_BAR; PG8_MMA(1, 1, At, B1); PG8_BAR;
            }
        }
        if constexpr (ALIGN_EPI) { if (wr == 0) PG8_BAR; }
        if constexpr (!Epi::AFTER_DRAIN) { E(acc, cur, wr, wc, fr, fq); S.done(cur); }
        if (!has_next) break;
#pragma unroll
        for (int a = 0; a < 2; ++a)
#pragma unroll
            for (int b = 0; b < 2; ++b)
#pragma unroll
                for (int m = 0; m < 4; ++m)
#pragma unroll
                    for (int n = 0; n < 2; ++n) acc[a][b][m][n] = (f32x4){0.f, 0.f, 0.f, 0.f};
        cur = nxt; cA = nA; cB = nB; ++ui;
        if constexpr (ALIGN_EPI) { if (wr == 1) PG8_BAR; }
    }
    PG8_WAIT_V(0);
    if constexpr (!ALIGN_EPI) { if (wr == 0) PG8_BAR; }
    PG8_BAR;
    if constexpr (Epi::AFTER_DRAIN) { E.fused(acc, cur, wr, wc, fr, fq, lds, wid, lane); S.done(cur); }
#undef PG8_SA
#undef PG8_SB
#undef PG8_STAGE
#undef PG8_LDA
#undef PG8_LDB
#undef PG8_MMA
#undef PG8_WAIT_V
#undef PG8_WAIT_L
#undef PG8_BAR
#undef PG8_SCHED
}
}

#ifndef PG8_SP2
#define PG8_SP2 true
#endif
#ifndef PG8_ALIGN
#define PG8_ALIGN true
#endif
#include <hip/hip_bf16.h>
#include <cmath>
namespace attn_body {
using bf16=__hip_bfloat16;
using bf16x8=__attribute__((ext_vector_type(8)))short;
using s16x4=__attribute__((ext_vector_type(4)))short;
using f32x16=__attribute__((ext_vector_type(16)))float;
using u32x4=__attribute__((ext_vector_type(4)))unsigned;
constexpr int BATCH=2,NHEAD=16,SEQ=8192,D=64,DM=NHEAD*D;
constexpr int NW=8,QBLK=32,QB=QBLK*NW,KVBLK=64,NQB=SEQ/QB;
constexpr int ATTN_PITCH=DM, ATTN_UNIT_ROWS=QB;
constexpr int PQ=3584,QCOL=1536,KCOL=2048,VCOL=2560;
__device__ __forceinline__ int crow(int r,int hi){return (r&3)+8*(r>>2)+4*hi;}
#define SBAR() __builtin_amdgcn_sched_barrier(0)
__device__ __forceinline__ void cmask(f32x16&p0,f32x16&p1,int jb,int qrel,int hi){
  const float NEG=-INFINITY; int kb=64*jb+4*hi;
  #pragma unroll
  for(int r=0;r<16;++r){int kv=kb+(r&3)+8*(r>>2); if(kv>qrel)p0[r]=NEG; if(kv+32>qrel)p1[r]=NEG;}
}

constexpr int NSLOT=3, SLOTB=8192;
constexpr int LDS_K=0, LDS_V=NSLOT*SLOTB, LDS_WS=3*NSLOT*SLOTB, LDS_OST=LDS_WS+NW*64*4, LDS_BYTES=LDS_OST+NW*4096;
constexpr float C2=0.125f*1.4426950408889634f;
__device__ __forceinline__ void glds16(const void*gsrc,unsigned lds_dst){unsigned keep;
  asm volatile("s_mov_b32 %0, m0\n\ts_mov_b32 m0, %2\n\ts_nop 0\n\tglobal_load_lds_dwordx4 %1, off\n\ts_mov_b32 m0, %0":"=&s"(keep):"v"(gsrc),"s"(lds_dst):"memory");}
__device__ __forceinline__ float max3f(float a,float b,float c){float r;asm("v_max3_f32 %0, %1, %2, %3":"=v"(r):"v"(a),"v"(b),"v"(c));return r;}
__device__ __forceinline__ float max2f(float a,float b){float r;asm("v_max_f32_e32 %0, %1, %2":"=v"(r):"v"(a),"v"(b));return r;}
__device__ __forceinline__ float fadd_s(float a,float b){float r;asm("v_add_f32_e32 %0, %1, %2":"=v"(r):"v"(a),"v"(b));return r;}
__device__ __forceinline__ float fsub_s(float a,float b){float r;asm("v_sub_f32_e32 %0, %1, %2":"=v"(r):"v"(a),"v"(b));return r;}
typedef float f32x2_t __attribute__((ext_vector_type(2))); typedef __bf16 bf16x2_t __attribute__((ext_vector_type(2)));
__device__ __forceinline__ unsigned cvtpk_s(float lo,float hi){f32x2_t v={lo,hi};bf16x2_t b=__builtin_convertvector(v,bf16x2_t);return __builtin_bit_cast(unsigned,b);}
#define WAIT_BAR(N) asm volatile("s_waitcnt vmcnt(" #N ") lgkmcnt(0)\n\ts_barrier":::"memory")

__device__ __forceinline__ void qkt(f32x16&p0,f32x16&p1,const char*Kslot,const bf16x8*qr,const f32x16&negm,int r32,int hi){
  const char*kb=Kslot+hi*1024+r32*16;
  #pragma unroll
  for(int d0=0;d0<4;++d0){
    const bf16x8 b0=*reinterpret_cast<const bf16x8*>(kb+d0*2048);
    const bf16x8 b1=*reinterpret_cast<const bf16x8*>(kb+d0*2048+512);
    if(d0==0){p0=__builtin_amdgcn_mfma_f32_32x32x16_bf16(b0,qr[0],negm,0,0,0);p1=__builtin_amdgcn_mfma_f32_32x32x16_bf16(b1,qr[0],negm,0,0,0);}
    else{p0=__builtin_amdgcn_mfma_f32_32x32x16_bf16(b0,qr[d0],p0,0,0,0);p1=__builtin_amdgcn_mfma_f32_32x32x16_bf16(b1,qr[d0],p1,0,0,0);}}
}
typedef __attribute__((address_space(3))) const char* lds_cptr;
typedef short v4i16_t __attribute__((ext_vector_type(4)));
__device__ __forceinline__ void kload8(bf16x8*kf,lds_cptr kp){
  kf[0]=*(const __attribute__((address_space(3))) bf16x8*)(kp);      kf[1]=*(const __attribute__((address_space(3))) bf16x8*)(kp+512);
  kf[2]=*(const __attribute__((address_space(3))) bf16x8*)(kp+2048); kf[3]=*(const __attribute__((address_space(3))) bf16x8*)(kp+2560);
  kf[4]=*(const __attribute__((address_space(3))) bf16x8*)(kp+4096); kf[5]=*(const __attribute__((address_space(3))) bf16x8*)(kp+4608);
  kf[6]=*(const __attribute__((address_space(3))) bf16x8*)(kp+6144); kf[7]=*(const __attribute__((address_space(3))) bf16x8*)(kp+6656);
}
__device__ __forceinline__ void kload2(bf16x8*kf,lds_cptr kp,int j){ kf[2*j]=*(const __attribute__((address_space(3))) bf16x8*)(kp+j*2048); kf[2*j+1]=*(const __attribute__((address_space(3))) bf16x8*)(kp+j*2048+512); }
__device__ __forceinline__ s16x4 vtr(lds_cptr p){ return __builtin_bit_cast(s16x4,__builtin_amdgcn_ds_read_tr16_b64_v4i16((__attribute__((address_space(3))) v4i16_t*)p)); }
__device__ __forceinline__ float rowmax(const f32x16&p0,const f32x16&p1){
  float a=max3f(p0[0],p0[1],p1[0]),b=max3f(p0[2],p0[3],p1[1]);a=max3f(a,p1[2],p1[3]);
  #pragma unroll
  for(int r=4;r<16;r+=4){a=max3f(a,p0[r],p0[r+1]);b=max3f(b,p0[r+2],p0[r+3]);a=max3f(a,p1[r],p1[r+1]);b=max3f(b,p1[r+2],p1[r+3]);}
  const float m=max2f(a,b);
  auto rr=__builtin_amdgcn_permlane32_swap(__float_as_uint(m),__float_as_uint(m),false,false);
  return max2f(__uint_as_float(rr[0]),__uint_as_float(rr[1]));
}
__device__ __forceinline__ void pv(f32x16*o,int vb,bf16x8 pa0,bf16x8 pa1,bf16x8 pa2,bf16x8 pa3){
  #pragma unroll
  for(int d0=0;d0<2;++d0){s16x4 lo[4],hi[4];
    #pragma unroll
    for(int ks=0;ks<4;++ks){
      asm volatile("ds_read_b64_tr_b16 %0,%1 offset:%c2":"=&v"(lo[ks]):"v"(vb),"i"(d0*4096+ks*1024):"memory");
      asm volatile("ds_read_b64_tr_b16 %0,%1 offset:%c2":"=&v"(hi[ks]):"v"(vb),"i"(d0*4096+ks*1024+512):"memory");}
    asm volatile("s_waitcnt lgkmcnt(0)":::"memory");SBAR();
    #define PK(k) (bf16x8){lo[k][0],lo[k][1],lo[k][2],lo[k][3],hi[k][0],hi[k][1],hi[k][2],hi[k][3]}
    o[d0]=__builtin_amdgcn_mfma_f32_32x32x16_bf16(pa0,PK(0),o[d0],0,0,0);
    o[d0]=__builtin_amdgcn_mfma_f32_32x32x16_bf16(pa1,PK(1),o[d0],0,0,0);
    o[d0]=__builtin_amdgcn_mfma_f32_32x32x16_bf16(pa2,PK(2),o[d0],0,0,0);
    o[d0]=__builtin_amdgcn_mfma_f32_32x32x16_bf16(pa3,PK(3),o[d0],0,0,0);
    #undef PK
  }
}

#ifndef ATTN_STORE16
#define ATTN_STORE16(p,v) (*(u32x4*)(p)=(v))
#endif
template<int THRL> __device__ __forceinline__ void attn_unit(int b,int h,int qb,const bf16*Q,const bf16*__restrict__ K,const bf16*__restrict__ V,bf16*O,char*shm){
  int tid_l=threadIdx.x; asm volatile("":"+v"(tid_l)); const int tid=tid_l,lane=tid&63,r32=lane&31,hi=lane>>5; const int wid=__builtin_amdgcn_readfirstlane(tid>>6);
  const long rowbase=(long)b*SEQ; const int q0=qb*QB;
  const int hh_=h>>1,mm_=h&1; const bf16*Qw=Q+(rowbase+q0+wid*QBLK)*PQ+QCOL+hh_*128+mm_*64;
  const bf16*Kh=K+rowbase*PQ+KCOL+hh_*128+mm_*64,*Vh=V+rowbase*PQ+VCOL+hh_*128;
  const unsigned lds0=(unsigned)(uintptr_t)shm;
  float*wsf=(float*)(shm+LDS_WS)+wid*64;
  const bf16*ksrc=Kh+(long)lane*PQ+wid*8;
  const bf16*vsrc=Vh+(long)(16*(wid&3)+(lane>>2))*PQ+(wid>>2)*32+(lane&3)*8;
  const unsigned kdst=lds0+LDS_K+wid*1024, vdst=lds0+LDS_V+wid*1024;
  #define DMA_K(t,slot) glds16(ksrc+(long)(t)*KVBLK*PQ,(unsigned)__builtin_amdgcn_readfirstlane(kdst+(slot)))
  #define DMA_V(t,slot) do{ glds16(vsrc+(long)(t)*KVBLK*PQ,(unsigned)__builtin_amdgcn_readfirstlane(vdst+2*(slot))); glds16(vsrc+(long)(t)*KVBLK*PQ+64,(unsigned)__builtin_amdgcn_readfirstlane(vdst+2*(slot)+8192)); }while(0)
  const int vb0=(int)(lds0+LDS_V)+((lane>>4)&1)*32+(lane&3)*8+(4*hi+((lane&15)>>2))*64;
  const char*Kbase=shm+LDS_K; bf16x8 kf[8];
  const lds_cptr shm3=(lds_cptr)shm; const lds_cptr kp0=shm3+LDS_K+hi*1024+r32*16; const lds_cptr vp0=shm3+LDS_V+((lane>>4)&1)*32+(lane&3)*8+(4*hi+((lane&15)>>2))*64;
  const int NT=(q0+QB)/KVBLK;
  DMA_K(0,0);DMA_V(0,0);DMA_K(1,SLOTB);
  bf16x8 qr[4];
  #pragma unroll
  for(int d0=0;d0<4;++d0)qr[d0]=*reinterpret_cast<const bf16x8*>(&Qw[(long)r32*PQ+d0*16+hi*8]);
  float mhat=0.f,l_reg=0.f;f32x16 o[4];o[0]=f32x16{};o[1]=f32x16{};o[2]=f32x16{};o[3]=f32x16{};f32x16 negm=f32x16{};asm volatile("":"+v"(negm));
  const int qrel=wid*QBLK+r32;
  #define CMASK(P0,P1,t) do{int jb_=(t)-(NT-4); if(jb_>=0)cmask(P0,P1,jb_,qrel,hi);}while(0)
  bool resc=false;
  #define START(P0,P1) do{ const float rm=rowmax(P0,P1); resc=false; \
    { const float dl=rm; mhat=fadd_s(mhat,dl); \
      _Pragma("unroll") for(int r=0;r<16;++r){P0[r]=fsub_s(P0[r],dl);P1[r]=fsub_s(P1[r],dl);} \
      _Pragma("unroll") for(int r=0;r<16;++r)negm[r]=-mhat; asm volatile("":"+v"(negm)); } \
    _Pragma("unroll") for(int r=0;r<16;++r)P0[r]=__builtin_amdgcn_exp2f(P0[r]); }while(0)
  #define RESC() do{ if(resc){ asm volatile("s_waitcnt lgkmcnt(0)":::"memory"); \
      _Pragma("unroll") for(int d_=0;d_<4;++d_) _Pragma("unroll") for(int r=0;r<16;++r)o[d_][r]*=wsf[crow(r,hi)]; } }while(0)
  f32x16 pA0,pA1,pB0,pB1;
  int sl_prev=0,sl_cur=0,sl_next=SLOTB;
  #define ROT() do{sl_prev=sl_cur;sl_cur=sl_next;sl_next=(sl_next==(NSLOT-1)*SLOTB)?0:sl_next+SLOTB;}while(0)
  DMA_K(2,2*SLOTB);
  WAIT_BAR(3);
  qkt(pA0,pA1,Kbase,qr,negm,r32,hi);asm volatile("s_nop 15\n\ts_nop 7":"+v"(pA0),"+v"(pA1));CMASK(pA0,pA1,0);
  START(pA0,pA1);
  _Pragma("unroll") for(int r=0;r<16;++r)pA1[r]=__builtin_amdgcn_exp2f(pA1[r]);
  WAIT_BAR(0);
  DMA_K(3,0);DMA_V(1,SLOTB);
  ROT();
  kload8(kf,kp0+sl_cur);
  WAIT_BAR(3);
  s16x4 vlo[8],vhi[8],wlo[8],whi[8]; u32x4 pw0,pw1,pw2,pw3;
  #define PKW(P,B) cvtpk_s(P[B],P[B+1])
  #define PAF(k) __builtin_bit_cast(bf16x8,pw##k)
  #define VFR(i) (bf16x8){vlo[i][0],vlo[i][1],vlo[i][2],vlo[i][3],vhi[i][0],vhi[i][1],vhi[i][2],vhi[i][3]}
  #define PIN(x) asm volatile("":"+v"(x))
  #define MX3(a,b,c) __builtin_fmaxf(__builtin_fmaxf((a),(b)),(c))
  #define GAPA(MF,A0,A1,A2,A3,W0,W1,PW) do{ MF; sacc+=A0; sacc+=A1; sacc+=A2; sacc+=A3; PIN(sacc); W0; W1; PIN(PW); SBAR(); }while(0)
  #define EX(v) __builtin_amdgcn_exp2f(v)
  #define GAPB(MF,X,B) do{ MF; X[B]=EX(X[B]); X[B+1]=EX(X[B+1]); PIN(X); SBAR(); }while(0)
  #define VRD(i) do{ vlo[i]=vtr(vp_+(((i)>>2)*4096+((i)&3)*1024)); vhi[i]=vtr(vp_+(((i)>>2)*4096+((i)&3)*1024+512)); }while(0)
  #define VRD2(i) do{ wlo[i]=vtr(vp_+(8192+((i)>>2)*4096+((i)&3)*1024)); whi[i]=vtr(vp_+(8192+((i)>>2)*4096+((i)&3)*1024+512)); SBAR(); }while(0)
  #define WFR(i) (bf16x8){wlo[i][0],wlo[i][1],wlo[i][2],wlo[i][3],whi[i][0],whi[i][1],whi[i][2],whi[i][3]}
  #define GAPC(MF,X,B) do{ MF; X[B]=EX(X[B]); X[B+1]=EX(X[B+1]); PIN(X); SBAR(); }while(0)
  #define KRD(G,j) do{ if(G){ kload2(kf,kp0+sl_next,j); SBAR(); } }while(0)
  #define STEP(C0,C1,P0,P1,t,GK,GV,GL) do{ SBAR(); \
    const lds_cptr vp_=vp0+2*sl_prev; \
    VRD(0); SBAR(); float sacc=(P0[0]+P0[1]); \
    GAPA(C0=__builtin_amdgcn_mfma_f32_32x32x16_bf16(kf[0],qr[0],negm,0,0,0), P0[2],P0[3],P0[4],P0[5],     pw0[0]=PKW(P0,0), pw0[1]=PKW(P0,2), pw0); \
    VRD(4); SBAR(); GAPA(C1=__builtin_amdgcn_mfma_f32_32x32x16_bf16(kf[1],qr[0],negm,0,0,0), P0[6],P0[7],P0[8],P0[9],     pw0[2]=PKW(P0,4), pw0[3]=PKW(P0,6), pw0); \
    VRD(1); SBAR(); GAPA(C0=__builtin_amdgcn_mfma_f32_32x32x16_bf16(kf[2],qr[1],C0,0,0,0),   P0[10],P0[11],P0[12],P0[13], pw1[0]=PKW(P0,8), pw1[1]=PKW(P0,10), pw1); \
    VRD(5); SBAR(); GAPA(C1=__builtin_amdgcn_mfma_f32_32x32x16_bf16(kf[3],qr[1],C1,0,0,0),   P0[14],P0[15],P1[0],P1[1],   pw1[2]=PKW(P0,12),pw1[3]=PKW(P0,14), pw1); \
    VRD(2); SBAR(); GAPA(C0=__builtin_amdgcn_mfma_f32_32x32x16_bf16(kf[4],qr[2],C0,0,0,0),   P1[2],P1[3],P1[4],P1[5],     pw2[0]=PKW(P1,0), pw2[1]=PKW(P1,2), pw2); \
    VRD(6); SBAR(); GAPA(C1=__builtin_amdgcn_mfma_f32_32x32x16_bf16(kf[5],qr[2],C1,0,0,0),   P1[6],P1[7],P1[8],P1[9],     pw2[2]=PKW(P1,4), pw2[3]=PKW(P1,6), pw2); \
    VRD(3); SBAR(); GAPA(C0=__builtin_amdgcn_mfma_f32_32x32x16_bf16(kf[6],qr[3],C0,0,0,0),   P1[10],P1[11],P1[12],P1[13], pw3[0]=PKW(P1,8), pw3[1]=PKW(P1,10), pw3); \
    VRD(7); SBAR(); GAPA(C1=__builtin_amdgcn_mfma_f32_32x32x16_bf16(kf[7],qr[3],C1,0,0,0),   P1[14],P1[15],0.f,0.f,       pw3[2]=PKW(P1,12),pw3[3]=PKW(P1,14), pw3); \
    l_reg+=sacc; \
    if(GK){DMA_K((t)+3,sl_cur);} if(GV){DMA_V((t)+1,sl_next);} \
    CMASK(C0,C1,t); \
    { float a=MX3(C0[0],C0[1],C1[0]),b=MX3(C0[2],C0[3],C1[1]); a=MX3(a,C1[2],C1[3]); \
      _Pragma("unroll") for(int r=4;r<16;r+=4){a=MX3(a,C0[r],C0[r+1]);b=MX3(b,C0[r+2],C0[r+3]);a=MX3(a,C1[r],C1[r+1]);b=MX3(b,C1[r+2],C1[r+3]);} \
      float rm=__builtin_fmaxf(a,b); { auto rr=__builtin_amdgcn_permlane32_swap(__float_as_uint(rm),__float_as_uint(rm),false,false); rm=__builtin_fmaxf(__uint_as_float(rr[0]),__uint_as_float(rr[1])); } \
      resc=false; \
      if(__builtin_expect(__any(rm>(float)THRL),0)){ const float dl=__builtin_fmaxf(rm,0.f); mhat+=dl; \
        _Pragma("unroll") for(int r=0;r<16;++r){C0[r]-=dl;C1[r]-=dl;} \
        _Pragma("unroll") for(int r=0;r<16;++r)negm[r]=-mhat; asm volatile("":"+v"(negm)); \
        const float f=__builtin_amdgcn_exp2f(-dl); l_reg*=f; if(hi==0)wsf[r32]=f; resc=true; } } \
    SBAR(); \
    GAPB(o[0]=__builtin_amdgcn_mfma_f32_32x32x16_bf16(PAF(0),VFR(0),o[0],0,0,0), C0,0); VRD2(0); \
    GAPB(o[1]=__builtin_amdgcn_mfma_f32_32x32x16_bf16(PAF(0),VFR(4),o[1],0,0,0), C0,2); VRD2(4); \
    KRD(GL,0); GAPB(o[0]=__builtin_amdgcn_mfma_f32_32x32x16_bf16(PAF(1),VFR(1),o[0],0,0,0), C0,4); VRD2(1); \
    KRD(GL,1); GAPB(o[1]=__builtin_amdgcn_mfma_f32_32x32x16_bf16(PAF(1),VFR(5),o[1],0,0,0), C0,6); VRD2(5); \
    KRD(GL,2); GAPB(o[0]=__builtin_amdgcn_mfma_f32_32x32x16_bf16(PAF(2),VFR(2),o[0],0,0,0), C0,8); VRD2(2); \
    KRD(GL,3); GAPB(o[1]=__builtin_amdgcn_mfma_f32_32x32x16_bf16(PAF(2),VFR(6),o[1],0,0,0), C0,10); VRD2(6); \
    GAPB(o[0]=__builtin_amdgcn_mfma_f32_32x32x16_bf16(PAF(3),VFR(3),o[0],0,0,0), C0,12); VRD2(3); \
    GAPB(o[1]=__builtin_amdgcn_mfma_f32_32x32x16_bf16(PAF(3),VFR(7),o[1],0,0,0), C0,14); VRD2(7); \
    GAPC(o[2]=__builtin_amdgcn_mfma_f32_32x32x16_bf16(PAF(0),WFR(0),o[2],0,0,0), C1,0); \
    GAPC(o[3]=__builtin_amdgcn_mfma_f32_32x32x16_bf16(PAF(0),WFR(4),o[3],0,0,0), C1,2); \
    GAPC(o[2]=__builtin_amdgcn_mfma_f32_32x32x16_bf16(PAF(1),WFR(1),o[2],0,0,0), C1,4); \
    GAPC(o[3]=__builtin_amdgcn_mfma_f32_32x32x16_bf16(PAF(1),WFR(5),o[3],0,0,0), C1,6); \
    GAPC(o[2]=__builtin_amdgcn_mfma_f32_32x32x16_bf16(PAF(2),WFR(2),o[2],0,0,0), C1,8); \
    GAPC(o[3]=__builtin_amdgcn_mfma_f32_32x32x16_bf16(PAF(2),WFR(6),o[3],0,0,0), C1,10); \
    GAPC(o[2]=__builtin_amdgcn_mfma_f32_32x32x16_bf16(PAF(3),WFR(3),o[2],0,0,0), C1,12); \
    GAPC(o[3]=__builtin_amdgcn_mfma_f32_32x32x16_bf16(PAF(3),WFR(7),o[3],0,0,0), C1,14); \
    }while(0)
  int t=1;
  #undef CMASK
  #define CMASK(P0,P1,t) do{}while(0)
  for(;t+5<NT;t+=2){
    STEP(pB0,pB1,pA0,pA1,t,true,true,true);     WAIT_BAR(3); RESC(); ROT();
    STEP(pA0,pA1,pB0,pB1,t+1,true,true,true);   WAIT_BAR(3); RESC(); ROT();
  }
  #undef CMASK
  #define CMASK(P0,P1,t) do{int jb_=(t)-(NT-4); if(jb_>=0)cmask(P0,P1,jb_,qrel,hi);}while(0)
  #define ENDW(tt) do{ if((tt)+3<NT){WAIT_BAR(3);} else if((tt)+2<NT){WAIT_BAR(2);} else {WAIT_BAR(0);} }while(0)
  for(;t+1<NT;t+=2){
    STEP(pB0,pB1,pA0,pA1,t,(t+3<NT),(t+1<NT),(t+1<NT));       ENDW(t);   RESC(); ROT();
    STEP(pA0,pA1,pB0,pB1,t+1,(t+4<NT),(t+2<NT),(t+2<NT));     ENDW(t+1); RESC(); ROT();
  }
  STEP(pB0,pB1,pA0,pA1,NT-1,false,false,false); RESC();
  { float sacc=pB0[0]+pB0[1]; _Pragma("unroll") for(int r=2;r<16;++r)sacc+=pB0[r]; _Pragma("unroll") for(int r=0;r<16;++r)sacc+=pB1[r]; l_reg+=sacc;
    pw0=(u32x4){PKW(pB0,0),PKW(pB0,2),PKW(pB0,4),PKW(pB0,6)};pw1=(u32x4){PKW(pB0,8),PKW(pB0,10),PKW(pB0,12),PKW(pB0,14)};pw2=(u32x4){PKW(pB1,0),PKW(pB1,2),PKW(pB1,4),PKW(pB1,6)};pw3=(u32x4){PKW(pB1,8),PKW(pB1,10),PKW(pB1,12),PKW(pB1,14)};
    SBAR(); pv(o,vb0+2*sl_cur,PAF(0),PAF(1),PAF(2),PAF(3)); pv(o+2,vb0+2*sl_cur+8192,PAF(0),PAF(1),PAF(2),PAF(3)); }
  #undef PKW
  #undef PAF
  #undef VFR
  #undef PIN
  #undef MX3
  #undef GAPA
  #undef GAPB
  #undef EX
  #undef VRD
  #undef VRD2
  #undef WFR
  #undef GAPC
  #undef KRD
  #undef STEP
  #undef ENDW
  {auto rr=__builtin_amdgcn_permlane32_swap(__float_as_uint(l_reg),__float_as_uint(l_reg),false,false);l_reg=__uint_as_float(rr[0])+__uint_as_float(rr[1]);}
  if(hi==0)wsf[32+r32]=l_reg;asm volatile("s_waitcnt lgkmcnt(0)":::"memory");
  float rli[16];
  #pragma unroll
  for(int r=0;r<16;++r)rli[r]=__builtin_amdgcn_rcpf(wsf[32+crow(r,hi)]);
  bf16*Ow=O+(rowbase+q0+wid*QBLK)*DM+hh_*256+mm_*128;
  #pragma unroll
  for(int half=0;half<2;++half)
  { bf16*stg=(bf16*)(shm+LDS_OST)+wid*2048;
    #pragma unroll
    for(int r=0;r<16;++r){const int orow=crow(r,hi);
      #pragma unroll
      for(int d0=0;d0<2;++d0)stg[orow*64+d0*32+r32]=__float2bfloat16(o[2*half+d0][r]*rli[r]);}
    asm volatile("s_waitcnt lgkmcnt(0)":::"memory");
    #pragma unroll
    for(int i=0;i<4;++i){const int row=i*8+(lane>>3),ch=lane&7; const u32x4 v=*(const u32x4*)(stg+row*64+ch*8); ATTN_STORE16(Ow+(long)row*DM+half*64+ch*8,v);}
    asm volatile("s_waitcnt lgkmcnt(0)":::"memory"); }
  asm volatile("s_waitcnt lgkmcnt(0)\n\ts_barrier":::"memory");
  #undef DMA_K
  #undef DMA_V
  #undef CMASK
  #undef START
  #undef RESC
  #undef ROT
}
constexpr int ATTN_LDS_BYTES=LDS_BYTES;
struct AttnTensors { const bf16* Q; const bf16* K; const bf16* V; bf16* O; };
struct AttnUnit { int bh; int qb; };
struct StaticOrder {
  int vcu;
  __device__ __forceinline__ explicit StaticOrder(int v):vcu(v){}
  __device__ __forceinline__ bool next(int i,AttnUnit&u)const{ if(i>=2)return false; const int s=vcu&15; u.bh=vcu>>4; u.qb=(i==0)?31-s:s; return true; }
  __device__ __forceinline__ void a_ready(const AttnUnit&)const{}
  __device__ __forceinline__ void done(const AttnUnit&)const{}
};
template<class Sched,int THRL=8> __device__ __forceinline__ void attn_phase(char*lds,const AttnTensors&T,const Sched&S){
  AttnUnit u;
  for(int i=0;S.next(i,u);++i){ S.a_ready(u); attn_unit<THRL>(u.bh>>3,u.bh&7,u.qb,T.Q,T.K,T.V,T.O,lds); S.done(u); }
}
#undef SBAR
#undef WAIT_BAR
}
namespace cg = cooperative_groups;
constexpr int NWAVES = 8;
constexpr int BATCH = 2, T = 8192, D = 1024, DIN = 3584, M = BATCH * T, DEPTH = 2;
constexpr float EPS = 1e-6f;
constexpr size_t MiB = 1u << 20;
constexpr size_t WS_CTL = 0;
constexpr size_t WS_TAB = 64 * 1024;
constexpr size_t WS_ROWSS = 128 * 1024;
constexpr size_t WS_ROWSS2 = 192 * 1024;
constexpr size_t WS_PCNT = 14336;
constexpr size_t WS_SUCNT = 15616;
constexpr size_t WS_SCNT = 14592;
constexpr size_t WS_WIN = 2 * MiB;
constexpr size_t WS_WOUT = 16 * MiB;
constexpr size_t WS_GLU = 20 * MiB;
constexpr size_t WS_ROPE = 20 * MiB + 512 * 1024;
constexpr size_t WS_S5A = 21 * MiB;
constexpr size_t WS_S5B = 21 * MiB + 64 * 1024;
constexpr size_t WS_S5C = 21 * MiB + 256 * 1024;
constexpr size_t WS_HU = 22 * MiB;
constexpr size_t WS_HA = 30 * MiB;
constexpr size_t WS_XLOC = 31 * MiB;
constexpr size_t WS_XN = 34 * MiB;
constexpr size_t WS_O = WS_XN;
constexpr size_t WS_PROJ = 66 * MiB;
constexpr size_t WS_MIX = 178 * MiB;
constexpr size_t WS_YG = 210 * MiB;
constexpr size_t WS_YGS = 218 * MiB;
constexpr size_t WS_END = 226 * MiB;
constexpr int LDS_BYTES = 147456, RING_BYTES = 131072;

#define GAS __attribute__((address_space(1)))
#define LAS __attribute__((address_space(3)))
typedef unsigned short bf16;
typedef unsigned v4u __attribute__((ext_vector_type(4)));
typedef unsigned v2u __attribute__((ext_vector_type(2)));
typedef float f32x4 __attribute__((ext_vector_type(4)));
typedef short bf16x8 __attribute__((ext_vector_type(8)));
#define LDS_WAIT() asm volatile("s_waitcnt lgkmcnt(0)" ::: "memory")
__device__ __forceinline__ unsigned f2bf(float f) { unsigned u = __builtin_bit_cast(unsigned, f); return (u + 0x7fffu + ((u >> 16) & 1u)) >> 16; }
__device__ __forceinline__ unsigned pk2(float lo, float hi) { return f2bf(lo) | (f2bf(hi) << 16); }
__device__ __forceinline__ float bflo(unsigned w) { return __uint_as_float(w << 16); }
__device__ __forceinline__ float bfhi(unsigned w) { return __uint_as_float(w & 0xffff0000u); }
__device__ __forceinline__ float bf1(bf16 h) { return __uint_as_float(((unsigned)h) << 16); }
__device__ __forceinline__ float sigmf(float v) { return __builtin_amdgcn_rcpf(1.0f + __builtin_amdgcn_exp2f(-1.4426950408889634f * v)); }
__device__ __forceinline__ float siluf(float v) { return v * sigmf(v); }
__device__ __forceinline__ float wave_sum(float v) {
#pragma unroll
    for (int o = 1; o < 64; o <<= 1) v += __shfl_xor(v, o);
    return v;
}
__device__ __forceinline__ void p0_transpose_item(const float* W, int K, int N, bf16* WT, LAS float* scr, int item, int lane) {
    const int nblk = N / 32, kb = item / nblk, nb = item % nblk, k0 = 64 * kb, n0 = 32 * nb;
#pragma unroll 8
    for (int i = 0; i < 32; ++i) { const int kk = 2 * i + (lane >> 5); scr[kk * 33 + (lane & 31)] = W[(size_t)(k0 + kk) * N + n0 + (lane & 31)]; }
    LDS_WAIT(); asm volatile("" ::: "memory");
    const int c = lane & 7;
#pragma unroll
    for (int j = 0; j < 4; ++j) { const int n = (lane >> 3) + 8 * j; const LAS float* s = scr + (8 * c) * 33 + n;
        v4u o; o.x = pk2(s[0 * 33], s[1 * 33]); o.y = pk2(s[2 * 33], s[3 * 33]); o.z = pk2(s[4 * 33], s[5 * 33]); o.w = pk2(s[6 * 33], s[7 * 33]);
        *(v4u*)(WT + (size_t)(n0 + n) * K + k0 + 8 * c) = o; }
    LDS_WAIT(); asm volatile("" ::: "memory");
}
template <bool OUTF> __device__ __forceinline__ void rms_row(const float* xrow, const float* w, bf16* orow, float* frow, int lane) {
    const f32x4* xr = (const f32x4*)xrow + lane; const f32x4* wr = (const f32x4*)w + lane;
    f32x4 v[4]; float s = 0.f;
#pragma unroll
    for (int j = 0; j < 4; ++j) { v[j] = xr[64 * j]; s += (v[j].x * v[j].x + v[j].y * v[j].y) + (v[j].z * v[j].z + v[j].w * v[j].w); }
    const float rs = 1.0f / sqrtf(wave_sum(s) * (1.f / D) + EPS);
#pragma unroll
    for (int j = 0; j < 4; ++j) { const f32x4 ww = wr[64 * j]; const f32x4 o = v[j] * rs * ww;
        if (OUTF) ((f32x4*)frow + lane)[64 * j] = o;
        else ((v2u*)orow + lane)[64 * j] = (v2u){pk2(o.x, o.y), pk2(o.z, o.w)}; }
}

typedef GAS unsigned gu32;
#define RLX_AGENT __ATOMIC_RELAXED, __HIP_MEMORY_SCOPE_AGENT
#define XB_TMO      128
#define XB_XCNT(j)  (256  + 64 * (j))
#define XB_XSUB(j)  (1280 + 64 * (j))
#define XB_XGEN(j)  (2304 + 64 * (j))
#define XB_TOP      3328
#define XB_TOPGEN   3392
#define XCD_BAR_WORDS 3456
#define XB_SPIN_CAP (1u << 18)

__device__ __forceinline__ unsigned xb_ld(unsigned* p)              { return __hip_atomic_load(p, __ATOMIC_RELAXED, __HIP_MEMORY_SCOPE_AGENT); }
__device__ __forceinline__ unsigned xb_add(unsigned* p, unsigned v) { return __hip_atomic_fetch_add(p, v, __ATOMIC_RELAXED, __HIP_MEMORY_SCOPE_AGENT); }
__device__ __forceinline__ unsigned xb_xcc_id() { return (unsigned)__builtin_amdgcn_s_getreg((3 << 11) | 20) & 0xFu; }
#define XB_SPIN(cond, bar) do { unsigned _sp = 0; while (cond) { __builtin_amdgcn_s_sleep(1); \
    if ((++_sp & 255u) == 0u) { if (xb_ld(&(bar)[XB_TMO])) break; if (_sp > XB_SPIN_CAP) { atomicAdd(&(bar)[XB_TMO], 1u); break; } } } } while (0)

struct XcdBarrier {
    unsigned* bar; unsigned x;
    volatile LAS unsigned* st;
};

__device__ __forceinline__ XcdBarrier xcd_barrier_post(unsigned* bar, volatile LAS unsigned* st) {
    XcdBarrier b; b.bar = bar; b.x = xb_xcc_id(); b.st = st;
    if (threadIdx.x == 0) (void)xb_add(&bar[XB_XCNT(b.x)], 1u);
    return b;
}
__device__ __forceinline__ void xcd_barrier_complete(unsigned* bar, unsigned x, unsigned& nloc, unsigned& nx) {
    const unsigned G = gridDim.x * gridDim.y * gridDim.z;
    unsigned sum, cnt, mine, sp = 0u;
    for (;;) {
        sum = 0u; cnt = 0u; mine = 0u;
#pragma unroll
        for (unsigned j = 0; j < 16; ++j) { const unsigned c = xb_ld(&bar[XB_XCNT(j)]); sum += c; cnt += (c > 0u) ? 1u : 0u; mine = (j == x) ? c : mine; }
        if (sum == G) break;
        __builtin_amdgcn_s_sleep(1);
        if ((++sp & 255u) == 0u) { if (xb_ld(&bar[XB_TMO])) break; if (sp > XB_SPIN_CAP) { atomicAdd(&bar[XB_TMO], 1u); break; } }
    }
    nloc = mine > 0u ? mine : 1u; nx = cnt > 0u ? cnt : 1u;
}

__device__ __forceinline__ void xcd_barrier(const XcdBarrier& b) {
    asm volatile("s_waitcnt vmcnt(0)" ::: "memory");
    __syncthreads();
    if (threadIdx.x == 0) {
        unsigned* bar = b.bar;
        __builtin_amdgcn_s_waitcnt(0);
        unsigned nloc = b.st[0], nx = b.st[1];
        if (nloc == 0u) { xcd_barrier_complete(bar, b.x, nloc, nx); b.st[0] = nloc; b.st[1] = nx; }
        const unsigned old = xb_add(&bar[XB_XSUB(b.x)], 1u);
        const unsigned gen = old / nloc;
        if (old + 1u == (gen + 1u) * nloc) {
            __builtin_amdgcn_fence(__ATOMIC_RELEASE, "agent");
            asm volatile("s_waitcnt vmcnt(0)" ::: "memory");
            const unsigned og = xb_add(&bar[XB_TOP], 1u);
            const unsigned tg = og / nx;
            if (og + 1u == (tg + 1u) * nx) xb_add(&bar[XB_TOPGEN], 1u);
            else XB_SPIN(xb_ld(&bar[XB_TOPGEN]) == tg, bar);
            __builtin_amdgcn_fence(__ATOMIC_ACQUIRE, "agent");
            xb_add(&bar[XB_XGEN(b.x)], 1u);
            asm volatile("s_waitcnt vmcnt(0)" ::: "memory");
        } else {
            XB_SPIN(xb_ld(&bar[XB_XGEN(b.x)]) == gen, bar);
            __builtin_amdgcn_fence(__ATOMIC_ACQUIRE, "agent");
            asm volatile("s_waitcnt vmcnt(0)" ::: "memory");
        }
    }
    __syncthreads();
}
struct Args { const float* in[22]; float* out; unsigned char* ws; int ph_lo, ph_hi; };
struct PA { const float* const* in; float* out; unsigned char* ws; };

__device__ __forceinline__ void s5_prep(const float* const* in, unsigned char* ws, int t0, int nthreads) {
    const double TWO_PI = 6.283185307179586476925;
    for (int ec = t0; ec < DEPTH * 16 * 64 * 16; ec += nthreads) {
        const int e = ec >> 4, c = ec & 15;
        const int l = e >> 10, g = (e >> 6) & 15, p = e & 63;
        const double dt = (double)expf(in[12][l * 16 + g]);
        const double are = (double)in[6][e], aim = (double)in[7][e];
        const double mag = (double)expf((float)(dt * are));
        double tt = dt * aim * (1.0 / TWO_PI); tt -= __builtin_floor(tt);
        const float ang = (float)(tt * TWO_PI);
        const double abr = mag * (double)cosf(ang), abi = mag * (double)sinf(ang);
        const double den = are * are + aim * aim, nr = abr - 1.0, ni = abi;
        const double zr = (nr * are + ni * aim) / den, zi = (ni * are - nr * aim) / den;
        if (c == 0) {
            double pr = abr, pi = abi;
#pragma unroll
            for (int q = 0; q < 7; ++q) { const double r2 = pr * pr - pi * pi, i2 = 2.0 * pr * pi; pr = r2; pi = i2; }
            float* sa = (float*)(ws + WS_S5A) + (size_t)(l * 16 + g) * 256;
            sa[p] = (float)abr; sa[64 + p] = (float)abi; sa[128 + p] = (float)pr; sa[192 + p] = (float)pi;
        }
        bf16* bm = (bf16*)(ws + WS_S5B) + (size_t)(l * 16 + g) * 2048;
        const double br = in[8][(size_t)e * 16 + c], bi = in[9][(size_t)e * 16 + c];
        bm[p * 16 + c] = (bf16)f2bf((float)(zr * br - zi * bi)); bm[(64 + p) * 16 + c] = (bf16)f2bf((float)(zr * bi + zi * br));
        bf16* cm = (bf16*)(ws + WS_S5C) + (size_t)(l * 16 + g) * 2048;
        cm[c * 128 + p] = (bf16)f2bf(in[10][(size_t)(l * 16 + g) * 1024 + c * 64 + p]); cm[c * 128 + 64 + p] = (bf16)f2bf(-in[11][(size_t)(l * 16 + g) * 1024 + c * 64 + p]);
    }
}
__device__ __forceinline__ void prologue(const Args& a, LAS unsigned char* lds, int vcu, int G, int wave, int lane) {
    const bool defer_s5 = false;
    unsigned char* ws = a.ws;
    LAS float* scr = (LAS float*)(lds + wave * 16384);
    const int gw = vcu * NWAVES + wave, NGW = G * NWAVES;
    constexpr int I_IN = (D / 64) * (DIN / 32), I_OUT = (D / 64) * (D / 32), I_GLU = (256 / 64) * (256 / 32);
    constexpr int NITEMS = DEPTH * (I_IN + I_OUT + I_GLU);
    for (int it = gw; it < NITEMS; it += NGW) {
        int r = it; const int l = r / (I_IN + I_OUT + I_GLU); r -= l * (I_IN + I_OUT + I_GLU);
        if (r < I_IN) { p0_transpose_item(a.in[2] + (size_t)l * D * DIN, D, DIN, (bf16*)(ws + WS_WIN) + (size_t)l * DIN * D, scr, r, lane); continue; } r -= I_IN;
        if (r < I_OUT) { p0_transpose_item(a.in[3] + (size_t)l * D * D, D, D, (bf16*)(ws + WS_WOUT) + (size_t)l * D * D, scr, r, lane); continue; } r -= I_OUT;
        p0_transpose_item(a.in[14] + (size_t)l * 65536, 256, 256, (bf16*)(ws + WS_GLU) + (size_t)l * 65536, scr, r, lane);
    }
    for (int m = gw; m < M; m += 2 * NGW) {
        const int m2 = m + NGW; const bool has2 = m2 < M;
        const f32x4* x1 = (const f32x4*)(a.in[0] + (size_t)m * D) + lane; const f32x4* x2 = (const f32x4*)(a.in[0] + (size_t)(has2 ? m2 : m) * D) + lane; const f32x4* wr = (const f32x4*)a.in[1] + lane;
        f32x4 v1[4], v2[4]; float s1 = 0.f, s2 = 0.f;
#pragma unroll
        for (int j = 0; j < 4; ++j) { v1[j] = x1[64 * j]; v2[j] = x2[64 * j]; }
#pragma unroll
        for (int j = 0; j < 4; ++j) { s1 += (v1[j].x * v1[j].x + v1[j].y * v1[j].y) + (v1[j].z * v1[j].z + v1[j].w * v1[j].w); s2 += (v2[j].x * v2[j].x + v2[j].y * v2[j].y) + (v2[j].z * v2[j].z + v2[j].w * v2[j].w); }
        const float r1 = 1.0f / sqrtf(wave_sum(s1) * (1.f / D) + EPS), r2 = 1.0f / sqrtf(wave_sum(s2) * (1.f / D) + EPS);
#pragma unroll
        for (int j = 0; j < 4; ++j) { const f32x4 ww = wr[64 * j]; const f32x4 o1 = v1[j] * r1 * ww, o2 = v2[j] * r2 * ww;
            ((v2u*)((bf16*)(ws + WS_XN) + (size_t)m * D) + lane)[64 * j] = (v2u){pk2(o1.x, o1.y), pk2(o1.z, o1.w)};
            if (has2) ((v2u*)((bf16*)(ws + WS_XN) + (size_t)m2 * D) + lane)[64 * j] = (v2u){pk2(o2.x, o2.y), pk2(o2.z, o2.w)}; }
        if (lane == 0) { ((float*)(ws + WS_ROWSS))[m] = 0.f; ((float*)(ws + WS_ROWSS2))[m] = 0.f; if (has2) { ((float*)(ws + WS_ROWSS))[m2] = 0.f; ((float*)(ws + WS_ROWSS2))[m2] = 0.f; } }
    }
    const int gt = gw * 64 + lane, NGT = NGW * 64;
    const double TWO_PI = 6.283185307179586476925;
    for (int e = gt; e < 8192 * 8; e += NGT) {
        const int pos = e >> 3, i = e & 7;
        const double invf[8] = {1.0, 0.19392274474868576, 0.03760603093086393, 0.007292664737217109, 0.001414213562373095, 0.0002742481756762073, 5.318295896944988e-05, 1.031338537721246e-05};
        double inv = invf[0];
#pragma unroll
        for (int q = 1; q < 8; ++q) inv = (i == q) ? invf[q] : inv;
        double tt = (double)pos * inv * (1.0 / TWO_PI); tt -= __builtin_floor(tt);
        const float ang = (float)(tt * TWO_PI);
        float* rp = (float*)(ws + WS_ROPE) + (size_t)e * 2; rp[0] = cosf(ang); rp[1] = sinf(ang);
    }
    if (!defer_s5) s5_prep(a.in, ws, gt, NGT);
}

template <bool OUT> __device__ __forceinline__ void hgrn_item(const PA& a, LAS unsigned char* lds, int layer, int bh, int c, int tid, int wave, int lane) {
    const int b = bh >> 2, h = bh & 3;
    const bf16* PROJ = (const bf16*)(a.ws + WS_PROJ);
    float* HU = (float*)(a.ws + WS_HU); float* HA = (float*)(a.ws + WS_HA);
    LAS float* Fs = (LAS float*)lds; LAS float* Ks = Fs + 4096; LAS float* Vs = Ks + 4096; LAS float* Qs = Vs + 4096; LAS float* Ps = Qs + 4096;
    const size_t row0 = (size_t)b * T + (size_t)c * 128;
    float S[8];
#pragma unroll
    for (int j = 0; j < 8; ++j) S[j] = 0.f;
    if (OUT) {
        int cp = 0;
        for (; cp + 4 <= c; cp += 4) {
            float uu[4][8], aa[4][8];
#pragma unroll
            for (int q = 0; q < 4; ++q) {
                const float* U = HU + (size_t)(bh * 64 + cp + q) * 4096 + (size_t)(wave * 8) * 64 + lane; const float* A = HA + (size_t)(bh * 64 + cp + q) * 64 + wave * 8;
#pragma unroll
                for (int j = 0; j < 8; ++j) { uu[q][j] = U[j * 64]; aa[q][j] = A[j]; }
            }
#pragma unroll
            for (int q = 0; q < 4; ++q)
#pragma unroll
                for (int j = 0; j < 8; ++j) S[j] = aa[q][j] * S[j] + uu[q][j];
        }
        for (; cp < c; ++cp) {
            const float* U = HU + (size_t)(bh * 64 + cp) * 4096 + (size_t)(wave * 8) * 64 + lane; const float* A = HA + (size_t)(bh * 64 + cp) * 64 + wave * 8;
#pragma unroll
            for (int j = 0; j < 8; ++j) S[j] = A[j] * S[j] + U[j * 64];
        }
    }
    const int fcol = h * 64 + (tid & 7) * 8;
    float lb[8];
#pragma unroll
    for (int j = 0; j < 8; ++j) lb[j] = (layer == 0) ? 0.f : sigmf(a.in[4][256 + fcol + j] - a.in[4][fcol + j]);
    const float gnw = a.in[5][layer * 64 + lane];
    float aprod = 1.f;
    for (int sub = 0; sub < 2; ++sub) {
        __syncthreads();
        { const int t = tid >> 3; const bf16* pr = PROJ + (row0 + sub * 64 + t) * DIN + fcol;
          const v4u fw = *(const v4u*)(pr + 256), vw = *(const v4u*)(pr + 512);
          const unsigned fa[4] = {fw.x, fw.y, fw.z, fw.w}, va[4] = {vw.x, vw.y, vw.z, vw.w};
          float fo[8], ko[8], vo[8];
#pragma unroll
          for (int j = 0; j < 8; ++j) { const float x = (j & 1) ? bfhi(fa[j >> 1]) : bflo(fa[j >> 1]); const float sg = sigmf(x);
              fo[j] = lb[j] + (1.f - lb[j]) * sg; ko[j] = (1.f - lb[j]) * (1.f - sg); vo[j] = (j & 1) ? bfhi(va[j >> 1]) : bflo(va[j >> 1]); }
          LAS f32x4* d;
          d = (LAS f32x4*)(Fs + t * 64 + (tid & 7) * 8); d[0] = (f32x4){fo[0], fo[1], fo[2], fo[3]}; d[1] = (f32x4){fo[4], fo[5], fo[6], fo[7]};
          d = (LAS f32x4*)(Ks + t * 64 + (tid & 7) * 8); d[0] = (f32x4){ko[0], ko[1], ko[2], ko[3]}; d[1] = (f32x4){ko[4], ko[5], ko[6], ko[7]};
          d = (LAS f32x4*)(Vs + t * 64 + (tid & 7) * 8); d[0] = (f32x4){vo[0], vo[1], vo[2], vo[3]}; d[1] = (f32x4){vo[4], vo[5], vo[6], vo[7]};
          if (OUT) { const v4u qw = *(const v4u*)(pr); const unsigned qa[4] = {qw.x, qw.y, qw.z, qw.w}; float qo[8];
#pragma unroll
              for (int j = 0; j < 8; ++j) qo[j] = siluf((j & 1) ? bfhi(qa[j >> 1]) : bflo(qa[j >> 1]));
              d = (LAS f32x4*)(Qs + t * 64 + (tid & 7) * 8); d[0] = (f32x4){qo[0], qo[1], qo[2], qo[3]}; d[1] = (f32x4){qo[4], qo[5], qo[6], qo[7]}; }
        }
        __syncthreads();
        if (!OUT && tid < 64) { for (int t = 0; t < 64; ++t) aprod *= Fs[t * 64 + tid]; }
        for (int tb = 0; tb < 4; ++tb) {
#pragma unroll 4
            for (int tt = 0; tt < 16; ++tt) {
                const int t = tb * 16 + tt;
                const f32x4 f0 = *(const LAS f32x4*)(Fs + t * 64 + wave * 8), f1 = *(const LAS f32x4*)(Fs + t * 64 + wave * 8 + 4);
                const f32x4 k0 = *(const LAS f32x4*)(Ks + t * 64 + wave * 8), k1 = *(const LAS f32x4*)(Ks + t * 64 + wave * 8 + 4);
                const float v = Vs[t * 64 + lane];
                S[0] = f0[0] * S[0] + k0[0] * v; S[1] = f0[1] * S[1] + k0[1] * v; S[2] = f0[2] * S[2] + k0[2] * v; S[3] = f0[3] * S[3] + k0[3] * v;
                S[4] = f1[0] * S[4] + k1[0] * v; S[5] = f1[1] * S[5] + k1[1] * v; S[6] = f1[2] * S[6] + k1[2] * v; S[7] = f1[3] * S[7] + k1[3] * v;
                if (OUT) {
                    const f32x4 q0 = *(const LAS f32x4*)(Qs + t * 64 + wave * 8), q1 = *(const LAS f32x4*)(Qs + t * 64 + wave * 8 + 4);
                    const float p = ((q0[0] * S[0] + q0[1] * S[1]) + (q0[2] * S[2] + q0[3] * S[3])) + ((q1[0] * S[4] + q1[1] * S[5]) + (q1[2] * S[6] + q1[3] * S[7]));
                    Ps[(wave * 16 + tt) * 64 + lane] = p;
                }
            }
            if (OUT) {
                __syncthreads();
#pragma unroll
                for (int r = 0; r < 2; ++r) {
                    const int tt = wave + 8 * r; float o = 0.f;
#pragma unroll
                    for (int w2 = 0; w2 < 8; ++w2) o += Ps[(w2 * 16 + tt) * 64 + lane];
                    const float rs = 1.0f / sqrtf(wave_sum(o * o) * (1.f / 64.f) + EPS);
                    const size_t row = row0 + sub * 64 + tb * 16 + tt;
                    const float gt = siluf(bf1(PROJ[row * DIN + 768 + h * 64 + lane]));
                    ((bf16*)(a.ws + WS_MIX))[row * 1024 + h * 64 + lane] = (bf16)f2bf(o * rs * gnw * gt);
                }
                __syncthreads();
            }
        }
    }
    if (!OUT) {
        float* U = HU + (size_t)(bh * 64 + c) * 4096 + (size_t)(wave * 8) * 64 + lane;
#pragma unroll
        for (int j = 0; j < 8; ++j) U[j * 64] = S[j];
        if (tid < 64) HA[(size_t)(bh * 64 + c) * 64 + tid] = aprod;
    }
}

typedef unsigned short u16;
__device__ __forceinline__ bf16x8 pk8(const float* v) { v4u w = {pk2(v[0], v[1]), pk2(v[2], v[3]), pk2(v[4], v[5]), pk2(v[6], v[7])}; return __builtin_bit_cast(bf16x8, w); }
struct HRaw { v4u f[2], v[2], q[2], g[2]; };
template <bool OUT> __device__ __forceinline__ HRaw hgrn_load(const PA& a, int bh, int c, int wave, int lane) {
    const bf16* pr = (const bf16*)(a.ws + WS_PROJ) + ((size_t)(bh >> 2) * T + (size_t)c * 128 + wave * 16 + (lane >> 3)) * DIN + (bh & 3) * 64 + (lane & 7) * 8;
    HRaw r;
#pragma unroll
    for (int k = 0; k < 2; ++k) { r.f[k] = *(const v4u*)(pr + (size_t)(8 * k) * DIN + 256); r.v[k] = *(const v4u*)(pr + (size_t)(8 * k) * DIN + 512);
        if (OUT) { r.q[k] = *(const v4u*)(pr + (size_t)(8 * k) * DIN); r.g[k] = *(const v4u*)(pr + (size_t)(8 * k) * DIN + 768); } }
    return r;
}
template <bool OUT> __device__ __forceinline__ void hgrn_item2(const PA& a, LAS unsigned char* lds, int layer, int bh, int c, int wave, int lane, const HRaw& raw) {
    const int b = bh >> 2, h = bh & 3, item = bh * 64 + c;
    float* HU = (float*)(a.ws + WS_HU); float* HA = (float*)(a.ws + WS_HA);
    LAS unsigned char* wb = lds + wave * 12288;
    LAS bf16* QT = (LAS bf16*)wb; LAS bf16* KT = (LAS bf16*)(wb + 2304); LAS bf16* KHT = (LAS bf16*)(wb + 4608); LAS bf16* VT = (LAS bf16*)(wb + 7680); LAS bf16* P = (LAS bf16*)(wb + 10752);
    LAS float* DL = (LAS float*)(wb + 11520); LAS float* E7L = (LAS float*)(wb + 11776);
    LAS bf16* RF = (LAS bf16*)wb; LAS bf16* RV = (LAS bf16*)(wb + 2304); LAS bf16* RQ = (LAS bf16*)(wb + 4608);
    LAS bf16* GT = KHT; LAS bf16* OT = VT;
    LAS float* SBUF = (LAS float*)(lds + 98304); LAS float* DALL = (LAS float*)(lds + 114688);
    const int l15 = lane & 15, q = lane >> 4;
    const size_t row0 = (size_t)b * T + (size_t)c * 128 + wave * 16;
    const bf16x8 zero8 = {0, 0, 0, 0, 0, 0, 0, 0};
    __syncthreads();
    {
        const int rr = lane >> 3, cc = (lane & 7) * 8;
#pragma unroll
        for (int k = 0; k < 2; ++k) { *(LAS v4u*)(RF + (rr + 8 * k) * 72 + cc) = raw.f[k]; *(LAS v4u*)(RV + (rr + 8 * k) * 72 + cc) = raw.v[k]; if (OUT) *(LAS v4u*)(RQ + (rr + 8 * k) * 72 + cc) = raw.q[k]; }
        LDS_WAIT();
        const float lb = (layer == 0) ? 0.f : sigmf(a.in[4][256 + h * 64 + lane] - a.in[4][h * 64 + lane]);
        u16 fr[16], vr[16], qr[16];
#pragma unroll
        for (int t = 0; t < 16; ++t) { fr[t] = RF[t * 72 + lane]; vr[t] = RV[t * 72 + lane]; if (OUT) qr[t] = RQ[t * 72 + lane]; }
        LDS_WAIT();
        float cum[16], kk[16]; float run = 0.f;
#pragma unroll
        for (int t = 0; t < 16; ++t) { const float sg = sigmf(bf1(fr[t])); const float f = lb + (1.f - lb) * sg; kk[t] = (1.f - lb) * (1.f - sg); run += fmaxf(__logf(f), -69.f); cum[t] = run; }
        const float cl = cum[15], c7 = cum[7];
        DL[lane] = __expf(cl);
        if (OUT) E7L[lane] = __expf(c7); else DALL[wave * 64 + lane] = cl;
        float kh[16];
#pragma unroll
        for (int t = 0; t < 16; ++t) kh[t] = kk[t] * __expf(cl - cum[t]);
        *(LAS bf16x8*)(KHT + lane * 24) = pk8(kh); *(LAS bf16x8*)(KHT + lane * 24 + 8) = pk8(kh + 8);
        { v4u w0 = {(unsigned)vr[0] | ((unsigned)vr[1] << 16), (unsigned)vr[2] | ((unsigned)vr[3] << 16), (unsigned)vr[4] | ((unsigned)vr[5] << 16), (unsigned)vr[6] | ((unsigned)vr[7] << 16)};
          v4u w1 = {(unsigned)vr[8] | ((unsigned)vr[9] << 16), (unsigned)vr[10] | ((unsigned)vr[11] << 16), (unsigned)vr[12] | ((unsigned)vr[13] << 16), (unsigned)vr[14] | ((unsigned)vr[15] << 16)};
          *(LAS v4u*)(VT + lane * 24) = w0; *(LAS v4u*)(VT + lane * 24 + 8) = w1; }
        if (OUT) {
#pragma unroll
            for (int t = 0; t < 16; ++t) {
                QT[t * 72 + lane] = (bf16)f2bf(siluf(bf1(qr[t])) * __expf(fminf(cum[t] - c7, 60.f)));
                KT[t * 72 + lane] = (bf16)f2bf(kk[t] * __expf(fminf(c7 - cum[t], 60.f)));
            }
        }
    }
    LDS_WAIT();
    bf16x8 vfr[4];
#pragma unroll
    for (int nt = 0; nt < 4; ++nt) vfr[nt] = (q < 2) ? *(const LAS bf16x8*)(VT + (16 * nt + l15) * 24 + q * 8) : zero8;
    f32x4 U[4][4];
#pragma unroll
    for (int mt = 0; mt < 4; ++mt) { const bf16x8 afr = (q < 2) ? *(const LAS bf16x8*)(KHT + (16 * mt + l15) * 24 + q * 8) : zero8;
#pragma unroll
        for (int nt = 0; nt < 4; ++nt) U[mt][nt] = __builtin_amdgcn_mfma_f32_16x16x32_bf16(afr, vfr[nt], (f32x4){0.f, 0.f, 0.f, 0.f}, 0, 0, 0); }
    f32x4 o[4]; bf16x8 qf[2];
    if (OUT) {
        LDS_WAIT();
        { const int rr = lane >> 3, cc = (lane & 7) * 8; *(LAS v4u*)(GT + rr * 72 + cc) = raw.g[0]; *(LAS v4u*)(GT + (rr + 8) * 72 + cc) = raw.g[1]; }
        f32x4 sc = {0.f, 0.f, 0.f, 0.f};
#pragma unroll
        for (int ks = 0; ks < 2; ++ks) {
            const v2u qa = *(const LAS v2u*)(QT + l15 * 72 + 32 * ks + 4 * q), qb = *(const LAS v2u*)(QT + l15 * 72 + 32 * ks + 16 + 4 * q);
            const v2u ka = *(const LAS v2u*)(KT + l15 * 72 + 32 * ks + 4 * q), kb = *(const LAS v2u*)(KT + l15 * 72 + 32 * ks + 16 + 4 * q);
            qf[ks] = __builtin_bit_cast(bf16x8, (v4u){qa.x, qa.y, qb.x, qb.y});
            const bf16x8 kf = __builtin_bit_cast(bf16x8, (v4u){ka.x, ka.y, kb.x, kb.y});
            sc = __builtin_amdgcn_mfma_f32_16x16x32_bf16(qf[ks], kf, sc, 0, 0, 0);
        }
#pragma unroll
        for (int j = 0; j < 4; ++j) { const int t = 4 * q + j; P[t * 24 + l15] = (bf16)f2bf((l15 <= t) ? sc[j] : 0.f); }
        LDS_WAIT();
        const bf16x8 pf = (q < 2) ? *(const LAS bf16x8*)(P + l15 * 24 + q * 8) : zero8;
#pragma unroll
        for (int nt = 0; nt < 4; ++nt) o[nt] = __builtin_amdgcn_mfma_f32_16x16x32_bf16(pf, vfr[nt], (f32x4){0.f, 0.f, 0.f, 0.f}, 0, 0, 0);
    }
    {
        float S8[8];
#pragma unroll
        for (int i = 0; i < 8; ++i) S8[i] = 0.f;
        if (OUT) {
            const f32x4 h0 = *(const f32x4*)(HU + (size_t)item * 4096 + (size_t)((2 * wave) * 64 + lane) * 4), h1 = *(const f32x4*)(HU + (size_t)item * 4096 + (size_t)((2 * wave + 1) * 64 + lane) * 4);
            S8[0] = h0[0]; S8[1] = h0[1]; S8[2] = h0[2]; S8[3] = h0[3]; S8[4] = h1[0]; S8[5] = h1[1]; S8[6] = h1[2]; S8[7] = h1[3];
        }
        *(LAS f32x4*)(SBUF + ((2 * wave) * 64 + lane) * 4) = (f32x4){S8[0], S8[1], S8[2], S8[3]}; *(LAS f32x4*)(SBUF + ((2 * wave + 1) * 64 + lane) * 4) = (f32x4){S8[4], S8[5], S8[6], S8[7]};
    }
    __syncthreads();
    f32x4 Sp[4][4];
#pragma unroll 1
    for (int step = 0; step < 8; ++step) {
        if (wave == step) {
#pragma unroll
            for (int mt = 0; mt < 4; ++mt) { const f32x4 Dv = *(const LAS f32x4*)(DL + 16 * mt + 4 * q);
#pragma unroll
                for (int nt = 0; nt < 4; ++nt) {
                    Sp[mt][nt] = *(const LAS f32x4*)(SBUF + ((mt * 4 + nt) * 64 + lane) * 4);
                    U[mt][nt] = Dv * Sp[mt][nt] + U[mt][nt];
                    *(LAS f32x4*)(SBUF + ((mt * 4 + nt) * 64 + lane) * 4) = U[mt][nt];
                } }
        }
        __syncthreads();
    }
    if (OUT) {
#pragma unroll
        for (int mt = 0; mt < 4; ++mt) { const f32x4 Ev = *(const LAS f32x4*)(E7L + 16 * mt + 4 * q);
#pragma unroll
            for (int nt = 0; nt < 4; ++nt) Sp[mt][nt] = Sp[mt][nt] * Ev; }
#pragma unroll
        for (int nt = 0; nt < 4; ++nt)
#pragma unroll
            for (int ks = 0; ks < 2; ++ks) {
                const f32x4 s0 = Sp[2 * ks][nt], s1 = Sp[2 * ks + 1][nt];
                const bf16x8 bfrag = __builtin_bit_cast(bf16x8, (v4u){pk2(s0[0], s0[1]), pk2(s0[2], s0[3]), pk2(s1[0], s1[1]), pk2(s1[2], s1[3])});
                o[nt] = __builtin_amdgcn_mfma_f32_16x16x32_bf16(qf[ks], bfrag, o[nt], 0, 0, 0);
            }
        float gn[4];
#pragma unroll
        for (int nt = 0; nt < 4; ++nt) gn[nt] = a.in[5][layer * 64 + 16 * nt + l15];
#pragma unroll
        for (int j = 0; j < 4; ++j) {
            float ss = (o[0][j] * o[0][j] + o[1][j] * o[1][j]) + (o[2][j] * o[2][j] + o[3][j] * o[3][j]);
            ss += __shfl_xor(ss, 1); ss += __shfl_xor(ss, 2); ss += __shfl_xor(ss, 4); ss += __shfl_xor(ss, 8);
            const float rs = __builtin_amdgcn_rsqf(ss * (1.f / 64.f) + EPS);
#pragma unroll
            for (int nt = 0; nt < 4; ++nt) { const float gt = siluf(bf1(GT[(4 * q + j) * 72 + 16 * nt + l15]));
                OT[(4 * q + j) * 72 + 16 * nt + l15] = (bf16)f2bf(o[nt][j] * rs * gn[nt] * gt); }
        }
        LDS_WAIT();
        { const int rr = lane >> 3, cc = (lane & 7) * 8; bf16* mp = (bf16*)(a.ws + WS_MIX) + (row0 + rr) * 1024 + h * 64 + cc;
          *(v4u*)mp = *(const LAS v4u*)(OT + rr * 72 + cc); *(v4u*)(mp + 8 * 1024) = *(const LAS v4u*)(OT + (rr + 8) * 72 + cc); }
    } else {
        if (wave == 7) {
#pragma unroll
            for (int mt = 0; mt < 4; ++mt)
#pragma unroll
                for (int nt = 0; nt < 4; ++nt)
                    *(f32x4*)(HU + (size_t)item * 4096 + (size_t)((mt * 4 + nt) * 64 + lane) * 4) = U[mt][nt];
            float s = 0.f;
#pragma unroll
            for (int w2 = 0; w2 < 8; ++w2) s += DALL[w2 * 64 + lane];
            HA[(size_t)item * 64 + lane] = __expf(s);
        }
    }
}

template <bool OUT> __device__ __forceinline__ HRaw hgrn_loadc(const PA& a, int bh, int c, int chunk, int lane) {
    const bf16* pr = (const bf16*)(a.ws + WS_PROJ) + ((size_t)(bh >> 2) * T + (size_t)c * 128 + chunk * 16 + (lane >> 3)) * DIN + (bh & 3) * 64 + (lane & 7) * 8;
    HRaw r;
#pragma unroll
    for (int k = 0; k < 2; ++k) { r.f[k] = *(const v4u*)(pr + (size_t)(8 * k) * DIN + 256); r.v[k] = *(const v4u*)(pr + (size_t)(8 * k) * DIN + 512);
        if (OUT) { r.q[k] = *(const v4u*)(pr + (size_t)(8 * k) * DIN); } }
    return r;
}
template <bool OUT> __device__ __forceinline__ void hgrn_chunk(const PA& a, LAS unsigned char* wb, LAS float* DLk, LAS float* E7k, LAS float* DALLk, int layer, int h, int lane, const HRaw& raw,
                                                                f32x4 (&U)[4][4], f32x4 (&o)[4], bf16x8 (&qf)[2]) {
    LAS bf16* QT = (LAS bf16*)wb; LAS bf16* KT = (LAS bf16*)(wb + 2304); LAS bf16* KHT = (LAS bf16*)(wb + 4608); LAS bf16* VT = (LAS bf16*)(wb + 7680); LAS bf16* P = (LAS bf16*)(wb + 10752);
    LAS bf16* RF = (LAS bf16*)wb; LAS bf16* RV = (LAS bf16*)(wb + 2304); LAS bf16* RQ = (LAS bf16*)(wb + 4608);
    const int l15 = lane & 15, q = lane >> 4;
    const bf16x8 zero8 = {0, 0, 0, 0, 0, 0, 0, 0};
    LDS_WAIT();
    {
        const int rr = lane >> 3, cc = (lane & 7) * 8;
#pragma unroll
        for (int k = 0; k < 2; ++k) { *(LAS v4u*)(RF + (rr + 8 * k) * 72 + cc) = raw.f[k]; *(LAS v4u*)(RV + (rr + 8 * k) * 72 + cc) = raw.v[k]; if (OUT) *(LAS v4u*)(RQ + (rr + 8 * k) * 72 + cc) = raw.q[k]; }
        LDS_WAIT();
        const float lb = (layer == 0) ? 0.f : sigmf(a.in[4][256 + h * 64 + lane] - a.in[4][h * 64 + lane]);
        {
            u16 vr[16];
#pragma unroll
            for (int t = 0; t < 16; ++t) vr[t] = RV[t * 72 + lane];
            const v4u w0 = {(unsigned)vr[0] | ((unsigned)vr[1] << 16), (unsigned)vr[2] | ((unsigned)vr[3] << 16), (unsigned)vr[4] | ((unsigned)vr[5] << 16), (unsigned)vr[6] | ((unsigned)vr[7] << 16)};
            const v4u w1 = {(unsigned)vr[8] | ((unsigned)vr[9] << 16), (unsigned)vr[10] | ((unsigned)vr[11] << 16), (unsigned)vr[12] | ((unsigned)vr[13] << 16), (unsigned)vr[14] | ((unsigned)vr[15] << 16)};
            *(LAS v4u*)(VT + lane * 24) = w0; *(LAS v4u*)(VT + lane * 24 + 8) = w1;
        }
        float cum[16], kk[16]; float run = 0.f;
#pragma unroll
        for (int t = 0; t < 16; ++t) { const float sg = sigmf(bf1(RF[t * 72 + lane])); const float f = lb + (1.f - lb) * sg; kk[t] = (1.f - lb) * (1.f - sg); run += fmaxf(__logf(f), -69.f); cum[t] = run; }
        const float cl = cum[15], c7 = cum[7];
        DLk[lane] = __expf(cl);
        if (OUT) E7k[lane] = __expf(c7); else DALLk[lane] = cl;
        if (OUT) {
            float qv[16];
#pragma unroll
            for (int t = 0; t < 16; ++t) qv[t] = bf1(RQ[t * 72 + lane]);
            LDS_WAIT();
#pragma unroll
            for (int t = 0; t < 16; ++t) {
                QT[t * 72 + lane] = (bf16)f2bf(siluf(qv[t]) * __expf(fminf(cum[t] - c7, 60.f)));
                KT[t * 72 + lane] = (bf16)f2bf(kk[t] * __expf(fminf(c7 - cum[t], 60.f)));
            }
        }
        LDS_WAIT();
        float kh[16];
#pragma unroll
        for (int t = 0; t < 16; ++t) kh[t] = kk[t] * __expf(cl - cum[t]);
        *(LAS bf16x8*)(KHT + lane * 24) = pk8(kh); *(LAS bf16x8*)(KHT + lane * 24 + 8) = pk8(kh + 8);
    }
    LDS_WAIT();
    bf16x8 vfr[4];
#pragma unroll
    for (int nt = 0; nt < 4; ++nt) vfr[nt] = (q < 2) ? *(const LAS bf16x8*)(VT + (16 * nt + l15) * 24 + q * 8) : zero8;
#pragma unroll
    for (int mt = 0; mt < 4; ++mt) { const bf16x8 afr = (q < 2) ? *(const LAS bf16x8*)(KHT + (16 * mt + l15) * 24 + q * 8) : zero8;
#pragma unroll
        for (int nt = 0; nt < 4; ++nt) U[mt][nt] = __builtin_amdgcn_mfma_f32_16x16x32_bf16(afr, vfr[nt], (f32x4){0.f, 0.f, 0.f, 0.f}, 0, 0, 0); }
    if (OUT) {
        f32x4 sc = {0.f, 0.f, 0.f, 0.f};
#pragma unroll
        for (int ks = 0; ks < 2; ++ks) {
            const v2u qa = *(const LAS v2u*)(QT + l15 * 72 + 32 * ks + 4 * q), qb = *(const LAS v2u*)(QT + l15 * 72 + 32 * ks + 16 + 4 * q);
            const v2u ka = *(const LAS v2u*)(KT + l15 * 72 + 32 * ks + 4 * q), kb = *(const LAS v2u*)(KT + l15 * 72 + 32 * ks + 16 + 4 * q);
            qf[ks] = __builtin_bit_cast(bf16x8, (v4u){qa.x, qa.y, qb.x, qb.y});
            const bf16x8 kf = __builtin_bit_cast(bf16x8, (v4u){ka.x, ka.y, kb.x, kb.y});
            sc = __builtin_amdgcn_mfma_f32_16x16x32_bf16(qf[ks], kf, sc, 0, 0, 0);
        }
#pragma unroll
        for (int j = 0; j < 4; ++j) { const int t = 4 * q + j; P[t * 24 + l15] = (bf16)f2bf((l15 <= t) ? sc[j] : 0.f); }
        LDS_WAIT();
        const bf16x8 pf = (q < 2) ? *(const LAS bf16x8*)(P + l15 * 24 + q * 8) : zero8;
#pragma unroll
        for (int nt = 0; nt < 4; ++nt) o[nt] = __builtin_amdgcn_mfma_f32_16x16x32_bf16(pf, vfr[nt], (f32x4){0.f, 0.f, 0.f, 0.f}, 0, 0, 0);
    }
}
__device__ __forceinline__ void hgrn_ointer(f32x4 (&o)[4], const bf16x8 (&qf)[2], const f32x4 (&S)[4][4], const f32x4 (&sc)[4]) {
#pragma unroll
    for (int nt = 0; nt < 4; ++nt)
#pragma unroll
        for (int ks = 0; ks < 2; ++ks) {
            const f32x4 s0 = S[2 * ks][nt] * sc[2 * ks], s1 = S[2 * ks + 1][nt] * sc[2 * ks + 1];
            const bf16x8 bfrag = __builtin_bit_cast(bf16x8, (v4u){pk2(s0[0], s0[1]), pk2(s0[2], s0[3]), pk2(s1[0], s1[1]), pk2(s1[2], s1[3])});
            o[nt] = __builtin_amdgcn_mfma_f32_16x16x32_bf16(qf[ks], bfrag, o[nt], 0, 0, 0);
        }
}
#define HG_LAUNDER() do { asm volatile("" : "+v"(lane)); l15 = lane & 15; q = lane >> 4; } while (0)
template <bool OUT> __device__ __forceinline__ void hgrn_pair(const PA& a, LAS unsigned char* lds, int layer, int bh, int s, int wave, int lane) {
    const int half = wave >> 2, wl = wave & 3, c = half ? 63 - s : s, b = bh >> 2, h = bh & 3, item = bh * 64 + c;
    float* HU = (float*)(a.ws + WS_HU); float* HA = (float*)(a.ws + WS_HA);
    LAS unsigned char* wb = lds + wave * 12800;
    LAS float* DLs = (LAS float*)(wb + 11520);
    LAS float* SBUF = (LAS float*)(lds + 102400 + half * 16384);
    LAS float* DALL = (LAS float*)(lds + 135168 + half * 2048);
    int l15 = lane & 15, q = lane >> 4;
    const size_t rowc0 = (size_t)b * T + (size_t)c * 128 + (size_t)(2 * wl) * 16;
    __syncthreads();
    f32x4 U0[4][4], Up[4][4], o[2][4]; bf16x8 qf[2][2];
    { const HRaw r0 = hgrn_loadc<OUT>(a, bh, c, 2 * wl, lane); hgrn_chunk<OUT>(a, wb, DLs, DLs + 128, DALL + (2 * wl) * 64, layer, h, lane, r0, U0, o[0], qf[0]); }
    asm volatile("" ::: "memory"); __builtin_amdgcn_sched_barrier(0); HG_LAUNDER();
    { const HRaw r1 = hgrn_loadc<OUT>(a, bh, c, 2 * wl + 1, lane); hgrn_chunk<OUT>(a, wb, DLs + 64, DLs + 192, DALL + (2 * wl + 1) * 64, layer, h, lane, r1, Up, o[1], qf[1]); }
    asm volatile("" ::: "memory"); __builtin_amdgcn_sched_barrier(0); HG_LAUNDER();
    LDS_WAIT();
    if (OUT) { f32x4 E1[4];
#pragma unroll
        for (int mt = 0; mt < 4; ++mt) E1[mt] = *(const LAS f32x4*)(DLs + 192 + 16 * mt + 4 * q);
        hgrn_ointer(o[1], qf[1], U0, E1); }
#pragma unroll
    for (int mt = 0; mt < 4; ++mt) { const f32x4 D1 = *(const LAS f32x4*)(DLs + 64 + 16 * mt + 4 * q);
#pragma unroll
        for (int nt = 0; nt < 4; ++nt) Up[mt][nt] = D1 * U0[mt][nt] + Up[mt][nt]; }
    HG_LAUNDER();
#pragma unroll
    for (int i = 0; i < 4; ++i) { f32x4 hv = {0.f, 0.f, 0.f, 0.f};
        if (OUT) hv = *(const f32x4*)(HU + (size_t)item * 4096 + (size_t)((4 * wl + i) * 64 + lane) * 4);
        *(LAS f32x4*)(SBUF + ((4 * wl + i) * 64 + lane) * 4) = hv; }
    v4u gq[2][2];
    if (OUT) { const bf16* gp = (const bf16*)(a.ws + WS_PROJ) + (rowc0 + (lane >> 3)) * DIN + 768 + h * 64 + (lane & 7) * 8;
#pragma unroll
        for (int k = 0; k < 2; ++k) { gq[k][0] = *(const v4u*)(gp + (size_t)(16 * k) * DIN); gq[k][1] = *(const v4u*)(gp + (size_t)(16 * k + 8) * DIN); } }
    __syncthreads();
    HG_LAUNDER();
    f32x4 Sin[4][4];
#pragma unroll 1
    for (int step = 0; step < 4; ++step) {
        if (wl == step) {
#pragma unroll
            for (int mt = 0; mt < 4; ++mt) { const f32x4 Dp = *(const LAS f32x4*)(DLs + 16 * mt + 4 * q) * *(const LAS f32x4*)(DLs + 64 + 16 * mt + 4 * q);
#pragma unroll
                for (int nt = 0; nt < 4; ++nt) {
                    Sin[mt][nt] = *(const LAS f32x4*)(SBUF + ((mt * 4 + nt) * 64 + lane) * 4);
                    Up[mt][nt] = Dp * Sin[mt][nt] + Up[mt][nt];
                    *(LAS f32x4*)(SBUF + ((mt * 4 + nt) * 64 + lane) * 4) = Up[mt][nt];
                } }
        }
        __syncthreads();
    }
    HG_LAUNDER();
    if (OUT) {
        { f32x4 E0[4];
#pragma unroll
          for (int mt = 0; mt < 4; ++mt) E0[mt] = *(const LAS f32x4*)(DLs + 128 + 16 * mt + 4 * q);
          hgrn_ointer(o[0], qf[0], Sin, E0);
#pragma unroll
          for (int mt = 0; mt < 4; ++mt) E0[mt] = *(const LAS f32x4*)(DLs + 192 + 16 * mt + 4 * q) * *(const LAS f32x4*)(DLs + 16 * mt + 4 * q);
          hgrn_ointer(o[1], qf[1], Sin, E0); }
        HG_LAUNDER();
        LAS bf16* GT = (LAS bf16*)(wb + 4608); LAS bf16* OT = (LAS bf16*)(wb + 7680);
        float gn[4];
#pragma unroll
        for (int nt = 0; nt < 4; ++nt) gn[nt] = a.in[5][layer * 64 + 16 * nt + l15];
#pragma unroll
        for (int k = 0; k < 2; ++k) {
            const int rr = lane >> 3, cc = (lane & 7) * 8;
            LDS_WAIT();
            *(LAS v4u*)(GT + rr * 72 + cc) = gq[k][0]; *(LAS v4u*)(GT + (rr + 8) * 72 + cc) = gq[k][1];
            LDS_WAIT();
#pragma unroll
            for (int j = 0; j < 4; ++j) {
                float ss = (o[k][0][j] * o[k][0][j] + o[k][1][j] * o[k][1][j]) + (o[k][2][j] * o[k][2][j] + o[k][3][j] * o[k][3][j]);
                ss += __shfl_xor(ss, 1); ss += __shfl_xor(ss, 2); ss += __shfl_xor(ss, 4); ss += __shfl_xor(ss, 8);
                const float rs = __builtin_amdgcn_rsqf(ss * (1.f / 64.f) + EPS);
#pragma unroll
                for (int nt = 0; nt < 4; ++nt) { const float gt = siluf(bf1(GT[(4 * q + j) * 72 + 16 * nt + l15]));
                    OT[(4 * q + j) * 72 + 16 * nt + l15] = (bf16)f2bf(o[k][nt][j] * rs * gn[nt] * gt); }
            }
            LDS_WAIT();
            bf16* mp = (bf16*)(a.ws + WS_MIX) + (rowc0 + k * 16 + rr) * 1024 + h * 64 + cc;
            *(v4u*)mp = *(const LAS v4u*)(OT + rr * 72 + cc); *(v4u*)(mp + 8 * 1024) = *(const LAS v4u*)(OT + (rr + 8) * 72 + cc);
        }
    } else {
        if (wl == 3) {
#pragma unroll
            for (int mt = 0; mt < 4; ++mt)
#pragma unroll
                for (int nt = 0; nt < 4; ++nt)
                    *(f32x4*)(HU + (size_t)item * 4096 + (size_t)((mt * 4 + nt) * 64 + lane) * 4) = Up[mt][nt];
            float sm = 0.f;
#pragma unroll
            for (int w2 = 0; w2 < 8; ++w2) sm += DALL[w2 * 64 + lane];
            HA[(size_t)item * 64 + lane] = __expf(sm);
        }
    }
}

__device__ __forceinline__ float gelu_tanh(float y) { const float z = 0.7978845608028654f * (y + 0.044715f * y * y * y); return y * sigmf(2.f * z); }
template <bool OUT> __device__ __forceinline__ void s5_item(const PA& a, LAS unsigned char* lds, int layer, int item, int wave, int lane) {
    const int b = item >> 10, g = (item >> 6) & 15, c = item & 63, lg = layer * 16 + g;
    const bf16* PROJ = (const bf16*)(a.ws + WS_PROJ);
    const float* sa = (const float*)(a.ws + WS_S5A) + (size_t)lg * 256;
    float* XL = (float*)(a.ws + WS_XLOC) + (size_t)((b * 16 + g) * 64) * 128;
    const float ar = sa[lane], ai = sa[64 + lane];
    float xr = 0.f, xi = 0.f;
    if (OUT) { xr = XL[c * 128 + lane]; xi = XL[c * 128 + 64 + lane]; }
    const int l15 = lane & 15, quad = lane >> 4;
    const bf16x8 zero8 = {0, 0, 0, 0, 0, 0, 0, 0};
    bf16x8 bfr[8];
#pragma unroll
    for (int nt = 0; nt < 8; ++nt) bfr[nt] = (quad < 2) ? *(const bf16x8*)((const bf16*)(a.ws + WS_S5B) + (size_t)lg * 2048 + (nt * 16 + l15) * 16 + quad * 8) : zero8;
    bf16x8 cfr[4];
    if (OUT) {
#pragma unroll
        for (int ks = 0; ks < 4; ++ks) cfr[ks] = *(const bf16x8*)((const bf16*)(a.ws + WS_S5C) + (size_t)lg * 2048 + l15 * 128 + ks * 32 + quad * 8);
    }
    const float dsk = a.in[13][layer * 256 + g * 16 + l15];
    LAS float* BU = (LAS float*)(lds + wave * 12800);
    LAS bf16* X = (LAS bf16*)(lds + wave * 12800 + 8448);
    const size_t rowb = (size_t)b * T + (size_t)c * 128;
    bf16x8 afr_n = (quad < 2) ? *(const bf16x8*)(PROJ + (rowb + l15) * DIN + 1024 + g * 16 + quad * 8) : zero8;
    bf16 ue_n[4] = {0, 0, 0, 0}, se_n[4] = {0, 0, 0, 0};
    if (OUT) {
#pragma unroll
        for (int j = 0; j < 4; ++j) { ue_n[j] = PROJ[(rowb + quad * 4 + j) * DIN + 1024 + g * 16 + l15]; se_n[j] = PROJ[(rowb + quad * 4 + j) * DIN + 1280 + g * 16 + l15]; }
    }
    f32x4 accn[8];
#pragma unroll
    for (int nt = 0; nt < 8; ++nt) accn[nt] = __builtin_amdgcn_mfma_f32_16x16x32_bf16(afr_n, bfr[nt], (f32x4){0.f, 0.f, 0.f, 0.f}, 0, 0, 0);
#pragma unroll
    for (int nt = 0; nt < 8; ++nt)
#pragma unroll
        for (int j = 0; j < 4; ++j) BU[(quad * 4 + j) * 132 + nt * 16 + l15] = accn[nt][j];
    afr_n = (quad < 2) ? *(const bf16x8*)(PROJ + (rowb + 16 + l15) * DIN + 1024 + g * 16 + quad * 8) : zero8;
    for (int blk = 0; blk < 8; ++blk) {
        const size_t row0 = rowb + blk * 16;
        bf16 ue[4], se[4];
#pragma unroll
        for (int j = 0; j < 4; ++j) { ue[j] = ue_n[j]; se[j] = se_n[j]; }
        if (blk + 1 < 8) {
#pragma unroll
            for (int nt = 0; nt < 8; ++nt) accn[nt] = __builtin_amdgcn_mfma_f32_16x16x32_bf16(afr_n, bfr[nt], (f32x4){0.f, 0.f, 0.f, 0.f}, 0, 0, 0);
            if (blk + 2 < 8) afr_n = (quad < 2) ? *(const bf16x8*)(PROJ + (row0 + 32 + l15) * DIN + 1024 + g * 16 + quad * 8) : zero8;
            if (OUT) {
#pragma unroll
                for (int j = 0; j < 4; ++j) { ue_n[j] = PROJ[(row0 + 16 + quad * 4 + j) * DIN + 1024 + g * 16 + l15]; se_n[j] = PROJ[(row0 + 16 + quad * 4 + j) * DIN + 1280 + g * 16 + l15]; }
            }
        }
#pragma unroll
        for (int t = 0; t < 16; ++t) {
            const float br = BU[t * 132 + lane], bi = BU[t * 132 + 64 + lane];
            const float nr = ar * xr - ai * xi + br, ni = ar * xi + ai * xr + bi; xr = nr; xi = ni;
            if (OUT) { X[t * 136 + lane] = (bf16)f2bf(xr); X[t * 136 + 64 + lane] = (bf16)f2bf(xi); }
        }
        if (blk + 1 < 8) {
#pragma unroll
            for (int nt = 0; nt < 8; ++nt)
#pragma unroll
                for (int j = 0; j < 4; ++j) BU[(quad * 4 + j) * 132 + nt * 16 + l15] = accn[nt][j];
        }
        if (OUT) {
            f32x4 acc = {0.f, 0.f, 0.f, 0.f};
#pragma unroll
            for (int ks = 0; ks < 4; ++ks) { const bf16x8 xa = *(const LAS bf16x8*)(X + l15 * 136 + ks * 32 + quad * 8); acc = __builtin_amdgcn_mfma_f32_16x16x32_bf16(xa, cfr[ks], acc, 0, 0, 0); }
#pragma unroll
            for (int j = 0; j < 4; ++j) { const size_t row = row0 + quad * 4 + j;
                const float u = bf1(ue[j]);
                const float yg = gelu_tanh(acc[j] + dsk * u);
                ((bf16*)(a.ws + WS_YG))[row * 256 + g * 16 + l15] = (bf16)f2bf(yg);
                ((bf16*)(a.ws + WS_YGS))[row * 256 + g * 16 + l15] = (bf16)f2bf(yg * siluf(bf1(se[j]))); }
        }
    }
    LDS_WAIT();
    if (!OUT) { XL[c * 128 + lane] = xr; XL[c * 128 + 64 + lane] = xi; }
}


__device__ __forceinline__ void hgrn_scan(const PA& a, int task, int lane) {
    float* HU = (float*)(a.ws + WS_HU); const float* HA = (const float*)(a.ws + WS_HA);
    const int bh = task >> 6, r = task & 63, dk = 16 * (r >> 4) + 4 * (r & 3) + (lane & 3);
    float* up = HU + (size_t)(bh * 64) * 4096 + (size_t)r * 64 + lane; const float* ap = HA + (size_t)(bh * 64) * 64 + dk;
    float S = 0.f;
#pragma unroll 1
    for (int c0 = 0; c0 < 64; c0 += 32) {
        float u[32], av[32];
#pragma unroll
        for (int i = 0; i < 32; ++i) { u[i] = up[(size_t)(c0 + i) * 4096]; av[i] = ap[(size_t)(c0 + i) * 64]; }
#pragma unroll
        for (int i = 0; i < 32; ++i) { __hip_atomic_store(up + (size_t)(c0 + i) * 4096, S, __ATOMIC_RELAXED, __HIP_MEMORY_SCOPE_AGENT); S = av[i] * S + u[i]; }
    }
}
__device__ __forceinline__ void s5_scan(const PA& a, int layer, int task, int lane) {
    const int g = task & 15;
    const float* sa = (const float*)(a.ws + WS_S5A) + (size_t)(layer * 16 + g) * 256;
    float* XL = (float*)(a.ws + WS_XLOC) + (size_t)(task * 64) * 128;
    const float Lr = sa[128 + lane], Li = sa[192 + lane];
    float xr = 0.f, xi = 0.f;
#pragma unroll 1
    for (int c0 = 0; c0 < 64; c0 += 32) {
        float lr[32], li[32];
#pragma unroll
        for (int i = 0; i < 32; ++i) { lr[i] = XL[(c0 + i) * 128 + lane]; li[i] = XL[(c0 + i) * 128 + 64 + lane]; }
#pragma unroll
        for (int i = 0; i < 32; ++i) { __hip_atomic_store(XL + (c0 + i) * 128 + lane, xr, __ATOMIC_RELAXED, __HIP_MEMORY_SCOPE_AGENT); __hip_atomic_store(XL + (c0 + i) * 128 + 64 + lane, xi, __ATOMIC_RELAXED, __HIP_MEMORY_SCOPE_AGENT);
            const float nr = Lr * xr - Li * xi + lr[i], ni = Lr * xi + Li * xr + li[i]; xr = nr; xi = ni; }
    }
}
template <int NR> __device__ __forceinline__ void combine_rows(const PA& a, int layer, float lam, float post, size_t row0, size_t rstride, int lane) {
    const bf16* O = (const bf16*)(a.ws + WS_O); const bf16* PROJ = (const bf16*)(a.ws + WS_PROJ);
    const int h = lane >> 4, e0 = (lane & 15) * 8, j = e0 >> 6, d = e0 & 63;
    v4u o0[NR], o1[NR], gv[NR];
#pragma unroll
    for (int r = 0; r < NR; ++r) { const size_t row = row0 + r * rstride;
        o0[r] = *(const v4u*)(O + row * 1024 + (h * 4 + j) * 64 + d); o1[r] = *(const v4u*)(O + row * 1024 + (h * 4 + 2 + j) * 64 + d); gv[r] = *(const v4u*)(PROJ + row * DIN + 3072 + h * 128 + e0); }
    const f32x4 sw0 = *(const f32x4*)(a.in[20] + layer * 128 + e0), sw1 = *(const f32x4*)(a.in[20] + layer * 128 + e0 + 4);
    const float sw[8] = {sw0[0], sw0[1], sw0[2], sw0[3], sw1[0], sw1[1], sw1[2], sw1[3]};
#pragma unroll
    for (int r = 0; r < NR; ++r) { const size_t row = row0 + r * rstride;
        const unsigned a0[4] = {o0[r].x, o0[r].y, o0[r].z, o0[r].w}, a1[4] = {o1[r].x, o1[r].y, o1[r].z, o1[r].w}, ga[4] = {gv[r].x, gv[r].y, gv[r].z, gv[r].w};
        float v[8]; float ss = 0.f;
#pragma unroll
        for (int q = 0; q < 8; ++q) { const float x0 = (q & 1) ? bfhi(a0[q >> 1]) : bflo(a0[q >> 1]), x1 = (q & 1) ? bfhi(a1[q >> 1]) : bflo(a1[q >> 1]); v[q] = x0 - lam * x1; ss += v[q] * v[q]; }
        ss += __shfl_xor(ss, 1); ss += __shfl_xor(ss, 2); ss += __shfl_xor(ss, 4); ss += __shfl_xor(ss, 8);
        const float rs = post * __builtin_amdgcn_rsqf(ss * (1.f / 128.f) + EPS);
        float o[8];
#pragma unroll
        for (int q = 0; q < 8; ++q) { const float gq = (q & 1) ? bfhi(ga[q >> 1]) : bflo(ga[q >> 1]); o[q] = v[q] * rs * sw[q] * siluf(gq); }
        *(v4u*)((bf16*)(a.ws + WS_MIX) + row * 1024 + 512 + h * 128 + e0) = (v4u){pk2(o[0], o[1]), pk2(o[2], o[3]), pk2(o[4], o[5]), pk2(o[6], o[7])};
    }
}

__global__ void __launch_bounds__(NWAVES * 64, 2) hymba_fwd(Args args) {
    extern __shared__ __attribute__((aligned(16))) unsigned char lds_raw[];
    LAS unsigned char* lds = (LAS unsigned char*)lds_raw;
    cg::grid_group grid = cg::this_grid();
    int tid = threadIdx.x, lane = tid & 63, wave = __builtin_amdgcn_readfirstlane(tid >> 6);
#define RELAUNDER() do { int t_ = threadIdx.x; asm volatile("" : "+v"(t_)); tid = t_; lane = tid & 63; wave = __builtin_amdgcn_readfirstlane(tid >> 6); } while (0)
    const int G = gridDim.x, bx = blockIdx.x, vcu = (G % 8 == 0) ? (bx % 8) * (G / 8) + bx / 8 : bx;
    unsigned char* ws = args.ws;
    const int lo = args.ph_lo, hi = args.ph_hi;
    volatile LAS unsigned* MISC = (volatile LAS unsigned*)(lds + LDS_BYTES - 256);
    if (tid < 32) MISC[tid] = 0u;
    __syncthreads();
    unsigned* barw = (unsigned*)(ws + WS_CTL);
    XcdBarrier bar; bar.bar = barw; bar.x = 0; bar.st = MISC + 8;
    int ph = 0;
#ifndef MK_DIS
#define MK_DIS 0
#endif
#define EN(bit) (!((MK_DIS >> (bit)) & 1))
#ifndef MK_REP
#define MK_REP 0
#endif
#define REPS(bit) for (int rep_ = 0; rep_ < 1 + ((MK_REP >> (bit)) & 1); ++rep_)
#define IN(k) (lo <= (k) && (k) < hi)
#define SEAM() do { if (IN(ph) && IN(ph + 1)) { xcd_barrier(bar); if ((MK_REP >> 10) & 1) xcd_barrier(bar); } ++ph; RELAUNDER(); } while (0)
    bf16* PROJ = (bf16*)(ws + WS_PROJ); bf16* XN = (bf16*)(ws + WS_XN); bf16* MIX = (bf16*)(ws + WS_MIX);
    const int NGW = G * NWAVES;
#define gw (vcu * NWAVES + wave)

    const float** tabw = (const float**)(ws + WS_TAB);
    bar = xcd_barrier_post(barw, MISC + 8);
    if (IN(ph) && EN(0)) { if (bx == 0) {
            if (tid == 0) {
#pragma unroll
                for (int i = 0; i < 22; ++i) tabw[i] = args.in[i]; } }
        REPS(0) { __syncthreads(); prologue(args, lds, vcu, G, wave, lane); } }
    const PA pa{(const float* const*)tabw, args.out, ws};
    if (lo < 0) grid.sync();
    SEAM();
    for (int layer = 0; layer < DEPTH; ++layer) {
        if (IN(ph) && EN(1)) REPS(1) {
            pg8::Gemm g{XN, (const bf16*)(ws + WS_WIN) + (size_t)layer * DIN * D, M, DIN, D}; pg8::StaticOrder S; S.init(M, DIN, G, bx);
            pg8::EpiInProj E{PROJ, (const float*)(ws + WS_ROPE), attn_body::C2, layer == 0 ? nullptr : (const float*)(ws + WS_ROWSS), (unsigned*)(ws + WS_SUCNT) + layer * 64};
            pg8::gemm_phase<pg8::EpiInProj, pg8::StaticOrder, PG8_ALIGN, PG8_SP2>(lds, g, S, E);
            if (G == 256 && bx >= 128) {
                __syncthreads();
                if (wave == 0) { unsigned* sucnt = (unsigned*)(ws + WS_SUCNT) + layer * 64; unsigned spins = 0;
                    while ((unsigned)__builtin_amdgcn_readfirstlane(__hip_atomic_load(sucnt, __ATOMIC_RELAXED, __HIP_MEMORY_SCOPE_AGENT)) < 512u) { __builtin_amdgcn_s_sleep(4); if (++spins > (1u << 22)) break; }
                    __builtin_amdgcn_fence(__ATOMIC_ACQUIRE, "agent"); asm volatile("s_waitcnt vmcnt(0)" ::: "memory"); }
                __syncthreads();
                RELAUNDER();
                for (int it = (bx - 128) * NWAVES + wave; it < 2048; it += 128 * NWAVES) s5_item<false>(pa, lds, layer, it, wave, lane);
            }
        }
        if (G == 256) { ++ph; RELAUNDER(); } else SEAM();
        if (IN(ph)) {
            if (G == 256) {
                __syncthreads();
                if (wave == 0) { unsigned* hcnt = (unsigned*)(ws + WS_SUCNT) + layer * 64 + 16; unsigned spins = 0;
                    while ((unsigned)__builtin_amdgcn_readfirstlane(__hip_atomic_load(hcnt, __ATOMIC_RELAXED, __HIP_MEMORY_SCOPE_AGENT)) < 1024u) { __builtin_amdgcn_s_sleep(4); if (++spins > (1u << 22)) break; }
                    __builtin_amdgcn_fence(__ATOMIC_ACQUIRE, "agent"); asm volatile("s_waitcnt vmcnt(0)" ::: "memory"); }
                __syncthreads();
            }
            if (EN(2) && G != 256) REPS(2) for (int it = gw; it < 2048; it += NGW) s5_item<false>(pa, lds, layer, it, wave, lane);
            RELAUNDER();
            if (EN(3)) REPS(3) for (int v = vcu; v < 256; v += G) hgrn_pair<false>(pa, lds, layer, v >> 5, v & 31, wave, lane);
            xcd_barrier(bar);
            unsigned* scnt = (unsigned*)(ws + WS_SCNT) + layer * 64;
            { unsigned ndone = 0;
              if (wave < 2) { for (int t2 = wave * G + vcu; t2 < 512; t2 += 2 * G) { hgrn_scan(pa, t2, lane); ++ndone; } }
              else if (wave == 2) { for (int t2 = vcu; t2 < 32; t2 += G) { s5_scan(pa, layer, t2, lane); ++ndone; } }
              if (ndone) { asm volatile("s_waitcnt vmcnt(0)" ::: "memory"); if (lane == 0) (void)__hip_atomic_fetch_add(scnt, ndone, __ATOMIC_RELAXED, __HIP_MEMORY_SCOPE_AGENT); } }
            __syncthreads();
            const attn_body::AttnTensors AT{(const attn_body::bf16*)PROJ, (const attn_body::bf16*)PROJ, (const attn_body::bf16*)PROJ, (attn_body::bf16*)(ws + WS_O)};
            if (EN(4)) REPS(4) for (int v = vcu; v < 256; v += G) { const attn_body::StaticOrder S(v); attn_body::attn_phase<attn_body::StaticOrder>((char*)lds_raw, AT, S); }
        }
        ++ph; RELAUNDER();
        if (IN(ph)) {
            __syncthreads();
            if (wave == 0) { unsigned* scnt = (unsigned*)(ws + WS_SCNT) + layer * 64; unsigned spins = 0;
                while ((unsigned)__builtin_amdgcn_readfirstlane(__hip_atomic_load(scnt, __ATOMIC_RELAXED, __HIP_MEMORY_SCOPE_AGENT)) < 544u) { __builtin_amdgcn_s_sleep(4); if (++spins > (1u << 22)) break; }
                __builtin_amdgcn_fence(__ATOMIC_ACQUIRE, "agent"); asm volatile("s_waitcnt vmcnt(0)" ::: "memory"); }
            __syncthreads();
            if (EN(5)) REPS(5) for (int it = gw; it < 2048; it += NGW) s5_item<true>(pa, lds, layer, it, wave, lane);
            RELAUNDER();
            if (EN(6)) REPS(6) for (int v = vcu; v < 256; v += G) { const int bh = v >> 5, s = v & 31; const HRaw r1 = hgrn_load<true>(pa, bh, s, wave, lane), r2 = hgrn_load<true>(pa, bh, 63 - s, wave, lane); hgrn_item2<true>(pa, lds, layer, bh, s, wave, lane, r1); hgrn_item2<true>(pa, lds, layer, bh, 63 - s, wave, lane, r2); }
        }
        SEAM();
        const int cb0 = (G > 64) ? 64 : 0;
        if (IN(ph) && bx >= cb0) {
            const float l1 = wave_sum(pa.in[16][layer * 64 + lane] * pa.in[17][layer * 64 + lane]), l2 = wave_sum(pa.in[18][layer * 64 + lane] * pa.in[19][layer * 64 + lane]);
            const float linit = (layer == 0) ? 0.2f : 0.35550906759096934f;
            const float lam = __expf(l1) - __expf(l2) + linit;
            if (EN(7)) REPS(7) { const int nw_ = (G - cb0) * NWAVES; int m = (bx - cb0) * NWAVES + wave;
                for (; m + 3 * nw_ < M; m += 4 * nw_) combine_rows<4>(pa, layer, lam, 1.f - linit, (size_t)m, (size_t)nw_, lane);
                for (; m < M; m += nw_) combine_rows<1>(pa, layer, lam, 1.f - linit, (size_t)m, 0, lane); }
        }
        if (IN(ph) && EN(8) && (bx < 64 || G <= 64)) REPS(8) {
            __syncthreads();
            int kglu = 256; asm volatile("" : "+s"(kglu));
            pg8::Gemm g{(const bf16*)(ws + WS_YG), (const bf16*)(ws + WS_GLU) + (size_t)layer * 65536, M, 256, kglu}; pg8::StaticOrder S; S.init(M, 256, G, bx);
            pg8::EpiGlu E{(const bf16*)(ws + WS_YGS), pa.in[15] + layer * 256, MIX};
            pg8::gemm_phase<pg8::EpiGlu, pg8::StaticOrder, PG8_ALIGN, PG8_SP2>(lds, g, S, E);
        }
        SEAM();
        if (IN(ph) && EN(9)) for (int rep_ = 0; rep_ < 1 + (((MK_REP >> 9) & 1) && layer == 0); ++rep_) {
            pg8::Gemm g{MIX, (const bf16*)(ws + WS_WOUT) + (size_t)layer * D * D, M, D, D}; pg8::StaticOrder S; S.init(M, D, G, bx);
            if (layer + 1 < DEPTH) { pg8::EpiRes<true> E{layer == 0 ? pa.in[0] : pa.out, pa.out, (float*)(ws + WS_ROWSS), pa.in[1] + (layer + 1) * D, XN};
                pg8::gemm_phase<pg8::EpiRes<true>, pg8::StaticOrder, PG8_ALIGN, PG8_SP2>(lds, g, S, E); }
            else if (G == 256) { pg8::EpiResFinal E{layer == 0 ? pa.in[0] : pa.out, pa.out, (float*)(ws + WS_ROWSS2), (unsigned*)(ws + WS_PCNT), pa.in[21]};
                pg8::gemm_phase<pg8::EpiResFinal, pg8::StaticOrder, false, PG8_SP2>(lds, g, S, E); }
            else { pg8::EpiRes<false> E{layer == 0 ? pa.in[0] : pa.out, pa.out, nullptr, nullptr, nullptr};
                pg8::gemm_phase<pg8::EpiRes<false>, pg8::StaticOrder, PG8_ALIGN, PG8_SP2>(lds, g, S, E); }
        }
        if (layer + 1 < DEPTH) { SEAM(); continue; }
        if (G == 256) break;
        SEAM();
        if (IN(ph)) {
            for (int m = gw; m < M; m += NGW) rms_row<true>(pa.out + (size_t)m * D, pa.in[21], nullptr, pa.out + (size_t)m * D, lane);
        }
    }
#undef IN
#undef SEAM
}
constexpr int N_PHASES = 1 + DEPTH * 5 + 1;

#ifndef MK_SPLIT
#define MK_SPLIT 0
#endif
extern "C" void kernel_launch(void* const* d_in, const int* in_sizes, int n_in, void* d_out, int out_size, void* d_ws, size_t ws_size, hipStream_t stream) {
    static int grid = 0;
    if (grid == 0) {
        if (n_in != 22 || in_sizes[0] != M * D || out_size != M * D || ws_size < WS_END) { fprintf(stderr, "kernel_launch: unexpected shapes (n_in %d, in0 %d, out %d, ws %zu)\n", n_in, n_in > 0 ? in_sizes[0] : -1, out_size, ws_size); grid = -1; return; }
        int dev = 0, cus = 0, per_cu = 0;
        hipGetDevice(&dev); hipDeviceGetAttribute(&cus, hipDeviceAttributeMultiprocessorCount, dev);
        hipFuncSetAttribute((const void*)hymba_fwd, hipFuncAttributeMaxDynamicSharedMemorySize, LDS_BYTES);
        hipOccupancyMaxActiveBlocksPerMultiprocessor(&per_cu, (const void*)hymba_fwd, NWAVES * 64, LDS_BYTES);
        (void)hipGetLastError();
        if (per_cu < 1) per_cu = 1;
        grid = cus * per_cu; if (grid > 256) grid = 256;
        fprintf(stderr, "kernel_launch: cus %d per_cu %d grid %d\n", cus, per_cu, grid);
    }
    if (grid < 0) return;
    Args a{};
    for (int i = 0; i < 22; ++i) a.in[i] = (const float*)d_in[i];
    a.out = (float*)d_out; a.ws = (unsigned char*)d_ws;
#if MK_SPLIT
    for (int p = 0; p < N_PHASES; ++p) { a.ph_lo = p; a.ph_hi = p + 1; hipLaunchKernelGGL(hymba_fwd, dim3(grid), dim3(NWAVES * 64), LDS_BYTES, stream, a); }
#else
    a.ph_lo = 0; a.ph_hi = N_PHASES;
    (void)hipMemsetAsync((char*)d_ws + WS_CTL, 0, 16384, stream);
    void* kargs[] = {&a};
    hipError_t e = hipLaunchCooperativeKernel((const void*)hymba_fwd, dim3(grid), dim3(NWAVES * 64), kargs, LDS_BYTES, stream);
    if (e != hipSuccess) fprintf(stderr, "cooperative launch failed: %s (grid %d)\n", hipGetErrorString(e), grid);
#endif
}
```

```cpp
#include <hip/hip_runtime.h>
#include <hip/hip_cooperative_groups.h>
#include <cstdio>
#include <cstdint>
namespace pg8 {
#define PG8_LAS __attribute__((address_space(3)))
typedef unsigned short bf16_t;
typedef short bf16x8 __attribute__((ext_vector_type(8)));
typedef float f32x4 __attribute__((ext_vector_type(4)));
typedef unsigned u32x4 __attribute__((ext_vector_type(4)));
constexpr int BM = 256, BK = 64, HALF = 128, HTB = HALF * BK * 2  , STAGE_BYTES = 8 * HTB, NXCD = 8, WGM = 8;

__host__ __device__ __forceinline__ int lds_byte(int r, int c) { const int st = (r >> 4) * 2 + (c >> 5), rr = r & 15, cc = c & 31, ob = rr * 64 + cc * 2; return st * 1024 + (ob ^ (((ob >> 9) & 1) << 5)); }
__host__ __device__ __forceinline__ void stage_rc(int b, int& R, int& C) { const int st = b / 1024, sb = b % 1024, swz = sb ^ (((sb >> 9) & 1) << 5); R = (st >> 1) * 16 + swz / 64; C = (st & 1) * 32 + (swz % 64) / 2; }
__host__ __device__ __forceinline__ int perm32(int rho) { const int n = rho >> 4, i = rho & 15; return 8 * (i >> 2) + 4 * n + (i & 3); }

struct Unit { int pm, pn; };
struct Gemm { const bf16_t* A; const bf16_t* Bt; int M, N, K; };

struct StaticOrder {
    int nM, nN, nwg, G, c;
    __host__ __device__ void init(int M, int N, int G_, int c_) { nM = M / BM; nN = N / BM; nwg = nM * nN; G = G_; c = c_; }
    __host__ __device__ bool next(int i, Unit& u) const {
        const long L = (long)i * G + c; if (L >= nwg) return false;
        int wgid = (int)L; { const int q = nwg / NXCD, r = nwg % NXCD, xcd = wgid % NXCD, off = wgid / NXCD; wgid = (xcd < r ? xcd * (q + 1) : r * (q + 1) + (xcd - r) * q) + off; }
        const int nig = WGM * nN, gid = wgid / nig, fm = gid * WGM, gsz = (nM - fm) < WGM ? (nM - fm) : WGM;
        u.pm = fm + ((wgid % nig) % gsz); u.pn = (wgid % nig) / gsz; return true;
    }
    __device__ __forceinline__ void a_ready(const Unit&) const {}
    __device__ __forceinline__ void done(const Unit&) const {}
};

__device__ __forceinline__ unsigned cvt_pk_bf16(float lo, float hi) { unsigned r; asm volatile("v_cvt_pk_bf16_f32 %0, %1, %2" : "=v"(r) : "v"(lo), "v"(hi)); return r; }
typedef float f32x2 __attribute__((ext_vector_type(2)));
__device__ __forceinline__ f32x2 gelu_pk(f32x2 v) {
    const f32x2 av = __builtin_elementwise_abs(v), d = av * 0.2316418882f + 1.0f;
    f32x2 t; t.x = __builtin_amdgcn_rcpf(d.x); t.y = __builtin_amdgcn_rcpf(d.y);
    f32x2 q = t * 0.5307027145f + (-0.7265760135f); q = q * t + 0.7107068705f; q = q * t + (-0.142248368f); q = q * t + 0.127414796f; q = q * t;
    const f32x2 s = (v * v) * (-0.72134752044f);
    f32x2 e; e.x = __builtin_amdgcn_exp2f(s.x); e.y = __builtin_amdgcn_exp2f(s.y);
    const f32x2 m = v * (q * e), r = v - m;
    f32x2 o; o.x = v.x < 0.f ? m.x : r.x; o.y = v.y < 0.f ? m.y : r.y; return o;
}

template <int ACT  > struct EpiBf16 {
    static constexpr bool PERM = true, AFTER_DRAIN = false; static_assert(ACT == 0 || ACT == 1, "EpiBf16: ACT is 0 (none) or 1 (gelu_pk)");
    bf16_t* O; int ldc; const float* bias; int split_cols; size_t split_stride; float scale0;
    __device__ __forceinline__ void operator()(const f32x4 (&acc)[2][2][4][2], const Unit& u, int wr, int wc, int fr, int fq) const {
        const int row0 = u.pm * BM + wr * 64 + fr; int colt = u.pn * BM; bf16_t* base = O;
        float sc = 1.f; if (split_cols) { const int t = colt / split_cols; base += (size_t)t * split_stride; colt -= t * split_cols; if (t == 0) sc = scale0; }
        const int col0 = colt + wc * 32 + 8 * fq, bcol0 = u.pn * BM + wc * 32 + 8 * fq;
        f32x4 bv[2][2];
#pragma unroll
        for (int bj = 0; bj < 2; ++bj)
#pragma unroll
            for (int n = 0; n < 2; ++n) bv[bj][n] = bias ? *(const f32x4*)(bias + bcol0 + bj * HALF + 4 * n) : (f32x4){0.f, 0.f, 0.f, 0.f};
#pragma unroll
        for (int ai = 0; ai < 2; ++ai)
#pragma unroll
            for (int m = 0; m < 4; ++m) { bf16_t* rowp = base + (size_t)(row0 + ai * HALF + m * 16) * ldc + col0;
#pragma unroll
                for (int bj = 0; bj < 2; ++bj) { f32x4 v0 = acc[ai][bj][m][0] + bv[bj][0], v1 = acc[ai][bj][m][1] + bv[bj][1];
                    if (ACT == 1) { f32x2 a = gelu_pk((f32x2){v0[0], v0[1]}), b = gelu_pk((f32x2){v0[2], v0[3]}), c = gelu_pk((f32x2){v1[0], v1[1]}), d = gelu_pk((f32x2){v1[2], v1[3]});
                        v0 = (f32x4){a.x, a.y, b.x, b.y}; v1 = (f32x4){c.x, c.y, d.x, d.y}; }
                    v0 = v0 * sc; v1 = v1 * sc; u32x4 w; w.x = cvt_pk_bf16(v0[0], v0[1]); w.y = cvt_pk_bf16(v0[2], v0[3]); w.z = cvt_pk_bf16(v1[0], v1[1]); w.w = cvt_pk_bf16(v1[2], v1[3]);
                    *(u32x4*)(rowp + bj * HALF) = w; } }
    }
};
__device__ __forceinline__ float bf2f(unsigned short h) { return __uint_as_float(((unsigned)h) << 16); }
#define WT_RSRC(base, bytes) __builtin_amdgcn_make_buffer_rsrc((void*)(base), 0, (int)(bytes), 0x00020000)
#define WT_ST16(rsrc, byteoff, v) __builtin_amdgcn_raw_buffer_store_b128((v), (rsrc), (unsigned)(byteoff), 0, 16)
__device__ __forceinline__ float sigm(float v) { return __builtin_amdgcn_rcpf(1.0f + __builtin_amdgcn_exp2f(-1.4426950408889634f * v)); }
struct EpiInProj {
    static constexpr bool PERM = true, AFTER_DRAIN = false;
    bf16_t* O; const float* rope; float qscale; const float* rowss; unsigned* sucnt;
    __device__ __forceinline__ void operator()(const f32x4 (&acc)[2][2][4][2], const Unit& u, int wr, int wc, int fr, int fq) const {
        const int row0 = u.pm * BM + wr * 64 + fr, col0 = u.pn * BM + wc * 32 + 8 * fq;
        const bool ropewave = (u.pn >= 6 && u.pn < 10) && ((wc & 1) == 0);
        const float sc = (u.pn == 6 || u.pn == 7) ? qscale : 1.f;
        const float sgn = (fq == 0) ? -1.f : 1.f;
        const bool pub = (u.pn == 4);
        const __amdgpu_buffer_rsrc_t orsrc = WT_RSRC(O, 16384u * 3584u * 2u);
#pragma unroll
        for (int ai = 0; ai < 2; ++ai)
#pragma unroll
            for (int m = 0; m < 4; ++m) {
                const int row = row0 + ai * HALF + m * 16;
                bf16_t* rowp = O + (size_t)row * 3584 + col0;
                const float scr = rowss ? sc * __builtin_amdgcn_rsqf(rowss[row] * (1.0f / 1024.0f) + 1e-6f) : sc;
                f32x4 cs[4];
                if (ropewave) { const float* rp = rope + (size_t)(row & 8191) * 16;
#pragma unroll
                    for (int k = 0; k < 4; ++k) cs[k] = *(const f32x4*)(rp + 4 * k); }
#pragma unroll
                for (int bj = 0; bj < 2; ++bj) {
                    f32x4 v0 = acc[ai][bj][m][0], v1 = acc[ai][bj][m][1];
                    if (ropewave) {
                        float v[8] = {v0[0], v0[1], v0[2], v0[3], v1[0], v1[1], v1[2], v1[3]};
#pragma unroll
                        for (int j = 0; j < 8; ++j) {
                            const float p = __shfl_xor(v[j], 16);
                            const float c = cs[j >> 1][(j & 1) * 2], s = cs[j >> 1][(j & 1) * 2 + 1];
                            const float nv = v[j] * c + sgn * p * s;
                            v[j] = (fq < 2) ? nv : v[j];
                        }
                        v0 = (f32x4){v[0], v[1], v[2], v[3]}; v1 = (f32x4){v[4], v[5], v[6], v[7]};
                    }
                    v0 = v0 * scr; v1 = v1 * scr;
                    u32x4 w; w.x = cvt_pk_bf16(v0[0], v0[1]); w.y = cvt_pk_bf16(v0[2], v0[3]); w.z = cvt_pk_bf16(v1[0], v1[1]); w.w = cvt_pk_bf16(v1[2], v1[3]);
                    if (pub) WT_ST16(orsrc, ((size_t)row * 3584 + col0 + bj * HALF) * 2, w); else *(u32x4*)(rowp + bj * HALF) = w;
                }
                asm volatile("" ::: "memory");
            }
        if (pub) { asm volatile("s_waitcnt vmcnt(0)" ::: "memory"); if (fr == 0 && fq == 0) (void)__hip_atomic_fetch_add(sucnt, 1u, __ATOMIC_RELAXED, __HIP_MEMORY_SCOPE_AGENT); }
    }
};
template <bool NEXT> struct EpiRes {
    static constexpr bool PERM = false, AFTER_DRAIN = false;
    const float* base; float* out; float* rowss; const bf16_t* baseh; bf16_t* XN;
    __device__ __forceinline__ void operator()(const f32x4 (&acc)[2][2][4][2], const Unit& u, int wr, int wc, int fr, int fq) const {
        typedef unsigned u32x2 __attribute__((ext_vector_type(2)));
        const int col0 = u.pn * BM + wc * 32 + 4 * fq;
#pragma unroll
        for (int ai = 0; ai < 2; ++ai)
#pragma unroll
            for (int m = 0; m < 4; ++m) {
                const int row = u.pm * BM + ai * HALF + wr * 64 + m * 16 + fr;
                const size_t off = (size_t)row * 1024 + col0;
                float ss = 0.f;
#pragma unroll
                for (int bj = 0; bj < 2; ++bj)
#pragma unroll
                    for (int n = 0; n < 2; ++n) {
                        f32x4 bs;
                        if (NEXT) bs = *(const f32x4*)(base + off + bj * HALF + n * 16);
                        else { const u32x2 hb = *(const u32x2*)(baseh + off + bj * HALF + n * 16); bs = (f32x4){__uint_as_float(hb.x << 16), __uint_as_float(hb.x & 0xffff0000u), __uint_as_float(hb.y << 16), __uint_as_float(hb.y & 0xffff0000u)}; }
                        const f32x4 o = bs + acc[ai][bj][m][n];
                        if (NEXT) { ss += (o[0] * o[0] + o[1] * o[1]) + (o[2] * o[2] + o[3] * o[3]);
                            u32x2 w; w.x = cvt_pk_bf16(o[0], o[1]); w.y = cvt_pk_bf16(o[2], o[3]); *(u32x2*)(XN + off + bj * HALF + n * 16) = w; }
                        else *(f32x4*)(out + off + bj * HALF + n * 16) = o;
                    }
                if (NEXT) { ss += __shfl_xor(ss, 16); ss += __shfl_xor(ss, 32); if (fq == 0) atomicAdd(rowss + row, ss); }
                if (m & 1) asm volatile("" ::: "memory");
            }
    }
};
struct EpiResFinal {
    static constexpr bool PERM = false, AFTER_DRAIN = true;
    const bf16_t* baseh; float* out; float* rowss2; unsigned* cnt; const float* fw;
    __device__ __forceinline__ void operator()(const f32x4 (&)[2][2][4][2], const Unit&, int, int, int, int) const {}
    __device__ __forceinline__ void fused(f32x4 (&acc)[2][2][4][2], const Unit& u, int wr, int wc, int fr, int fq, PG8_LAS unsigned char*, int wid, int lane) const {
        typedef unsigned u32x2 __attribute__((ext_vector_type(2)));
        const int col0 = u.pn * BM + wc * 32 + 4 * fq;
#pragma unroll
        for (int ai = 0; ai < 2; ++ai)
#pragma unroll
            for (int m = 0; m < 4; ++m) {
                const int row = u.pm * BM + ai * HALF + wr * 64 + m * 16 + fr;
                const size_t off = (size_t)row * 1024 + col0;
                float ss = 0.f;
#pragma unroll
                for (int bj = 0; bj < 2; ++bj)
#pragma unroll
                    for (int n = 0; n < 2; ++n) { const u32x2 hb = *(const u32x2*)(baseh + off + bj * HALF + n * 16);
                        const f32x4 o = (f32x4){__uint_as_float(hb.x << 16), __uint_as_float(hb.x & 0xffff0000u), __uint_as_float(hb.y << 16), __uint_as_float(hb.y & 0xffff0000u)} + acc[ai][bj][m][n]; acc[ai][bj][m][n] = o;
                        ss += (o[0] * o[0] + o[1] * o[1]) + (o[2] * o[2] + o[3] * o[3]); }
                ss += __shfl_xor(ss, 16); ss += __shfl_xor(ss, 32);
                if (fq == 0) (void)__hip_atomic_fetch_add(rowss2 + row, ss, __ATOMIC_RELAXED, __HIP_MEMORY_SCOPE_AGENT);
                if (m & 1) asm volatile("" ::: "memory");
            }
        asm volatile("s_waitcnt vmcnt(0)" ::: "memory");
        __builtin_amdgcn_s_barrier(); asm volatile("" ::: "memory");
        if (wid == 0) {
            if (lane == 0) (void)__hip_atomic_fetch_add(cnt + u.pm, 1u, __ATOMIC_RELAXED, __HIP_MEMORY_SCOPE_AGENT);
            unsigned spins = 0;
            while ((unsigned)__builtin_amdgcn_readfirstlane(__hip_atomic_load(cnt + u.pm, __ATOMIC_RELAXED, __HIP_MEMORY_SCOPE_AGENT)) < 4u) { __builtin_amdgcn_s_sleep(4); if (++spins > (1u << 20)) break; }
            __builtin_amdgcn_fence(__ATOMIC_ACQUIRE, "agent");
            asm volatile("s_waitcnt vmcnt(0)" ::: "memory");
        }
        __builtin_amdgcn_s_barrier(); asm volatile("" ::: "memory");
        f32x4 wv[2][2];
#pragma unroll
        for (int bj = 0; bj < 2; ++bj)
#pragma unroll
            for (int n = 0; n < 2; ++n) wv[bj][n] = *(const f32x4*)(fw + col0 + bj * HALF + n * 16);
#pragma unroll
        for (int ai = 0; ai < 2; ++ai)
#pragma unroll
            for (int m = 0; m < 4; ++m) {
                const int row = u.pm * BM + ai * HALF + wr * 64 + m * 16 + fr;
                const size_t off = (size_t)row * 1024 + col0;
                const float rs = __builtin_amdgcn_rsqf(__hip_atomic_load(rowss2 + row, __ATOMIC_RELAXED, __HIP_MEMORY_SCOPE_AGENT) * (1.0f / 1024.0f) + 1e-6f);
#pragma unroll
                for (int bj = 0; bj < 2; ++bj)
#pragma unroll
                    for (int n = 0; n < 2; ++n) *(f32x4*)(out + off + bj * HALF + n * 16) = acc[ai][bj][m][n] * rs * wv[bj][n];
            }
    }
};
struct EpiGlu {
    static constexpr bool PERM = true, AFTER_DRAIN = false;
    const bf16_t* YGS; const float* bias; bf16_t* MIX;
    __device__ __forceinline__ void operator()(const f32x4 (&acc)[2][2][4][2], const Unit& u, int wr, int wc, int fr, int fq) const {
        typedef unsigned u32x2 __attribute__((ext_vector_type(2)));
        const int row0 = u.pm * BM + wr * 64 + fr, col0 = wc * 32 + 8 * fq;
#pragma unroll
        for (int bj = 0; bj < 2; ++bj)
#pragma unroll
            for (int n = 0; n < 2; ++n) {
                const int c = col0 + bj * HALF + 4 * n;
                const f32x4 bv = *(const f32x4*)(bias + c);
#pragma unroll
                for (int ai = 0; ai < 2; ++ai)
#pragma unroll
                    for (int m = 0; m < 4; ++m) {
                        const size_t row = (size_t)(row0 + ai * HALF + m * 16);
                        const f32x4 v = acc[ai][bj][m][n] + bv;
                        const u32x2 yv = *(const u32x2*)(YGS + row * 256 + c);
                        const float y0 = __uint_as_float(yv.x << 16), y1 = __uint_as_float(yv.x & 0xffff0000u), y2 = __uint_as_float(yv.y << 16), y3 = __uint_as_float(yv.y & 0xffff0000u);
                        u32x2 w; w.x = cvt_pk_bf16(y0 * sigm(v[0]), y1 * sigm(v[1])); w.y = cvt_pk_bf16(y2 * sigm(v[2]), y3 * sigm(v[3]));
                        *(u32x2*)(MIX + row * 1024 + 256 + c) = w;
                        if (m & 1) asm volatile("" ::: "memory");
                    }
            }
    }
};
template <class Epi, class Sched, bool ALIGN_EPI = false, bool SP2 = false>
__device__ __forceinline__ void gemm_phase(PG8_LAS unsigned char* lds, const Gemm g, const Sched& S, const Epi& E) {
    int tid_l = threadIdx.x; asm volatile("" : "+v"(tid_l));
    const int tid = tid_l, wid = __builtin_amdgcn_readfirstlane(tid >> 6), lane = tid & 63, wr = wid >> 2, wc = wid & 3, fr = lane & 15, fq = lane >> 4;
    const int K = g.K, nt = K / BK;
    unsigned voffA[2], voffB[2];
#pragma unroll
    for (int i = 0; i < 2; ++i) { int R, C; stage_rc(tid * 16 + i * 8192, R, C); const int Rb = Epi::PERM ? ((R & ~31) + perm32(R & 31)) : R;
        voffA[i] = (unsigned)(R * K + C) * 2u; voffB[i] = (unsigned)(Rb * K + C) * 2u; }
    const size_t kstep = (size_t)(BK * 2);
    const size_t hstep = (size_t)HALF * K * 2;
    const size_t tstep = 2 * hstep;
    const unsigned ldsw = (unsigned)wid * 1024u;
    const int aoff = lds_byte(wr * 64 + fr, fq * 8), boff = lds_byte(wc * 32 + fr, fq * 8);
#define PG8_SA(b, h) (((b) * 2 + (h)) * HTB)
#define PG8_SB(b, h) ((4 + (b) * 2 + (h)) * HTB)
#define PG8_STAGE(bufoff, gbase, voff) do { _Pragma("unroll") for (int _i = 0; _i < 2; ++_i) \
        __builtin_amdgcn_global_load_lds((const unsigned*)((const char*)(gbase) + (voff)[_i]), (PG8_LAS unsigned*)(lds + (bufoff) + ldsw + _i * 8192), 16, 0, 0); } while (0)
#define PG8_LDA(dst, b, h) do { _Pragma("unroll") for (int m = 0; m < 4; ++m) _Pragma("unroll") for (int k = 0; k < 2; ++k) dst[m][k] = *(const PG8_LAS bf16x8*)(lds + PG8_SA(b, h) + aoff + m * 2048 + k * 1024); } while (0)
#define PG8_LDB(dst, b, h) do { _Pragma("unroll") for (int n = 0; n < 2; ++n) _Pragma("unroll") for (int k = 0; k < 2; ++k) dst[n][k] = *(const PG8_LAS bf16x8*)(lds + PG8_SB(b, h) + boff + n * 2048 + k * 1024); } while (0)
#define PG8_MMA(ai, bj, At, Bt) do { __builtin_amdgcn_s_setprio(1); _Pragma("unroll") for (int m = 0; m < 4; ++m) _Pragma("unroll") for (int n = 0; n < 2; ++n) _Pragma("unroll") for (int k = 0; k < 2; ++k) \
        acc[ai][bj][m][n] = __builtin_amdgcn_mfma_f32_16x16x32_bf16(Bt[n][k], At[m][k], acc[ai][bj][m][n], 0, 0, 0); __builtin_amdgcn_s_setprio(0); } while (0)
#define PG8_WAIT_V(n) asm volatile("s_waitcnt vmcnt(" #n ")" ::: "memory")
#define PG8_WAIT_L(n) asm volatile("s_waitcnt lgkmcnt(" #n ")" ::: "memory")
#define PG8_BAR __builtin_amdgcn_s_barrier()
#define PG8_SCHED __builtin_amdgcn_sched_barrier(0)
    Unit cur, nxt; int ui = 0;
    if (!S.next(0, cur)) return;
    f32x4 acc[2][2][4][2];
#pragma unroll
    for (int a = 0; a < 2; ++a)
#pragma unroll
        for (int b = 0; b < 2; ++b)
#pragma unroll
            for (int m = 0; m < 4; ++m)
#pragma unroll
                for (int n = 0; n < 2; ++n) acc[a][b][m][n] = (f32x4){0.f, 0.f, 0.f, 0.f};
    bf16x8 At[4][2], B0[2][2], B1[2][2];
    const char* cA = (const char*)g.A + (size_t)cur.pm * tstep; const char* cB = (const char*)g.Bt + (size_t)cur.pn * tstep;
    S.a_ready(cur);
    if constexpr (SP2) {
        PG8_STAGE(PG8_SB(0, 0), cB, voffB); PG8_STAGE(PG8_SB(0, 1), cB + hstep, voffB); PG8_STAGE(PG8_SA(0, 0), cA, voffA); PG8_STAGE(PG8_SA(0, 1), cA + hstep, voffA);
        if (wr == 1) PG8_BAR;
        PG8_WAIT_V(2); PG8_BAR;
        PG8_STAGE(PG8_SB(1, 0), cB + kstep, voffB); PG8_STAGE(PG8_SA(1, 0), cA + kstep, voffA); PG8_STAGE(PG8_SB(1, 1), cB + hstep + kstep, voffB);
        PG8_WAIT_V(6); PG8_BAR;
    } else {
        PG8_STAGE(PG8_SB(0, 0), cB, voffB); PG8_STAGE(PG8_SA(0, 0), cA, voffA); PG8_STAGE(PG8_SB(0, 1), cB + hstep, voffB); PG8_STAGE(PG8_SA(0, 1), cA + hstep, voffA);
        if (wr == 1) PG8_BAR;
        PG8_WAIT_V(4); PG8_BAR;
        PG8_STAGE(PG8_SB(1, 0), cB + kstep, voffB); PG8_STAGE(PG8_SA(1, 0), cA + kstep, voffA); PG8_STAGE(PG8_SB(1, 1), cB + hstep + kstep, voffB);
        PG8_WAIT_V(6); PG8_BAR;
    }
    for (;;) {
        const bool has_next = S.next(ui + 1, nxt);
        const char* nA = has_next ? (const char*)g.A + (size_t)nxt.pm * tstep : cA; const char* nB = has_next ? (const char*)g.Bt + (size_t)nxt.pn * tstep : cB;
        for (int t = 0; t < nt; t += 2) {
            const bool last = (t == nt - 2);
            const char* a1 = cA + (size_t)(t + 1) * kstep;
            const char* a2 = last ? nA : cA + (size_t)(t + 2) * kstep; const char* b2 = last ? nB : cB + (size_t)(t + 2) * kstep;
            const char* a3 = a2 + kstep; const char* b3 = b2 + kstep;
            if (last && has_next) S.a_ready(nxt);
            if constexpr (SP2) {
            PG8_LDB(B0, 0, 0); PG8_LDB(B1, 0, 1); PG8_SCHED; PG8_LDA(At, 0, 0); PG8_STAGE(PG8_SA(1, 1), a1 + hstep, voffA);
            PG8_WAIT_V(8); PG8_WAIT_L(0); PG8_BAR; PG8_MMA(0, 0, At, B0); PG8_MMA(0, 1, At, B1); PG8_BAR; PG8_SCHED;
            PG8_LDA(At, 0, 1); PG8_STAGE(PG8_SB(0, 0), b2, voffB); PG8_STAGE(PG8_SB(0, 1), b2 + hstep, voffB); PG8_STAGE(PG8_SA(0, 0), a2, voffA);
            PG8_WAIT_V(8); PG8_WAIT_L(0); PG8_BAR; PG8_MMA(1, 0, At, B0); PG8_MMA(1, 1, At, B1); PG8_BAR; PG8_SCHED;
            PG8_LDB(B0, 1, 0); PG8_LDB(B1, 1, 1); PG8_SCHED; PG8_LDA(At, 1, 0); PG8_STAGE(PG8_SA(0, 1), a2 + hstep, voffA);
            PG8_WAIT_V(8); PG8_WAIT_L(0); PG8_BAR; PG8_MMA(0, 0, At, B0); PG8_MMA(0, 1, At, B1); PG8_BAR; PG8_SCHED;
            PG8_LDA(At, 1, 1); PG8_STAGE(PG8_SB(1, 0), b3, voffB); PG8_STAGE(PG8_SB(1, 1), b3 + hstep, voffB); PG8_STAGE(PG8_SA(1, 0), a3, voffA);
            PG8_WAIT_V(8); PG8_WAIT_L(0); PG8_BAR; PG8_MMA(1, 0, At, B0); PG8_MMA(1, 1, At, B1); PG8_BAR; PG8_SCHED;
            } else {
            PG8_LDB(B0, 0, 0); PG8_SCHED; PG8_LDA(At, 0, 0); PG8_STAGE(PG8_SA(1, 1), a1 + hstep, voffA);
            PG8_WAIT_L(8); PG8_BAR; PG8_WAIT_L(0); PG8_MMA(0, 0, At, B0); PG8_BAR; PG8_SCHED;
            PG8_LDB(B1, 0, 1); PG8_STAGE(PG8_SB(0, 0), b2, voffB);
            PG8_BAR; PG8_WAIT_L(0); PG8_MMA(0, 1, At, B1); PG8_BAR;
            PG8_LDA(At, 0, 1); PG8_STAGE(PG8_SA(0, 0), a2, voffA);
            PG8_BAR; PG8_WAIT_L(0); PG8_MMA(1, 0, At, B0); PG8_BAR; PG8_SCHED;
            PG8_STAGE(PG8_SB(0, 1), b2 + hstep, voffB);
            PG8_WAIT_V(6); PG8_BAR; PG8_MMA(1, 1, At, B1); PG8_BAR;
            PG8_LDB(B0, 1, 0); PG8_SCHED; PG8_LDA(At, 1, 0); PG8_STAGE(PG8_SA(0, 1), a2 + hstep, voffA);
            PG8_WAIT_L(8); PG8_BAR; PG8_WAIT_L(0); PG8_MMA(0, 0, At, B0); PG8_BAR; PG8_SCHED;
            PG8_LDB(B1, 1, 1); PG8_STAGE(PG8_SB(1, 0), b3, voffB);
            PG8_BAR; PG8_WAIT_L(0); PG8_MMA(0, 1, At, B1); PG8_BAR;
            PG8_LDA(At, 1, 1); PG8_STAGE(PG8_SA(1, 0), a3, voffA);
            PG8_BAR; PG8_WAIT_L(0); PG8_MMA(1, 0, At, B0); PG8_BAR; PG8_SCHED;
            PG8_STAGE(PG8_SB(1, 1), b3 + hstep, voffB);
            PG8_WAIT_V(6); PG8_BAR; PG8_MMA(1, 1, At, B1); PG8_BAR;
            }
        }
        if constexpr (ALIGN_EPI) { if (wr == 0) PG8_BAR; }
        if constexpr (!Epi::AFTER_DRAIN) { E(acc, cur, wr, wc, fr, fq); S.done(cur); }
        if (!has_next) break;
#pragma unroll
        for (int a = 0; a < 2; ++a)
#pragma unroll
            for (int b = 0; b < 2; ++b)
#pragma unroll
                for (int m = 0; m < 4; ++m)
#pragma unroll
                    for (int n = 0; n < 2; ++n) acc[a][b][m][n] = (f32x4){0.f, 0.f, 0.f, 0.f};
        cur = nxt; cA = nA; cB = nB; ++ui;
        if constexpr (ALIGN_EPI) { if (wr == 1) PG8_BAR; }
    }
    PG8_WAIT_V(0);
    if constexpr (!ALIGN_EPI) { if (wr == 0) PG8_BAR; }
    PG8_BAR;
    if constexpr (Epi::AFTER_DRAIN) { E.fused(acc, cur, wr, wc, fr, fq, lds, wid, lane); S.done(cur); }
#undef PG8_SA
#undef PG8_SB
#undef PG8_STAGE
#undef PG8_LDA
#undef PG8_LDB
#undef PG8_MMA
#undef PG8_WAIT_V
#undef PG8_WAIT_L
#undef PG8_BAR
#undef PG8_SCHED
}
}

#ifndef PG8_SP2
#define PG8_SP2 true
#endif
#ifndef PG8_ALIGN
#define PG8_ALIGN true
#endif
#include <hip/hip_bf16.h>
#include <cmath>
namespace attn_body {
using bf16=__hip_bfloat16;
using bf16x8=__attribute__((ext_vector_type(8)))short;
using s16x4=__attribute__((ext_vector_type(4)))short;
using f32x16=__attribute__((ext_vector_type(16)))float;
using u32x4=__attribute__((ext_vector_type(4)))unsigned;
constexpr int BATCH=2,NHEAD=16,SEQ=8192,D=64,DM=NHEAD*D;
constexpr int NW=8,QBLK=32,QB=QBLK*NW,KVBLK=64,NQB=SEQ/QB;
constexpr int ATTN_PITCH=DM, ATTN_UNIT_ROWS=QB;
constexpr int PQ=3584,QCOL=1536,KCOL=2048,VCOL=2560;
__device__ __forceinline__ int crow(int r,int hi){return (r&3)+8*(r>>2)+4*hi;}
#define SBAR() __builtin_amdgcn_sched_barrier(0)
__device__ __forceinline__ void cmask(f32x16&p0,f32x16&p1,int jb,int qrel,int hi){
  const float NEG=-INFINITY; int kb=64*jb+4*hi;
  #pragma unroll
  for(int r=0;r<16;++r){int kv=kb+(r&3)+8*(r>>2); if(kv>qrel)p0[r]=NEG; if(kv+32>qrel)p1[r]=NEG;}
}

constexpr int NSLOT=3, SLOTB=8192;
constexpr int LDS_K=0, LDS_V=NSLOT*SLOTB, LDS_WS=3*NSLOT*SLOTB, LDS_OST=LDS_WS+NW*64*4, LDS_BYTES=LDS_OST+NW*4096;
constexpr float C2=0.125f*1.4426950408889634f;
__device__ __forceinline__ void glds16(const void*gsrc,unsigned lds_dst){unsigned keep;
  asm volatile("s_mov_b32 %0, m0\n\ts_mov_b32 m0, %2\n\ts_nop 0\n\tglobal_load_lds_dwordx4 %1, off\n\ts_mov_b32 m0, %0":"=&s"(keep):"v"(gsrc),"s"(lds_dst):"memory");}
__device__ __forceinline__ float max3f(float a,float b,float c){float r;asm("v_max3_f32 %0, %1, %2, %3":"=v"(r):"v"(a),"v"(b),"v"(c));return r;}
__device__ __forceinline__ float max2f(float a,float b){float r;asm("v_max_f32_e32 %0, %1, %2":"=v"(r):"v"(a),"v"(b));return r;}
__device__ __forceinline__ float fadd_s(float a,float b){float r;asm("v_add_f32_e32 %0, %1, %2":"=v"(r):"v"(a),"v"(b));return r;}
__device__ __forceinline__ float fsub_s(float a,float b){float r;asm("v_sub_f32_e32 %0, %1, %2":"=v"(r):"v"(a),"v"(b));return r;}
typedef float f32x2_t __attribute__((ext_vector_type(2))); typedef __bf16 bf16x2_t __attribute__((ext_vector_type(2)));
__device__ __forceinline__ unsigned cvtpk_s(float lo,float hi){f32x2_t v={lo,hi};bf16x2_t b=__builtin_convertvector(v,bf16x2_t);return __builtin_bit_cast(unsigned,b);}
#define WAIT_BAR(N) asm volatile("s_waitcnt vmcnt(" #N ") lgkmcnt(0)\n\ts_barrier":::"memory")

__device__ __forceinline__ void qkt(f32x16&p0,f32x16&p1,const char*Kslot,const bf16x8*qr,const f32x16&negm,int r32,int hi){
  const char*kb=Kslot+hi*1024+r32*16;
  #pragma unroll
  for(int d0=0;d0<4;++d0){
    const bf16x8 b0=*reinterpret_cast<const bf16x8*>(kb+d0*2048);
    const bf16x8 b1=*reinterpret_cast<const bf16x8*>(kb+d0*2048+512);
    if(d0==0){p0=__builtin_amdgcn_mfma_f32_32x32x16_bf16(b0,qr[0],negm,0,0,0);p1=__builtin_amdgcn_mfma_f32_32x32x16_bf16(b1,qr[0],negm,0,0,0);}
    else{p0=__builtin_amdgcn_mfma_f32_32x32x16_bf16(b0,qr[d0],p0,0,0,0);p1=__builtin_amdgcn_mfma_f32_32x32x16_bf16(b1,qr[d0],p1,0,0,0);}}
}
typedef __attribute__((address_space(3))) const char* lds_cptr;
typedef short v4i16_t __attribute__((ext_vector_type(4)));
__device__ __forceinline__ void kload8(bf16x8*kf,lds_cptr kp){
  kf[0]=*(const __attribute__((address_space(3))) bf16x8*)(kp);      kf[1]=*(const __attribute__((address_space(3))) bf16x8*)(kp+512);
  kf[2]=*(const __attribute__((address_space(3))) bf16x8*)(kp+2048); kf[3]=*(const __attribute__((address_space(3))) bf16x8*)(kp+2560);
  kf[4]=*(const __attribute__((address_space(3))) bf16x8*)(kp+4096); kf[5]=*(const __attribute__((address_space(3))) bf16x8*)(kp+4608);
  kf[6]=*(const __attribute__((address_space(3))) bf16x8*)(kp+6144); kf[7]=*(const __attribute__((address_space(3))) bf16x8*)(kp+6656);
}
__device__ __forceinline__ void kload2(bf16x8*kf,lds_cptr kp,int j){ kf[2*j]=*(const __attribute__((address_space(3))) bf16x8*)(kp+j*2048); kf[2*j+1]=*(const __attribute__((address_space(3))) bf16x8*)(kp+j*2048+512); }
__device__ __forceinline__ s16x4 vtr(lds_cptr p){ return __builtin_bit_cast(s16x4,__builtin_amdgcn_ds_read_tr16_b64_v4i16((__attribute__((address_space(3))) v4i16_t*)p)); }
__device__ __forceinline__ float rowmax(const f32x16&p0,const f32x16&p1){
  float a=max3f(p0[0],p0[1],p1[0]),b=max3f(p0[2],p0[3],p1[1]);a=max3f(a,p1[2],p1[3]);
  #pragma unroll
  for(int r=4;r<16;r+=4){a=max3f(a,p0[r],p0[r+1]);b=max3f(b,p0[r+2],p0[r+3]);a=max3f(a,p1[r],p1[r+1]);b=max3f(b,p1[r+2],p1[r+3]);}
  const float m=max2f(a,b);
  auto rr=__builtin_amdgcn_permlane32_swap(__float_as_uint(m),__float_as_uint(m),false,false);
  return max2f(__uint_as_float(rr[0]),__uint_as_float(rr[1]));
}
__device__ __forceinline__ void pv(f32x16*o,int vb,bf16x8 pa0,bf16x8 pa1,bf16x8 pa2,bf16x8 pa3){
  #pragma unroll
  for(int d0=0;d0<2;++d0){s16x4 lo[4],hi[4];
    #pragma unroll
    for(int ks=0;ks<4;++ks){
      asm volatile("ds_read_b64_tr_b16 %0,%1 offset:%c2":"=&v"(lo[ks]):"v"(vb),"i"(d0*4096+ks*1024):"memory");
      asm volatile("ds_read_b64_tr_b16 %0,%1 offset:%c2":"=&v"(hi[ks]):"v"(vb),"i"(d0*4096+ks*1024+512):"memory");}
    asm volatile("s_waitcnt lgkmcnt(0)":::"memory");SBAR();
    #define PK(k) (bf16x8){lo[k][0],lo[k][1],lo[k][2],lo[k][3],hi[k][0],hi[k][1],hi[k][2],hi[k][3]}
    o[d0]=__builtin_amdgcn_mfma_f32_32x32x16_bf16(pa0,PK(0),o[d0],0,0,0);
    o[d0]=__builtin_amdgcn_mfma_f32_32x32x16_bf16(pa1,PK(1),o[d0],0,0,0);
    o[d0]=__builtin_amdgcn_mfma_f32_32x32x16_bf16(pa2,PK(2),o[d0],0,0,0);
    o[d0]=__builtin_amdgcn_mfma_f32_32x32x16_bf16(pa3,PK(3),o[d0],0,0,0);
    #undef PK
  }
}

#ifndef ATTN_STORE16
#define ATTN_STORE16(p,v) (*(u32x4*)(p)=(v))
#endif
template<int THRL> __device__ __forceinline__ void attn_unit(int b,int h,int qb,const bf16*Q,const bf16*__restrict__ K,const bf16*__restrict__ V,bf16*O,char*shm){
  int tid_l=threadIdx.x; asm volatile("":"+v"(tid_l)); const int tid=tid_l,lane=tid&63,r32=lane&31,hi=lane>>5; const int wid=__builtin_amdgcn_readfirstlane(tid>>6);
  const long rowbase=(long)b*SEQ; const int q0=qb*QB;
  const int hh_=h>>1,mm_=h&1; const bf16*Qw=Q+(rowbase+q0+wid*QBLK)*PQ+QCOL+hh_*128+mm_*64;
  const bf16*Kh=K+rowbase*PQ+KCOL+hh_*128+mm_*64,*Vh=V+rowbase*PQ+VCOL+hh_*128;
  const unsigned lds0=(unsigned)(uintptr_t)shm;
  float*wsf=(float*)(shm+LDS_WS)+wid*64;
  const bf16*ksrc=Kh+(long)lane*PQ+wid*8;
  const bf16*vsrc=Vh+(long)(16*(wid&3)+(lane>>2))*PQ+(wid>>2)*32+(lane&3)*8;
  const unsigned kdst=lds0+LDS_K+wid*1024, vdst=lds0+LDS_V+wid*1024;
  #define DMA_K(t,slot) glds16(ksrc+(long)(t)*KVBLK*PQ,(unsigned)__builtin_amdgcn_readfirstlane(kdst+(slot)))
  #define DMA_V(t,slot) do{ glds16(vsrc+(long)(t)*KVBLK*PQ,(unsigned)__builtin_amdgcn_readfirstlane(vdst+2*(slot))); glds16(vsrc+(long)(t)*KVBLK*PQ+64,(unsigned)__builtin_amdgcn_readfirstlane(vdst+2*(slot)+8192)); }while(0)
  const int vb0=(int)(lds0+LDS_V)+((lane>>4)&1)*32+(lane&3)*8+(4*hi+((lane&15)>>2))*64;
  const char*Kbase=shm+LDS_K; bf16x8 kf[8];
  const lds_cptr shm3=(lds_cptr)shm; const lds_cptr kp0=shm3+LDS_K+hi*1024+r32*16; const lds_cptr vp0=shm3+LDS_V+((lane>>4)&1)*32+(lane&3)*8+(4*hi+((lane&15)>>2))*64;
  const int NT=(q0+QB)/KVBLK;
  DMA_K(0,0);DMA_V(0,0);DMA_K(1,SLOTB);
  bf16x8 qr[4];
  #pragma unroll
  for(int d0=0;d0<4;++d0)qr[d0]=*reinterpret_cast<const bf16x8*>(&Qw[(long)r32*PQ+d0*16+hi*8]);
  float mhat=0.f,l_reg=0.f;f32x16 o[4];o[0]=f32x16{};o[1]=f32x16{};o[2]=f32x16{};o[3]=f32x16{};f32x16 negm=f32x16{};asm volatile("":"+v"(negm));
  const int qrel=wid*QBLK+r32;
  #define CMASK(P0,P1,t) do{int jb_=(t)-(NT-4); if(jb_>=0)cmask(P0,P1,jb_,qrel,hi);}while(0)
  bool resc=false;
  #define START(P0,P1) do{ const float rm=rowmax(P0,P1); resc=false; \
    { const float dl=rm; mhat=fadd_s(mhat,dl); \
      _Pragma("unroll") for(int r=0;r<16;++r){P0[r]=fsub_s(P0[r],dl);P1[r]=fsub_s(P1[r],dl);} \
      _Pragma("unroll") for(int r=0;r<16;++r)negm[r]=-mhat; asm volatile("":"+v"(negm)); } \
    _Pragma("unroll") for(int r=0;r<16;++r)P0[r]=__builtin_amdgcn_exp2f(P0[r]); }while(0)
  #define RESC() do{ if(resc){ asm volatile("s_waitcnt lgkmcnt(0)":::"memory"); \
      _Pragma("unroll") for(int d_=0;d_<4;++d_) _Pragma("unroll") for(int r=0;r<16;++r)o[d_][r]*=wsf[crow(r,hi)]; } }while(0)
  f32x16 pA0,pA1,pB0,pB1;
  int sl_prev=0,sl_cur=0,sl_next=SLOTB;
  #define ROT() do{sl_prev=sl_cur;sl_cur=sl_next;sl_next=(sl_next==(NSLOT-1)*SLOTB)?0:sl_next+SLOTB;}while(0)
  DMA_K(2,2*SLOTB);
  WAIT_BAR(3);
  qkt(pA0,pA1,Kbase,qr,negm,r32,hi);asm volatile("s_nop 15\n\ts_nop 7":"+v"(pA0),"+v"(pA1));CMASK(pA0,pA1,0);
  START(pA0,pA1);
  _Pragma("unroll") for(int r=0;r<16;++r)pA1[r]=__builtin_amdgcn_exp2f(pA1[r]);
  WAIT_BAR(0);
  DMA_K(3,0);DMA_V(1,SLOTB);
  ROT();
  kload8(kf,kp0+sl_cur);
  WAIT_BAR(3);
  s16x4 vlo[8],vhi[8],wlo[8],whi[8]; u32x4 pw0,pw1,pw2,pw3;
  #define PKW(P,B) cvtpk_s(P[B],P[B+1])
  #define PAF(k) __builtin_bit_cast(bf16x8,pw##k)
  #define VFR(i) (bf16x8){vlo[i][0],vlo[i][1],vlo[i][2],vlo[i][3],vhi[i][0],vhi[i][1],vhi[i][2],vhi[i][3]}
  #define PIN(x) asm volatile("":"+v"(x))
  #define MX3(a,b,c) __builtin_fmaxf(__builtin_fmaxf((a),(b)),(c))
  #define GAPA(MF,A0,A1,A2,A3,W0,W1,PW) do{ MF; sacc+=A0; sacc+=A1; sacc+=A2; sacc+=A3; PIN(sacc); W0; W1; PIN(PW); SBAR(); }while(0)
  #define EX(v) __builtin_amdgcn_exp2f(v)
  #define GAPB(MF,X,B) do{ MF; X[B]=EX(X[B]); X[B+1]=EX(X[B+1]); PIN(X); SBAR(); }while(0)
  #define VRD(i) do{ vlo[i]=vtr(vp_+(((i)>>2)*4096+((i)&3)*1024)); vhi[i]=vtr(vp_+(((i)>>2)*4096+((i)&3)*1024+512)); }while(0)
  #define VRD2(i) do{ wlo[i]=vtr(vp_+(8192+((i)>>2)*4096+((i)&3)*1024)); whi[i]=vtr(vp_+(8192+((i)>>2)*4096+((i)&3)*1024+512)); SBAR(); }while(0)
  #define WFR(i) (bf16x8){wlo[i][0],wlo[i][1],wlo[i][2],wlo[i][3],whi[i][0],whi[i][1],whi[i][2],whi[i][3]}
  #define GAPC(MF,X,B) do{ MF; X[B]=EX(X[B]); X[B+1]=EX(X[B+1]); PIN(X); SBAR(); }while(0)
  #define KRD(G,j) do{ if(G){ kload2(kf,kp0+sl_next,j); SBAR(); } }while(0)
  #define STEP(C0,C1,P0,P1,t,GK,GV,GL) do{ SBAR(); \
    const lds_cptr vp_=vp0+2*sl_prev; \
    VRD(0); SBAR(); float sacc=(P0[0]+P0[1]); \
    GAPA(C0=__builtin_amdgcn_mfma_f32_32x32x16_bf16(kf[0],qr[0],negm,0,0,0), P0[2],P0[3],P0[4],P0[5],     pw0[0]=PKW(P0,0), pw0[1]=PKW(P0,2), pw0); \
    VRD(4); SBAR(); GAPA(C1=__builtin_amdgcn_mfma_f32_32x32x16_bf16(kf[1],qr[0],negm,0,0,0), P0[6],P0[7],P0[8],P0[9],     pw0[2]=PKW(P0,4), pw0[3]=PKW(P0,6), pw0); \
    VRD(1); SBAR(); GAPA(C0=__builtin_amdgcn_mfma_f32_32x32x16_bf16(kf[2],qr[1],C0,0,0,0),   P0[10],P0[11],P0[12],P0[13], pw1[0]=PKW(P0,8), pw1[1]=PKW(P0,10), pw1); \
    VRD(5); SBAR(); GAPA(C1=__builtin_amdgcn_mfma_f32_32x32x16_bf16(kf[3],qr[1],C1,0,0,0),   P0[14],P0[15],P1[0],P1[1],   pw1[2]=PKW(P0,12),pw1[3]=PKW(P0,14), pw1); \
    VRD(2); SBAR(); GAPA(C0=__builtin_amdgcn_mfma_f32_32x32x16_bf16(kf[4],qr[2],C0,0,0,0),   P1[2],P1[3],P1[4],P1[5],     pw2[0]=PKW(P1,0), pw2[1]=PKW(P1,2), pw2); \
    VRD(6); SBAR(); GAPA(C1=__builtin_amdgcn_mfma_f32_32x32x16_bf16(kf[5],qr[2],C1,0,0,0),   P1[6],P1[7],P1[8],P1[9],     pw2[2]=PKW(P1,4), pw2[3]=PKW(P1,6), pw2); \
    VRD(3); SBAR(); GAPA(C0=__builtin_amdgcn_mfma_f32_32x32x16_bf16(kf[6],qr[3],C0,0,0,0),   P1[10],P1[11],P1[12],P1[13], pw3[0]=PKW(P1,8), pw3[1]=PKW(P1,10), pw3); \
    VRD(7); SBAR(); GAPA(C1=__builtin_amdgcn_mfma_f32_32x32x16_bf16(kf[7],qr[3],C1,0,0,0),   P1[14],P1[15],0.f,0.f,       pw3[2]=PKW(P1,12),pw3[3]=PKW(P1,14), pw3); \
    l_reg+=sacc; \
    if(GK){DMA_K((t)+3,sl_cur);} if(GV){DMA_V((t)+1,sl_next);} \
    CMASK(C0,C1,t); \
    { float a=MX3(C0[0],C0[1],C1[0]),b=MX3(C0[2],C0[3],C1[1]); a=MX3(a,C1[2],C1[3]); \
      _Pragma("unroll") for(int r=4;r<16;r+=4){a=MX3(a,C0[r],C0[r+1]);b=MX3(b,C0[r+2],C0[r+3]);a=MX3(a,C1[r],C1[r+1]);b=MX3(b,C1[r+2],C1[r+3]);} \
      float rm=__builtin_fmaxf(a,b); { auto rr=__builtin_amdgcn_permlane32_swap(__float_as_uint(rm),__float_as_uint(rm),false,false); rm=__builtin_fmaxf(__uint_as_float(rr[0]),__uint_as_float(rr[1])); } \
      resc=false; \
      if(__builtin_expect(__any(rm>(float)THRL),0)){ const float dl=__builtin_fmaxf(rm,0.f); mhat+=dl; \
        _Pragma("unroll") for(int r=0;r<16;++r){C0[r]-=dl;C1[r]-=dl;} \
        _Pragma("unroll") for(int r=0;r<16;++r)negm[r]=-mhat; asm volatile("":"+v"(negm)); \
        const float f=__builtin_amdgcn_exp2f(-dl); l_reg*=f; if(hi==0)wsf[r32]=f; resc=true; } } \
    SBAR(); \
    GAPB(o[0]=__builtin_amdgcn_mfma_f32_32x32x16_bf16(PAF(0),VFR(0),o[0],0,0,0), C0,0); VRD2(0); \
    GAPB(o[1]=__builtin_amdgcn_mfma_f32_32x32x16_bf16(PAF(0),VFR(4),o[1],0,0,0), C0,2); VRD2(4); \
    KRD(GL,0); GAPB(o[0]=__builtin_amdgcn_mfma_f32_32x32x16_bf16(PAF(1),VFR(1),o[0],0,0,0), C0,4); VRD2(1); \
    KRD(GL,1); GAPB(o[1]=__builtin_amdgcn_mfma_f32_32x32x16_bf16(PAF(1),VFR(5),o[1],0,0,0), C0,6); VRD2(5); \
    KRD(GL,2); GAPB(o[0]=__builtin_amdgcn_mfma_f32_32x32x16_bf16(PAF(2),VFR(2),o[0],0,0,0), C0,8); VRD2(2); \
    KRD(GL,3); GAPB(o[1]=__builtin_amdgcn_mfma_f32_32x32x16_bf16(PAF(2),VFR(6),o[1],0,0,0), C0,10); VRD2(6); \
    GAPB(o[0]=__builtin_amdgcn_mfma_f32_32x32x16_bf16(PAF(3),VFR(3),o[0],0,0,0), C0,12); VRD2(3); \
    GAPB(o[1]=__builtin_amdgcn_mfma_f32_32x32x16_bf16(PAF(3),VFR(7),o[1],0,0,0), C0,14); VRD2(7); \
    GAPC(o[2]=__builtin_amdgcn_mfma_f32_32x32x16_bf16(PAF(0),WFR(0),o[2],0,0,0), C1,0); \
    GAPC(o[3]=__builtin_amdgcn_mfma_f32_32x32x16_bf16(PAF(0),WFR(4),o[3],0,0,0), C1,2); \
    GAPC(o[2]=__builtin_amdgcn_mfma_f32_32x32x16_bf16(PAF(1),WFR(1),o[2],0,0,0), C1,4); \
    GAPC(o[3]=__builtin_amdgcn_mfma_f32_32x32x16_bf16(PAF(1),WFR(5),o[3],0,0,0), C1,6); \
    GAPC(o[2]=__builtin_amdgcn_mfma_f32_32x32x16_bf16(PAF(2),WFR(2),o[2],0,0,0), C1,8); \
    GAPC(o[3]=__builtin_amdgcn_mfma_f32_32x32x16_bf16(PAF(2),WFR(6),o[3],0,0,0), C1,10); \
    GAPC(o[2]=__builtin_amdgcn_mfma_f32_32x32x16_bf16(PAF(3),WFR(3),o[2],0,0,0), C1,12); \
    GAPC(o[3]=__builtin_amdgcn_mfma_f32_32x32x16_bf16(PAF(3),WFR(7),o[3],0,0,0), C1,14); \
    }while(0)
  int t=1;
  #undef CMASK
  #define CMASK(P0,P1,t) do{}while(0)
  for(;t+5<NT;t+=2){
    STEP(pB0,pB1,pA0,pA1,t,true,true,true);     WAIT_BAR(3); RESC(); ROT();
    STEP(pA0,pA1,pB0,pB1,t+1,true,true,true);   WAIT_BAR(3); RESC(); ROT();
  }
  #undef CMASK
  #define CMASK(P0,P1,t) do{int jb_=(t)-(NT-4); if(jb_>=0)cmask(P0,P1,jb_,qrel,hi);}while(0)
  #define ENDW(tt) do{ if((tt)+3<NT){WAIT_BAR(3);} else if((tt)+2<NT){WAIT_BAR(2);} else {WAIT_BAR(0);} }while(0)
  for(;t+1<NT;t+=2){
    STEP(pB0,pB1,pA0,pA1,t,(t+3<NT),(t+1<NT),(t+1<NT));       ENDW(t);   RESC(); ROT();
    STEP(pA0,pA1,pB0,pB1,t+1,(t+4<NT),(t+2<NT),(t+2<NT));     ENDW(t+1); RESC(); ROT();
  }
  STEP(pB0,pB1,pA0,pA1,NT-1,false,false,false); RESC();
  { float sacc=pB0[0]+pB0[1]; _Pragma("unroll") for(int r=2;r<16;++r)sacc+=pB0[r]; _Pragma("unroll") for(int r=0;r<16;++r)sacc+=pB1[r]; l_reg+=sacc;
    pw0=(u32x4){PKW(pB0,0),PKW(pB0,2),PKW(pB0,4),PKW(pB0,6)};pw1=(u32x4){PKW(pB0,8),PKW(pB0,10),PKW(pB0,12),PKW(pB0,14)};pw2=(u32x4){PKW(pB1,0),PKW(pB1,2),PKW(pB1,4),PKW(pB1,6)};pw3=(u32x4){PKW(pB1,8),PKW(pB1,10),PKW(pB1,12),PKW(pB1,14)};
    SBAR(); pv(o,vb0+2*sl_cur,PAF(0),PAF(1),PAF(2),PAF(3)); pv(o+2,vb0+2*sl_cur+8192,PAF(0),PAF(1),PAF(2),PAF(3)); }
  #undef PKW
  #undef PAF
  #undef VFR
  #undef PIN
  #undef MX3
  #undef GAPA
  #undef GAPB
  #undef EX
  #undef VRD
  #undef VRD2
  #undef WFR
  #undef GAPC
  #undef KRD
  #undef STEP
  #undef ENDW
  {auto rr=__builtin_amdgcn_permlane32_swap(__float_as_uint(l_reg),__float_as_uint(l_reg),false,false);l_reg=__uint_as_float(rr[0])+__uint_as_float(rr[1]);}
  if(hi==0)wsf[32+r32]=l_reg;asm volatile("s_waitcnt lgkmcnt(0)":::"memory");
  float rli[16];
  #pragma unroll
  for(int r=0;r<16;++r)rli[r]=__builtin_amdgcn_rcpf(wsf[32+crow(r,hi)]);
  bf16*Ow=O+(rowbase+q0+wid*QBLK)*DM+hh_*256+mm_*128;
  #pragma unroll
  for(int half=0;half<2;++half)
  { bf16*stg=(bf16*)(shm+LDS_OST)+wid*2048;
    #pragma unroll
    for(int r=0;r<16;++r){const int orow=crow(r,hi);
      #pragma unroll
      for(int d0=0;d0<2;++d0)stg[orow*64+d0*32+r32]=__float2bfloat16(o[2*half+d0][r]*rli[r]);}
    asm volatile("s_waitcnt lgkmcnt(0)":::"memory");
    #pragma unroll
    for(int i=0;i<4;++i){const int row=i*8+(lane>>3),ch=lane&7; const u32x4 v=*(const u32x4*)(stg+row*64+ch*8); ATTN_STORE16(Ow+(long)row*DM+half*64+ch*8,v);}
    asm volatile("s_waitcnt lgkmcnt(0)":::"memory"); }
  asm volatile("s_waitcnt lgkmcnt(0)\n\ts_barrier":::"memory");
  #undef DMA_K
  #undef DMA_V
  #undef CMASK
  #undef START
  #undef RESC
  #undef ROT
}
constexpr int ATTN_LDS_BYTES=LDS_BYTES;
struct AttnTensors { const bf16* Q; const bf16* K; const bf16* V; bf16* O; };
struct AttnUnit { int bh; int qb; };
struct StaticOrder {
  int vcu;
  __device__ __forceinline__ explicit StaticOrder(int v):vcu(v){}
  __device__ __forceinline__ bool next(int i,AttnUnit&u)const{ if(i>=2)return false; const int s=vcu&15; u.bh=vcu>>4; u.qb=(i==0)?31-s:s; return true; }
  __device__ __forceinline__ void a_ready(const AttnUnit&)const{}
  __device__ __forceinline__ void done(const AttnUnit&)const{}
};
template<class Sched,int THRL=8> __device__ __forceinline__ void attn_phase(char*lds,const AttnTensors&T,const Sched&S){
  AttnUnit u;
  for(int i=0;S.next(i,u);++i){ S.a_ready(u); attn_unit<THRL>(u.bh>>3,u.bh&7,u.qb,T.Q,T.K,T.V,T.O,lds); S.done(u); }
}
#undef SBAR
#undef WAIT_BAR
}
namespace cg = cooperative_groups;
constexpr int NWAVES = 8;
constexpr int BATCH = 2, T = 8192, D = 1024, DIN = 3584, M = BATCH * T, DEPTH = 2;
constexpr float EPS = 1e-6f;
constexpr size_t MiB = 1u << 20;
constexpr size_t WS_CTL = 0;
constexpr size_t WS_TAB = 64 * 1024;
constexpr size_t WS_ROWSS = 128 * 1024;
constexpr size_t WS_ROWSS2 = 192 * 1024;
constexpr size_t WS_PCNT = 14336;
constexpr size_t WS_SUCNT = 15616;
constexpr size_t WS_SCNT = 14592;
constexpr size_t WS_WIN = 2 * MiB;
constexpr size_t WS_WOUT = 16 * MiB;
constexpr size_t WS_GLU = 20 * MiB;
constexpr size_t WS_ROPE = 20 * MiB + 512 * 1024;
constexpr size_t WS_S5A = 21 * MiB;
constexpr size_t WS_S5B = 21 * MiB + 64 * 1024;
constexpr size_t WS_S5C = 21 * MiB + 256 * 1024;
constexpr size_t WS_HU = 22 * MiB;
constexpr size_t WS_HA = 30 * MiB;
constexpr size_t WS_XLOC = 31 * MiB;
constexpr size_t WS_XN = 32 * MiB;
constexpr size_t WS_O = WS_XN;
constexpr size_t WS_PROJ = 64 * MiB;
constexpr size_t WS_MIX = 176 * MiB;
constexpr size_t WS_YG = 208 * MiB;
constexpr size_t WS_YGS = 216 * MiB;
constexpr size_t WS_HRES = 224 * MiB;
constexpr size_t WS_END = 256 * MiB;
constexpr int LDS_BYTES = 147456, RING_BYTES = 131072;

#define GAS __attribute__((address_space(1)))
#define LAS __attribute__((address_space(3)))
typedef unsigned short bf16;
typedef unsigned v4u __attribute__((ext_vector_type(4)));
typedef unsigned v2u __attribute__((ext_vector_type(2)));
typedef float f32x4 __attribute__((ext_vector_type(4)));
typedef short bf16x8 __attribute__((ext_vector_type(8)));
#define LDS_WAIT() asm volatile("s_waitcnt lgkmcnt(0)" ::: "memory")
__device__ __forceinline__ unsigned f2bf(float f) { unsigned u = __builtin_bit_cast(unsigned, f); return (u + 0x7fffu + ((u >> 16) & 1u)) >> 16; }
__device__ __forceinline__ unsigned pk2(float lo, float hi) { return f2bf(lo) | (f2bf(hi) << 16); }
__device__ __forceinline__ float bflo(unsigned w) { return __uint_as_float(w << 16); }
__device__ __forceinline__ float bfhi(unsigned w) { return __uint_as_float(w & 0xffff0000u); }
__device__ __forceinline__ float bf1(bf16 h) { return __uint_as_float(((unsigned)h) << 16); }
__device__ __forceinline__ float sigmf(float v) { return __builtin_amdgcn_rcpf(1.0f + __builtin_amdgcn_exp2f(-1.4426950408889634f * v)); }
__device__ __forceinline__ float siluf(float v) { return v * sigmf(v); }
__device__ __forceinline__ float wave_sum(float v) {
#pragma unroll
    for (int o = 1; o < 64; o <<= 1) v += __shfl_xor(v, o);
    return v;
}
__device__ __forceinline__ void p0_transpose_item(const float* W, int K, int N, bf16* WT, LAS float* scr, int item, int lane, const float* kscale = nullptr) {
    const int nblk = N / 32, kb = item / nblk, nb = item % nblk, k0 = 64 * kb, n0 = 32 * nb;
#pragma unroll 8
    for (int i = 0; i < 32; ++i) { const int kk = 2 * i + (lane >> 5); scr[kk * 33 + (lane & 31)] = W[(size_t)(k0 + kk) * N + n0 + (lane & 31)] * (kscale ? kscale[k0 + kk] : 1.0f); }
    LDS_WAIT(); asm volatile("" ::: "memory");
    const int c = lane & 7;
#pragma unroll
    for (int j = 0; j < 4; ++j) { const int n = (lane >> 3) + 8 * j; const LAS float* s = scr + (8 * c) * 33 + n;
        v4u o; o.x = pk2(s[0 * 33], s[1 * 33]); o.y = pk2(s[2 * 33], s[3 * 33]); o.z = pk2(s[4 * 33], s[5 * 33]); o.w = pk2(s[6 * 33], s[7 * 33]);
        *(v4u*)(WT + (size_t)(n0 + n) * K + k0 + 8 * c) = o; }
    LDS_WAIT(); asm volatile("" ::: "memory");
}
template <bool OUTF> __device__ __forceinline__ void rms_row(const float* xrow, const float* w, bf16* orow, float* frow, int lane) {
    const f32x4* xr = (const f32x4*)xrow + lane; const f32x4* wr = (const f32x4*)w + lane;
    f32x4 v[4]; float s = 0.f;
#pragma unroll
    for (int j = 0; j < 4; ++j) { v[j] = xr[64 * j]; s += (v[j].x * v[j].x + v[j].y * v[j].y) + (v[j].z * v[j].z + v[j].w * v[j].w); }
    const float rs = 1.0f / sqrtf(wave_sum(s) * (1.f / D) + EPS);
#pragma unroll
    for (int j = 0; j < 4; ++j) { const f32x4 ww = wr[64 * j]; const f32x4 o = v[j] * rs * ww;
        if (OUTF) ((f32x4*)frow + lane)[64 * j] = o;
        else ((v2u*)orow + lane)[64 * j] = (v2u){pk2(o.x, o.y), pk2(o.z, o.w)}; }
}

typedef GAS unsigned gu32;
#define RLX_AGENT __ATOMIC_RELAXED, __HIP_MEMORY_SCOPE_AGENT
#define XB_TMO      128
#define XB_XCNT(j)  (256  + 64 * (j))
#define XB_XSUB(j)  (1280 + 64 * (j))
#define XB_XGEN(j)  (2304 + 64 * (j))
#define XB_TOP      3328
#define XB_TOPGEN   3392
#define XCD_BAR_WORDS 3456
#define XB_SPIN_CAP (1u << 18)

__device__ __forceinline__ unsigned xb_ld(unsigned* p)              { return __hip_atomic_load(p, __ATOMIC_RELAXED, __HIP_MEMORY_SCOPE_AGENT); }
__device__ __forceinline__ unsigned xb_add(unsigned* p, unsigned v) { return __hip_atomic_fetch_add(p, v, __ATOMIC_RELAXED, __HIP_MEMORY_SCOPE_AGENT); }
__device__ __forceinline__ unsigned xb_xcc_id() { return (unsigned)__builtin_amdgcn_s_getreg((3 << 11) | 20) & 0xFu; }
#define XB_SPIN(cond, bar) do { unsigned _sp = 0; while (cond) { __builtin_amdgcn_s_sleep(1); \
    if ((++_sp & 255u) == 0u) { if (xb_ld(&(bar)[XB_TMO])) break; if (_sp > XB_SPIN_CAP) { atomicAdd(&(bar)[XB_TMO], 1u); break; } } } } while (0)

struct XcdBarrier {
    unsigned* bar; unsigned x;
    volatile LAS unsigned* st;
};

__device__ __forceinline__ XcdBarrier xcd_barrier_post(unsigned* bar, volatile LAS unsigned* st) {
    XcdBarrier b; b.bar = bar; b.x = xb_xcc_id(); b.st = st;
    if (threadIdx.x == 0) (void)xb_add(&bar[XB_XCNT(b.x)], 1u);
    return b;
}
__device__ __forceinline__ void xcd_barrier_complete(unsigned* bar, unsigned x, unsigned& nloc, unsigned& nx) {
    const unsigned G = gridDim.x * gridDim.y * gridDim.z;
    unsigned sum, cnt, mine, sp = 0u;
    for (;;) {
        sum = 0u; cnt = 0u; mine = 0u;
#pragma unroll
        for (unsigned j = 0; j < 16; ++j) { const unsigned c = xb_ld(&bar[XB_XCNT(j)]); sum += c; cnt += (c > 0u) ? 1u : 0u; mine = (j == x) ? c : mine; }
        if (sum == G) break;
        __builtin_amdgcn_s_sleep(1);
        if ((++sp & 255u) == 0u) { if (xb_ld(&bar[XB_TMO])) break; if (sp > XB_SPIN_CAP) { atomicAdd(&bar[XB_TMO], 1u); break; } }
    }
    nloc = mine > 0u ? mine : 1u; nx = cnt > 0u ? cnt : 1u;
}

__device__ __forceinline__ void xcd_barrier(const XcdBarrier& b) {
    asm volatile("s_waitcnt vmcnt(0)" ::: "memory");
    __syncthreads();
    if (threadIdx.x == 0) {
        unsigned* bar = b.bar;
        __builtin_amdgcn_s_waitcnt(0);
        unsigned nloc = b.st[0], nx = b.st[1];
        if (nloc == 0u) { xcd_barrier_complete(bar, b.x, nloc, nx); b.st[0] = nloc; b.st[1] = nx; }
        const unsigned old = xb_add(&bar[XB_XSUB(b.x)], 1u);
        const unsigned gen = old / nloc;
        if (old + 1u == (gen + 1u) * nloc) {
            __builtin_amdgcn_fence(__ATOMIC_RELEASE, "agent");
            asm volatile("s_waitcnt vmcnt(0)" ::: "memory");
            const unsigned og = xb_add(&bar[XB_TOP], 1u);
            const unsigned tg = og / nx;
            if (og + 1u == (tg + 1u) * nx) xb_add(&bar[XB_TOPGEN], 1u);
            else XB_SPIN(xb_ld(&bar[XB_TOPGEN]) == tg, bar);
            __builtin_amdgcn_fence(__ATOMIC_ACQUIRE, "agent");
            xb_add(&bar[XB_XGEN(b.x)], 1u);
            asm volatile("s_waitcnt vmcnt(0)" ::: "memory");
        } else {
            XB_SPIN(xb_ld(&bar[XB_XGEN(b.x)]) == gen, bar);
            __builtin_amdgcn_fence(__ATOMIC_ACQUIRE, "agent");
            asm volatile("s_waitcnt vmcnt(0)" ::: "memory");
        }
    }
    __syncthreads();
}
struct Args { const float* in[22]; float* out; unsigned char* ws; int ph_lo, ph_hi; };
struct PA { const float* const* in; float* out; unsigned char* ws; };

__device__ __forceinline__ void s5_prep(const float* const* in, unsigned char* ws, int t0, int nthreads) {
    const double TWO_PI = 6.283185307179586476925;
    for (int ec = t0; ec < DEPTH * 16 * 64 * 16; ec += nthreads) {
        const int e = ec >> 4, c = ec & 15;
        const int l = e >> 10, g = (e >> 6) & 15, p = e & 63;
        const double dt = (double)expf(in[12][l * 16 + g]);
        const double are = (double)in[6][e], aim = (double)in[7][e];
        const double mag = (double)expf((float)(dt * are));
        double tt = dt * aim * (1.0 / TWO_PI); tt -= __builtin_floor(tt);
        const float ang = (float)(tt * TWO_PI);
        const double abr = mag * (double)cosf(ang), abi = mag * (double)sinf(ang);
        const double den = are * are + aim * aim, nr = abr - 1.0, ni = abi;
        const double zr = (nr * are + ni * aim) / den, zi = (ni * are - nr * aim) / den;
        if (c == 0) {
            double pr = abr, pi = abi;
#pragma unroll
            for (int q = 0; q < 7; ++q) { const double r2 = pr * pr - pi * pi, i2 = 2.0 * pr * pi; pr = r2; pi = i2; }
            float* sa = (float*)(ws + WS_S5A) + (size_t)(l * 16 + g) * 256;
            sa[p] = (float)abr; sa[64 + p] = (float)abi; sa[128 + p] = (float)pr; sa[192 + p] = (float)pi;
        }
        bf16* bm = (bf16*)(ws + WS_S5B) + (size_t)(l * 16 + g) * 2048;
        const double br = in[8][(size_t)e * 16 + c], bi = in[9][(size_t)e * 16 + c];
        bm[p * 16 + c] = (bf16)f2bf((float)(zr * br - zi * bi)); bm[(64 + p) * 16 + c] = (bf16)f2bf((float)(zr * bi + zi * br));
        bf16* cm = (bf16*)(ws + WS_S5C) + (size_t)(l * 16 + g) * 2048;
        cm[c * 128 + p] = (bf16)f2bf(in[10][(size_t)(l * 16 + g) * 1024 + c * 64 + p]); cm[c * 128 + 64 + p] = (bf16)f2bf(-in[11][(size_t)(l * 16 + g) * 1024 + c * 64 + p]);
    }
}
__device__ __forceinline__ void prologue(const Args& a, LAS unsigned char* lds, int vcu, int G, int wave, int lane) {
    const bool defer_s5 = false;
    unsigned char* ws = a.ws;
    LAS float* scr = (LAS float*)(lds + wave * 16384);
    const int gw = vcu * NWAVES + wave, NGW = G * NWAVES;
    constexpr int I_IN = (D / 64) * (DIN / 32), I_OUT = (D / 64) * (D / 32), I_GLU = (256 / 64) * (256 / 32);
    constexpr int NITEMS = DEPTH * (I_IN + I_OUT + I_GLU);
    for (int it = gw; it < NITEMS; it += NGW) {
        int r = it; const int l = r / (I_IN + I_OUT + I_GLU); r -= l * (I_IN + I_OUT + I_GLU);
        if (r < I_IN) { p0_transpose_item(a.in[2] + (size_t)l * D * DIN, D, DIN, (bf16*)(ws + WS_WIN) + (size_t)l * DIN * D, scr, r, lane, l > 0 ? a.in[1] + (size_t)l * D : nullptr); continue; } r -= I_IN;
        if (r < I_OUT) { p0_transpose_item(a.in[3] + (size_t)l * D * D, D, D, (bf16*)(ws + WS_WOUT) + (size_t)l * D * D, scr, r, lane); continue; } r -= I_OUT;
        p0_transpose_item(a.in[14] + (size_t)l * 65536, 256, 256, (bf16*)(ws + WS_GLU) + (size_t)l * 65536, scr, r, lane);
    }
    for (int m = gw; m < M; m += 2 * NGW) {
        const int m2 = m + NGW; const bool has2 = m2 < M;
        const f32x4* x1 = (const f32x4*)(a.in[0] + (size_t)m * D) + lane; const f32x4* x2 = (const f32x4*)(a.in[0] + (size_t)(has2 ? m2 : m) * D) + lane; const f32x4* wr = (const f32x4*)a.in[1] + lane;
        f32x4 v1[4], v2[4]; float s1 = 0.f, s2 = 0.f;
#pragma unroll
        for (int j = 0; j < 4; ++j) { v1[j] = x1[64 * j]; v2[j] = x2[64 * j]; }
#pragma unroll
        for (int j = 0; j < 4; ++j) { s1 += (v1[j].x * v1[j].x + v1[j].y * v1[j].y) + (v1[j].z * v1[j].z + v1[j].w * v1[j].w); s2 += (v2[j].x * v2[j].x + v2[j].y * v2[j].y) + (v2[j].z * v2[j].z + v2[j].w * v2[j].w); }
        const float r1 = 1.0f / sqrtf(wave_sum(s1) * (1.f / D) + EPS), r2 = 1.0f / sqrtf(wave_sum(s2) * (1.f / D) + EPS);
#pragma unroll
        for (int j = 0; j < 4; ++j) { const f32x4 ww = wr[64 * j]; const f32x4 o1 = v1[j] * r1 * ww, o2 = v2[j] * r2 * ww;
            ((v2u*)((bf16*)(ws + WS_XN) + (size_t)m * D) + lane)[64 * j] = (v2u){pk2(o1.x, o1.y), pk2(o1.z, o1.w)};
            if (has2) ((v2u*)((bf16*)(ws + WS_XN) + (size_t)m2 * D) + lane)[64 * j] = (v2u){pk2(o2.x, o2.y), pk2(o2.z, o2.w)}; }
        if (lane == 0) { ((float*)(ws + WS_ROWSS))[m] = 0.f; ((float*)(ws + WS_ROWSS2))[m] = 0.f; if (has2) { ((float*)(ws + WS_ROWSS))[m2] = 0.f; ((float*)(ws + WS_ROWSS2))[m2] = 0.f; } }
    }
    const int gt = gw * 64 + lane, NGT = NGW * 64;
    const double TWO_PI = 6.283185307179586476925;
    for (int e = gt; e < 8192 * 8; e += NGT) {
        const int pos = e >> 3, i = e & 7;
        const double invf[8] = {1.0, 0.19392274474868576, 0.03760603093086393, 0.007292664737217109, 0.001414213562373095, 0.0002742481756762073, 5.318295896944988e-05, 1.031338537721246e-05};
        double inv = invf[0];
#pragma unroll
        for (int q = 1; q < 8; ++q) inv = (i == q) ? invf[q] : inv;
        double tt = (double)pos * inv * (1.0 / TWO_PI); tt -= __builtin_floor(tt);
        const float ang = (float)(tt * TWO_PI);
        float* rp = (float*)(ws + WS_ROPE) + (size_t)e * 2; rp[0] = cosf(ang); rp[1] = sinf(ang);
    }
    if (!defer_s5) s5_prep(a.in, ws, gt, NGT);
}

template <bool OUT> __device__ __forceinline__ void hgrn_item(const PA& a, LAS unsigned char* lds, int layer, int bh, int c, int tid, int wave, int lane) {
    const int b = bh >> 2, h = bh & 3;
    const bf16* PROJ = (const bf16*)(a.ws + WS_PROJ);
    float* HU = (float*)(a.ws + WS_HU); float* HA = (float*)(a.ws + WS_HA);
    LAS float* Fs = (LAS float*)lds; LAS float* Ks = Fs + 4096; LAS float* Vs = Ks + 4096; LAS float* Qs = Vs + 4096; LAS float* Ps = Qs + 4096;
    const size_t row0 = (size_t)b * T + (size_t)c * 128;
    float S[8];
#pragma unroll
    for (int j = 0; j < 8; ++j) S[j] = 0.f;
    if (OUT) {
        int cp = 0;
        for (; cp + 4 <= c; cp += 4) {
            float uu[4][8], aa[4][8];
#pragma unroll
            for (int q = 0; q < 4; ++q) {
                const float* U = HU + (size_t)(bh * 64 + cp + q) * 4096 + (size_t)(wave * 8) * 64 + lane; const float* A = HA + (size_t)(bh * 64 + cp + q) * 64 + wave * 8;
#pragma unroll
                for (int j = 0; j < 8; ++j) { uu[q][j] = U[j * 64]; aa[q][j] = A[j]; }
            }
#pragma unroll
            for (int q = 0; q < 4; ++q)
#pragma unroll
                for (int j = 0; j < 8; ++j) S[j] = aa[q][j] * S[j] + uu[q][j];
        }
        for (; cp < c; ++cp) {
            const float* U = HU + (size_t)(bh * 64 + cp) * 4096 + (size_t)(wave * 8) * 64 + lane; const float* A = HA + (size_t)(bh * 64 + cp) * 64 + wave * 8;
#pragma unroll
            for (int j = 0; j < 8; ++j) S[j] = A[j] * S[j] + U[j * 64];
        }
    }
    const int fcol = h * 64 + (tid & 7) * 8;
    float lb[8];
#pragma unroll
    for (int j = 0; j < 8; ++j) lb[j] = (layer == 0) ? 0.f : sigmf(a.in[4][256 + fcol + j] - a.in[4][fcol + j]);
    const float gnw = a.in[5][layer * 64 + lane];
    float aprod = 1.f;
    for (int sub = 0; sub < 2; ++sub) {
        __syncthreads();
        { const int t = tid >> 3; const bf16* pr = PROJ + (row0 + sub * 64 + t) * DIN + fcol;
          const v4u fw = *(const v4u*)(pr + 256), vw = *(const v4u*)(pr + 512);
          const unsigned fa[4] = {fw.x, fw.y, fw.z, fw.w}, va[4] = {vw.x, vw.y, vw.z, vw.w};
          float fo[8], ko[8], vo[8];
#pragma unroll
          for (int j = 0; j < 8; ++j) { const float x = (j & 1) ? bfhi(fa[j >> 1]) : bflo(fa[j >> 1]); const float sg = sigmf(x);
              fo[j] = lb[j] + (1.f - lb[j]) * sg; ko[j] = (1.f - lb[j]) * (1.f - sg); vo[j] = (j & 1) ? bfhi(va[j >> 1]) : bflo(va[j >> 1]); }
          LAS f32x4* d;
          d = (LAS f32x4*)(Fs + t * 64 + (tid & 7) * 8); d[0] = (f32x4){fo[0], fo[1], fo[2], fo[3]}; d[1] = (f32x4){fo[4], fo[5], fo[6], fo[7]};
          d = (LAS f32x4*)(Ks + t * 64 + (tid & 7) * 8); d[0] = (f32x4){ko[0], ko[1], ko[2], ko[3]}; d[1] = (f32x4){ko[4], ko[5], ko[6], ko[7]};
          d = (LAS f32x4*)(Vs + t * 64 + (tid & 7) * 8); d[0] = (f32x4){vo[0], vo[1], vo[2], vo[3]}; d[1] = (f32x4){vo[4], vo[5], vo[6], vo[7]};
          if (OUT) { const v4u qw = *(const v4u*)(pr); const unsigned qa[4] = {qw.x, qw.y, qw.z, qw.w}; float qo[8];
#pragma unroll
              for (int j = 0; j < 8; ++j) qo[j] = siluf((j & 1) ? bfhi(qa[j >> 1]) : bflo(qa[j >> 1]));
              d = (LAS f32x4*)(Qs + t * 64 + (tid & 7) * 8); d[0] = (f32x4){qo[0], qo[1], qo[2], qo[3]}; d[1] = (f32x4){qo[4], qo[5], qo[6], qo[7]}; }
        }
        __syncthreads();
        if (!OUT && tid < 64) { for (int t = 0; t < 64; ++t) aprod *= Fs[t * 64 + tid]; }
        for (int tb = 0; tb < 4; ++tb) {
#pragma unroll 4
            for (int tt = 0; tt < 16; ++tt) {
                const int t = tb * 16 + tt;
                const f32x4 f0 = *(const LAS f32x4*)(Fs + t * 64 + wave * 8), f1 = *(const LAS f32x4*)(Fs + t * 64 + wave * 8 + 4);
                const f32x4 k0 = *(const LAS f32x4*)(Ks + t * 64 + wave * 8), k1 = *(const LAS f32x4*)(Ks + t * 64 + wave * 8 + 4);
                const float v = Vs[t * 64 + lane];
                S[0] = f0[0] * S[0] + k0[0] * v; S[1] = f0[1] * S[1] + k0[1] * v; S[2] = f0[2] * S[2] + k0[2] * v; S[3] = f0[3] * S[3] + k0[3] * v;
                S[4] = f1[0] * S[4] + k1[0] * v; S[5] = f1[1] * S[5] + k1[1] * v; S[6] = f1[2] * S[6] + k1[2] * v; S[7] = f1[3] * S[7] + k1[3] * v;
                if (OUT) {
                    const f32x4 q0 = *(const LAS f32x4*)(Qs + t * 64 + wave * 8), q1 = *(const LAS f32x4*)(Qs + t * 64 + wave * 8 + 4);
                    const float p = ((q0[0] * S[0] + q0[1] * S[1]) + (q0[2] * S[2] + q0[3] * S[3])) + ((q1[0] * S[4] + q1[1] * S[5]) + (q1[2] * S[6] + q1[3] * S[7]));
                    Ps[(wave * 16 + tt) * 64 + lane] = p;
                }
            }
            if (OUT) {
                __syncthreads();
#pragma unroll
                for (int r = 0; r < 2; ++r) {
                    const int tt = wave + 8 * r; float o = 0.f;
#pragma unroll
                    for (int w2 = 0; w2 < 8; ++w2) o += Ps[(w2 * 16 + tt) * 64 + lane];
                    const float rs = 1.0f / sqrtf(wave_sum(o * o) * (1.f / 64.f) + EPS);
                    const size_t row = row0 + sub * 64 + tb * 16 + tt;
                    const float gt = siluf(bf1(PROJ[row * DIN + 768 + h * 64 + lane]));
                    ((bf16*)(a.ws + WS_MIX))[row * 1024 + h * 64 + lane] = (bf16)f2bf(o * rs * gnw * gt);
                }
                __syncthreads();
            }
        }
    }
    if (!OUT) {
        float* U = HU + (size_t)(bh * 64 + c) * 4096 + (size_t)(wave * 8) * 64 + lane;
#pragma unroll
        for (int j = 0; j < 8; ++j) U[j * 64] = S[j];
        if (tid < 64) HA[(size_t)(bh * 64 + c) * 64 + tid] = aprod;
    }
}

typedef unsigned short u16;
__device__ __forceinline__ bf16x8 pk8(const float* v) { v4u w = {pk2(v[0], v[1]), pk2(v[2], v[3]), pk2(v[4], v[5]), pk2(v[6], v[7])}; return __builtin_bit_cast(bf16x8, w); }
struct HRaw { v4u f[2], v[2], q[2], g[2]; };
template <bool OUT> __device__ __forceinline__ HRaw hgrn_load(const PA& a, int bh, int c, int wave, int lane) {
    const bf16* pr = (const bf16*)(a.ws + WS_PROJ) + ((size_t)(bh >> 2) * T + (size_t)c * 128 + wave * 16 + (lane >> 3)) * DIN + (bh & 3) * 64 + (lane & 7) * 8;
    HRaw r;
#pragma unroll
    for (int k = 0; k < 2; ++k) { r.f[k] = *(const v4u*)(pr + (size_t)(8 * k) * DIN + 256); r.v[k] = *(const v4u*)(pr + (size_t)(8 * k) * DIN + 512);
        if (OUT) { r.q[k] = *(const v4u*)(pr + (size_t)(8 * k) * DIN); r.g[k] = *(const v4u*)(pr + (size_t)(8 * k) * DIN + 768); } }
    return r;
}
template <bool OUT> __device__ __forceinline__ void hgrn_item2(const PA& a, LAS unsigned char* lds, int layer, int bh, int c, int wave, int lane, const HRaw& raw) {
    const int b = bh >> 2, h = bh & 3, item = bh * 64 + c;
    float* HU = (float*)(a.ws + WS_HU); float* HA = (float*)(a.ws + WS_HA);
    LAS unsigned char* wb = lds + wave * 12288;
    LAS bf16* QT = (LAS bf16*)wb; LAS bf16* KT = (LAS bf16*)(wb + 2304); LAS bf16* KHT = (LAS bf16*)(wb + 4608); LAS bf16* VT = (LAS bf16*)(wb + 7680); LAS bf16* P = (LAS bf16*)(wb + 10752);
    LAS float* DL = (LAS float*)(wb + 11520); LAS float* E7L = (LAS float*)(wb + 11776);
    LAS bf16* RF = (LAS bf16*)wb; LAS bf16* RV = (LAS bf16*)(wb + 2304); LAS bf16* RQ = (LAS bf16*)(wb + 4608);
    LAS bf16* GT = KHT; LAS bf16* OT = VT;
    LAS float* SBUF = (LAS float*)(lds + 98304); LAS float* DALL = (LAS float*)(lds + 114688);
    const int l15 = lane & 15, q = lane >> 4;
    const size_t row0 = (size_t)b * T + (size_t)c * 128 + wave * 16;
    const bf16x8 zero8 = {0, 0, 0, 0, 0, 0, 0, 0};
    __syncthreads();
    {
        const int rr = lane >> 3, cc = (lane & 7) * 8;
#pragma unroll
        for (int k = 0; k < 2; ++k) { *(LAS v4u*)(RF + (rr + 8 * k) * 72 + cc) = raw.f[k]; *(LAS v4u*)(RV + (rr + 8 * k) * 72 + cc) = raw.v[k]; if (OUT) *(LAS v4u*)(RQ + (rr + 8 * k) * 72 + cc) = raw.q[k]; }
        LDS_WAIT();
        const float lb = (layer == 0) ? 0.f : sigmf(a.in[4][256 + h * 64 + lane] - a.in[4][h * 64 + lane]);
        u16 fr[16], vr[16], qr[16];
#pragma unroll
        for (int t = 0; t < 16; ++t) { fr[t] = RF[t * 72 + lane]; vr[t] = RV[t * 72 + lane]; if (OUT) qr[t] = RQ[t * 72 + lane]; }
        LDS_WAIT();
        float cum[16], kk[16]; float run = 0.f;
#pragma unroll
        for (int t = 0; t < 16; ++t) { const float sg = sigmf(bf1(fr[t])); const float f = lb + (1.f - lb) * sg; kk[t] = (1.f - lb) * (1.f - sg); run += fmaxf(__logf(f), -69.f); cum[t] = run; }
        const float cl = cum[15], c7 = cum[7];
        DL[lane] = __expf(cl);
        if (OUT) E7L[lane] = __expf(c7); else DALL[wave * 64 + lane] = cl;
        float kh[16];
#pragma unroll
        for (int t = 0; t < 16; ++t) kh[t] = kk[t] * __expf(cl - cum[t]);
        *(LAS bf16x8*)(KHT + lane * 24) = pk8(kh); *(LAS bf16x8*)(KHT + lane * 24 + 8) = pk8(kh + 8);
        { v4u w0 = {(unsigned)vr[0] | ((unsigned)vr[1] << 16), (unsigned)vr[2] | ((unsigned)vr[3] << 16), (unsigned)vr[4] | ((unsigned)vr[5] << 16), (unsigned)vr[6] | ((unsigned)vr[7] << 16)};
          v4u w1 = {(unsigned)vr[8] | ((unsigned)vr[9] << 16), (unsigned)vr[10] | ((unsigned)vr[11] << 16), (unsigned)vr[12] | ((unsigned)vr[13] << 16), (unsigned)vr[14] | ((unsigned)vr[15] << 16)};
          *(LAS v4u*)(VT + lane * 24) = w0; *(LAS v4u*)(VT + lane * 24 + 8) = w1; }
        if (OUT) {
#pragma unroll
            for (int t = 0; t < 16; ++t) {
                QT[t * 72 + lane] = (bf16)f2bf(siluf(bf1(qr[t])) * __expf(fminf(cum[t] - c7, 60.f)));
                KT[t * 72 + lane] = (bf16)f2bf(kk[t] * __expf(fminf(c7 - cum[t], 60.f)));
            }
        }
    }
    LDS_WAIT();
    bf16x8 vfr[4];
#pragma unroll
    for (int nt = 0; nt < 4; ++nt) vfr[nt] = (q < 2) ? *(const LAS bf16x8*)(VT + (16 * nt + l15) * 24 + q * 8) : zero8;
    f32x4 U[4][4];
#pragma unroll
    for (int mt = 0; mt < 4; ++mt) { const bf16x8 afr = (q < 2) ? *(const LAS bf16x8*)(KHT + (16 * mt + l15) * 24 + q * 8) : zero8;
#pragma unroll
        for (int nt = 0; nt < 4; ++nt) U[mt][nt] = __builtin_amdgcn_mfma_f32_16x16x32_bf16(afr, vfr[nt], (f32x4){0.f, 0.f, 0.f, 0.f}, 0, 0, 0); }
    f32x4 o[4]; bf16x8 qf[2];
    if (OUT) {
        LDS_WAIT();
        { const int rr = lane >> 3, cc = (lane & 7) * 8; *(LAS v4u*)(GT + rr * 72 + cc) = raw.g[0]; *(LAS v4u*)(GT + (rr + 8) * 72 + cc) = raw.g[1]; }
        f32x4 sc = {0.f, 0.f, 0.f, 0.f};
#pragma unroll
        for (int ks = 0; ks < 2; ++ks) {
            const v2u qa = *(const LAS v2u*)(QT + l15 * 72 + 32 * ks + 4 * q), qb = *(const LAS v2u*)(QT + l15 * 72 + 32 * ks + 16 + 4 * q);
            const v2u ka = *(const LAS v2u*)(KT + l15 * 72 + 32 * ks + 4 * q), kb = *(const LAS v2u*)(KT + l15 * 72 + 32 * ks + 16 + 4 * q);
            qf[ks] = __builtin_bit_cast(bf16x8, (v4u){qa.x, qa.y, qb.x, qb.y});
            const bf16x8 kf = __builtin_bit_cast(bf16x8, (v4u){ka.x, ka.y, kb.x, kb.y});
            sc = __builtin_amdgcn_mfma_f32_16x16x32_bf16(qf[ks], kf, sc, 0, 0, 0);
        }
#pragma unroll
        for (int j = 0; j < 4; ++j) { const int t = 4 * q + j; P[t * 24 + l15] = (bf16)f2bf((l15 <= t) ? sc[j] : 0.f); }
        LDS_WAIT();
        const bf16x8 pf = (q < 2) ? *(const LAS bf16x8*)(P + l15 * 24 + q * 8) : zero8;
#pragma unroll
        for (int nt = 0; nt < 4; ++nt) o[nt] = __builtin_amdgcn_mfma_f32_16x16x32_bf16(pf, vfr[nt], (f32x4){0.f, 0.f, 0.f, 0.f}, 0, 0, 0);
    }
    {
        float S8[8];
#pragma unroll
        for (int i = 0; i < 8; ++i) S8[i] = 0.f;
        if (OUT) {
            const f32x4 h0 = *(const f32x4*)(HU + (size_t)item * 4096 + (size_t)((2 * wave) * 64 + lane) * 4), h1 = *(const f32x4*)(HU + (size_t)item * 4096 + (size_t)((2 * wave + 1) * 64 + lane) * 4);
            S8[0] = h0[0]; S8[1] = h0[1]; S8[2] = h0[2]; S8[3] = h0[3]; S8[4] = h1[0]; S8[5] = h1[1]; S8[6] = h1[2]; S8[7] = h1[3];
        }
        *(LAS f32x4*)(SBUF + ((2 * wave) * 64 + lane) * 4) = (f32x4){S8[0], S8[1], S8[2], S8[3]}; *(LAS f32x4*)(SBUF + ((2 * wave + 1) * 64 + lane) * 4) = (f32x4){S8[4], S8[5], S8[6], S8[7]};
    }
    __syncthreads();
    f32x4 Sp[4][4];
#pragma unroll 1
    for (int step = 0; step < 8; ++step) {
        if (wave == step) {
#pragma unroll
            for (int mt = 0; mt < 4; ++mt) { const f32x4 Dv = *(const LAS f32x4*)(DL + 16 * mt + 4 * q);
#pragma unroll
                for (int nt = 0; nt < 4; ++nt) {
                    Sp[mt][nt] = *(const LAS f32x4*)(SBUF + ((mt * 4 + nt) * 64 + lane) * 4);
                    U[mt][nt] = Dv * Sp[mt][nt] + U[mt][nt];
                    *(LAS f32x4*)(SBUF + ((mt * 4 + nt) * 64 + lane) * 4) = U[mt][nt];
                } }
        }
        __syncthreads();
    }
    if (OUT) {
#pragma unroll
        for (int mt = 0; mt < 4; ++mt) { const f32x4 Ev = *(const LAS f32x4*)(E7L + 16 * mt + 4 * q);
#pragma unroll
            for (int nt = 0; nt < 4; ++nt) Sp[mt][nt] = Sp[mt][nt] * Ev; }
#pragma unroll
        for (int nt = 0; nt < 4; ++nt)
#pragma unroll
            for (int ks = 0; ks < 2; ++ks) {
                const f32x4 s0 = Sp[2 * ks][nt], s1 = Sp[2 * ks + 1][nt];
                const bf16x8 bfrag = __builtin_bit_cast(bf16x8, (v4u){pk2(s0[0], s0[1]), pk2(s0[2], s0[3]), pk2(s1[0], s1[1]), pk2(s1[2], s1[3])});
                o[nt] = __builtin_amdgcn_mfma_f32_16x16x32_bf16(qf[ks], bfrag, o[nt], 0, 0, 0);
            }
        float gn[4];
#pragma unroll
        for (int nt = 0; nt < 4; ++nt) gn[nt] = a.in[5][layer * 64 + 16 * nt + l15];
#pragma unroll
        for (int j = 0; j < 4; ++j) {
            float ss = (o[0][j] * o[0][j] + o[1][j] * o[1][j]) + (o[2][j] * o[2][j] + o[3][j] * o[3][j]);
            ss += __shfl_xor(ss, 1); ss += __shfl_xor(ss, 2); ss += __shfl_xor(ss, 4); ss += __shfl_xor(ss, 8);
            const float rs = __builtin_amdgcn_rsqf(ss * (1.f / 64.f) + EPS);
#pragma unroll
            for (int nt = 0; nt < 4; ++nt) { const float gt = siluf(bf1(GT[(4 * q + j) * 72 + 16 * nt + l15]));
                OT[(4 * q + j) * 72 + 16 * nt + l15] = (bf16)f2bf(o[nt][j] * rs * gn[nt] * gt); }
        }
        LDS_WAIT();
        { const int rr = lane >> 3, cc = (lane & 7) * 8; bf16* mp = (bf16*)(a.ws + WS_MIX) + (row0 + rr) * 1024 + h * 64 + cc;
          *(v4u*)mp = *(const LAS v4u*)(OT + rr * 72 + cc); *(v4u*)(mp + 8 * 1024) = *(const LAS v4u*)(OT + (rr + 8) * 72 + cc); }
    } else {
        if (wave == 7) {
#pragma unroll
            for (int mt = 0; mt < 4; ++mt)
#pragma unroll
                for (int nt = 0; nt < 4; ++nt)
                    *(f32x4*)(HU + (size_t)item * 4096 + (size_t)((mt * 4 + nt) * 64 + lane) * 4) = U[mt][nt];
            float s = 0.f;
#pragma unroll
            for (int w2 = 0; w2 < 8; ++w2) s += DALL[w2 * 64 + lane];
            HA[(size_t)item * 64 + lane] = __expf(s);
        }
    }
}

template <bool OUT> __device__ __forceinline__ HRaw hgrn_loadc(const PA& a, int bh, int c, int chunk, int lane) {
    const bf16* pr = (const bf16*)(a.ws + WS_PROJ) + ((size_t)(bh >> 2) * T + (size_t)c * 128 + chunk * 16 + (lane >> 3)) * DIN + (bh & 3) * 64 + (lane & 7) * 8;
    HRaw r;
#pragma unroll
    for (int k = 0; k < 2; ++k) { r.f[k] = *(const v4u*)(pr + (size_t)(8 * k) * DIN + 256); r.v[k] = *(const v4u*)(pr + (size_t)(8 * k) * DIN + 512);
        if (OUT) { r.q[k] = *(const v4u*)(pr + (size_t)(8 * k) * DIN); } }
    return r;
}
template <bool OUT> __device__ __forceinline__ void hgrn_chunk(const PA& a, LAS unsigned char* wb, LAS float* DLk, LAS float* E7k, LAS float* DALLk, int layer, int h, int lane, const HRaw& raw,
                                                                f32x4 (&U)[4][4], f32x4 (&o)[4], bf16x8 (&qf)[2]) {
    LAS bf16* QT = (LAS bf16*)wb; LAS bf16* KT = (LAS bf16*)(wb + 2304); LAS bf16* KHT = (LAS bf16*)(wb + 4608); LAS bf16* VT = (LAS bf16*)(wb + 7680); LAS bf16* P = (LAS bf16*)(wb + 10752);
    LAS bf16* RF = (LAS bf16*)wb; LAS bf16* RV = (LAS bf16*)(wb + 2304); LAS bf16* RQ = (LAS bf16*)(wb + 4608);
    const int l15 = lane & 15, q = lane >> 4;
    const bf16x8 zero8 = {0, 0, 0, 0, 0, 0, 0, 0};
    LDS_WAIT();
    {
        const int rr = lane >> 3, cc = (lane & 7) * 8;
#pragma unroll
        for (int k = 0; k < 2; ++k) { *(LAS v4u*)(RF + (rr + 8 * k) * 72 + cc) = raw.f[k]; *(LAS v4u*)(RV + (rr + 8 * k) * 72 + cc) = raw.v[k]; if (OUT) *(LAS v4u*)(RQ + (rr + 8 * k) * 72 + cc) = raw.q[k]; }
        LDS_WAIT();
        const float lb = (layer == 0) ? 0.f : sigmf(a.in[4][256 + h * 64 + lane] - a.in[4][h * 64 + lane]);
        {
            u16 vr[16];
#pragma unroll
            for (int t = 0; t < 16; ++t) vr[t] = RV[t * 72 + lane];
            const v4u w0 = {(unsigned)vr[0] | ((unsigned)vr[1] << 16), (unsigned)vr[2] | ((unsigned)vr[3] << 16), (unsigned)vr[4] | ((unsigned)vr[5] << 16), (unsigned)vr[6] | ((unsigned)vr[7] << 16)};
            const v4u w1 = {(unsigned)vr[8] | ((unsigned)vr[9] << 16), (unsigned)vr[10] | ((unsigned)vr[11] << 16), (unsigned)vr[12] | ((unsigned)vr[13] << 16), (unsigned)vr[14] | ((unsigned)vr[15] << 16)};
            *(LAS v4u*)(VT + lane * 24) = w0; *(LAS v4u*)(VT + lane * 24 + 8) = w1;
        }
        float cum[16], kk[16]; float run = 0.f;
#pragma unroll
        for (int t = 0; t < 16; ++t) { const float sg = sigmf(bf1(RF[t * 72 + lane])); const float f = lb + (1.f - lb) * sg; kk[t] = (1.f - lb) * (1.f - sg); run += fmaxf(__logf(f), -69.f); cum[t] = run; }
        const float cl = cum[15], c7 = cum[7];
        DLk[lane] = __expf(cl);
        if (OUT) E7k[lane] = __expf(c7); else DALLk[lane] = cl;
        if (OUT) {
            float qv[16];
#pragma unroll
            for (int t = 0; t < 16; ++t) qv[t] = bf1(RQ[t * 72 + lane]);
            LDS_WAIT();
#pragma unroll
            for (int t = 0; t < 16; ++t) {
                QT[t * 72 + lane] = (bf16)f2bf(siluf(qv[t]) * __expf(fminf(cum[t] - c7, 60.f)));
                KT[t * 72 + lane] = (bf16)f2bf(kk[t] * __expf(fminf(c7 - cum[t], 60.f)));
            }
        }
        LDS_WAIT();
        float kh[16];
#pragma unroll
        for (int t = 0; t < 16; ++t) kh[t] = kk[t] * __expf(cl - cum[t]);
        *(LAS bf16x8*)(KHT + lane * 24) = pk8(kh); *(LAS bf16x8*)(KHT + lane * 24 + 8) = pk8(kh + 8);
    }
    LDS_WAIT();
    bf16x8 vfr[4];
#pragma unroll
    for (int nt = 0; nt < 4; ++nt) vfr[nt] = (q < 2) ? *(const LAS bf16x8*)(VT + (16 * nt + l15) * 24 + q * 8) : zero8;
#pragma unroll
    for (int mt = 0; mt < 4; ++mt) { const bf16x8 afr = (q < 2) ? *(const LAS bf16x8*)(KHT + (16 * mt + l15) * 24 + q * 8) : zero8;
#pragma unroll
        for (int nt = 0; nt < 4; ++nt) U[mt][nt] = __builtin_amdgcn_mfma_f32_16x16x32_bf16(afr, vfr[nt], (f32x4){0.f, 0.f, 0.f, 0.f}, 0, 0, 0); }
    if (OUT) {
        f32x4 sc = {0.f, 0.f, 0.f, 0.f};
#pragma unroll
        for (int ks = 0; ks < 2; ++ks) {
            const v2u qa = *(const LAS v2u*)(QT + l15 * 72 + 32 * ks + 4 * q), qb = *(const LAS v2u*)(QT + l15 * 72 + 32 * ks + 16 + 4 * q);
            const v2u ka = *(const LAS v2u*)(KT + l15 * 72 + 32 * ks + 4 * q), kb = *(const LAS v2u*)(KT + l15 * 72 + 32 * ks + 16 + 4 * q);
            qf[ks] = __builtin_bit_cast(bf16x8, (v4u){qa.x, qa.y, qb.x, qb.y});
            const bf16x8 kf = __builtin_bit_cast(bf16x8, (v4u){ka.x, ka.y, kb.x, kb.y});
            sc = __builtin_amdgcn_mfma_f32_16x16x32_bf16(qf[ks], kf, sc, 0, 0, 0);
        }
#pragma unroll
        for (int j = 0; j < 4; ++j) { const int t = 4 * q + j; P[t * 24 + l15] = (bf16)f2bf((l15 <= t) ? sc[j] : 0.f); }
        LDS_WAIT();
        const bf16x8 pf = (q < 2) ? *(const LAS bf16x8*)(P + l15 * 24 + q * 8) : zero8;
#pragma unroll
        for (int nt = 0; nt < 4; ++nt) o[nt] = __builtin_amdgcn_mfma_f32_16x16x32_bf16(pf, vfr[nt], (f32x4){0.f, 0.f, 0.f, 0.f}, 0, 0, 0);
    }
}
__device__ __forceinline__ void hgrn_ointer(f32x4 (&o)[4], const bf16x8 (&qf)[2], const f32x4 (&S)[4][4], const f32x4 (&sc)[4]) {
#pragma unroll
    for (int nt = 0; nt < 4; ++nt)
#pragma unroll
        for (int ks = 0; ks < 2; ++ks) {
            const f32x4 s0 = S[2 * ks][nt] * sc[2 * ks], s1 = S[2 * ks + 1][nt] * sc[2 * ks + 1];
            const bf16x8 bfrag = __builtin_bit_cast(bf16x8, (v4u){pk2(s0[0], s0[1]), pk2(s0[2], s0[3]), pk2(s1[0], s1[1]), pk2(s1[2], s1[3])});
            o[nt] = __builtin_amdgcn_mfma_f32_16x16x32_bf16(qf[ks], bfrag, o[nt], 0, 0, 0);
        }
}
#define HG_LAUNDER() do { asm volatile("" : "+v"(lane)); l15 = lane & 15; q = lane >> 4; } while (0)
template <bool OUT> __device__ __forceinline__ void hgrn_pair(const PA& a, LAS unsigned char* lds, int layer, int bh, int s, int wave, int lane) {
    const int half = wave >> 2, wl = wave & 3, c = half ? 63 - s : s, b = bh >> 2, h = bh & 3, item = bh * 64 + c;
    float* HU = (float*)(a.ws + WS_HU); float* HA = (float*)(a.ws + WS_HA);
    LAS unsigned char* wb = lds + wave * 12800;
    LAS float* DLs = (LAS float*)(wb + 11520);
    LAS float* SBUF = (LAS float*)(lds + 102400 + half * 16384);
    LAS float* DALL = (LAS float*)(lds + 135168 + half * 2048);
    int l15 = lane & 15, q = lane >> 4;
    const size_t rowc0 = (size_t)b * T + (size_t)c * 128 + (size_t)(2 * wl) * 16;
    __syncthreads();
    f32x4 U0[4][4], Up[4][4], o[2][4]; bf16x8 qf[2][2];
    { const HRaw r0 = hgrn_loadc<OUT>(a, bh, c, 2 * wl, lane); hgrn_chunk<OUT>(a, wb, DLs, DLs + 128, DALL + (2 * wl) * 64, layer, h, lane, r0, U0, o[0], qf[0]); }
    asm volatile("" ::: "memory"); __builtin_amdgcn_sched_barrier(0); HG_LAUNDER();
    { const HRaw r1 = hgrn_loadc<OUT>(a, bh, c, 2 * wl + 1, lane); hgrn_chunk<OUT>(a, wb, DLs + 64, DLs + 192, DALL + (2 * wl + 1) * 64, layer, h, lane, r1, Up, o[1], qf[1]); }
    asm volatile("" ::: "memory"); __builtin_amdgcn_sched_barrier(0); HG_LAUNDER();
    LDS_WAIT();
    if (OUT) { f32x4 E1[4];
#pragma unroll
        for (int mt = 0; mt < 4; ++mt) E1[mt] = *(const LAS f32x4*)(DLs + 192 + 16 * mt + 4 * q);
        hgrn_ointer(o[1], qf[1], U0, E1); }
#pragma unroll
    for (int mt = 0; mt < 4; ++mt) { const f32x4 D1 = *(const LAS f32x4*)(DLs + 64 + 16 * mt + 4 * q);
#pragma unroll
        for (int nt = 0; nt < 4; ++nt) Up[mt][nt] = D1 * U0[mt][nt] + Up[mt][nt]; }
    HG_LAUNDER();
#pragma unroll
    for (int i = 0; i < 4; ++i) { f32x4 hv = {0.f, 0.f, 0.f, 0.f};
        if (OUT) hv = *(const f32x4*)(HU + (size_t)item * 4096 + (size_t)((4 * wl + i) * 64 + lane) * 4);
        *(LAS f32x4*)(SBUF + ((4 * wl + i) * 64 + lane) * 4) = hv; }
    v4u gq[2][2];
    if (OUT) { const bf16* gp = (const bf16*)(a.ws + WS_PROJ) + (rowc0 + (lane >> 3)) * DIN + 768 + h * 64 + (lane & 7) * 8;
#pragma unroll
        for (int k = 0; k < 2; ++k) { gq[k][0] = *(const v4u*)(gp + (size_t)(16 * k) * DIN); gq[k][1] = *(const v4u*)(gp + (size_t)(16 * k + 8) * DIN); } }
    __syncthreads();
    HG_LAUNDER();
    f32x4 Sin[4][4];
#pragma unroll 1
    for (int step = 0; step < 4; ++step) {
        if (wl == step) {
#pragma unroll
            for (int mt = 0; mt < 4; ++mt) { const f32x4 Dp = *(const LAS f32x4*)(DLs + 16 * mt + 4 * q) * *(const LAS f32x4*)(DLs + 64 + 16 * mt + 4 * q);
#pragma unroll
                for (int nt = 0; nt < 4; ++nt) {
                    Sin[mt][nt] = *(const LAS f32x4*)(SBUF + ((mt * 4 + nt) * 64 + lane) * 4);
                    Up[mt][nt] = Dp * Sin[mt][nt] + Up[mt][nt];
                    *(LAS f32x4*)(SBUF + ((mt * 4 + nt) * 64 + lane) * 4) = Up[mt][nt];
                } }
        }
        __syncthreads();
    }
    HG_LAUNDER();
    if (OUT) {
        { f32x4 E0[4];
#pragma unroll
          for (int mt = 0; mt < 4; ++mt) E0[mt] = *(const LAS f32x4*)(DLs + 128 + 16 * mt + 4 * q);
          hgrn_ointer(o[0], qf[0], Sin, E0);
#pragma unroll
          for (int mt = 0; mt < 4; ++mt) E0[mt] = *(const LAS f32x4*)(DLs + 192 + 16 * mt + 4 * q) * *(const LAS f32x4*)(DLs + 16 * mt + 4 * q);
          hgrn_ointer(o[1], qf[1], Sin, E0); }
        HG_LAUNDER();
        LAS bf16* GT = (LAS bf16*)(wb + 4608); LAS bf16* OT = (LAS bf16*)(wb + 7680);
        float gn[4];
#pragma unroll
        for (int nt = 0; nt < 4; ++nt) gn[nt] = a.in[5][layer * 64 + 16 * nt + l15];
#pragma unroll
        for (int k = 0; k < 2; ++k) {
            const int rr = lane >> 3, cc = (lane & 7) * 8;
            LDS_WAIT();
            *(LAS v4u*)(GT + rr * 72 + cc) = gq[k][0]; *(LAS v4u*)(GT + (rr + 8) * 72 + cc) = gq[k][1];
            LDS_WAIT();
#pragma unroll
            for (int j = 0; j < 4; ++j) {
                float ss = (o[k][0][j] * o[k][0][j] + o[k][1][j] * o[k][1][j]) + (o[k][2][j] * o[k][2][j] + o[k][3][j] * o[k][3][j]);
                ss += __shfl_xor(ss, 1); ss += __shfl_xor(ss, 2); ss += __shfl_xor(ss, 4); ss += __shfl_xor(ss, 8);
                const float rs = __builtin_amdgcn_rsqf(ss * (1.f / 64.f) + EPS);
#pragma unroll
                for (int nt = 0; nt < 4; ++nt) { const float gt = siluf(bf1(GT[(4 * q + j) * 72 + 16 * nt + l15]));
                    OT[(4 * q + j) * 72 + 16 * nt + l15] = (bf16)f2bf(o[k][nt][j] * rs * gn[nt] * gt); }
            }
            LDS_WAIT();
            bf16* mp = (bf16*)(a.ws + WS_MIX) + (rowc0 + k * 16 + rr) * 1024 + h * 64 + cc;
            *(v4u*)mp = *(const LAS v4u*)(OT + rr * 72 + cc); *(v4u*)(mp + 8 * 1024) = *(const LAS v4u*)(OT + (rr + 8) * 72 + cc);
        }
    } else {
        if (wl == 3) {
#pragma unroll
            for (int mt = 0; mt < 4; ++mt)
#pragma unroll
                for (int nt = 0; nt < 4; ++nt)
                    *(f32x4*)(HU + (size_t)item * 4096 + (size_t)((mt * 4 + nt) * 64 + lane) * 4) = Up[mt][nt];
            float sm = 0.f;
#pragma unroll
            for (int w2 = 0; w2 < 8; ++w2) sm += DALL[w2 * 64 + lane];
            HA[(size_t)item * 64 + lane] = __expf(sm);
        }
    }
}

__device__ __forceinline__ float gelu_tanh(float y) { const float z = 0.7978845608028654f * (y + 0.044715f * y * y * y); return y * sigmf(2.f * z); }
template <bool OUT> __device__ __forceinline__ void s5_item(const PA& a, LAS unsigned char* lds, int layer, int item, int wave, int lane) {
    const int b = item >> 10, g = (item >> 6) & 15, c = item & 63, lg = layer * 16 + g;
    const bf16* PROJ = (const bf16*)(a.ws + WS_PROJ);
    const float* sa = (const float*)(a.ws + WS_S5A) + (size_t)lg * 256;
    float* XL = (float*)(a.ws + WS_XLOC) + (size_t)((b * 16 + g) * 64) * 128;
    const float ar = sa[lane], ai = sa[64 + lane];
    float xr = 0.f, xi = 0.f;
    if (OUT) { xr = XL[c * 128 + lane]; xi = XL[c * 128 + 64 + lane]; }
    const int l15 = lane & 15, quad = lane >> 4;
    const bf16x8 zero8 = {0, 0, 0, 0, 0, 0, 0, 0};
    bf16x8 bfr[8];
#pragma unroll
    for (int nt = 0; nt < 8; ++nt) bfr[nt] = (quad < 2) ? *(const bf16x8*)((const bf16*)(a.ws + WS_S5B) + (size_t)lg * 2048 + (nt * 16 + l15) * 16 + quad * 8) : zero8;
    bf16x8 cfr[4];
    if (OUT) {
#pragma unroll
        for (int ks = 0; ks < 4; ++ks) cfr[ks] = *(const bf16x8*)((const bf16*)(a.ws + WS_S5C) + (size_t)lg * 2048 + l15 * 128 + ks * 32 + quad * 8);
    }
    const float dsk = a.in[13][layer * 256 + g * 16 + l15];
    LAS float* BU = (LAS float*)(lds + wave * 12800);
    LAS bf16* X = (LAS bf16*)(lds + wave * 12800 + 8448);
    const size_t rowb = (size_t)b * T + (size_t)c * 128;
    bf16x8 afr_n = (quad < 2) ? *(const bf16x8*)(PROJ + (rowb + l15) * DIN + 1024 + g * 16 + quad * 8) : zero8;
    bf16 ue_n[4] = {0, 0, 0, 0}, se_n[4] = {0, 0, 0, 0};
    if (OUT) {
#pragma unroll
        for (int j = 0; j < 4; ++j) { ue_n[j] = PROJ[(rowb + quad * 4 + j) * DIN + 1024 + g * 16 + l15]; se_n[j] = PROJ[(rowb + quad * 4 + j) * DIN + 1280 + g * 16 + l15]; }
    }
    f32x4 accn[8];
#pragma unroll
    for (int nt = 0; nt < 8; ++nt) accn[nt] = __builtin_amdgcn_mfma_f32_16x16x32_bf16(afr_n, bfr[nt], (f32x4){0.f, 0.f, 0.f, 0.f}, 0, 0, 0);
#pragma unroll
    for (int nt = 0; nt < 8; ++nt)
#pragma unroll
        for (int j = 0; j < 4; ++j) BU[(quad * 4 + j) * 132 + nt * 16 + l15] = accn[nt][j];
    afr_n = (quad < 2) ? *(const bf16x8*)(PROJ + (rowb + 16 + l15) * DIN + 1024 + g * 16 + quad * 8) : zero8;
    for (int blk = 0; blk < 8; ++blk) {
        const size_t row0 = rowb + blk * 16;
        bf16 ue[4], se[4];
#pragma unroll
        for (int j = 0; j < 4; ++j) { ue[j] = ue_n[j]; se[j] = se_n[j]; }
        if (blk + 1 < 8) {
#pragma unroll
            for (int nt = 0; nt < 8; ++nt) accn[nt] = __builtin_amdgcn_mfma_f32_16x16x32_bf16(afr_n, bfr[nt], (f32x4){0.f, 0.f, 0.f, 0.f}, 0, 0, 0);
            if (blk + 2 < 8) afr_n = (quad < 2) ? *(const bf16x8*)(PROJ + (row0 + 32 + l15) * DIN + 1024 + g * 16 + quad * 8) : zero8;
            if (OUT) {
#pragma unroll
                for (int j = 0; j < 4; ++j) { ue_n[j] = PROJ[(row0 + 16 + quad * 4 + j) * DIN + 1024 + g * 16 + l15]; se_n[j] = PROJ[(row0 + 16 + quad * 4 + j) * DIN + 1280 + g * 16 + l15]; }
            }
        }
#pragma unroll
        for (int t = 0; t < 16; ++t) {
            const float br = BU[t * 132 + lane], bi = BU[t * 132 + 64 + lane];
            const float nr = ar * xr - ai * xi + br, ni = ar * xi + ai * xr + bi; xr = nr; xi = ni;
            if (OUT) { X[t * 136 + lane] = (bf16)f2bf(xr); X[t * 136 + 64 + lane] = (bf16)f2bf(xi); }
        }
        if (blk + 1 < 8) {
#pragma unroll
            for (int nt = 0; nt < 8; ++nt)
#pragma unroll
                for (int j = 0; j < 4; ++j) BU[(quad * 4 + j) * 132 + nt * 16 + l15] = accn[nt][j];
        }
        if (OUT) {
            f32x4 acc = {0.f, 0.f, 0.f, 0.f};
#pragma unroll
            for (int ks = 0; ks < 4; ++ks) { const bf16x8 xa = *(const LAS bf16x8*)(X + l15 * 136 + ks * 32 + quad * 8); acc = __builtin_amdgcn_mfma_f32_16x16x32_bf16(xa, cfr[ks], acc, 0, 0, 0); }
#pragma unroll
            for (int j = 0; j < 4; ++j) { const size_t row = row0 + quad * 4 + j;
                const float u = bf1(ue[j]);
                const float yg = gelu_tanh(acc[j] + dsk * u);
                ((bf16*)(a.ws + WS_YG))[row * 256 + g * 16 + l15] = (bf16)f2bf(yg);
                ((bf16*)(a.ws + WS_YGS))[row * 256 + g * 16 + l15] = (bf16)f2bf(yg * siluf(bf1(se[j]))); }
        }
    }
    LDS_WAIT();
    if (!OUT) { XL[c * 128 + lane] = xr; XL[c * 128 + 64 + lane] = xi; }
}


__device__ __forceinline__ void hgrn_scan(const PA& a, int task, int lane) {
    float* HU = (float*)(a.ws + WS_HU); const float* HA = (const float*)(a.ws + WS_HA);
    const int bh = task >> 6, r = task & 63, dk = 16 * (r >> 4) + 4 * (r & 3) + (lane & 3);
    float* up = HU + (size_t)(bh * 64) * 4096 + (size_t)r * 64 + lane; const float* ap = HA + (size_t)(bh * 64) * 64 + dk;
    float S = 0.f;
#pragma unroll 1
    for (int c0 = 0; c0 < 64; c0 += 32) {
        float u[32], av[32];
#pragma unroll
        for (int i = 0; i < 32; ++i) { u[i] = up[(size_t)(c0 + i) * 4096]; av[i] = ap[(size_t)(c0 + i) * 64]; }
#pragma unroll
        for (int i = 0; i < 32; ++i) { __hip_atomic_store(up + (size_t)(c0 + i) * 4096, S, __ATOMIC_RELAXED, __HIP_MEMORY_SCOPE_AGENT); S = av[i] * S + u[i]; }
    }
}
__device__ __forceinline__ void s5_scan(const PA& a, int layer, int task, int lane) {
    const int g = task & 15;
    const float* sa = (const float*)(a.ws + WS_S5A) + (size_t)(layer * 16 + g) * 256;
    float* XL = (float*)(a.ws + WS_XLOC) + (size_t)(task * 64) * 128;
    const float Lr = sa[128 + lane], Li = sa[192 + lane];
    float xr = 0.f, xi = 0.f;
#pragma unroll 1
    for (int c0 = 0; c0 < 64; c0 += 32) {
        float lr[32], li[32];
#pragma unroll
        for (int i = 0; i < 32; ++i) { lr[i] = XL[(c0 + i) * 128 + lane]; li[i] = XL[(c0 + i) * 128 + 64 + lane]; }
#pragma unroll
        for (int i = 0; i < 32; ++i) { __hip_atomic_store(XL + (c0 + i) * 128 + lane, xr, __ATOMIC_RELAXED, __HIP_MEMORY_SCOPE_AGENT); __hip_atomic_store(XL + (c0 + i) * 128 + 64 + lane, xi, __ATOMIC_RELAXED, __HIP_MEMORY_SCOPE_AGENT);
            const float nr = Lr * xr - Li * xi + lr[i], ni = Lr * xi + Li * xr + li[i]; xr = nr; xi = ni; }
    }
}
template <int NR> __device__ __forceinline__ void combine_rows(const PA& a, int layer, float lam, float post, size_t row0, size_t rstride, int lane) {
    const bf16* O = (const bf16*)(a.ws + WS_O); const bf16* PROJ = (const bf16*)(a.ws + WS_PROJ);
    const int h = lane >> 4, e0 = (lane & 15) * 8, j = e0 >> 6, d = e0 & 63;
    v4u o0[NR], o1[NR], gv[NR];
#pragma unroll
    for (int r = 0; r < NR; ++r) { const size_t row = row0 + r * rstride;
        o0[r] = *(const v4u*)(O + row * 1024 + (h * 4 + j) * 64 + d); o1[r] = *(const v4u*)(O + row * 1024 + (h * 4 + 2 + j) * 64 + d); gv[r] = *(const v4u*)(PROJ + row * DIN + 3072 + h * 128 + e0); }
    const f32x4 sw0 = *(const f32x4*)(a.in[20] + layer * 128 + e0), sw1 = *(const f32x4*)(a.in[20] + layer * 128 + e0 + 4);
    const float sw[8] = {sw0[0], sw0[1], sw0[2], sw0[3], sw1[0], sw1[1], sw1[2], sw1[3]};
#pragma unroll
    for (int r = 0; r < NR; ++r) { const size_t row = row0 + r * rstride;
        const unsigned a0[4] = {o0[r].x, o0[r].y, o0[r].z, o0[r].w}, a1[4] = {o1[r].x, o1[r].y, o1[r].z, o1[r].w}, ga[4] = {gv[r].x, gv[r].y, gv[r].z, gv[r].w};
        float v[8]; float ss = 0.f;
#pragma unroll
        for (int q = 0; q < 8; ++q) { const float x0 = (q & 1) ? bfhi(a0[q >> 1]) : bflo(a0[q >> 1]), x1 = (q & 1) ? bfhi(a1[q >> 1]) : bflo(a1[q >> 1]); v[q] = x0 - lam * x1; ss += v[q] * v[q]; }
        ss += __shfl_xor(ss, 1); ss += __shfl_xor(ss, 2); ss += __shfl_xor(ss, 4); ss += __shfl_xor(ss, 8);
        const float rs = post * __builtin_amdgcn_rsqf(ss * (1.f / 128.f) + EPS);
        float o[8];
#pragma unroll
        for (int q = 0; q < 8; ++q) { const float gq = (q & 1) ? bfhi(ga[q >> 1]) : bflo(ga[q >> 1]); o[q] = v[q] * rs * sw[q] * siluf(gq); }
        *(v4u*)((bf16*)(a.ws + WS_MIX) + row * 1024 + 512 + h * 128 + e0) = (v4u){pk2(o[0], o[1]), pk2(o[2], o[3]), pk2(o[4], o[5]), pk2(o[6], o[7])};
    }
}

__global__ void __launch_bounds__(NWAVES * 64, 2) hymba_fwd(Args args) {
    extern __shared__ __attribute__((aligned(16))) unsigned char lds_raw[];
    LAS unsigned char* lds = (LAS unsigned char*)lds_raw;
    cg::grid_group grid = cg::this_grid();
    int tid = threadIdx.x, lane = tid & 63, wave = __builtin_amdgcn_readfirstlane(tid >> 6);
#define RELAUNDER() do { int t_ = threadIdx.x; asm volatile("" : "+v"(t_)); tid = t_; lane = tid & 63; wave = __builtin_amdgcn_readfirstlane(tid >> 6); } while (0)
    const int G = gridDim.x, bx = blockIdx.x, vcu = (G % 8 == 0) ? (bx % 8) * (G / 8) + bx / 8 : bx;
    unsigned char* ws = args.ws;
    const int lo = args.ph_lo, hi = args.ph_hi;
    volatile LAS unsigned* MISC = (volatile LAS unsigned*)(lds + LDS_BYTES - 256);
    if (tid < 32) MISC[tid] = 0u;
    __syncthreads();
    unsigned* barw = (unsigned*)(ws + WS_CTL);
    XcdBarrier bar; bar.bar = barw; bar.x = 0; bar.st = MISC + 8;
    int ph = 0;
#ifndef MK_DIS
#define MK_DIS 0
#endif
#define EN(bit) (!((MK_DIS >> (bit)) & 1))
#ifndef MK_REP
#define MK_REP 0
#endif
#define REPS(bit) for (int rep_ = 0; rep_ < 1 + ((MK_REP >> (bit)) & 1); ++rep_)
#define IN(k) (lo <= (k) && (k) < hi)
#define SEAM() do { if (IN(ph) && IN(ph + 1)) { xcd_barrier(bar); if ((MK_REP >> 10) & 1) xcd_barrier(bar); } ++ph; RELAUNDER(); } while (0)
    bf16* PROJ = (bf16*)(ws + WS_PROJ); bf16* XN = (bf16*)(ws + WS_XN); bf16* MIX = (bf16*)(ws + WS_MIX);
    const int NGW = G * NWAVES;
#define gw (vcu * NWAVES + wave)

    const float** tabw = (const float**)(ws + WS_TAB);
    bar = xcd_barrier_post(barw, MISC + 8);
    if (IN(ph) && EN(0)) { if (bx == 0) {
            if (tid == 0) {
#pragma unroll
                for (int i = 0; i < 22; ++i) tabw[i] = args.in[i]; } }
        REPS(0) { __syncthreads(); prologue(args, lds, vcu, G, wave, lane); } }
    const PA pa{(const float* const*)tabw, args.out, ws};
    if (lo < 0) grid.sync();
    SEAM();
    for (int layer = 0; layer < DEPTH; ++layer) {
        if (IN(ph) && EN(1)) REPS(1) {
            pg8::Gemm g{layer == 0 ? (const bf16*)XN : (const bf16*)(ws + WS_HRES), (const bf16*)(ws + WS_WIN) + (size_t)layer * DIN * D, M, DIN, D}; pg8::StaticOrder S; S.init(M, DIN, G, bx);
            pg8::EpiInProj E{PROJ, (const float*)(ws + WS_ROPE), attn_body::C2, layer == 0 ? nullptr : (const float*)(ws + WS_ROWSS), (unsigned*)(ws + WS_SUCNT) + layer * 64};
            pg8::gemm_phase<pg8::EpiInProj, pg8::StaticOrder, PG8_ALIGN, PG8_SP2>(lds, g, S, E);
            if (G == 256 && bx >= 128) {
                __syncthreads();
                if (wave == 0) { unsigned* sucnt = (unsigned*)(ws + WS_SUCNT) + layer * 64; unsigned spins = 0;
                    while ((unsigned)__builtin_amdgcn_readfirstlane(__hip_atomic_load(sucnt, __ATOMIC_RELAXED, __HIP_MEMORY_SCOPE_AGENT)) < 512u) { __builtin_amdgcn_s_sleep(4); if (++spins > (1u << 22)) break; }
                    __builtin_amdgcn_fence(__ATOMIC_ACQUIRE, "agent"); asm volatile("s_waitcnt vmcnt(0)" ::: "memory"); }
                __syncthreads();
                RELAUNDER();
                for (int it = (bx - 128) * NWAVES + wave; it < 2048; it += 128 * NWAVES) s5_item<false>(pa, lds, layer, it, wave, lane);
            }
        }
        SEAM();
        if (IN(ph)) {
            if (EN(2) && G != 256) REPS(2) for (int it = gw; it < 2048; it += NGW) s5_item<false>(pa, lds, layer, it, wave, lane);
            RELAUNDER();
            if (EN(3)) REPS(3) for (int v = vcu; v < 256; v += G) hgrn_pair<false>(pa, lds, layer, v >> 5, v & 31, wave, lane);
            xcd_barrier(bar);
            unsigned* scnt = (unsigned*)(ws + WS_SCNT) + layer * 64;
            { unsigned ndone = 0;
              if (wave < 2) { for (int t2 = wave * G + vcu; t2 < 512; t2 += 2 * G) { hgrn_scan(pa, t2, lane); ++ndone; } }
              else if (wave == 2) { for (int t2 = vcu; t2 < 32; t2 += G) { s5_scan(pa, layer, t2, lane); ++ndone; } }
              if (ndone) { asm volatile("s_waitcnt vmcnt(0)" ::: "memory"); if (lane == 0) (void)__hip_atomic_fetch_add(scnt, ndone, __ATOMIC_RELAXED, __HIP_MEMORY_SCOPE_AGENT); } }
            __syncthreads();
            const attn_body::AttnTensors AT{(const attn_body::bf16*)PROJ, (const attn_body::bf16*)PROJ, (const attn_body::bf16*)PROJ, (attn_body::bf16*)(ws + WS_O)};
            if (EN(4)) REPS(4) for (int v = vcu; v < 256; v += G) { const attn_body::StaticOrder S(v); attn_body::attn_phase<attn_body::StaticOrder>((char*)lds_raw, AT, S); }
        }
        ++ph; RELAUNDER();
        if (IN(ph)) {
            __syncthreads();
            if (wave == 0) { unsigned* scnt = (unsigned*)(ws + WS_SCNT) + layer * 64; unsigned spins = 0;
                while ((unsigned)__builtin_amdgcn_readfirstlane(__hip_atomic_load(scnt, __ATOMIC_RELAXED, __HIP_MEMORY_SCOPE_AGENT)) < 544u) { __builtin_amdgcn_s_sleep(4); if (++spins > (1u << 22)) break; }
                __builtin_amdgcn_fence(__ATOMIC_ACQUIRE, "agent"); asm volatile("s_waitcnt vmcnt(0)" ::: "memory"); }
            __syncthreads();
            if (EN(5)) REPS(5) for (int it = gw; it < 2048; it += NGW) s5_item<true>(pa, lds, layer, it, wave, lane);
            RELAUNDER();
            if (EN(6)) REPS(6) for (int v = vcu; v < 256; v += G) { const int bh = v >> 5, s = v & 31; const HRaw r1 = hgrn_load<true>(pa, bh, s, wave, lane), r2 = hgrn_load<true>(pa, bh, 63 - s, wave, lane); hgrn_item2<true>(pa, lds, layer, bh, s, wave, lane, r1); hgrn_item2<true>(pa, lds, layer, bh, 63 - s, wave, lane, r2); }
        }
        SEAM();
        const int cb0 = (G > 64) ? 64 : 0;
        if (IN(ph) && bx >= cb0) {
            const float l1 = wave_sum(pa.in[16][layer * 64 + lane] * pa.in[17][layer * 64 + lane]), l2 = wave_sum(pa.in[18][layer * 64 + lane] * pa.in[19][layer * 64 + lane]);
            const float linit = (layer == 0) ? 0.2f : 0.35550906759096934f;
            const float lam = __expf(l1) - __expf(l2) + linit;
            if (EN(7)) REPS(7) { const int nw_ = (G - cb0) * NWAVES; int m = (bx - cb0) * NWAVES + wave;
                for (; m + 3 * nw_ < M; m += 4 * nw_) combine_rows<4>(pa, layer, lam, 1.f - linit, (size_t)m, (size_t)nw_, lane);
                for (; m < M; m += nw_) combine_rows<1>(pa, layer, lam, 1.f - linit, (size_t)m, 0, lane); }
        }
        if (IN(ph) && EN(8) && (bx < 64 || G <= 64)) REPS(8) {
            __syncthreads();
            int kglu = 256; asm volatile("" : "+s"(kglu));
            pg8::Gemm g{(const bf16*)(ws + WS_YG), (const bf16*)(ws + WS_GLU) + (size_t)layer * 65536, M, 256, kglu}; pg8::StaticOrder S; S.init(M, 256, G, bx);
            pg8::EpiGlu E{(const bf16*)(ws + WS_YGS), pa.in[15] + layer * 256, MIX};
            pg8::gemm_phase<pg8::EpiGlu, pg8::StaticOrder, PG8_ALIGN, PG8_SP2>(lds, g, S, E);
        }
        SEAM();
        if (IN(ph) && EN(9)) for (int rep_ = 0; rep_ < 1 + (((MK_REP >> 9) & 1) && layer == 0); ++rep_) {
            pg8::Gemm g{MIX, (const bf16*)(ws + WS_WOUT) + (size_t)layer * D * D, M, D, D}; pg8::StaticOrder S; S.init(M, D, G, bx);
            if (layer + 1 < DEPTH) { pg8::EpiRes<true> E{pa.in[0], nullptr, (float*)(ws + WS_ROWSS), nullptr, (bf16*)(ws + WS_HRES)};
                pg8::gemm_phase<pg8::EpiRes<true>, pg8::StaticOrder, PG8_ALIGN, PG8_SP2>(lds, g, S, E); }
            else if (G == 256) { pg8::EpiResFinal E{(const bf16*)(ws + WS_HRES), pa.out, (float*)(ws + WS_ROWSS2), (unsigned*)(ws + WS_PCNT), pa.in[21]};
                pg8::gemm_phase<pg8::EpiResFinal, pg8::StaticOrder, false, PG8_SP2>(lds, g, S, E); }
            else { pg8::EpiRes<false> E{nullptr, pa.out, nullptr, (const bf16*)(ws + WS_HRES), nullptr};
                pg8::gemm_phase<pg8::EpiRes<false>, pg8::StaticOrder, PG8_ALIGN, PG8_SP2>(lds, g, S, E); }
        }
        if (layer + 1 < DEPTH) { SEAM(); continue; }
        if (G == 256) break;
        SEAM();
        if (IN(ph)) {
            for (int m = gw; m < M; m += NGW) rms_row<true>(pa.out + (size_t)m * D, pa.in[21], nullptr, pa.out + (size_t)m * D, lane);
        }
    }
#undef IN
#undef SEAM
}
constexpr int N_PHASES = 1 + DEPTH * 5 + 1;

#ifndef MK_SPLIT
#define MK_SPLIT 0
#endif
extern "C" void kernel_launch(void* const* d_in, const int* in_sizes, int n_in, void* d_out, int out_size, void* d_ws, size_t ws_size, hipStream_t stream) {
    static int grid = 0;
    if (grid == 0) {
        if (n_in != 22 || in_sizes[0] != M * D || out_size != M * D || ws_size < WS_END) { fprintf(stderr, "kernel_launch: unexpected shapes (n_in %d, in0 %d, out %d, ws %zu)\n", n_in, n_in > 0 ? in_sizes[0] : -1, out_size, ws_size); grid = -1; return; }
        int dev = 0, cus = 0, per_cu = 0;
        hipGetDevice(&dev); hipDeviceGetAttribute(&cus, hipDeviceAttributeMultiprocessorCount, dev);
        hipFuncSetAttribute((const void*)hymba_fwd, hipFuncAttributeMaxDynamicSharedMemorySize, LDS_BYTES);
        hipOccupancyMaxActiveBlocksPerMultiprocessor(&per_cu, (const void*)hymba_fwd, NWAVES * 64, LDS_BYTES);
        (void)hipGetLastError();
        if (per_cu < 1) per_cu = 1;
        grid = cus * per_cu; if (grid > 256) grid = 256;
        fprintf(stderr, "kernel_launch: cus %d per_cu %d grid %d\n", cus, per_cu, grid);
    }
    if (grid < 0) return;
    Args a{};
    for (int i = 0; i < 22; ++i) a.in[i] = (const float*)d_in[i];
    a.out = (float*)d_out; a.ws = (unsigned char*)d_ws;
#if MK_SPLIT
    for (int p = 0; p < N_PHASES; ++p) { a.ph_lo = p; a.ph_hi = p + 1; hipLaunchKernelGGL(hymba_fwd, dim3(grid), dim3(NWAVES * 64), LDS_BYTES, stream, a); }
#else
    a.ph_lo = 0; a.ph_hi = N_PHASES;
    (void)hipMemsetAsync((char*)d_ws + WS_CTL, 0, 16384, stream);
    void* kargs[] = {&a};
    hipError_t e = hipLaunchCooperativeKernel((const void*)hymba_fwd, dim3(grid), dim3(NWAVES * 64), kargs, LDS_BYTES, stream);
    if (e != hipSuccess) fprintf(stderr, "cooperative launch failed: %s (grid %d)\n", hipGetErrorString(e), grid);
#endif
}
```

```cpp
#include <hip/hip_runtime.h>
#include <hip/hip_cooperative_groups.h>
#include <cstdio>
#include <cstdint>
namespace pg8 {
#define PG8_LAS __attribute__((address_space(3)))
typedef unsigned short bf16_t;
typedef short bf16x8 __attribute__((ext_vector_type(8)));
typedef float f32x4 __attribute__((ext_vector_type(4)));
typedef unsigned u32x4 __attribute__((ext_vector_type(4)));
constexpr int BM = 256, BK = 64, HALF = 128, HTB = HALF * BK * 2  , STAGE_BYTES = 8 * HTB, NXCD = 8, WGM = 8;

__host__ __device__ __forceinline__ int lds_byte(int r, int c) { const int st = (r >> 4) * 2 + (c >> 5), rr = r & 15, cc = c & 31, ob = rr * 64 + cc * 2; return st * 1024 + (ob ^ (((ob >> 9) & 1) << 5)); }
__host__ __device__ __forceinline__ void stage_rc(int b, int& R, int& C) { const int st = b / 1024, sb = b % 1024, swz = sb ^ (((sb >> 9) & 1) << 5); R = (st >> 1) * 16 + swz / 64; C = (st & 1) * 32 + (swz % 64) / 2; }
__host__ __device__ __forceinline__ int perm32(int rho) { const int n = rho >> 4, i = rho & 15; return 8 * (i >> 2) + 4 * n + (i & 3); }

struct Unit { int pm, pn; };
struct Gemm { const bf16_t* A; const bf16_t* Bt; int M, N, K; };

struct StaticOrder {
    int nM, nN, nwg, G, c;
    __host__ __device__ void init(int M, int N, int G_, int c_) { nM = M / BM; nN = N / BM; nwg = nM * nN; G = G_; c = c_; }
    __host__ __device__ bool next(int i, Unit& u) const {
        const long L = (long)i * G + c; if (L >= nwg) return false;
        int wgid = (int)L; { const int q = nwg / NXCD, r = nwg % NXCD, xcd = wgid % NXCD, off = wgid / NXCD; wgid = (xcd < r ? xcd * (q + 1) : r * (q + 1) + (xcd - r) * q) + off; }
        const int nig = WGM * nN, gid = wgid / nig, fm = gid * WGM, gsz = (nM - fm) < WGM ? (nM - fm) : WGM;
        u.pm = fm + ((wgid % nig) % gsz); u.pn = (wgid % nig) / gsz; return true;
    }
    __device__ __forceinline__ void a_ready(const Unit&) const {}
    __device__ __forceinline__ void done(const Unit&) const {}
};

__device__ __forceinline__ unsigned cvt_pk_bf16(float lo, float hi) { unsigned r; asm volatile("v_cvt_pk_bf16_f32 %0, %1, %2" : "=v"(r) : "v"(lo), "v"(hi)); return r; }
typedef float f32x2 __attribute__((ext_vector_type(2)));
__device__ __forceinline__ f32x2 gelu_pk(f32x2 v) {
    const f32x2 av = __builtin_elementwise_abs(v), d = av * 0.2316418882f + 1.0f;
    f32x2 t; t.x = __builtin_amdgcn_rcpf(d.x); t.y = __builtin_amdgcn_rcpf(d.y);
    f32x2 q = t * 0.5307027145f + (-0.7265760135f); q = q * t + 0.7107068705f; q = q * t + (-0.142248368f); q = q * t + 0.127414796f; q = q * t;
    const f32x2 s = (v * v) * (-0.72134752044f);
    f32x2 e; e.x = __builtin_amdgcn_exp2f(s.x); e.y = __builtin_amdgcn_exp2f(s.y);
    const f32x2 m = v * (q * e), r = v - m;
    f32x2 o; o.x = v.x < 0.f ? m.x : r.x; o.y = v.y < 0.f ? m.y : r.y; return o;
}

template <int ACT  > struct EpiBf16 {
    static constexpr bool PERM = true, AFTER_DRAIN = false; static_assert(ACT == 0 || ACT == 1, "EpiBf16: ACT is 0 (none) or 1 (gelu_pk)");
    bf16_t* O; int ldc; const float* bias; int split_cols; size_t split_stride; float scale0;
    __device__ __forceinline__ void operator()(const f32x4 (&acc)[2][2][4][2], const Unit& u, int wr, int wc, int fr, int fq) const {
        const int row0 = u.pm * BM + wr * 64 + fr; int colt = u.pn * BM; bf16_t* base = O;
        float sc = 1.f; if (split_cols) { const int t = colt / split_cols; base += (size_t)t * split_stride; colt -= t * split_cols; if (t == 0) sc = scale0; }
        const int col0 = colt + wc * 32 + 8 * fq, bcol0 = u.pn * BM + wc * 32 + 8 * fq;
        f32x4 bv[2][2];
#pragma unroll
        for (int bj = 0; bj < 2; ++bj)
#pragma unroll
            for (int n = 0; n < 2; ++n) bv[bj][n] = bias ? *(const f32x4*)(bias + bcol0 + bj * HALF + 4 * n) : (f32x4){0.f, 0.f, 0.f, 0.f};
#pragma unroll
        for (int ai = 0; ai < 2; ++ai)
#pragma unroll
            for (int m = 0; m < 4; ++m) { bf16_t* rowp = base + (size_t)(row0 + ai * HALF + m * 16) * ldc + col0;
#pragma unroll
                for (int bj = 0; bj < 2; ++bj) { f32x4 v0 = acc[ai][bj][m][0] + bv[bj][0], v1 = acc[ai][bj][m][1] + bv[bj][1];
                    if (ACT == 1) { f32x2 a = gelu_pk((f32x2){v0[0], v0[1]}), b = gelu_pk((f32x2){v0[2], v0[3]}), c = gelu_pk((f32x2){v1[0], v1[1]}), d = gelu_pk((f32x2){v1[2], v1[3]});
                        v0 = (f32x4){a.x, a.y, b.x, b.y}; v1 = (f32x4){c.x, c.y, d.x, d.y}; }
                    v0 = v0 * sc; v1 = v1 * sc; u32x4 w; w.x = cvt_pk_bf16(v0[0], v0[1]); w.y = cvt_pk_bf16(v0[2], v0[3]); w.z = cvt_pk_bf16(v1[0], v1[1]); w.w = cvt_pk_bf16(v1[2], v1[3]);
                    *(u32x4*)(rowp + bj * HALF) = w; } }
    }
};
__device__ __forceinline__ float bf2f(unsigned short h) { return __uint_as_float(((unsigned)h) << 16); }
#define WT_RSRC(base, bytes) __builtin_amdgcn_make_buffer_rsrc((void*)(base), 0, (int)(bytes), 0x00020000)
#define WT_ST16(rsrc, byteoff, v) __builtin_amdgcn_raw_buffer_store_b128((v), (rsrc), (unsigned)(byteoff), 0, 16)
__device__ __forceinline__ float sigm(float v) { return __builtin_amdgcn_rcpf(1.0f + __builtin_amdgcn_exp2f(-1.4426950408889634f * v)); }
struct EpiInProj {
    static constexpr bool PERM = true, AFTER_DRAIN = false;
    bf16_t* O; const float* rope; float qscale; const float* rowss; unsigned* sucnt;
    __device__ __forceinline__ void operator()(const f32x4 (&acc)[2][2][4][2], const Unit& u, int wr, int wc, int fr, int fq) const {
        const int row0 = u.pm * BM + wr * 64 + fr, col0 = u.pn * BM + wc * 32 + 8 * fq;
        const bool ropewave = (u.pn >= 6 && u.pn < 10) && ((wc & 1) == 0);
        const float sc = (u.pn == 6 || u.pn == 7) ? qscale : 1.f;
        const float sgn = (fq == 0) ? -1.f : 1.f;
        const bool pub = (u.pn == 4);
        const __amdgpu_buffer_rsrc_t orsrc = WT_RSRC(O, 16384u * 3584u * 2u);
#pragma unroll
        for (int ai = 0; ai < 2; ++ai)
#pragma unroll
            for (int m = 0; m < 4; ++m) {
                const int row = row0 + ai * HALF + m * 16;
                bf16_t* rowp = O + (size_t)row * 3584 + col0;
                const float scr = rowss ? sc * __builtin_amdgcn_rsqf(rowss[row] * (1.0f / 1024.0f) + 1e-6f) : sc;
                f32x4 cs[4];
                if (ropewave) { const float* rp = rope + (size_t)(row & 8191) * 16;
#pragma unroll
                    for (int k = 0; k < 4; ++k) cs[k] = *(const f32x4*)(rp + 4 * k); }
#pragma unroll
                for (int bj = 0; bj < 2; ++bj) {
                    f32x4 v0 = acc[ai][bj][m][0], v1 = acc[ai][bj][m][1];
                    if (ropewave) {
                        float v[8] = {v0[0], v0[1], v0[2], v0[3], v1[0], v1[1], v1[2], v1[3]};
#pragma unroll
                        for (int j = 0; j < 8; ++j) {
                            const float p = __shfl_xor(v[j], 16);
                            const float c = cs[j >> 1][(j & 1) * 2], s = cs[j >> 1][(j & 1) * 2 + 1];
                            const float nv = v[j] * c + sgn * p * s;
                            v[j] = (fq < 2) ? nv : v[j];
                        }
                        v0 = (f32x4){v[0], v[1], v[2], v[3]}; v1 = (f32x4){v[4], v[5], v[6], v[7]};
                    }
                    v0 = v0 * scr; v1 = v1 * scr;
                    u32x4 w; w.x = cvt_pk_bf16(v0[0], v0[1]); w.y = cvt_pk_bf16(v0[2], v0[3]); w.z = cvt_pk_bf16(v1[0], v1[1]); w.w = cvt_pk_bf16(v1[2], v1[3]);
                    if (pub) WT_ST16(orsrc, ((size_t)row * 3584 + col0 + bj * HALF) * 2, w); else *(u32x4*)(rowp + bj * HALF) = w;
                }
                asm volatile("" ::: "memory");
            }
        if (pub) { asm volatile("s_waitcnt vmcnt(0)" ::: "memory"); if (fr == 0 && fq == 0) (void)__hip_atomic_fetch_add(sucnt, 1u, __ATOMIC_RELAXED, __HIP_MEMORY_SCOPE_AGENT); }
    }
};
template <bool NEXT> struct EpiRes {
    static constexpr bool PERM = false, AFTER_DRAIN = false;
    const float* base; float* out; float* rowss; const bf16_t* baseh; bf16_t* XN;
    __device__ __forceinline__ void operator()(const f32x4 (&acc)[2][2][4][2], const Unit& u, int wr, int wc, int fr, int fq) const {
        typedef unsigned u32x2 __attribute__((ext_vector_type(2)));
        const int col0 = u.pn * BM + wc * 32 + 4 * fq;
#pragma unroll
        for (int ai = 0; ai < 2; ++ai)
#pragma unroll
            for (int m = 0; m < 4; ++m) {
                const int row = u.pm * BM + ai * HALF + wr * 64 + m * 16 + fr;
                const size_t off = (size_t)row * 1024 + col0;
                float ss = 0.f;
#pragma unroll
                for (int bj = 0; bj < 2; ++bj)
#pragma unroll
                    for (int n = 0; n < 2; ++n) {
                        f32x4 bs;
                        { const u32x2 hb = *(const u32x2*)(baseh + off + bj * HALF + n * 16); bs = (f32x4){__uint_as_float(hb.x << 16), __uint_as_float(hb.x & 0xffff0000u), __uint_as_float(hb.y << 16), __uint_as_float(hb.y & 0xffff0000u)}; }
                        const f32x4 o = bs + acc[ai][bj][m][n];
                        if (NEXT) { ss += (o[0] * o[0] + o[1] * o[1]) + (o[2] * o[2] + o[3] * o[3]);
                            u32x2 w; w.x = cvt_pk_bf16(o[0], o[1]); w.y = cvt_pk_bf16(o[2], o[3]); *(u32x2*)(XN + off + bj * HALF + n * 16) = w; }
                        else *(f32x4*)(out + off + bj * HALF + n * 16) = o;
                    }
                if (NEXT) { ss += __shfl_xor(ss, 16); ss += __shfl_xor(ss, 32); if (fq == 0) atomicAdd(rowss + row, ss); }
                if (m & 1) asm volatile("" ::: "memory");
            }
    }
};
struct EpiResFinal {
    static constexpr bool PERM = false, AFTER_DRAIN = true;
    const bf16_t* baseh; float* out; float* rowss2; unsigned* cnt; const float* fw;
    __device__ __forceinline__ void operator()(const f32x4 (&)[2][2][4][2], const Unit&, int, int, int, int) const {}
    __device__ __forceinline__ void fused(f32x4 (&acc)[2][2][4][2], const Unit& u, int wr, int wc, int fr, int fq, PG8_LAS unsigned char*, int wid, int lane) const {
        typedef unsigned u32x2 __attribute__((ext_vector_type(2)));
        const int col0 = u.pn * BM + wc * 32 + 4 * fq;
#pragma unroll
        for (int ai = 0; ai < 2; ++ai)
#pragma unroll
            for (int m = 0; m < 4; ++m) {
                const int row = u.pm * BM + ai * HALF + wr * 64 + m * 16 + fr;
                const size_t off = (size_t)row * 1024 + col0;
                float ss = 0.f;
#pragma unroll
                for (int bj = 0; bj < 2; ++bj)
#pragma unroll
                    for (int n = 0; n < 2; ++n) { const u32x2 hb = *(const u32x2*)(baseh + off + bj * HALF + n * 16);
                        const f32x4 o = (f32x4){__uint_as_float(hb.x << 16), __uint_as_float(hb.x & 0xffff0000u), __uint_as_float(hb.y << 16), __uint_as_float(hb.y & 0xffff0000u)} + acc[ai][bj][m][n]; acc[ai][bj][m][n] = o;
                        ss += (o[0] * o[0] + o[1] * o[1]) + (o[2] * o[2] + o[3] * o[3]); }
                ss += __shfl_xor(ss, 16); ss += __shfl_xor(ss, 32);
                if (fq == 0) (void)__hip_atomic_fetch_add(rowss2 + row, ss, __ATOMIC_RELAXED, __HIP_MEMORY_SCOPE_AGENT);
                if (m & 1) asm volatile("" ::: "memory");
            }
        asm volatile("s_waitcnt vmcnt(0)" ::: "memory");
        __builtin_amdgcn_s_barrier(); asm volatile("" ::: "memory");
        if (wid == 0) {
            if (lane == 0) (void)__hip_atomic_fetch_add(cnt + u.pm, 1u, __ATOMIC_RELAXED, __HIP_MEMORY_SCOPE_AGENT);
            unsigned spins = 0;
            while ((unsigned)__builtin_amdgcn_readfirstlane(__hip_atomic_load(cnt + u.pm, __ATOMIC_RELAXED, __HIP_MEMORY_SCOPE_AGENT)) < 4u) { __builtin_amdgcn_s_sleep(4); if (++spins > (1u << 20)) break; }
            __builtin_amdgcn_fence(__ATOMIC_ACQUIRE, "agent");
            asm volatile("s_waitcnt vmcnt(0)" ::: "memory");
        }
        __builtin_amdgcn_s_barrier(); asm volatile("" ::: "memory");
        f32x4 wv[2][2];
#pragma unroll
        for (int bj = 0; bj < 2; ++bj)
#pragma unroll
            for (int n = 0; n < 2; ++n) wv[bj][n] = *(const f32x4*)(fw + col0 + bj * HALF + n * 16);
#pragma unroll
        for (int ai = 0; ai < 2; ++ai)
#pragma unroll
            for (int m = 0; m < 4; ++m) {
                const int row = u.pm * BM + ai * HALF + wr * 64 + m * 16 + fr;
                const size_t off = (size_t)row * 1024 + col0;
                const float rs = __builtin_amdgcn_rsqf(__hip_atomic_load(rowss2 + row, __ATOMIC_RELAXED, __HIP_MEMORY_SCOPE_AGENT) * (1.0f / 1024.0f) + 1e-6f);
#pragma unroll
                for (int bj = 0; bj < 2; ++bj)
#pragma unroll
                    for (int n = 0; n < 2; ++n) *(f32x4*)(out + off + bj * HALF + n * 16) = acc[ai][bj][m][n] * rs * wv[bj][n];
            }
    }
};
struct EpiGlu {
    static constexpr bool PERM = true, AFTER_DRAIN = false;
    const bf16_t* YGS; const float* bias; bf16_t* MIX;
    __device__ __forceinline__ void operator()(const f32x4 (&acc)[2][2][4][2], const Unit& u, int wr, int wc, int fr, int fq) const {
        typedef unsigned u32x2 __attribute__((ext_vector_type(2)));
        const int row0 = u.pm * BM + wr * 64 + fr, col0 = wc * 32 + 8 * fq;
#pragma unroll
        for (int bj = 0; bj < 2; ++bj)
#pragma unroll
            for (int n = 0; n < 2; ++n) {
                const int c = col0 + bj * HALF + 4 * n;
                const f32x4 bv = *(const f32x4*)(bias + c);
#pragma unroll
                for (int ai = 0; ai < 2; ++ai)
#pragma unroll
                    for (int m = 0; m < 4; ++m) {
                        const size_t row = (size_t)(row0 + ai * HALF + m * 16);
                        const f32x4 v = acc[ai][bj][m][n] + bv;
                        const u32x2 yv = *(const u32x2*)(YGS + row * 256 + c);
                        const float y0 = __uint_as_float(yv.x << 16), y1 = __uint_as_float(yv.x & 0xffff0000u), y2 = __uint_as_float(yv.y << 16), y3 = __uint_as_float(yv.y & 0xffff0000u);
                        u32x2 w; w.x = cvt_pk_bf16(y0 * sigm(v[0]), y1 * sigm(v[1])); w.y = cvt_pk_bf16(y2 * sigm(v[2]), y3 * sigm(v[3]));
                        *(u32x2*)(MIX + row * 1024 + 256 + c) = w;
                        if (m & 1) asm volatile("" ::: "memory");
                    }
            }
    }
};
template <class Epi, class Sched, bool ALIGN_EPI = false, bool SP2 = false>
__device__ __forceinline__ void gemm_phase(PG8_LAS unsigned char* lds, const Gemm g, const Sched& S, const Epi& E) {
    int tid_l = threadIdx.x; asm volatile("" : "+v"(tid_l));
    const int tid = tid_l, wid = __builtin_amdgcn_readfirstlane(tid >> 6), lane = tid & 63, wr = wid >> 2, wc = wid & 3, fr = lane & 15, fq = lane >> 4;
    const int K = g.K, nt = K / BK;
    unsigned voffA[2], voffB[2];
#pragma unroll
    for (int i = 0; i < 2; ++i) { int R, C; stage_rc(tid * 16 + i * 8192, R, C); const int Rb = Epi::PERM ? ((R & ~31) + perm32(R & 31)) : R;
        voffA[i] = (unsigned)(R * K + C) * 2u; voffB[i] = (unsigned)(Rb * K + C) * 2u; }
    const size_t kstep = (size_t)(BK * 2);
    const size_t hstep = (size_t)HALF * K * 2;
    const size_t tstep = 2 * hstep;
    const unsigned ldsw = (unsigned)wid * 1024u;
    const int aoff = lds_byte(wr * 64 + fr, fq * 8), boff = lds_byte(wc * 32 + fr, fq * 8);
#define PG8_SA(b, h) (((b) * 2 + (h)) * HTB)
#define PG8_SB(b, h) ((4 + (b) * 2 + (h)) * HTB)
#define PG8_STAGE(bufoff, gbase, voff) do { _Pragma("unroll") for (int _i = 0; _i < 2; ++_i) \
        __builtin_amdgcn_global_load_lds((const unsigned*)((const char*)(gbase) + (voff)[_i]), (PG8_LAS unsigned*)(lds + (bufoff) + ldsw + _i * 8192), 16, 0, 0); } while (0)
#define PG8_LDA(dst, b, h) do { _Pragma("unroll") for (int m = 0; m < 4; ++m) _Pragma("unroll") for (int k = 0; k < 2; ++k) dst[m][k] = *(const PG8_LAS bf16x8*)(lds + PG8_SA(b, h) + aoff + m * 2048 + k * 1024); } while (0)
#define PG8_LDB(dst, b, h) do { _Pragma("unroll") for (int n = 0; n < 2; ++n) _Pragma("unroll") for (int k = 0; k < 2; ++k) dst[n][k] = *(const PG8_LAS bf16x8*)(lds + PG8_SB(b, h) + boff + n * 2048 + k * 1024); } while (0)
#define PG8_MMA(ai, bj, At, Bt) do { __builtin_amdgcn_s_setprio(1); _Pragma("unroll") for (int m = 0; m < 4; ++m) _Pragma("unroll") for (int n = 0; n < 2; ++n) _Pragma("unroll") for (int k = 0; k < 2; ++k) \
        acc[ai][bj][m][n] = __builtin_amdgcn_mfma_f32_16x16x32_bf16(Bt[n][k], At[m][k], acc[ai][bj][m][n], 0, 0, 0); __builtin_amdgcn_s_setprio(0); } while (0)
#define PG8_WAIT_V(n) asm volatile("s_waitcnt vmcnt(" #n ")" ::: "memory")
#define PG8_WAIT_L(n) asm volatile("s_waitcnt lgkmcnt(" #n ")" ::: "memory")
#define PG8_BAR __builtin_amdgcn_s_barrier()
#define PG8_SCHED __builtin_amdgcn_sched_barrier(0)
    Unit cur, nxt; int ui = 0;
    if (!S.next(0, cur)) return;
    f32x4 acc[2][2][4][2];
#pragma unroll
    for (int a = 0; a < 2; ++a)
#pragma unroll
        for (int b = 0; b < 2; ++b)
#pragma unroll
            for (int m = 0; m < 4; ++m)
#pragma unroll
                for (int n = 0; n < 2; ++n) acc[a][b][m][n] = (f32x4){0.f, 0.f, 0.f, 0.f};
    bf16x8 At[4][2], B0[2][2], B1[2][2];
    const char* cA = (const char*)g.A + (size_t)cur.pm * tstep; const char* cB = (const char*)g.Bt + (size_t)cur.pn * tstep;
    S.a_ready(cur);
    if constexpr (SP2) {
        PG8_STAGE(PG8_SB(0, 0), cB, voffB); PG8_STAGE(PG8_SB(0, 1), cB + hstep, voffB); PG8_STAGE(PG8_SA(0, 0), cA, voffA); PG8_STAGE(PG8_SA(0, 1), cA + hstep, voffA);
        if (wr == 1) PG8_BAR;
        PG8_WAIT_V(2); PG8_BAR;
        PG8_STAGE(PG8_SB(1, 0), cB + kstep, voffB); PG8_STAGE(PG8_SA(1, 0), cA + kstep, voffA); PG8_STAGE(PG8_SB(1, 1), cB + hstep + kstep, voffB);
        PG8_WAIT_V(6); PG8_BAR;
    } else {
        PG8_STAGE(PG8_SB(0, 0), cB, voffB); PG8_STAGE(PG8_SA(0, 0), cA, voffA); PG8_STAGE(PG8_SB(0, 1), cB + hstep, voffB); PG8_STAGE(PG8_SA(0, 1), cA + hstep, voffA);
        if (wr == 1) PG8_BAR;
        PG8_WAIT_V(4); PG8_BAR;
        PG8_STAGE(PG8_SB(1, 0), cB + kstep, voffB); PG8_STAGE(PG8_SA(1, 0), cA + kstep, voffA); PG8_STAGE(PG8_SB(1, 1), cB + hstep + kstep, voffB);
        PG8_WAIT_V(6); PG8_BAR;
    }
    for (;;) {
        const bool has_next = S.next(ui + 1, nxt);
        const char* nA = has_next ? (const char*)g.A + (size_t)nxt.pm * tstep : cA; const char* nB = has_next ? (const char*)g.Bt + (size_t)nxt.pn * tstep : cB;
        for (int t = 0; t < nt; t += 2) {
            const bool last = (t == nt - 2);
            const char* a1 = cA + (size_t)(t + 1) * kstep;
            const char* a2 = last ? nA : cA + (size_t)(t + 2) * kstep; const char* b2 = last ? nB : cB + (size_t)(t + 2) * kstep;
            const char* a3 = a2 + kstep; const char* b3 = b2 + kstep;
            if (last && has_next) S.a_ready(nxt);
            if constexpr (SP2) {
            PG8_LDB(B0, 0, 0); PG8_LDB(B1, 0, 1); PG8_SCHED; PG8_LDA(At, 0, 0); PG8_STAGE(PG8_SA(1, 1), a1 + hstep, voffA);
            PG8_WAIT_V(8); PG8_WAIT_L(0); PG8_BAR; PG8_MMA(0, 0, At, B0); PG8_MMA(0, 1, At, B1); PG8_BAR; PG8_SCHED;
            PG8_LDA(At, 0, 1); PG8_STAGE(PG8_SB(0, 0), b2, voffB); PG8_STAGE(PG8_SB(0, 1), b2 + hstep, voffB); PG8_STAGE(PG8_SA(0, 0), a2, voffA);
            PG8_WAIT_V(8); PG8_WAIT_L(0); PG8_BAR; PG8_MMA(1, 0, At, B0); PG8_MMA(1, 1, At, B1); PG8_BAR; PG8_SCHED;
            PG8_LDB(B0, 1, 0); PG8_LDB(B1, 1, 1); PG8_SCHED; PG8_LDA(At, 1, 0); PG8_STAGE(PG8_SA(0, 1), a2 + hstep, voffA);
            PG8_WAIT_V(8); PG8_WAIT_L(0); PG8_BAR; PG8_MMA(0, 0, At, B0); PG8_MMA(0, 1, At, B1); PG8_BAR; PG8_SCHED;
            PG8_LDA(At, 1, 1); PG8_STAGE(PG8_SB(1, 0), b3, voffB); PG8_STAGE(PG8_SB(1, 1), b3 + hstep, voffB); PG8_STAGE(PG8_SA(1, 0), a3, voffA);
            PG8_WAIT_V(8); PG8_WAIT_L(0); PG8_BAR; PG8_MMA(1, 0, At, B0); PG8_MMA(1, 1, At, B1); PG8_BAR; PG8_SCHED;
            } else {
            PG8_LDB(B0, 0, 0); PG8_SCHED; PG8_LDA(At, 0, 0); PG8_STAGE(PG8_SA(1, 1), a1 + hstep, voffA);
            PG8_WAIT_L(8); PG8_BAR; PG8_WAIT_L(0); PG8_MMA(0, 0, At, B0); PG8_BAR; PG8_SCHED;
            PG8_LDB(B1, 0, 1); PG8_STAGE(PG8_SB(0, 0), b2, voffB);
            PG8_BAR; PG8_WAIT_L(0); PG8_MMA(0, 1, At, B1); PG8_BAR;
            PG8_LDA(At, 0, 1); PG8_STAGE(PG8_SA(0, 0), a2, voffA);
            PG8_BAR; PG8_WAIT_L(0); PG8_MMA(1, 0, At, B0); PG8_BAR; PG8_SCHED;
            PG8_STAGE(PG8_SB(0, 1), b2 + hstep, voffB);
            PG8_WAIT_V(6); PG8_BAR; PG8_MMA(1, 1, At, B1); PG8_BAR;
            PG8_LDB(B0, 1, 0); PG8_SCHED; PG8_LDA(At, 1, 0); PG8_STAGE(PG8_SA(0, 1), a2 + hstep, voffA);
            PG8_WAIT_L(8); PG8_BAR; PG8_WAIT_L(0); PG8_MMA(0, 0, At, B0); PG8_BAR; PG8_SCHED;
            PG8_LDB(B1, 1, 1); PG8_STAGE(PG8_SB(1, 0), b3, voffB);
            PG8_BAR; PG8_WAIT_L(0); PG8_MMA(0, 1, At, B1); PG8_BAR;
            PG8_LDA(At, 1, 1); PG8_STAGE(PG8_SA(1, 0), a3, voffA);
            PG8_BAR; PG8_WAIT_L(0); PG8_MMA(1, 0, At, B0); PG8_BAR; PG8_SCHED;
            PG8_STAGE(PG8_SB(1, 1), b3 + hstep, voffB);
            PG8_WAIT_V(6); PG8_BAR; PG8_MMA(1, 1, At, B1); PG8_BAR;
            }
        }
        if constexpr (ALIGN_EPI) { if (wr == 0) PG8_BAR; }
        if constexpr (!Epi::AFTER_DRAIN) { E(acc, cur, wr, wc, fr, fq); S.done(cur); }
        if (!has_next) break;
#pragma unroll
        for (int a = 0; a < 2; ++a)
#pragma unroll
            for (int b = 0; b < 2; ++b)
#pragma unroll
                for (int m = 0; m < 4; ++m)
#pragma unroll
                    for (int n = 0; n < 2; ++n) acc[a][b][m][n] = (f32x4){0.f, 0.f, 0.f, 0.f};
        cur = nxt; cA = nA; cB = nB; ++ui;
        if constexpr (ALIGN_EPI) { if (wr == 1) PG8_BAR; }
    }
    PG8_WAIT_V(0);
    if constexpr (!ALIGN_EPI) { if (wr == 0) PG8_BAR; }
    PG8_BAR;
    if constexpr (Epi::AFTER_DRAIN) { E.fused(acc, cur, wr, wc, fr, fq, lds, wid, lane); S.done(cur); }
#undef PG8_SA
#undef PG8_SB
#undef PG8_STAGE
#undef PG8_LDA
#undef PG8_LDB
#undef PG8_MMA
#undef PG8_WAIT_V
#undef PG8_WAIT_L
#undef PG8_BAR
#undef PG8_SCHED
}
}

#ifndef PG8_SP2
#define PG8_SP2 true
#endif
#ifndef PG8_ALIGN
#define PG8_ALIGN true
#endif
#include <hip/hip_bf16.h>
#include <cmath>
namespace attn_body {
using bf16=__hip_bfloat16;
using bf16x8=__attribute__((ext_vector_type(8)))short;
using s16x4=__attribute__((ext_vector_type(4)))short;
using f32x16=__attribute__((ext_vector_type(16)))float;
using u32x4=__attribute__((ext_vector_type(4)))unsigned;
constexpr int BATCH=2,NHEAD=16,SEQ=8192,D=64,DM=NHEAD*D;
constexpr int NW=8,QBLK=32,QB=QBLK*NW,KVBLK=64,NQB=SEQ/QB;
constexpr int ATTN_PITCH=DM, ATTN_UNIT_ROWS=QB;
constexpr int PQ=3584,QCOL=1536,KCOL=2048,VCOL=2560;
__device__ __forceinline__ int crow(int r,int hi){return (r&3)+8*(r>>2)+4*hi;}
#define SBAR() __builtin_amdgcn_sched_barrier(0)
__device__ __forceinline__ void cmask(f32x16&p0,f32x16&p1,int jb,int qrel,int hi){
  const float NEG=-INFINITY; int kb=64*jb+4*hi;
  #pragma unroll
  for(int r=0;r<16;++r){int kv=kb+(r&3)+8*(r>>2); if(kv>qrel)p0[r]=NEG; if(kv+32>qrel)p1[r]=NEG;}
}

constexpr int NSLOT=3, SLOTB=8192;
constexpr int LDS_K=0, LDS_V=NSLOT*SLOTB, LDS_WS=3*NSLOT*SLOTB, LDS_OST=LDS_WS+NW*64*4, LDS_BYTES=LDS_OST+NW*4096;
constexpr float C2=0.125f*1.4426950408889634f;
__device__ __forceinline__ void glds16(const void*gsrc,unsigned lds_dst){unsigned keep;
  asm volatile("s_mov_b32 %0, m0\n\ts_mov_b32 m0, %2\n\ts_nop 0\n\tglobal_load_lds_dwordx4 %1, off\n\ts_mov_b32 m0, %0":"=&s"(keep):"v"(gsrc),"s"(lds_dst):"memory");}
__device__ __forceinline__ float max3f(float a,float b,float c){float r;asm("v_max3_f32 %0, %1, %2, %3":"=v"(r):"v"(a),"v"(b),"v"(c));return r;}
__device__ __forceinline__ float max2f(float a,float b){float r;asm("v_max_f32_e32 %0, %1, %2":"=v"(r):"v"(a),"v"(b));return r;}
__device__ __forceinline__ float fadd_s(float a,float b){float r;asm("v_add_f32_e32 %0, %1, %2":"=v"(r):"v"(a),"v"(b));return r;}
__device__ __forceinline__ float fsub_s(float a,float b){float r;asm("v_sub_f32_e32 %0, %1, %2":"=v"(r):"v"(a),"v"(b));return r;}
typedef float f32x2_t __attribute__((ext_vector_type(2))); typedef __bf16 bf16x2_t __attribute__((ext_vector_type(2)));
__device__ __forceinline__ unsigned cvtpk_s(float lo,float hi){f32x2_t v={lo,hi};bf16x2_t b=__builtin_convertvector(v,bf16x2_t);return __builtin_bit_cast(unsigned,b);}
#define WAIT_BAR(N) asm volatile("s_waitcnt vmcnt(" #N ") lgkmcnt(0)\n\ts_barrier":::"memory")

__device__ __forceinline__ void qkt(f32x16&p0,f32x16&p1,const char*Kslot,const bf16x8*qr,const f32x16&negm,int r32,int hi){
  const char*kb=Kslot+hi*1024+r32*16;
  #pragma unroll
  for(int d0=0;d0<4;++d0){
    const bf16x8 b0=*reinterpret_cast<const bf16x8*>(kb+d0*2048);
    const bf16x8 b1=*reinterpret_cast<const bf16x8*>(kb+d0*2048+512);
    if(d0==0){p0=__builtin_amdgcn_mfma_f32_32x32x16_bf16(b0,qr[0],negm,0,0,0);p1=__builtin_amdgcn_mfma_f32_32x32x16_bf16(b1,qr[0],negm,0,0,0);}
    else{p0=__builtin_amdgcn_mfma_f32_32x32x16_bf16(b0,qr[d0],p0,0,0,0);p1=__builtin_amdgcn_mfma_f32_32x32x16_bf16(b1,qr[d0],p1,0,0,0);}}
}
typedef __attribute__((address_space(3))) const char* lds_cptr;
typedef short v4i16_t __attribute__((ext_vector_type(4)));
__device__ __forceinline__ void kload8(bf16x8*kf,lds_cptr kp){
  kf[0]=*(const __attribute__((address_space(3))) bf16x8*)(kp);      kf[1]=*(const __attribute__((address_space(3))) bf16x8*)(kp+512);
  kf[2]=*(const __attribute__((address_space(3))) bf16x8*)(kp+2048); kf[3]=*(const __attribute__((address_space(3))) bf16x8*)(kp+2560);
  kf[4]=*(const __attribute__((address_space(3))) bf16x8*)(kp+4096); kf[5]=*(const __attribute__((address_space(3))) bf16x8*)(kp+4608);
  kf[6]=*(const __attribute__((address_space(3))) bf16x8*)(kp+6144); kf[7]=*(const __attribute__((address_space(3))) bf16x8*)(kp+6656);
}
__device__ __forceinline__ void kload2(bf16x8*kf,lds_cptr kp,int j){ kf[2*j]=*(const __attribute__((address_space(3))) bf16x8*)(kp+j*2048); kf[2*j+1]=*(const __attribute__((address_space(3))) bf16x8*)(kp+j*2048+512); }
__device__ __forceinline__ s16x4 vtr(lds_cptr p){ return __builtin_bit_cast(s16x4,__builtin_amdgcn_ds_read_tr16_b64_v4i16((__attribute__((address_space(3))) v4i16_t*)p)); }
__device__ __forceinline__ float rowmax(const f32x16&p0,const f32x16&p1){
  float a=max3f(p0[0],p0[1],p1[0]),b=max3f(p0[2],p0[3],p1[1]);a=max3f(a,p1[2],p1[3]);
  #pragma unroll
  for(int r=4;r<16;r+=4){a=max3f(a,p0[r],p0[r+1]);b=max3f(b,p0[r+2],p0[r+3]);a=max3f(a,p1[r],p1[r+1]);b=max3f(b,p1[r+2],p1[r+3]);}
  const float m=max2f(a,b);
  auto rr=__builtin_amdgcn_permlane32_swap(__float_as_uint(m),__float_as_uint(m),false,false);
  return max2f(__uint_as_float(rr[0]),__uint_as_float(rr[1]));
}
__device__ __forceinline__ void pv(f32x16*o,int vb,bf16x8 pa0,bf16x8 pa1,bf16x8 pa2,bf16x8 pa3){
  #pragma unroll
  for(int d0=0;d0<2;++d0){s16x4 lo[4],hi[4];
    #pragma unroll
    for(int ks=0;ks<4;++ks){
      asm volatile("ds_read_b64_tr_b16 %0,%1 offset:%c2":"=&v"(lo[ks]):"v"(vb),"i"(d0*4096+ks*1024):"memory");
      asm volatile("ds_read_b64_tr_b16 %0,%1 offset:%c2":"=&v"(hi[ks]):"v"(vb),"i"(d0*4096+ks*1024+512):"memory");}
    asm volatile("s_waitcnt lgkmcnt(0)":::"memory");SBAR();
    #define PK(k) (bf16x8){lo[k][0],lo[k][1],lo[k][2],lo[k][3],hi[k][0],hi[k][1],hi[k][2],hi[k][3]}
    o[d0]=__builtin_amdgcn_mfma_f32_32x32x16_bf16(pa0,PK(0),o[d0],0,0,0);
    o[d0]=__builtin_amdgcn_mfma_f32_32x32x16_bf16(pa1,PK(1),o[d0],0,0,0);
    o[d0]=__builtin_amdgcn_mfma_f32_32x32x16_bf16(pa2,PK(2),o[d0],0,0,0);
    o[d0]=__builtin_amdgcn_mfma_f32_32x32x16_bf16(pa3,PK(3),o[d0],0,0,0);
    #undef PK
  }
}

#ifndef ATTN_STORE16
#define ATTN_STORE16(p,v) (*(u32x4*)(p)=(v))
#endif
template<int THRL> __device__ __forceinline__ void attn_unit(int b,int h,int qb,const bf16*Q,const bf16*__restrict__ K,const bf16*__restrict__ V,bf16*O,char*shm){
  int tid_l=threadIdx.x; asm volatile("":"+v"(tid_l)); const int tid=tid_l,lane=tid&63,r32=lane&31,hi=lane>>5; const int wid=__builtin_amdgcn_readfirstlane(tid>>6);
  const long rowbase=(long)b*SEQ; const int q0=qb*QB;
  const int hh_=h>>1,mm_=h&1; const bf16*Qw=Q+(rowbase+q0+wid*QBLK)*PQ+QCOL+hh_*128+mm_*64;
  const bf16*Kh=K+rowbase*PQ+KCOL+hh_*128+mm_*64,*Vh=V+rowbase*PQ+VCOL+hh_*128;
  const unsigned lds0=(unsigned)(uintptr_t)shm;
  float*wsf=(float*)(shm+LDS_WS)+wid*64;
  const bf16*ksrc=Kh+(long)lane*PQ+wid*8;
  const bf16*vsrc=Vh+(long)(16*(wid&3)+(lane>>2))*PQ+(wid>>2)*32+(lane&3)*8;
  const unsigned kdst=lds0+LDS_K+wid*1024, vdst=lds0+LDS_V+wid*1024;
  #define DMA_K(t,slot) glds16(ksrc+(long)(t)*KVBLK*PQ,(unsigned)__builtin_amdgcn_readfirstlane(kdst+(slot)))
  #define DMA_V(t,slot) do{ glds16(vsrc+(long)(t)*KVBLK*PQ,(unsigned)__builtin_amdgcn_readfirstlane(vdst+2*(slot))); glds16(vsrc+(long)(t)*KVBLK*PQ+64,(unsigned)__builtin_amdgcn_readfirstlane(vdst+2*(slot)+8192)); }while(0)
  const int vb0=(int)(lds0+LDS_V)+((lane>>4)&1)*32+(lane&3)*8+(4*hi+((lane&15)>>2))*64;
  const char*Kbase=shm+LDS_K; bf16x8 kf[8];
  const lds_cptr shm3=(lds_cptr)shm; const lds_cptr kp0=shm3+LDS_K+hi*1024+r32*16; const lds_cptr vp0=shm3+LDS_V+((lane>>4)&1)*32+(lane&3)*8+(4*hi+((lane&15)>>2))*64;
  const int NT=(q0+QB)/KVBLK;
  DMA_K(0,0);DMA_V(0,0);DMA_K(1,SLOTB);
  bf16x8 qr[4];
  #pragma unroll
  for(int d0=0;d0<4;++d0)qr[d0]=*reinterpret_cast<const bf16x8*>(&Qw[(long)r32*PQ+d0*16+hi*8]);
  float mhat=0.f,l_reg=0.f;f32x16 o[4];o[0]=f32x16{};o[1]=f32x16{};o[2]=f32x16{};o[3]=f32x16{};f32x16 negm=f32x16{};asm volatile("":"+v"(negm));
  const int qrel=wid*QBLK+r32;
  #define CMASK(P0,P1,t) do{int jb_=(t)-(NT-4); if(jb_>=0)cmask(P0,P1,jb_,qrel,hi);}while(0)
  bool resc=false;
  #define START(P0,P1) do{ const float rm=rowmax(P0,P1); resc=false; \
    { const float dl=rm; mhat=fadd_s(mhat,dl); \
      _Pragma("unroll") for(int r=0;r<16;++r){P0[r]=fsub_s(P0[r],dl);P1[r]=fsub_s(P1[r],dl);} \
      _Pragma("unroll") for(int r=0;r<16;++r)negm[r]=-mhat; asm volatile("":"+v"(negm)); } \
    _Pragma("unroll") for(int r=0;r<16;++r)P0[r]=__builtin_amdgcn_exp2f(P0[r]); }while(0)
  #define RESC() do{ if(resc){ asm volatile("s_waitcnt lgkmcnt(0)":::"memory"); \
      _Pragma("unroll") for(int d_=0;d_<4;++d_) _Pragma("unroll") for(int r=0;r<16;++r)o[d_][r]*=wsf[crow(r,hi)]; } }while(0)
  f32x16 pA0,pA1,pB0,pB1;
  int sl_prev=0,sl_cur=0,sl_next=SLOTB;
  #define ROT() do{sl_prev=sl_cur;sl_cur=sl_next;sl_next=(sl_next==(NSLOT-1)*SLOTB)?0:sl_next+SLOTB;}while(0)
  DMA_K(2,2*SLOTB);
  WAIT_BAR(3);
  qkt(pA0,pA1,Kbase,qr,negm,r32,hi);asm volatile("s_nop 15\n\ts_nop 7":"+v"(pA0),"+v"(pA1));CMASK(pA0,pA1,0);
  START(pA0,pA1);
  _Pragma("unroll") for(int r=0;r<16;++r)pA1[r]=__builtin_amdgcn_exp2f(pA1[r]);
  WAIT_BAR(0);
  DMA_K(3,0);DMA_V(1,SLOTB);
  ROT();
  kload8(kf,kp0+sl_cur);
  WAIT_BAR(3);
  s16x4 vlo[8],vhi[8],wlo[8],whi[8]; u32x4 pw0,pw1,pw2,pw3;
  #define PKW(P,B) cvtpk_s(P[B],P[B+1])
  #define PAF(k) __builtin_bit_cast(bf16x8,pw##k)
  #define VFR(i) (bf16x8){vlo[i][0],vlo[i][1],vlo[i][2],vlo[i][3],vhi[i][0],vhi[i][1],vhi[i][2],vhi[i][3]}
  #define PIN(x) asm volatile("":"+v"(x))
  #define MX3(a,b,c) __builtin_fmaxf(__builtin_fmaxf((a),(b)),(c))
  #define GAPA(MF,A0,A1,A2,A3,W0,W1,PW) do{ MF; sacc+=A0; sacc+=A1; sacc+=A2; sacc+=A3; PIN(sacc); W0; W1; PIN(PW); SBAR(); }while(0)
  #define EX(v) __builtin_amdgcn_exp2f(v)
  #define GAPB(MF,X,B) do{ MF; X[B]=EX(X[B]); X[B+1]=EX(X[B+1]); PIN(X); SBAR(); }while(0)
  #define VRD(i) do{ vlo[i]=vtr(vp_+(((i)>>2)*4096+((i)&3)*1024)); vhi[i]=vtr(vp_+(((i)>>2)*4096+((i)&3)*1024+512)); }while(0)
  #define VRD2(i) do{ wlo[i]=vtr(vp_+(8192+((i)>>2)*4096+((i)&3)*1024)); whi[i]=vtr(vp_+(8192+((i)>>2)*4096+((i)&3)*1024+512)); SBAR(); }while(0)
  #define WFR(i) (bf16x8){wlo[i][0],wlo[i][1],wlo[i][2],wlo[i][3],whi[i][0],whi[i][1],whi[i][2],whi[i][3]}
  #define GAPC(MF,X,B) do{ MF; X[B]=EX(X[B]); X[B+1]=EX(X[B+1]); PIN(X); SBAR(); }while(0)
  #define KRD(G,j) do{ if(G){ kload2(kf,kp0+sl_next,j); SBAR(); } }while(0)
  #define STEP(C0,C1,P0,P1,t,GK,GV,GL) do{ SBAR(); \
    const lds_cptr vp_=vp0+2*sl_prev; \
    VRD(0); SBAR(); float sacc=(P0[0]+P0[1]); \
    GAPA(C0=__builtin_amdgcn_mfma_f32_32x32x16_bf16(kf[0],qr[0],negm,0,0,0), P0[2],P0[3],P0[4],P0[5],     pw0[0]=PKW(P0,0), pw0[1]=PKW(P0,2), pw0); \
    VRD(4); SBAR(); GAPA(C1=__builtin_amdgcn_mfma_f32_32x32x16_bf16(kf[1],qr[0],negm,0,0,0), P0[6],P0[7],P0[8],P0[9],     pw0[2]=PKW(P0,4), pw0[3]=PKW(P0,6), pw0); \
    VRD(1); SBAR(); GAPA(C0=__builtin_amdgcn_mfma_f32_32x32x16_bf16(kf[2],qr[1],C0,0,0,0),   P0[10],P0[11],P0[12],P0[13], pw1[0]=PKW(P0,8), pw1[1]=PKW(P0,10), pw1); \
    VRD(5); SBAR(); GAPA(C1=__builtin_amdgcn_mfma_f32_32x32x16_bf16(kf[3],qr[1],C1,0,0,0),   P0[14],P0[15],P1[0],P1[1],   pw1[2]=PKW(P0,12),pw1[3]=PKW(P0,14), pw1); \
    VRD(2); SBAR(); GAPA(C0=__builtin_amdgcn_mfma_f32_32x32x16_bf16(kf[4],qr[2],C0,0,0,0),   P1[2],P1[3],P1[4],P1[5],     pw2[0]=PKW(P1,0), pw2[1]=PKW(P1,2), pw2); \
    VRD(6); SBAR(); GAPA(C1=__builtin_amdgcn_mfma_f32_32x32x16_bf16(kf[5],qr[2],C1,0,0,0),   P1[6],P1[7],P1[8],P1[9],     pw2[2]=PKW(P1,4), pw2[3]=PKW(P1,6), pw2); \
    VRD(3); SBAR(); GAPA(C0=__builtin_amdgcn_mfma_f32_32x32x16_bf16(kf[6],qr[3],C0,0,0,0),   P1[10],P1[11],P1[12],P1[13], pw3[0]=PKW(P1,8), pw3[1]=PKW(P1,10), pw3); \
    VRD(7); SBAR(); GAPA(C1=__builtin_amdgcn_mfma_f32_32x32x16_bf16(kf[7],qr[3],C1,0,0,0),   P1[14],P1[15],0.f,0.f,       pw3[2]=PKW(P1,12),pw3[3]=PKW(P1,14), pw3); \
    l_reg+=sacc; \
    if(GK){DMA_K((t)+3,sl_cur);} if(GV){DMA_V((t)+1,sl_next);} \
    CMASK(C0,C1,t); \
    { float a=MX3(C0[0],C0[1],C1[0]),b=MX3(C0[2],C0[3],C1[1]); a=MX3(a,C1[2],C1[3]); \
      _Pragma("unroll") for(int r=4;r<16;r+=4){a=MX3(a,C0[r],C0[r+1]);b=MX3(b,C0[r+2],C0[r+3]);a=MX3(a,C1[r],C1[r+1]);b=MX3(b,C1[r+2],C1[r+3]);} \
      float rm=__builtin_fmaxf(a,b); { auto rr=__builtin_amdgcn_permlane32_swap(__float_as_uint(rm),__float_as_uint(rm),false,false); rm=__builtin_fmaxf(__uint_as_float(rr[0]),__uint_as_float(rr[1])); } \
      resc=false; \
      if(__builtin_expect(__any(rm>(float)THRL),0)){ const float dl=__builtin_fmaxf(rm,0.f); mhat+=dl; \
        _Pragma("unroll") for(int r=0;r<16;++r){C0[r]-=dl;C1[r]-=dl;} \
        _Pragma("unroll") for(int r=0;r<16;++r)negm[r]=-mhat; asm volatile("":"+v"(negm)); \
        const float f=__builtin_amdgcn_exp2f(-dl); l_reg*=f; if(hi==0)wsf[r32]=f; resc=true; } } \
    SBAR(); \
    GAPB(o[0]=__builtin_amdgcn_mfma_f32_32x32x16_bf16(PAF(0),VFR(0),o[0],0,0,0), C0,0); VRD2(0); \
    GAPB(o[1]=__builtin_amdgcn_mfma_f32_32x32x16_bf16(PAF(0),VFR(4),o[1],0,0,0), C0,2); VRD2(4); \
    KRD(GL,0); GAPB(o[0]=__builtin_amdgcn_mfma_f32_32x32x16_bf16(PAF(1),VFR(1),o[0],0,0,0), C0,4); VRD2(1); \
    KRD(GL,1); GAPB(o[1]=__builtin_amdgcn_mfma_f32_32x32x16_bf16(PAF(1),VFR(5),o[1],0,0,0), C0,6); VRD2(5); \
    KRD(GL,2); GAPB(o[0]=__builtin_amdgcn_mfma_f32_32x32x16_bf16(PAF(2),VFR(2),o[0],0,0,0), C0,8); VRD2(2); \
    KRD(GL,3); GAPB(o[1]=__builtin_amdgcn_mfma_f32_32x32x16_bf16(PAF(2),VFR(6),o[1],0,0,0), C0,10); VRD2(6); \
    GAPB(o[0]=__builtin_amdgcn_mfma_f32_32x32x16_bf16(PAF(3),VFR(3),o[0],0,0,0), C0,12); VRD2(3); \
    GAPB(o[1]=__builtin_amdgcn_mfma_f32_32x32x16_bf16(PAF(3),VFR(7),o[1],0,0,0), C0,14); VRD2(7); \
    GAPC(o[2]=__builtin_amdgcn_mfma_f32_32x32x16_bf16(PAF(0),WFR(0),o[2],0,0,0), C1,0); \
    GAPC(o[3]=__builtin_amdgcn_mfma_f32_32x32x16_bf16(PAF(0),WFR(4),o[3],0,0,0), C1,2); \
    GAPC(o[2]=__builtin_amdgcn_mfma_f32_32x32x16_bf16(PAF(1),WFR(1),o[2],0,0,0), C1,4); \
    GAPC(o[3]=__builtin_amdgcn_mfma_f32_32x32x16_bf16(PAF(1),WFR(5),o[3],0,0,0), C1,6); \
    GAPC(o[2]=__builtin_amdgcn_mfma_f32_32x32x16_bf16(PAF(2),WFR(2),o[2],0,0,0), C1,8); \
    GAPC(o[3]=__builtin_amdgcn_mfma_f32_32x32x16_bf16(PAF(2),WFR(6),o[3],0,0,0), C1,10); \
    GAPC(o[2]=__builtin_amdgcn_mfma_f32_32x32x16_bf16(PAF(3),WFR(3),o[2],0,0,0), C1,12); \
    GAPC(o[3]=__builtin_amdgcn_mfma_f32_32x32x16_bf16(PAF(3),WFR(7),o[3],0,0,0), C1,14); \
    }while(0)
  int t=1;
  #undef CMASK
  #define CMASK(P0,P1,t) do{}while(0)
  for(;t+5<NT;t+=2){
    STEP(pB0,pB1,pA0,pA1,t,true,true,true);     WAIT_BAR(3); RESC(); ROT();
    STEP(pA0,pA1,pB0,pB1,t+1,true,true,true);   WAIT_BAR(3); RESC(); ROT();
  }
  #undef CMASK
  #define CMASK(P0,P1,t) do{int jb_=(t)-(NT-4); if(jb_>=0)cmask(P0,P1,jb_,qrel,hi);}while(0)
  #define ENDW(tt) do{ if((tt)+3<NT){WAIT_BAR(3);} else if((tt)+2<NT){WAIT_BAR(2);} else {WAIT_BAR(0);} }while(0)
  for(;t+1<NT;t+=2){
    STEP(pB0,pB1,pA0,pA1,t,(t+3<NT),(t+1<NT),(t+1<NT));       ENDW(t);   RESC(); ROT();
    STEP(pA0,pA1,pB0,pB1,t+1,(t+4<NT),(t+2<NT),(t+2<NT));     ENDW(t+1); RESC(); ROT();
  }
  STEP(pB0,pB1,pA0,pA1,NT-1,false,false,false); RESC();
  { float sacc=pB0[0]+pB0[1]; _Pragma("unroll") for(int r=2;r<16;++r)sacc+=pB0[r]; _Pragma("unroll") for(int r=0;r<16;++r)sacc+=pB1[r]; l_reg+=sacc;
    pw0=(u32x4){PKW(pB0,0),PKW(pB0,2),PKW(pB0,4),PKW(pB0,6)};pw1=(u32x4){PKW(pB0,8),PKW(pB0,10),PKW(pB0,12),PKW(pB0,14)};pw2=(u32x4){PKW(pB1,0),PKW(pB1,2),PKW(pB1,4),PKW(pB1,6)};pw3=(u32x4){PKW(pB1,8),PKW(pB1,10),PKW(pB1,12),PKW(pB1,14)};
    SBAR(); pv(o,vb0+2*sl_cur,PAF(0),PAF(1),PAF(2),PAF(3)); pv(o+2,vb0+2*sl_cur+8192,PAF(0),PAF(1),PAF(2),PAF(3)); }
  #undef PKW
  #undef PAF
  #undef VFR
  #undef PIN
  #undef MX3
  #undef GAPA
  #undef GAPB
  #undef EX
  #undef VRD
  #undef VRD2
  #undef WFR
  #undef GAPC
  #undef KRD
  #undef STEP
  #undef ENDW
  {auto rr=__builtin_amdgcn_permlane32_swap(__float_as_uint(l_reg),__float_as_uint(l_reg),false,false);l_reg=__uint_as_float(rr[0])+__uint_as_float(rr[1]);}
  if(hi==0)wsf[32+r32]=l_reg;asm volatile("s_waitcnt lgkmcnt(0)":::"memory");
  float rli[16];
  #pragma unroll
  for(int r=0;r<16;++r)rli[r]=__builtin_amdgcn_rcpf(wsf[32+crow(r,hi)]);
  bf16*Ow=O+(rowbase+q0+wid*QBLK)*DM+hh_*256+mm_*128;
  #pragma unroll
  for(int half=0;half<2;++half)
  { bf16*stg=(bf16*)(shm+LDS_OST)+wid*2048;
    #pragma unroll
    for(int r=0;r<16;++r){const int orow=crow(r,hi);
      #pragma unroll
      for(int d0=0;d0<2;++d0)stg[orow*64+d0*32+r32]=__float2bfloat16(o[2*half+d0][r]*rli[r]);}
    asm volatile("s_waitcnt lgkmcnt(0)":::"memory");
    #pragma unroll
    for(int i=0;i<4;++i){const int row=i*8+(lane>>3),ch=lane&7; const u32x4 v=*(const u32x4*)(stg+row*64+ch*8); ATTN_STORE16(Ow+(long)row*DM+half*64+ch*8,v);}
    asm volatile("s_waitcnt lgkmcnt(0)":::"memory"); }
  asm volatile("s_waitcnt lgkmcnt(0)\n\ts_barrier":::"memory");
  #undef DMA_K
  #undef DMA_V
  #undef CMASK
  #undef START
  #undef RESC
  #undef ROT
}
constexpr int ATTN_LDS_BYTES=LDS_BYTES;
struct AttnTensors { const bf16* Q; const bf16* K; const bf16* V; bf16* O; };
struct AttnUnit { int bh; int qb; };
struct StaticOrder {
  int vcu;
  __device__ __forceinline__ explicit StaticOrder(int v):vcu(v){}
  __device__ __forceinline__ bool next(int i,AttnUnit&u)const{ if(i>=2)return false; const int s=vcu&15; u.bh=vcu>>4; u.qb=(i==0)?31-s:s; return true; }
  __device__ __forceinline__ void a_ready(const AttnUnit&)const{}
  __device__ __forceinline__ void done(const AttnUnit&)const{}
};
template<class Sched,int THRL=8> __device__ __forceinline__ void attn_phase(char*lds,const AttnTensors&T,const Sched&S){
  AttnUnit u;
  for(int i=0;S.next(i,u);++i){ S.a_ready(u); attn_unit<THRL>(u.bh>>3,u.bh&7,u.qb,T.Q,T.K,T.V,T.O,lds); S.done(u); }
}
#undef SBAR
#undef WAIT_BAR
}
namespace cg = cooperative_groups;
constexpr int NWAVES = 8;
constexpr int BATCH = 2, T = 8192, D = 1024, DIN = 3584, M = BATCH * T, DEPTH = 2;
constexpr float EPS = 1e-6f;
constexpr size_t MiB = 1u << 20;
constexpr size_t WS_CTL = 0;
constexpr size_t WS_TAB = 64 * 1024;
constexpr size_t WS_ROWSS = 128 * 1024;
constexpr size_t WS_ROWSS2 = 192 * 1024;
constexpr size_t WS_PCNT = 14336;
constexpr size_t WS_SUCNT = 15616;
constexpr size_t WS_SCNT = 14592;
constexpr size_t WS_ROWSS0 = 256 * 1024;
constexpr size_t WS_WIN = 2 * MiB;
constexpr size_t WS_WOUT = 16 * MiB;
constexpr size_t WS_GLU = 20 * MiB;
constexpr size_t WS_ROPE = 20 * MiB + 512 * 1024;
constexpr size_t WS_S5A = 21 * MiB;
constexpr size_t WS_S5B = 21 * MiB + 64 * 1024;
constexpr size_t WS_S5C = 21 * MiB + 256 * 1024;
constexpr size_t WS_HU = 22 * MiB;
constexpr size_t WS_HA = 30 * MiB;
constexpr size_t WS_XLOC = 31 * MiB;
constexpr size_t WS_XN = 32 * MiB;
constexpr size_t WS_O = WS_XN;
constexpr size_t WS_PROJ = 64 * MiB;
constexpr size_t WS_MIX = 176 * MiB;
constexpr size_t WS_YG = 208 * MiB;
constexpr size_t WS_YGS = 216 * MiB;
constexpr size_t WS_HRES = 224 * MiB;
constexpr size_t WS_END = 256 * MiB;
constexpr int LDS_BYTES = 147456, RING_BYTES = 131072;

#define GAS __attribute__((address_space(1)))
#define LAS __attribute__((address_space(3)))
typedef unsigned short bf16;
typedef unsigned v4u __attribute__((ext_vector_type(4)));
typedef unsigned v2u __attribute__((ext_vector_type(2)));
typedef float f32x4 __attribute__((ext_vector_type(4)));
typedef short bf16x8 __attribute__((ext_vector_type(8)));
#define LDS_WAIT() asm volatile("s_waitcnt lgkmcnt(0)" ::: "memory")
__device__ __forceinline__ unsigned f2bf(float f) { unsigned u = __builtin_bit_cast(unsigned, f); return (u + 0x7fffu + ((u >> 16) & 1u)) >> 16; }
__device__ __forceinline__ unsigned pk2(float lo, float hi) { return f2bf(lo) | (f2bf(hi) << 16); }
__device__ __forceinline__ float bflo(unsigned w) { return __uint_as_float(w << 16); }
__device__ __forceinline__ float bfhi(unsigned w) { return __uint_as_float(w & 0xffff0000u); }
__device__ __forceinline__ float bf1(bf16 h) { return __uint_as_float(((unsigned)h) << 16); }
__device__ __forceinline__ float sigmf(float v) { return __builtin_amdgcn_rcpf(1.0f + __builtin_amdgcn_exp2f(-1.4426950408889634f * v)); }
__device__ __forceinline__ float siluf(float v) { return v * sigmf(v); }
__device__ __forceinline__ float wave_sum(float v) {
#pragma unroll
    for (int o = 1; o < 64; o <<= 1) v += __shfl_xor(v, o);
    return v;
}
__device__ __forceinline__ void p0_transpose_item(const float* W, int K, int N, bf16* WT, LAS float* scr, int item, int lane, const float* kscale = nullptr) {
    const int nblk = N / 32, kb = item / nblk, nb = item % nblk, k0 = 64 * kb, n0 = 32 * nb;
#pragma unroll 8
    for (int i = 0; i < 32; ++i) { const int kk = 2 * i + (lane >> 5); scr[kk * 33 + (lane & 31)] = W[(size_t)(k0 + kk) * N + n0 + (lane & 31)] * (kscale ? kscale[k0 + kk] : 1.0f); }
    LDS_WAIT(); asm volatile("" ::: "memory");
    const int c = lane & 7;
#pragma unroll
    for (int j = 0; j < 4; ++j) { const int n = (lane >> 3) + 8 * j; const LAS float* s = scr + (8 * c) * 33 + n;
        v4u o; o.x = pk2(s[0 * 33], s[1 * 33]); o.y = pk2(s[2 * 33], s[3 * 33]); o.z = pk2(s[4 * 33], s[5 * 33]); o.w = pk2(s[6 * 33], s[7 * 33]);
        *(v4u*)(WT + (size_t)(n0 + n) * K + k0 + 8 * c) = o; }
    LDS_WAIT(); asm volatile("" ::: "memory");
}
template <bool OUTF> __device__ __forceinline__ void rms_row(const float* xrow, const float* w, bf16* orow, float* frow, int lane) {
    const f32x4* xr = (const f32x4*)xrow + lane; const f32x4* wr = (const f32x4*)w + lane;
    f32x4 v[4]; float s = 0.f;
#pragma unroll
    for (int j = 0; j < 4; ++j) { v[j] = xr[64 * j]; s += (v[j].x * v[j].x + v[j].y * v[j].y) + (v[j].z * v[j].z + v[j].w * v[j].w); }
    const float rs = 1.0f / sqrtf(wave_sum(s) * (1.f / D) + EPS);
#pragma unroll
    for (int j = 0; j < 4; ++j) { const f32x4 ww = wr[64 * j]; const f32x4 o = v[j] * rs * ww;
        if (OUTF) ((f32x4*)frow + lane)[64 * j] = o;
        else ((v2u*)orow + lane)[64 * j] = (v2u){pk2(o.x, o.y), pk2(o.z, o.w)}; }
}

typedef GAS unsigned gu32;
#define RLX_AGENT __ATOMIC_RELAXED, __HIP_MEMORY_SCOPE_AGENT
#define XB_TMO      128
#define XB_XCNT(j)  (256  + 64 * (j))
#define XB_XSUB(j)  (1280 + 64 * (j))
#define XB_XGEN(j)  (2304 + 64 * (j))
#define XB_TOP      3328
#define XB_TOPGEN   3392
#define XCD_BAR_WORDS 3456
#define XB_SPIN_CAP (1u << 18)

__device__ __forceinline__ unsigned xb_ld(unsigned* p)              { return __hip_atomic_load(p, __ATOMIC_RELAXED, __HIP_MEMORY_SCOPE_AGENT); }
__device__ __forceinline__ unsigned xb_add(unsigned* p, unsigned v) { return __hip_atomic_fetch_add(p, v, __ATOMIC_RELAXED, __HIP_MEMORY_SCOPE_AGENT); }
__device__ __forceinline__ unsigned xb_xcc_id() { return (unsigned)__builtin_amdgcn_s_getreg((3 << 11) | 20) & 0xFu; }
#define XB_SPIN(cond, bar) do { unsigned _sp = 0; while (cond) { __builtin_amdgcn_s_sleep(1); \
    if ((++_sp & 255u) == 0u) { if (xb_ld(&(bar)[XB_TMO])) break; if (_sp > XB_SPIN_CAP) { atomicAdd(&(bar)[XB_TMO], 1u); break; } } } } while (0)

struct XcdBarrier {
    unsigned* bar; unsigned x;
    volatile LAS unsigned* st;
};

__device__ __forceinline__ XcdBarrier xcd_barrier_post(unsigned* bar, volatile LAS unsigned* st) {
    XcdBarrier b; b.bar = bar; b.x = xb_xcc_id(); b.st = st;
    if (threadIdx.x == 0) (void)xb_add(&bar[XB_XCNT(b.x)], 1u);
    return b;
}
__device__ __forceinline__ void xcd_barrier_complete(unsigned* bar, unsigned x, unsigned& nloc, unsigned& nx) {
    const unsigned G = gridDim.x * gridDim.y * gridDim.z;
    unsigned sum, cnt, mine, sp = 0u;
    for (;;) {
        sum = 0u; cnt = 0u; mine = 0u;
#pragma unroll
        for (unsigned j = 0; j < 16; ++j) { const unsigned c = xb_ld(&bar[XB_XCNT(j)]); sum += c; cnt += (c > 0u) ? 1u : 0u; mine = (j == x) ? c : mine; }
        if (sum == G) break;
        __builtin_amdgcn_s_sleep(1);
        if ((++sp & 255u) == 0u) { if (xb_ld(&bar[XB_TMO])) break; if (sp > XB_SPIN_CAP) { atomicAdd(&bar[XB_TMO], 1u); break; } }
    }
    nloc = mine > 0u ? mine : 1u; nx = cnt > 0u ? cnt : 1u;
}

__device__ __forceinline__ void xcd_barrier(const XcdBarrier& b) {
    asm volatile("s_waitcnt vmcnt(0)" ::: "memory");
    __syncthreads();
    if (threadIdx.x == 0) {
        unsigned* bar = b.bar;
        __builtin_amdgcn_s_waitcnt(0);
        unsigned nloc = b.st[0], nx = b.st[1];
        if (nloc == 0u) { xcd_barrier_complete(bar, b.x, nloc, nx); b.st[0] = nloc; b.st[1] = nx; }
        const unsigned old = xb_add(&bar[XB_XSUB(b.x)], 1u);
        const unsigned gen = old / nloc;
        if (old + 1u == (gen + 1u) * nloc) {
            __builtin_amdgcn_fence(__ATOMIC_RELEASE, "agent");
            asm volatile("s_waitcnt vmcnt(0)" ::: "memory");
            const unsigned og = xb_add(&bar[XB_TOP], 1u);
            const unsigned tg = og / nx;
            if (og + 1u == (tg + 1u) * nx) xb_add(&bar[XB_TOPGEN], 1u);
            else XB_SPIN(xb_ld(&bar[XB_TOPGEN]) == tg, bar);
            __builtin_amdgcn_fence(__ATOMIC_ACQUIRE, "agent");
            xb_add(&bar[XB_XGEN(b.x)], 1u);
            asm volatile("s_waitcnt vmcnt(0)" ::: "memory");
        } else {
            XB_SPIN(xb_ld(&bar[XB_XGEN(b.x)]) == gen, bar);
            __builtin_amdgcn_fence(__ATOMIC_ACQUIRE, "agent");
            asm volatile("s_waitcnt vmcnt(0)" ::: "memory");
        }
    }
    __syncthreads();
}
struct Args { const float* in[22]; float* out; unsigned char* ws; int ph_lo, ph_hi; };
struct PA { const float* const* in; float* out; unsigned char* ws; };

__device__ __forceinline__ void s5_prep(const float* const* in, unsigned char* ws, int t0, int nthreads) {
    const double TWO_PI = 6.283185307179586476925;
    for (int ec = t0; ec < DEPTH * 16 * 64 * 16; ec += nthreads) {
        const int e = ec >> 4, c = ec & 15;
        const int l = e >> 10, g = (e >> 6) & 15, p = e & 63;
        const double dt = (double)expf(in[12][l * 16 + g]);
        const double are = (double)in[6][e], aim = (double)in[7][e];
        const double mag = (double)expf((float)(dt * are));
        double tt = dt * aim * (1.0 / TWO_PI); tt -= __builtin_floor(tt);
        const float ang = (float)(tt * TWO_PI);
        const double abr = mag * (double)cosf(ang), abi = mag * (double)sinf(ang);
        const double den = are * are + aim * aim, nr = abr - 1.0, ni = abi;
        const double zr = (nr * are + ni * aim) / den, zi = (ni * are - nr * aim) / den;
        if (c == 0) {
            double pr = abr, pi = abi;
#pragma unroll
            for (int q = 0; q < 7; ++q) { const double r2 = pr * pr - pi * pi, i2 = 2.0 * pr * pi; pr = r2; pi = i2; }
            float* sa = (float*)(ws + WS_S5A) + (size_t)(l * 16 + g) * 256;
            sa[p] = (float)abr; sa[64 + p] = (float)abi; sa[128 + p] = (float)pr; sa[192 + p] = (float)pi;
        }
        bf16* bm = (bf16*)(ws + WS_S5B) + (size_t)(l * 16 + g) * 2048;
        const double br = in[8][(size_t)e * 16 + c], bi = in[9][(size_t)e * 16 + c];
        bm[p * 16 + c] = (bf16)f2bf((float)(zr * br - zi * bi)); bm[(64 + p) * 16 + c] = (bf16)f2bf((float)(zr * bi + zi * br));
        bf16* cm = (bf16*)(ws + WS_S5C) + (size_t)(l * 16 + g) * 2048;
        cm[c * 128 + p] = (bf16)f2bf(in[10][(size_t)(l * 16 + g) * 1024 + c * 64 + p]); cm[c * 128 + 64 + p] = (bf16)f2bf(-in[11][(size_t)(l * 16 + g) * 1024 + c * 64 + p]);
    }
}
__device__ __forceinline__ void prologue(const Args& a, LAS unsigned char* lds, int vcu, int G, int wave, int lane) {
    const bool defer_s5 = false;
    unsigned char* ws = a.ws;
    LAS float* scr = (LAS float*)(lds + wave * 16384);
    const int gw = vcu * NWAVES + wave, NGW = G * NWAVES;
    constexpr int I_IN = (D / 64) * (DIN / 32), I_OUT = (D / 64) * (D / 32), I_GLU = (256 / 64) * (256 / 32);
    constexpr int NITEMS = DEPTH * (I_IN + I_OUT + I_GLU);
    for (int it = gw; it < NITEMS; it += NGW) {
        int r = it; const int l = r / (I_IN + I_OUT + I_GLU); r -= l * (I_IN + I_OUT + I_GLU);
        if (r < I_IN) { p0_transpose_item(a.in[2] + (size_t)l * D * DIN, D, DIN, (bf16*)(ws + WS_WIN) + (size_t)l * DIN * D, scr, r, lane, a.in[1] + (size_t)l * D); continue; } r -= I_IN;
        if (r < I_OUT) { p0_transpose_item(a.in[3] + (size_t)l * D * D, D, D, (bf16*)(ws + WS_WOUT) + (size_t)l * D * D, scr, r, lane); continue; } r -= I_OUT;
        p0_transpose_item(a.in[14] + (size_t)l * 65536, 256, 256, (bf16*)(ws + WS_GLU) + (size_t)l * 65536, scr, r, lane);
    }
    for (int m = gw; m < M; m += 2 * NGW) {
        const int m2 = m + NGW; const bool has2 = m2 < M;
        const f32x4* x1 = (const f32x4*)(a.in[0] + (size_t)m * D) + lane; const f32x4* x2 = (const f32x4*)(a.in[0] + (size_t)(has2 ? m2 : m) * D) + lane;
        f32x4 v1[4], v2[4]; float s1 = 0.f, s2 = 0.f;
#pragma unroll
        for (int j = 0; j < 4; ++j) { v1[j] = x1[64 * j]; v2[j] = x2[64 * j]; }
#pragma unroll
        for (int j = 0; j < 4; ++j) { s1 += (v1[j].x * v1[j].x + v1[j].y * v1[j].y) + (v1[j].z * v1[j].z + v1[j].w * v1[j].w); s2 += (v2[j].x * v2[j].x + v2[j].y * v2[j].y) + (v2[j].z * v2[j].z + v2[j].w * v2[j].w);
            ((v2u*)((bf16*)(ws + WS_HRES) + (size_t)m * D) + lane)[64 * j] = (v2u){pk2(v1[j].x, v1[j].y), pk2(v1[j].z, v1[j].w)};
            if (has2) ((v2u*)((bf16*)(ws + WS_HRES) + (size_t)m2 * D) + lane)[64 * j] = (v2u){pk2(v2[j].x, v2[j].y), pk2(v2[j].z, v2[j].w)}; }
        s1 = wave_sum(s1); s2 = wave_sum(s2);
        if (lane == 0) { ((float*)(ws + WS_ROWSS0))[m] = s1; if (has2) ((float*)(ws + WS_ROWSS0))[m2] = s2; }
        if (lane == 0) { ((float*)(ws + WS_ROWSS))[m] = 0.f; ((float*)(ws + WS_ROWSS2))[m] = 0.f; if (has2) { ((float*)(ws + WS_ROWSS))[m2] = 0.f; ((float*)(ws + WS_ROWSS2))[m2] = 0.f; } }
    }
    const int gt = gw * 64 + lane, NGT = NGW * 64;
    const double TWO_PI = 6.283185307179586476925;
    for (int e = gt; e < 8192 * 8; e += NGT) {
        const int pos = e >> 3, i = e & 7;
        const double invf[8] = {1.0, 0.19392274474868576, 0.03760603093086393, 0.007292664737217109, 0.001414213562373095, 0.0002742481756762073, 5.318295896944988e-05, 1.031338537721246e-05};
        double inv = invf[0];
#pragma unroll
        for (int q = 1; q < 8; ++q) inv = (i == q) ? invf[q] : inv;
        double tt = (double)pos * inv * (1.0 / TWO_PI); tt -= __builtin_floor(tt);
        const float ang = (float)(tt * TWO_PI);
        float* rp = (float*)(ws + WS_ROPE) + (size_t)e * 2; rp[0] = cosf(ang); rp[1] = sinf(ang);
    }
    if (!defer_s5) s5_prep(a.in, ws, gt, NGT);
}

template <bool OUT> __device__ __forceinline__ void hgrn_item(const PA& a, LAS unsigned char* lds, int layer, int bh, int c, int tid, int wave, int lane) {
    const int b = bh >> 2, h = bh & 3;
    const bf16* PROJ = (const bf16*)(a.ws + WS_PROJ);
    float* HU = (float*)(a.ws + WS_HU); float* HA = (float*)(a.ws + WS_HA);
    LAS float* Fs = (LAS float*)lds; LAS float* Ks = Fs + 4096; LAS float* Vs = Ks + 4096; LAS float* Qs = Vs + 4096; LAS float* Ps = Qs + 4096;
    const size_t row0 = (size_t)b * T + (size_t)c * 128;
    float S[8];
#pragma unroll
    for (int j = 0; j < 8; ++j) S[j] = 0.f;
    if (OUT) {
        int cp = 0;
        for (; cp + 4 <= c; cp += 4) {
            float uu[4][8], aa[4][8];
#pragma unroll
            for (int q = 0; q < 4; ++q) {
                const float* U = HU + (size_t)(bh * 64 + cp + q) * 4096 + (size_t)(wave * 8) * 64 + lane; const float* A = HA + (size_t)(bh * 64 + cp + q) * 64 + wave * 8;
#pragma unroll
                for (int j = 0; j < 8; ++j) { uu[q][j] = U[j * 64]; aa[q][j] = A[j]; }
            }
#pragma unroll
            for (int q = 0; q < 4; ++q)
#pragma unroll
                for (int j = 0; j < 8; ++j) S[j] = aa[q][j] * S[j] + uu[q][j];
        }
        for (; cp < c; ++cp) {
            const float* U = HU + (size_t)(bh * 64 + cp) * 4096 + (size_t)(wave * 8) * 64 + lane; const float* A = HA + (size_t)(bh * 64 + cp) * 64 + wave * 8;
#pragma unroll
            for (int j = 0; j < 8; ++j) S[j] = A[j] * S[j] + U[j * 64];
        }
    }
    const int fcol = h * 64 + (tid & 7) * 8;
    float lb[8];
#pragma unroll
    for (int j = 0; j < 8; ++j) lb[j] = (layer == 0) ? 0.f : sigmf(a.in[4][256 + fcol + j] - a.in[4][fcol + j]);
    const float gnw = a.in[5][layer * 64 + lane];
    float aprod = 1.f;
    for (int sub = 0; sub < 2; ++sub) {
        __syncthreads();
        { const int t = tid >> 3; const bf16* pr = PROJ + (row0 + sub * 64 + t) * DIN + fcol;
          const v4u fw = *(const v4u*)(pr + 256), vw = *(const v4u*)(pr + 512);
          const unsigned fa[4] = {fw.x, fw.y, fw.z, fw.w}, va[4] = {vw.x, vw.y, vw.z, vw.w};
          float fo[8], ko[8], vo[8];
#pragma unroll
          for (int j = 0; j < 8; ++j) { const float x = (j & 1) ? bfhi(fa[j >> 1]) : bflo(fa[j >> 1]); const float sg = sigmf(x);
              fo[j] = lb[j] + (1.f - lb[j]) * sg; ko[j] = (1.f - lb[j]) * (1.f - sg); vo[j] = (j & 1) ? bfhi(va[j >> 1]) : bflo(va[j >> 1]); }
          LAS f32x4* d;
          d = (LAS f32x4*)(Fs + t * 64 + (tid & 7) * 8); d[0] = (f32x4){fo[0], fo[1], fo[2], fo[3]}; d[1] = (f32x4){fo[4], fo[5], fo[6], fo[7]};
          d = (LAS f32x4*)(Ks + t * 64 + (tid & 7) * 8); d[0] = (f32x4){ko[0], ko[1], ko[2], ko[3]}; d[1] = (f32x4){ko[4], ko[5], ko[6], ko[7]};
          d = (LAS f32x4*)(Vs + t * 64 + (tid & 7) * 8); d[0] = (f32x4){vo[0], vo[1], vo[2], vo[3]}; d[1] = (f32x4){vo[4], vo[5], vo[6], vo[7]};
          if (OUT) { const v4u qw = *(const v4u*)(pr); const unsigned qa[4] = {qw.x, qw.y, qw.z, qw.w}; float qo[8];
#pragma unroll
              for (int j = 0; j < 8; ++j) qo[j] = siluf((j & 1) ? bfhi(qa[j >> 1]) : bflo(qa[j >> 1]));
              d = (LAS f32x4*)(Qs + t * 64 + (tid & 7) * 8); d[0] = (f32x4){qo[0], qo[1], qo[2], qo[3]}; d[1] = (f32x4){qo[4], qo[5], qo[6], qo[7]}; }
        }
        __syncthreads();
        if (!OUT && tid < 64) { for (int t = 0; t < 64; ++t) aprod *= Fs[t * 64 + tid]; }
        for (int tb = 0; tb < 4; ++tb) {
#pragma unroll 4
            for (int tt = 0; tt < 16; ++tt) {
                const int t = tb * 16 + tt;
                const f32x4 f0 = *(const LAS f32x4*)(Fs + t * 64 + wave * 8), f1 = *(const LAS f32x4*)(Fs + t * 64 + wave * 8 + 4);
                const f32x4 k0 = *(const LAS f32x4*)(Ks + t * 64 + wave * 8), k1 = *(const LAS f32x4*)(Ks + t * 64 + wave * 8 + 4);
                const float v = Vs[t * 64 + lane];
                S[0] = f0[0] * S[0] + k0[0] * v; S[1] = f0[1] * S[1] + k0[1] * v; S[2] = f0[2] * S[2] + k0[2] * v; S[3] = f0[3] * S[3] + k0[3] * v;
                S[4] = f1[0] * S[4] + k1[0] * v; S[5] = f1[1] * S[5] + k1[1] * v; S[6] = f1[2] * S[6] + k1[2] * v; S[7] = f1[3] * S[7] + k1[3] * v;
                if (OUT) {
                    const f32x4 q0 = *(const LAS f32x4*)(Qs + t * 64 + wave * 8), q1 = *(const LAS f32x4*)(Qs + t * 64 + wave * 8 + 4);
                    const float p = ((q0[0] * S[0] + q0[1] * S[1]) + (q0[2] * S[2] + q0[3] * S[3])) + ((q1[0] * S[4] + q1[1] * S[5]) + (q1[2] * S[6] + q1[3] * S[7]));
                    Ps[(wave * 16 + tt) * 64 + lane] = p;
                }
            }
            if (OUT) {
                __syncthreads();
#pragma unroll
                for (int r = 0; r < 2; ++r) {
                    const int tt = wave + 8 * r; float o = 0.f;
#pragma unroll
                    for (int w2 = 0; w2 < 8; ++w2) o += Ps[(w2 * 16 + tt) * 64 + lane];
                    const float rs = 1.0f / sqrtf(wave_sum(o * o) * (1.f / 64.f) + EPS);
                    const size_t row = row0 + sub * 64 + tb * 16 + tt;
                    const float gt = siluf(bf1(PROJ[row * DIN + 768 + h * 64 + lane]));
                    ((bf16*)(a.ws + WS_MIX))[row * 1024 + h * 64 + lane] = (bf16)f2bf(o * rs * gnw * gt);
                }
                __syncthreads();
            }
        }
    }
    if (!OUT) {
        float* U = HU + (size_t)(bh * 64 + c) * 4096 + (size_t)(wave * 8) * 64 + lane;
#pragma unroll
        for (int j = 0; j < 8; ++j) U[j * 64] = S[j];
        if (tid < 64) HA[(size_t)(bh * 64 + c) * 64 + tid] = aprod;
    }
}

typedef unsigned short u16;
__device__ __forceinline__ bf16x8 pk8(const float* v) { v4u w = {pk2(v[0], v[1]), pk2(v[2], v[3]), pk2(v[4], v[5]), pk2(v[6], v[7])}; return __builtin_bit_cast(bf16x8, w); }
struct HRaw { v4u f[2], v[2], q[2], g[2]; };
template <bool OUT> __device__ __forceinline__ HRaw hgrn_load(const PA& a, int bh, int c, int wave, int lane) {
    const bf16* pr = (const bf16*)(a.ws + WS_PROJ) + ((size_t)(bh >> 2) * T + (size_t)c * 128 + wave * 16 + (lane >> 3)) * DIN + (bh & 3) * 64 + (lane & 7) * 8;
    HRaw r;
#pragma unroll
    for (int k = 0; k < 2; ++k) { r.f[k] = *(const v4u*)(pr + (size_t)(8 * k) * DIN + 256); r.v[k] = *(const v4u*)(pr + (size_t)(8 * k) * DIN + 512);
        if (OUT) { r.q[k] = *(const v4u*)(pr + (size_t)(8 * k) * DIN); r.g[k] = *(const v4u*)(pr + (size_t)(8 * k) * DIN + 768); } }
    return r;
}
template <bool OUT> __device__ __forceinline__ void hgrn_item2(const PA& a, LAS unsigned char* lds, int layer, int bh, int c, int wave, int lane, const HRaw& raw) {
    const int b = bh >> 2, h = bh & 3, item = bh * 64 + c;
    float* HU = (float*)(a.ws + WS_HU); float* HA = (float*)(a.ws + WS_HA);
    LAS unsigned char* wb = lds + wave * 12288;
    LAS bf16* QT = (LAS bf16*)wb; LAS bf16* KT = (LAS bf16*)(wb + 2304); LAS bf16* KHT = (LAS bf16*)(wb + 4608); LAS bf16* VT = (LAS bf16*)(wb + 7680); LAS bf16* P = (LAS bf16*)(wb + 10752);
    LAS float* DL = (LAS float*)(wb + 11520); LAS float* E7L = (LAS float*)(wb + 11776);
    LAS bf16* RF = (LAS bf16*)wb; LAS bf16* RV = (LAS bf16*)(wb + 2304); LAS bf16* RQ = (LAS bf16*)(wb + 4608);
    LAS bf16* GT = KHT; LAS bf16* OT = VT;
    LAS float* SBUF = (LAS float*)(lds + 98304); LAS float* DALL = (LAS float*)(lds + 114688);
    const int l15 = lane & 15, q = lane >> 4;
    const size_t row0 = (size_t)b * T + (size_t)c * 128 + wave * 16;
    const bf16x8 zero8 = {0, 0, 0, 0, 0, 0, 0, 0};
    __syncthreads();
    {
        const int rr = lane >> 3, cc = (lane & 7) * 8;
#pragma unroll
        for (int k = 0; k < 2; ++k) { *(LAS v4u*)(RF + (rr + 8 * k) * 72 + cc) = raw.f[k]; *(LAS v4u*)(RV + (rr + 8 * k) * 72 + cc) = raw.v[k]; if (OUT) *(LAS v4u*)(RQ + (rr + 8 * k) * 72 + cc) = raw.q[k]; }
        LDS_WAIT();
        const float lb = (layer == 0) ? 0.f : sigmf(a.in[4][256 + h * 64 + lane] - a.in[4][h * 64 + lane]);
        u16 fr[16], vr[16], qr[16];
#pragma unroll
        for (int t = 0; t < 16; ++t) { fr[t] = RF[t * 72 + lane]; vr[t] = RV[t * 72 + lane]; if (OUT) qr[t] = RQ[t * 72 + lane]; }
        LDS_WAIT();
        float cum[16], kk[16]; float run = 0.f;
#pragma unroll
        for (int t = 0; t < 16; ++t) { const float sg = sigmf(bf1(fr[t])); const float f = lb + (1.f - lb) * sg; kk[t] = (1.f - lb) * (1.f - sg); run += fmaxf(__logf(f), -69.f); cum[t] = run; }
        const float cl = cum[15], c7 = cum[7];
        DL[lane] = __expf(cl);
        if (OUT) E7L[lane] = __expf(c7); else DALL[wave * 64 + lane] = cl;
        float kh[16];
#pragma unroll
        for (int t = 0; t < 16; ++t) kh[t] = kk[t] * __expf(cl - cum[t]);
        *(LAS bf16x8*)(KHT + lane * 24) = pk8(kh); *(LAS bf16x8*)(KHT + lane * 24 + 8) = pk8(kh + 8);
        { v4u w0 = {(unsigned)vr[0] | ((unsigned)vr[1] << 16), (unsigned)vr[2] | ((unsigned)vr[3] << 16), (unsigned)vr[4] | ((unsigned)vr[5] << 16), (unsigned)vr[6] | ((unsigned)vr[7] << 16)};
          v4u w1 = {(unsigned)vr[8] | ((unsigned)vr[9] << 16), (unsigned)vr[10] | ((unsigned)vr[11] << 16), (unsigned)vr[12] | ((unsigned)vr[13] << 16), (unsigned)vr[14] | ((unsigned)vr[15] << 16)};
          *(LAS v4u*)(VT + lane * 24) = w0; *(LAS v4u*)(VT + lane * 24 + 8) = w1; }
        if (OUT) {
#pragma unroll
            for (int t = 0; t < 16; ++t) {
                QT[t * 72 + lane] = (bf16)f2bf(siluf(bf1(qr[t])) * __expf(fminf(cum[t] - c7, 60.f)));
                KT[t * 72 + lane] = (bf16)f2bf(kk[t] * __expf(fminf(c7 - cum[t], 60.f)));
            }
        }
    }
    LDS_WAIT();
    bf16x8 vfr[4];
#pragma unroll
    for (int nt = 0; nt < 4; ++nt) vfr[nt] = (q < 2) ? *(const LAS bf16x8*)(VT + (16 * nt + l15) * 24 + q * 8) : zero8;
    f32x4 U[4][4];
#pragma unroll
    for (int mt = 0; mt < 4; ++mt) { const bf16x8 afr = (q < 2) ? *(const LAS bf16x8*)(KHT + (16 * mt + l15) * 24 + q * 8) : zero8;
#pragma unroll
        for (int nt = 0; nt < 4; ++nt) U[mt][nt] = __builtin_amdgcn_mfma_f32_16x16x32_bf16(afr, vfr[nt], (f32x4){0.f, 0.f, 0.f, 0.f}, 0, 0, 0); }
    f32x4 o[4]; bf16x8 qf[2];
    if (OUT) {
        LDS_WAIT();
        { const int rr = lane >> 3, cc = (lane & 7) * 8; *(LAS v4u*)(GT + rr * 72 + cc) = raw.g[0]; *(LAS v4u*)(GT + (rr + 8) * 72 + cc) = raw.g[1]; }
        f32x4 sc = {0.f, 0.f, 0.f, 0.f};
#pragma unroll
        for (int ks = 0; ks < 2; ++ks) {
            const v2u qa = *(const LAS v2u*)(QT + l15 * 72 + 32 * ks + 4 * q), qb = *(const LAS v2u*)(QT + l15 * 72 + 32 * ks + 16 + 4 * q);
            const v2u ka = *(const LAS v2u*)(KT + l15 * 72 + 32 * ks + 4 * q), kb = *(const LAS v2u*)(KT + l15 * 72 + 32 * ks + 16 + 4 * q);
            qf[ks] = __builtin_bit_cast(bf16x8, (v4u){qa.x, qa.y, qb.x, qb.y});
            const bf16x8 kf = __builtin_bit_cast(bf16x8, (v4u){ka.x, ka.y, kb.x, kb.y});
            sc = __builtin_amdgcn_mfma_f32_16x16x32_bf16(qf[ks], kf, sc, 0, 0, 0);
        }
#pragma unroll
        for (int j = 0; j < 4; ++j) { const int t = 4 * q + j; P[t * 24 + l15] = (bf16)f2bf((l15 <= t) ? sc[j] : 0.f); }
        LDS_WAIT();
        const bf16x8 pf = (q < 2) ? *(const LAS bf16x8*)(P + l15 * 24 + q * 8) : zero8;
#pragma unroll
        for (int nt = 0; nt < 4; ++nt) o[nt] = __builtin_amdgcn_mfma_f32_16x16x32_bf16(pf, vfr[nt], (f32x4){0.f, 0.f, 0.f, 0.f}, 0, 0, 0);
    }
    {
        float S8[8];
#pragma unroll
        for (int i = 0; i < 8; ++i) S8[i] = 0.f;
        if (OUT) {
            const f32x4 h0 = *(const f32x4*)(HU + (size_t)item * 4096 + (size_t)((2 * wave) * 64 + lane) * 4), h1 = *(const f32x4*)(HU + (size_t)item * 4096 + (size_t)((2 * wave + 1) * 64 + lane) * 4);
            S8[0] = h0[0]; S8[1] = h0[1]; S8[2] = h0[2]; S8[3] = h0[3]; S8[4] = h1[0]; S8[5] = h1[1]; S8[6] = h1[2]; S8[7] = h1[3];
        }
        *(LAS f32x4*)(SBUF + ((2 * wave) * 64 + lane) * 4) = (f32x4){S8[0], S8[1], S8[2], S8[3]}; *(LAS f32x4*)(SBUF + ((2 * wave + 1) * 64 + lane) * 4) = (f32x4){S8[4], S8[5], S8[6], S8[7]};
    }
    __syncthreads();
    f32x4 Sp[4][4];
#pragma unroll 1
    for (int step = 0; step < 8; ++step) {
        if (wave == step) {
#pragma unroll
            for (int mt = 0; mt < 4; ++mt) { const f32x4 Dv = *(const LAS f32x4*)(DL + 16 * mt + 4 * q);
#pragma unroll
                for (int nt = 0; nt < 4; ++nt) {
                    Sp[mt][nt] = *(const LAS f32x4*)(SBUF + ((mt * 4 + nt) * 64 + lane) * 4);
                    U[mt][nt] = Dv * Sp[mt][nt] + U[mt][nt];
                    *(LAS f32x4*)(SBUF + ((mt * 4 + nt) * 64 + lane) * 4) = U[mt][nt];
                } }
        }
        __syncthreads();
    }
    if (OUT) {
#pragma unroll
        for (int mt = 0; mt < 4; ++mt) { const f32x4 Ev = *(const LAS f32x4*)(E7L + 16 * mt + 4 * q);
#pragma unroll
            for (int nt = 0; nt < 4; ++nt) Sp[mt][nt] = Sp[mt][nt] * Ev; }
#pragma unroll
        for (int nt = 0; nt < 4; ++nt)
#pragma unroll
            for (int ks = 0; ks < 2; ++ks) {
                const f32x4 s0 = Sp[2 * ks][nt], s1 = Sp[2 * ks + 1][nt];
                const bf16x8 bfrag = __builtin_bit_cast(bf16x8, (v4u){pk2(s0[0], s0[1]), pk2(s0[2], s0[3]), pk2(s1[0], s1[1]), pk2(s1[2], s1[3])});
                o[nt] = __builtin_amdgcn_mfma_f32_16x16x32_bf16(qf[ks], bfrag, o[nt], 0, 0, 0);
            }
        float gn[4];
#pragma unroll
        for (int nt = 0; nt < 4; ++nt) gn[nt] = a.in[5][layer * 64 + 16 * nt + l15];
#pragma unroll
        for (int j = 0; j < 4; ++j) {
            float ss = (o[0][j] * o[0][j] + o[1][j] * o[1][j]) + (o[2][j] * o[2][j] + o[3][j] * o[3][j]);
            ss += __shfl_xor(ss, 1); ss += __shfl_xor(ss, 2); ss += __shfl_xor(ss, 4); ss += __shfl_xor(ss, 8);
            const float rs = __builtin_amdgcn_rsqf(ss * (1.f / 64.f) + EPS);
#pragma unroll
            for (int nt = 0; nt < 4; ++nt) { const float gt = siluf(bf1(GT[(4 * q + j) * 72 + 16 * nt + l15]));
                OT[(4 * q + j) * 72 + 16 * nt + l15] = (bf16)f2bf(o[nt][j] * rs * gn[nt] * gt); }
        }
        LDS_WAIT();
        { const int rr = lane >> 3, cc = (lane & 7) * 8; bf16* mp = (bf16*)(a.ws + WS_MIX) + (row0 + rr) * 1024 + h * 64 + cc;
          *(v4u*)mp = *(const LAS v4u*)(OT + rr * 72 + cc); *(v4u*)(mp + 8 * 1024) = *(const LAS v4u*)(OT + (rr + 8) * 72 + cc); }
    } else {
        if (wave == 7) {
#pragma unroll
            for (int mt = 0; mt < 4; ++mt)
#pragma unroll
                for (int nt = 0; nt < 4; ++nt)
                    *(f32x4*)(HU + (size_t)item * 4096 + (size_t)((mt * 4 + nt) * 64 + lane) * 4) = U[mt][nt];
            float s = 0.f;
#pragma unroll
            for (int w2 = 0; w2 < 8; ++w2) s += DALL[w2 * 64 + lane];
            HA[(size_t)item * 64 + lane] = __expf(s);
        }
    }
}

template <bool OUT> __device__ __forceinline__ HRaw hgrn_loadc(const PA& a, int bh, int c, int chunk, int lane) {
    const bf16* pr = (const bf16*)(a.ws + WS_PROJ) + ((size_t)(bh >> 2) * T + (size_t)c * 128 + chunk * 16 + (lane >> 3)) * DIN + (bh & 3) * 64 + (lane & 7) * 8;
    HRaw r;
#pragma unroll
    for (int k = 0; k < 2; ++k) { r.f[k] = *(const v4u*)(pr + (size_t)(8 * k) * DIN + 256); r.v[k] = *(const v4u*)(pr + (size_t)(8 * k) * DIN + 512);
        if (OUT) { r.q[k] = *(const v4u*)(pr + (size_t)(8 * k) * DIN); } }
    return r;
}
template <bool OUT> __device__ __forceinline__ void hgrn_chunk(const PA& a, LAS unsigned char* wb, LAS float* DLk, LAS float* E7k, LAS float* DALLk, int layer, int h, int lane, const HRaw& raw,
                                                                f32x4 (&U)[4][4], f32x4 (&o)[4], bf16x8 (&qf)[2]) {
    LAS bf16* QT = (LAS bf16*)wb; LAS bf16* KT = (LAS bf16*)(wb + 2304); LAS bf16* KHT = (LAS bf16*)(wb + 4608); LAS bf16* VT = (LAS bf16*)(wb + 7680); LAS bf16* P = (LAS bf16*)(wb + 10752);
    LAS bf16* RF = (LAS bf16*)wb; LAS bf16* RV = (LAS bf16*)(wb + 2304); LAS bf16* RQ = (LAS bf16*)(wb + 4608);
    const int l15 = lane & 15, q = lane >> 4;
    const bf16x8 zero8 = {0, 0, 0, 0, 0, 0, 0, 0};
    LDS_WAIT();
    {
        const int rr = lane >> 3, cc = (lane & 7) * 8;
#pragma unroll
        for (int k = 0; k < 2; ++k) { *(LAS v4u*)(RF + (rr + 8 * k) * 72 + cc) = raw.f[k]; *(LAS v4u*)(RV + (rr + 8 * k) * 72 + cc) = raw.v[k]; if (OUT) *(LAS v4u*)(RQ + (rr + 8 * k) * 72 + cc) = raw.q[k]; }
        LDS_WAIT();
        const float lb = (layer == 0) ? 0.f : sigmf(a.in[4][256 + h * 64 + lane] - a.in[4][h * 64 + lane]);
        {
            u16 vr[16];
#pragma unroll
            for (int t = 0; t < 16; ++t) vr[t] = RV[t * 72 + lane];
            const v4u w0 = {(unsigned)vr[0] | ((unsigned)vr[1] << 16), (unsigned)vr[2] | ((unsigned)vr[3] << 16), (unsigned)vr[4] | ((unsigned)vr[5] << 16), (unsigned)vr[6] | ((unsigned)vr[7] << 16)};
            const v4u w1 = {(unsigned)vr[8] | ((unsigned)vr[9] << 16), (unsigned)vr[10] | ((unsigned)vr[11] << 16), (unsigned)vr[12] | ((unsigned)vr[13] << 16), (unsigned)vr[14] | ((unsigned)vr[15] << 16)};
            *(LAS v4u*)(VT + lane * 24) = w0; *(LAS v4u*)(VT + lane * 24 + 8) = w1;
        }
        float cum[16], kk[16]; float run = 0.f;
#pragma unroll
        for (int t = 0; t < 16; ++t) { const float sg = sigmf(bf1(RF[t * 72 + lane])); const float f = lb + (1.f - lb) * sg; kk[t] = (1.f - lb) * (1.f - sg); run += fmaxf(__logf(f), -69.f); cum[t] = run; }
        const float cl = cum[15], c7 = cum[7];
        DLk[lane] = __expf(cl);
        if (OUT) E7k[lane] = __expf(c7); else DALLk[lane] = cl;
        if (OUT) {
            float qv[16];
#pragma unroll
            for (int t = 0; t < 16; ++t) qv[t] = bf1(RQ[t * 72 + lane]);
            LDS_WAIT();
#pragma unroll
            for (int t = 0; t < 16; ++t) {
                QT[t * 72 + lane] = (bf16)f2bf(siluf(qv[t]) * __expf(fminf(cum[t] - c7, 60.f)));
                KT[t * 72 + lane] = (bf16)f2bf(kk[t] * __expf(fminf(c7 - cum[t], 60.f)));
            }
        }
        LDS_WAIT();
        float kh[16];
#pragma unroll
        for (int t = 0; t < 16; ++t) kh[t] = kk[t] * __expf(cl - cum[t]);
        *(LAS bf16x8*)(KHT + lane * 24) = pk8(kh); *(LAS bf16x8*)(KHT + lane * 24 + 8) = pk8(kh + 8);
    }
    LDS_WAIT();
    bf16x8 vfr[4];
#pragma unroll
    for (int nt = 0; nt < 4; ++nt) vfr[nt] = (q < 2) ? *(const LAS bf16x8*)(VT + (16 * nt + l15) * 24 + q * 8) : zero8;
#pragma unroll
    for (int mt = 0; mt < 4; ++mt) { const bf16x8 afr = (q < 2) ? *(const LAS bf16x8*)(KHT + (16 * mt + l15) * 24 + q * 8) : zero8;
#pragma unroll
        for (int nt = 0; nt < 4; ++nt) U[mt][nt] = __builtin_amdgcn_mfma_f32_16x16x32_bf16(afr, vfr[nt], (f32x4){0.f, 0.f, 0.f, 0.f}, 0, 0, 0); }
    if (OUT) {
        f32x4 sc = {0.f, 0.f, 0.f, 0.f};
#pragma unroll
        for (int ks = 0; ks < 2; ++ks) {
            const v2u qa = *(const LAS v2u*)(QT + l15 * 72 + 32 * ks + 4 * q), qb = *(const LAS v2u*)(QT + l15 * 72 + 32 * ks + 16 + 4 * q);
            const v2u ka = *(const LAS v2u*)(KT + l15 * 72 + 32 * ks + 4 * q), kb = *(const LAS v2u*)(KT + l15 * 72 + 32 * ks + 16 + 4 * q);
            qf[ks] = __builtin_bit_cast(bf16x8, (v4u){qa.x, qa.y, qb.x, qb.y});
            const bf16x8 kf = __builtin_bit_cast(bf16x8, (v4u){ka.x, ka.y, kb.x, kb.y});
            sc = __builtin_amdgcn_mfma_f32_16x16x32_bf16(qf[ks], kf, sc, 0, 0, 0);
        }
#pragma unroll
        for (int j = 0; j < 4; ++j) { const int t = 4 * q + j; P[t * 24 + l15] = (bf16)f2bf((l15 <= t) ? sc[j] : 0.f); }
        LDS_WAIT();
        const bf16x8 pf = (q < 2) ? *(const LAS bf16x8*)(P + l15 * 24 + q * 8) : zero8;
#pragma unroll
        for (int nt = 0; nt < 4; ++nt) o[nt] = __builtin_amdgcn_mfma_f32_16x16x32_bf16(pf, vfr[nt], (f32x4){0.f, 0.f, 0.f, 0.f}, 0, 0, 0);
    }
}
__device__ __forceinline__ void hgrn_ointer(f32x4 (&o)[4], const bf16x8 (&qf)[2], const f32x4 (&S)[4][4], const f32x4 (&sc)[4]) {
#pragma unroll
    for (int nt = 0; nt < 4; ++nt)
#pragma unroll
        for (int ks = 0; ks < 2; ++ks) {
            const f32x4 s0 = S[2 * ks][nt] * sc[2 * ks], s1 = S[2 * ks + 1][nt] * sc[2 * ks + 1];
            const bf16x8 bfrag = __builtin_bit_cast(bf16x8, (v4u){pk2(s0[0], s0[1]), pk2(s0[2], s0[3]), pk2(s1[0], s1[1]), pk2(s1[2], s1[3])});
            o[nt] = __builtin_amdgcn_mfma_f32_16x16x32_bf16(qf[ks], bfrag, o[nt], 0, 0, 0);
        }
}
#define HG_LAUNDER() do { asm volatile("" : "+v"(lane)); l15 = lane & 15; q = lane >> 4; } while (0)
template <bool OUT> __device__ __forceinline__ void hgrn_pair(const PA& a, LAS unsigned char* lds, int layer, int bh, int s, int wave, int lane) {
    const int half = wave >> 2, wl = wave & 3, c = half ? 63 - s : s, b = bh >> 2, h = bh & 3, item = bh * 64 + c;
    float* HU = (float*)(a.ws + WS_HU); float* HA = (float*)(a.ws + WS_HA);
    LAS unsigned char* wb = lds + wave * 12800;
    LAS float* DLs = (LAS float*)(wb + 11520);
    LAS float* SBUF = (LAS float*)(lds + 102400 + half * 16384);
    LAS float* DALL = (LAS float*)(lds + 135168 + half * 2048);
    int l15 = lane & 15, q = lane >> 4;
    const size_t rowc0 = (size_t)b * T + (size_t)c * 128 + (size_t)(2 * wl) * 16;
    __syncthreads();
    f32x4 U0[4][4], Up[4][4], o[2][4]; bf16x8 qf[2][2];
    { const HRaw r0 = hgrn_loadc<OUT>(a, bh, c, 2 * wl, lane); hgrn_chunk<OUT>(a, wb, DLs, DLs + 128, DALL + (2 * wl) * 64, layer, h, lane, r0, U0, o[0], qf[0]); }
    asm volatile("" ::: "memory"); __builtin_amdgcn_sched_barrier(0); HG_LAUNDER();
    { const HRaw r1 = hgrn_loadc<OUT>(a, bh, c, 2 * wl + 1, lane); hgrn_chunk<OUT>(a, wb, DLs + 64, DLs + 192, DALL + (2 * wl + 1) * 64, layer, h, lane, r1, Up, o[1], qf[1]); }
    asm volatile("" ::: "memory"); __builtin_amdgcn_sched_barrier(0); HG_LAUNDER();
    LDS_WAIT();
    if (OUT) { f32x4 E1[4];
#pragma unroll
        for (int mt = 0; mt < 4; ++mt) E1[mt] = *(const LAS f32x4*)(DLs + 192 + 16 * mt + 4 * q);
        hgrn_ointer(o[1], qf[1], U0, E1); }
#pragma unroll
    for (int mt = 0; mt < 4; ++mt) { const f32x4 D1 = *(const LAS f32x4*)(DLs + 64 + 16 * mt + 4 * q);
#pragma unroll
        for (int nt = 0; nt < 4; ++nt) Up[mt][nt] = D1 * U0[mt][nt] + Up[mt][nt]; }
    HG_LAUNDER();
#pragma unroll
    for (int i = 0; i < 4; ++i) { f32x4 hv = {0.f, 0.f, 0.f, 0.f};
        if (OUT) hv = *(const f32x4*)(HU + (size_t)item * 4096 + (size_t)((4 * wl + i) * 64 + lane) * 4);
        *(LAS f32x4*)(SBUF + ((4 * wl + i) * 64 + lane) * 4) = hv; }
    v4u gq[2][2];
    if (OUT) { const bf16* gp = (const bf16*)(a.ws + WS_PROJ) + (rowc0 + (lane >> 3)) * DIN + 768 + h * 64 + (lane & 7) * 8;
#pragma unroll
        for (int k = 0; k < 2; ++k) { gq[k][0] = *(const v4u*)(gp + (size_t)(16 * k) * DIN); gq[k][1] = *(const v4u*)(gp + (size_t)(16 * k + 8) * DIN); } }
    __syncthreads();
    HG_LAUNDER();
    f32x4 Sin[4][4];
#pragma unroll 1
    for (int step = 0; step < 4; ++step) {
        if (wl == step) {
#pragma unroll
            for (int mt = 0; mt < 4; ++mt) { const f32x4 Dp = *(const LAS f32x4*)(DLs + 16 * mt + 4 * q) * *(const LAS f32x4*)(DLs + 64 + 16 * mt + 4 * q);
#pragma unroll
                for (int nt = 0; nt < 4; ++nt) {
                    Sin[mt][nt] = *(const LAS f32x4*)(SBUF + ((mt * 4 + nt) * 64 + lane) * 4);
                    Up[mt][nt] = Dp * Sin[mt][nt] + Up[mt][nt];
                    *(LAS f32x4*)(SBUF + ((mt * 4 + nt) * 64 + lane) * 4) = Up[mt][nt];
                } }
        }
        __syncthreads();
    }
    HG_LAUNDER();
    if (OUT) {
        { f32x4 E0[4];
#pragma unroll
          for (int mt = 0; mt < 4; ++mt) E0[mt] = *(const LAS f32x4*)(DLs + 128 + 16 * mt + 4 * q);
          hgrn_ointer(o[0], qf[0], Sin, E0);
#pragma unroll
          for (int mt = 0; mt < 4; ++mt) E0[mt] = *(const LAS f32x4*)(DLs + 192 + 16 * mt + 4 * q) * *(const LAS f32x4*)(DLs + 16 * mt + 4 * q);
          hgrn_ointer(o[1], qf[1], Sin, E0); }
        HG_LAUNDER();
        LAS bf16* GT = (LAS bf16*)(wb + 4608); LAS bf16* OT = (LAS bf16*)(wb + 7680);
        float gn[4];
#pragma unroll
        for (int nt = 0; nt < 4; ++nt) gn[nt] = a.in[5][layer * 64 + 16 * nt + l15];
#pragma unroll
        for (int k = 0; k < 2; ++k) {
            const int rr = lane >> 3, cc = (lane & 7) * 8;
            LDS_WAIT();
            *(LAS v4u*)(GT + rr * 72 + cc) = gq[k][0]; *(LAS v4u*)(GT + (rr + 8) * 72 + cc) = gq[k][1];
            LDS_WAIT();
#pragma unroll
            for (int j = 0; j < 4; ++j) {
                float ss = (o[k][0][j] * o[k][0][j] + o[k][1][j] * o[k][1][j]) + (o[k][2][j] * o[k][2][j] + o[k][3][j] * o[k][3][j]);
                ss += __shfl_xor(ss, 1); ss += __shfl_xor(ss, 2); ss += __shfl_xor(ss, 4); ss += __shfl_xor(ss, 8);
                const float rs = __builtin_amdgcn_rsqf(ss * (1.f / 64.f) + EPS);
#pragma unroll
                for (int nt = 0; nt < 4; ++nt) { const float gt = siluf(bf1(GT[(4 * q + j) * 72 + 16 * nt + l15]));
                    OT[(4 * q + j) * 72 + 16 * nt + l15] = (bf16)f2bf(o[k][nt][j] * rs * gn[nt] * gt); }
            }
            LDS_WAIT();
            bf16* mp = (bf16*)(a.ws + WS_MIX) + (rowc0 + k * 16 + rr) * 1024 + h * 64 + cc;
            *(v4u*)mp = *(const LAS v4u*)(OT + rr * 72 + cc); *(v4u*)(mp + 8 * 1024) = *(const LAS v4u*)(OT + (rr + 8) * 72 + cc);
        }
    } else {
        if (wl == 3) {
#pragma unroll
            for (int mt = 0; mt < 4; ++mt)
#pragma unroll
                for (int nt = 0; nt < 4; ++nt)
                    *(f32x4*)(HU + (size_t)item * 4096 + (size_t)((mt * 4 + nt) * 64 + lane) * 4) = Up[mt][nt];
            float sm = 0.f;
#pragma unroll
            for (int w2 = 0; w2 < 8; ++w2) sm += DALL[w2 * 64 + lane];
            HA[(size_t)item * 64 + lane] = __expf(sm);
        }
    }
}

__device__ __forceinline__ float gelu_tanh(float y) { const float z = 0.7978845608028654f * (y + 0.044715f * y * y * y); return y * sigmf(2.f * z); }
template <bool OUT> __device__ __forceinline__ void s5_item(const PA& a, LAS unsigned char* lds, int layer, int item, int wave, int lane) {
    const int b = item >> 10, g = (item >> 6) & 15, c = item & 63, lg = layer * 16 + g;
    const bf16* PROJ = (const bf16*)(a.ws + WS_PROJ);
    const float* sa = (const float*)(a.ws + WS_S5A) + (size_t)lg * 256;
    float* XL = (float*)(a.ws + WS_XLOC) + (size_t)((b * 16 + g) * 64) * 128;
    const float ar = sa[lane], ai = sa[64 + lane];
    float xr = 0.f, xi = 0.f;
    if (OUT) { xr = XL[c * 128 + lane]; xi = XL[c * 128 + 64 + lane]; }
    const int l15 = lane & 15, quad = lane >> 4;
    const bf16x8 zero8 = {0, 0, 0, 0, 0, 0, 0, 0};
    bf16x8 bfr[8];
#pragma unroll
    for (int nt = 0; nt < 8; ++nt) bfr[nt] = (quad < 2) ? *(const bf16x8*)((const bf16*)(a.ws + WS_S5B) + (size_t)lg * 2048 + (nt * 16 + l15) * 16 + quad * 8) : zero8;
    bf16x8 cfr[4];
    if (OUT) {
#pragma unroll
        for (int ks = 0; ks < 4; ++ks) cfr[ks] = *(const bf16x8*)((const bf16*)(a.ws + WS_S5C) + (size_t)lg * 2048 + l15 * 128 + ks * 32 + quad * 8);
    }
    const float dsk = a.in[13][layer * 256 + g * 16 + l15];
    LAS float* BU = (LAS float*)(lds + wave * 12800);
    LAS bf16* X = (LAS bf16*)(lds + wave * 12800 + 8448);
    const size_t rowb = (size_t)b * T + (size_t)c * 128;
    bf16x8 afr_n = (quad < 2) ? *(const bf16x8*)(PROJ + (rowb + l15) * DIN + 1024 + g * 16 + quad * 8) : zero8;
    bf16 ue_n[4] = {0, 0, 0, 0}, se_n[4] = {0, 0, 0, 0};
    if (OUT) {
#pragma unroll
        for (int j = 0; j < 4; ++j) { ue_n[j] = PROJ[(rowb + quad * 4 + j) * DIN + 1024 + g * 16 + l15]; se_n[j] = PROJ[(rowb + quad * 4 + j) * DIN + 1280 + g * 16 + l15]; }
    }
    f32x4 accn[8];
#pragma unroll
    for (int nt = 0; nt < 8; ++nt) accn[nt] = __builtin_amdgcn_mfma_f32_16x16x32_bf16(afr_n, bfr[nt], (f32x4){0.f, 0.f, 0.f, 0.f}, 0, 0, 0);
#pragma unroll
    for (int nt = 0; nt < 8; ++nt)
#pragma unroll
        for (int j = 0; j < 4; ++j) BU[(quad * 4 + j) * 132 + nt * 16 + l15] = accn[nt][j];
    afr_n = (quad < 2) ? *(const bf16x8*)(PROJ + (rowb + 16 + l15) * DIN + 1024 + g * 16 + quad * 8) : zero8;
    for (int blk = 0; blk < 8; ++blk) {
        const size_t row0 = rowb + blk * 16;
        bf16 ue[4], se[4];
#pragma unroll
        for (int j = 0; j < 4; ++j) { ue[j] = ue_n[j]; se[j] = se_n[j]; }
        if (blk + 1 < 8) {
#pragma unroll
            for (int nt = 0; nt < 8; ++nt) accn[nt] = __builtin_amdgcn_mfma_f32_16x16x32_bf16(afr_n, bfr[nt], (f32x4){0.f, 0.f, 0.f, 0.f}, 0, 0, 0);
            if (blk + 2 < 8) afr_n = (quad < 2) ? *(const bf16x8*)(PROJ + (row0 + 32 + l15) * DIN + 1024 + g * 16 + quad * 8) : zero8;
            if (OUT) {
#pragma unroll
                for (int j = 0; j < 4; ++j) { ue_n[j] = PROJ[(row0 + 16 + quad * 4 + j) * DIN + 1024 + g * 16 + l15]; se_n[j] = PROJ[(row0 + 16 + quad * 4 + j) * DIN + 1280 + g * 16 + l15]; }
            }
        }
#pragma unroll
        for (int t = 0; t < 16; ++t) {
            const float br = BU[t * 132 + lane], bi = BU[t * 132 + 64 + lane];
            const float nr = ar * xr - ai * xi + br, ni = ar * xi + ai * xr + bi; xr = nr; xi = ni;
            if (OUT) { X[t * 136 + lane] = (bf16)f2bf(xr); X[t * 136 + 64 + lane] = (bf16)f2bf(xi); }
        }
        if (blk + 1 < 8) {
#pragma unroll
            for (int nt = 0; nt < 8; ++nt)
#pragma unroll
                for (int j = 0; j < 4; ++j) BU[(quad * 4 + j) * 132 + nt * 16 + l15] = accn[nt][j];
        }
        if (OUT) {
            f32x4 acc = {0.f, 0.f, 0.f, 0.f};
#pragma unroll
            for (int ks = 0; ks < 4; ++ks) { const bf16x8 xa = *(const LAS bf16x8*)(X + l15 * 136 + ks * 32 + quad * 8); acc = __builtin_amdgcn_mfma_f32_16x16x32_bf16(xa, cfr[ks], acc, 0, 0, 0); }
#pragma unroll
            for (int j = 0; j < 4; ++j) { const size_t row = row0 + quad * 4 + j;
                const float u = bf1(ue[j]);
                const float yg = gelu_tanh(acc[j] + dsk * u);
                ((bf16*)(a.ws + WS_YG))[row * 256 + g * 16 + l15] = (bf16)f2bf(yg);
                ((bf16*)(a.ws + WS_YGS))[row * 256 + g * 16 + l15] = (bf16)f2bf(yg * siluf(bf1(se[j]))); }
        }
    }
    LDS_WAIT();
    if (!OUT) { XL[c * 128 + lane] = xr; XL[c * 128 + 64 + lane] = xi; }
}


__device__ __forceinline__ void hgrn_scan(const PA& a, int task, int lane) {
    float* HU = (float*)(a.ws + WS_HU); const float* HA = (const float*)(a.ws + WS_HA);
    const int bh = task >> 6, r = task & 63, dk = 16 * (r >> 4) + 4 * (r & 3) + (lane & 3);
    float* up = HU + (size_t)(bh * 64) * 4096 + (size_t)r * 64 + lane; const float* ap = HA + (size_t)(bh * 64) * 64 + dk;
    float S = 0.f;
#pragma unroll 1
    for (int c0 = 0; c0 < 64; c0 += 32) {
        float u[32], av[32];
#pragma unroll
        for (int i = 0; i < 32; ++i) { u[i] = up[(size_t)(c0 + i) * 4096]; av[i] = ap[(size_t)(c0 + i) * 64]; }
#pragma unroll
        for (int i = 0; i < 32; ++i) { __hip_atomic_store(up + (size_t)(c0 + i) * 4096, S, __ATOMIC_RELAXED, __HIP_MEMORY_SCOPE_AGENT); S = av[i] * S + u[i]; }
    }
}
__device__ __forceinline__ void s5_scan(const PA& a, int layer, int task, int lane) {
    const int g = task & 15;
    const float* sa = (const float*)(a.ws + WS_S5A) + (size_t)(layer * 16 + g) * 256;
    float* XL = (float*)(a.ws + WS_XLOC) + (size_t)(task * 64) * 128;
    const float Lr = sa[128 + lane], Li = sa[192 + lane];
    float xr = 0.f, xi = 0.f;
#pragma unroll 1
    for (int c0 = 0; c0 < 64; c0 += 32) {
        float lr[32], li[32];
#pragma unroll
        for (int i = 0; i < 32; ++i) { lr[i] = XL[(c0 + i) * 128 + lane]; li[i] = XL[(c0 + i) * 128 + 64 + lane]; }
#pragma unroll
        for (int i = 0; i < 32; ++i) { __hip_atomic_store(XL + (c0 + i) * 128 + lane, xr, __ATOMIC_RELAXED, __HIP_MEMORY_SCOPE_AGENT); __hip_atomic_store(XL + (c0 + i) * 128 + 64 + lane, xi, __ATOMIC_RELAXED, __HIP_MEMORY_SCOPE_AGENT);
            const float nr = Lr * xr - Li * xi + lr[i], ni = Lr * xi + Li * xr + li[i]; xr = nr; xi = ni; }
    }
}
template <int NR> __device__ __forceinline__ void combine_rows(const PA& a, int layer, float lam, float post, size_t row0, size_t rstride, int lane) {
    const bf16* O = (const bf16*)(a.ws + WS_O); const bf16* PROJ = (const bf16*)(a.ws + WS_PROJ);
    const int h = lane >> 4, e0 = (lane & 15) * 8, j = e0 >> 6, d = e0 & 63;
    v4u o0[NR], o1[NR], gv[NR];
#pragma unroll
    for (int r = 0; r < NR; ++r) { const size_t row = row0 + r * rstride;
        o0[r] = *(const v4u*)(O + row * 1024 + (h * 4 + j) * 64 + d); o1[r] = *(const v4u*)(O + row * 1024 + (h * 4 + 2 + j) * 64 + d); gv[r] = *(const v4u*)(PROJ + row * DIN + 3072 + h * 128 + e0); }
    const f32x4 sw0 = *(const f32x4*)(a.in[20] + layer * 128 + e0), sw1 = *(const f32x4*)(a.in[20] + layer * 128 + e0 + 4);
    const float sw[8] = {sw0[0], sw0[1], sw0[2], sw0[3], sw1[0], sw1[1], sw1[2], sw1[3]};
#pragma unroll
    for (int r = 0; r < NR; ++r) { const size_t row = row0 + r * rstride;
        const unsigned a0[4] = {o0[r].x, o0[r].y, o0[r].z, o0[r].w}, a1[4] = {o1[r].x, o1[r].y, o1[r].z, o1[r].w}, ga[4] = {gv[r].x, gv[r].y, gv[r].z, gv[r].w};
        float v[8]; float ss = 0.f;
#pragma unroll
        for (int q = 0; q < 8; ++q) { const float x0 = (q & 1) ? bfhi(a0[q >> 1]) : bflo(a0[q >> 1]), x1 = (q & 1) ? bfhi(a1[q >> 1]) : bflo(a1[q >> 1]); v[q] = x0 - lam * x1; ss += v[q] * v[q]; }
        ss += __shfl_xor(ss, 1); ss += __shfl_xor(ss, 2); ss += __shfl_xor(ss, 4); ss += __shfl_xor(ss, 8);
        const float rs = post * __builtin_amdgcn_rsqf(ss * (1.f / 128.f) + EPS);
        float o[8];
#pragma unroll
        for (int q = 0; q < 8; ++q) { const float gq = (q & 1) ? bfhi(ga[q >> 1]) : bflo(ga[q >> 1]); o[q] = v[q] * rs * sw[q] * siluf(gq); }
        *(v4u*)((bf16*)(a.ws + WS_MIX) + row * 1024 + 512 + h * 128 + e0) = (v4u){pk2(o[0], o[1]), pk2(o[2], o[3]), pk2(o[4], o[5]), pk2(o[6], o[7])};
    }
}

__global__ void __launch_bounds__(NWAVES * 64, 2) hymba_fwd(Args args) {
    extern __shared__ __attribute__((aligned(16))) unsigned char lds_raw[];
    LAS unsigned char* lds = (LAS unsigned char*)lds_raw;
    cg::grid_group grid = cg::this_grid();
    int tid = threadIdx.x, lane = tid & 63, wave = __builtin_amdgcn_readfirstlane(tid >> 6);
#define RELAUNDER() do { int t_ = threadIdx.x; asm volatile("" : "+v"(t_)); tid = t_; lane = tid & 63; wave = __builtin_amdgcn_readfirstlane(tid >> 6); } while (0)
    const int G = gridDim.x, bx = blockIdx.x, vcu = (G % 8 == 0) ? (bx % 8) * (G / 8) + bx / 8 : bx;
    unsigned char* ws = args.ws;
    const int lo = args.ph_lo, hi = args.ph_hi;
    volatile LAS unsigned* MISC = (volatile LAS unsigned*)(lds + LDS_BYTES - 256);
    if (tid < 32) MISC[tid] = 0u;
    __syncthreads();
    unsigned* barw = (unsigned*)(ws + WS_CTL);
    XcdBarrier bar; bar.bar = barw; bar.x = 0; bar.st = MISC + 8;
    int ph = 0;
#ifndef MK_DIS
#define MK_DIS 0
#endif
#define EN(bit) (!((MK_DIS >> (bit)) & 1))
#ifndef MK_REP
#define MK_REP 0
#endif
#define REPS(bit) for (int rep_ = 0; rep_ < 1 + ((MK_REP >> (bit)) & 1); ++rep_)
#define IN(k) (lo <= (k) && (k) < hi)
#define SEAM() do { if (IN(ph) && IN(ph + 1)) { xcd_barrier(bar); if ((MK_REP >> 10) & 1) xcd_barrier(bar); } ++ph; RELAUNDER(); } while (0)
    bf16* PROJ = (bf16*)(ws + WS_PROJ); bf16* XN = (bf16*)(ws + WS_XN); bf16* MIX = (bf16*)(ws + WS_MIX);
    const int NGW = G * NWAVES;
#define gw (vcu * NWAVES + wave)

    const float** tabw = (const float**)(ws + WS_TAB);
    bar = xcd_barrier_post(barw, MISC + 8);
    if (IN(ph) && EN(0)) { if (bx == 0) {
            if (tid == 0) {
#pragma unroll
                for (int i = 0; i < 22; ++i) tabw[i] = args.in[i]; } }
        REPS(0) { __syncthreads(); prologue(args, lds, vcu, G, wave, lane); } }
    const PA pa{(const float* const*)tabw, args.out, ws};
    if (lo < 0) grid.sync();
    SEAM();
    for (int layer = 0; layer < DEPTH; ++layer) {
        if (IN(ph) && EN(1)) REPS(1) {
            pg8::Gemm g{(const bf16*)(ws + WS_HRES), (const bf16*)(ws + WS_WIN) + (size_t)layer * DIN * D, M, DIN, D}; pg8::StaticOrder S; S.init(M, DIN, G, bx);
            pg8::EpiInProj E{PROJ, (const float*)(ws + WS_ROPE), attn_body::C2, layer == 0 ? (const float*)(ws + WS_ROWSS0) : (const float*)(ws + WS_ROWSS), (unsigned*)(ws + WS_SUCNT) + layer * 64};
            pg8::gemm_phase<pg8::EpiInProj, pg8::StaticOrder, PG8_ALIGN, PG8_SP2>(lds, g, S, E);
            if (G == 256 && bx >= 128) {
                __syncthreads();
                if (wave == 0) { unsigned* sucnt = (unsigned*)(ws + WS_SUCNT) + layer * 64; unsigned spins = 0;
                    while ((unsigned)__builtin_amdgcn_readfirstlane(__hip_atomic_load(sucnt, __ATOMIC_RELAXED, __HIP_MEMORY_SCOPE_AGENT)) < 512u) { __builtin_amdgcn_s_sleep(4); if (++spins > (1u << 22)) break; }
                    __builtin_amdgcn_fence(__ATOMIC_ACQUIRE, "agent"); asm volatile("s_waitcnt vmcnt(0)" ::: "memory"); }
                __syncthreads();
                RELAUNDER();
                for (int it = (bx - 128) * NWAVES + wave; it < 2048; it += 128 * NWAVES) s5_item<false>(pa, lds, layer, it, wave, lane);
            }
        }
        SEAM();
        if (IN(ph)) {
            if (EN(2) && G != 256) REPS(2) for (int it = gw; it < 2048; it += NGW) s5_item<false>(pa, lds, layer, it, wave, lane);
            RELAUNDER();
            if (EN(3)) REPS(3) for (int v = vcu; v < 256; v += G) hgrn_pair<false>(pa, lds, layer, v >> 5, v & 31, wave, lane);
            xcd_barrier(bar);
            unsigned* scnt = (unsigned*)(ws + WS_SCNT) + layer * 64;
            { unsigned ndone = 0;
              if (wave < 2) { for (int t2 = wave * G + vcu; t2 < 512; t2 += 2 * G) { hgrn_scan(pa, t2, lane); ++ndone; } }
              else if (wave == 2) { for (int t2 = vcu; t2 < 32; t2 += G) { s5_scan(pa, layer, t2, lane); ++ndone; } }
              if (ndone) { asm volatile("s_waitcnt vmcnt(0)" ::: "memory"); if (lane == 0) (void)__hip_atomic_fetch_add(scnt, ndone, __ATOMIC_RELAXED, __HIP_MEMORY_SCOPE_AGENT); } }
            __syncthreads();
            const attn_body::AttnTensors AT{(const attn_body::bf16*)PROJ, (const attn_body::bf16*)PROJ, (const attn_body::bf16*)PROJ, (attn_body::bf16*)(ws + WS_O)};
            if (EN(4)) REPS(4) for (int v = vcu; v < 256; v += G) { const attn_body::StaticOrder S(v); attn_body::attn_phase<attn_body::StaticOrder>((char*)lds_raw, AT, S); }
        }
        ++ph; RELAUNDER();
        if (IN(ph)) {
            __syncthreads();
            if (wave == 0) { unsigned* scnt = (unsigned*)(ws + WS_SCNT) + layer * 64; unsigned spins = 0;
                while ((unsigned)__builtin_amdgcn_readfirstlane(__hip_atomic_load(scnt, __ATOMIC_RELAXED, __HIP_MEMORY_SCOPE_AGENT)) < 544u) { __builtin_amdgcn_s_sleep(4); if (++spins > (1u << 22)) break; }
                __builtin_amdgcn_fence(__ATOMIC_ACQUIRE, "agent"); asm volatile("s_waitcnt vmcnt(0)" ::: "memory"); }
            __syncthreads();
            if (EN(5)) REPS(5) for (int it = gw; it < 2048; it += NGW) s5_item<true>(pa, lds, layer, it, wave, lane);
            RELAUNDER();
            if (EN(6)) REPS(6) for (int v = vcu; v < 256; v += G) { const int bh = v >> 5, s = v & 31; const HRaw r1 = hgrn_load<true>(pa, bh, s, wave, lane), r2 = hgrn_load<true>(pa, bh, 63 - s, wave, lane); hgrn_item2<true>(pa, lds, layer, bh, s, wave, lane, r1); hgrn_item2<true>(pa, lds, layer, bh, 63 - s, wave, lane, r2); }
        }
        SEAM();
        const int cb0 = (G > 64) ? 64 : 0;
        if (IN(ph) && bx >= cb0) {
            const float l1 = wave_sum(pa.in[16][layer * 64 + lane] * pa.in[17][layer * 64 + lane]), l2 = wave_sum(pa.in[18][layer * 64 + lane] * pa.in[19][layer * 64 + lane]);
            const float linit = (layer == 0) ? 0.2f : 0.35550906759096934f;
            const float lam = __expf(l1) - __expf(l2) + linit;
            if (EN(7)) REPS(7) { const int nw_ = (G - cb0) * NWAVES; int m = (bx - cb0) * NWAVES + wave;
                for (; m + 3 * nw_ < M; m += 4 * nw_) combine_rows<4>(pa, layer, lam, 1.f - linit, (size_t)m, (size_t)nw_, lane);
                for (; m < M; m += nw_) combine_rows<1>(pa, layer, lam, 1.f - linit, (size_t)m, 0, lane); }
        }
        if (IN(ph) && EN(8) && (bx < 64 || G <= 64)) REPS(8) {
            __syncthreads();
            int kglu = 256; asm volatile("" : "+s"(kglu));
            pg8::Gemm g{(const bf16*)(ws + WS_YG), (const bf16*)(ws + WS_GLU) + (size_t)layer * 65536, M, 256, kglu}; pg8::StaticOrder S; S.init(M, 256, G, bx);
            pg8::EpiGlu E{(const bf16*)(ws + WS_YGS), pa.in[15] + layer * 256, MIX};
            pg8::gemm_phase<pg8::EpiGlu, pg8::StaticOrder, PG8_ALIGN, PG8_SP2>(lds, g, S, E);
        }
        SEAM();
        if (IN(ph) && EN(9)) for (int rep_ = 0; rep_ < 1 + (((MK_REP >> 9) & 1) && layer == 0); ++rep_) {
            pg8::Gemm g{MIX, (const bf16*)(ws + WS_WOUT) + (size_t)layer * D * D, M, D, D}; pg8::StaticOrder S; S.init(M, D, G, bx);
            if (layer + 1 < DEPTH) { pg8::EpiRes<true> E{nullptr, nullptr, (float*)(ws + WS_ROWSS), (const bf16*)(ws + WS_HRES), (bf16*)(ws + WS_HRES)};
                pg8::gemm_phase<pg8::EpiRes<true>, pg8::StaticOrder, PG8_ALIGN, PG8_SP2>(lds, g, S, E); }
            else if (G == 256) { pg8::EpiResFinal E{(const bf16*)(ws + WS_HRES), pa.out, (float*)(ws + WS_ROWSS2), (unsigned*)(ws + WS_PCNT), pa.in[21]};
                pg8::gemm_phase<pg8::EpiResFinal, pg8::StaticOrder, false, PG8_SP2>(lds, g, S, E); }
            else { pg8::EpiRes<false> E{nullptr, pa.out, nullptr, (const bf16*)(ws + WS_HRES), nullptr};
                pg8::gemm_phase<pg8::EpiRes<false>, pg8::StaticOrder, PG8_ALIGN, PG8_SP2>(lds, g, S, E); }
        }
        if (layer + 1 < DEPTH) { SEAM(); continue; }
        if (G == 256) break;
        SEAM();
        if (IN(ph)) {
            for (int m = gw; m < M; m += NGW) rms_row<true>(pa.out + (size_t)m * D, pa.in[21], nullptr, pa.out + (size_t)m * D, lane);
        }
    }
#undef IN
#undef SEAM
}
constexpr int N_PHASES = 1 + DEPTH * 5 + 1;

#ifndef MK_SPLIT
#define MK_SPLIT 0
#endif
extern "C" void kernel_launch(void* const* d_in, const int* in_sizes, int n_in, void* d_out, int out_size, void* d_ws, size_t ws_size, hipStream_t stream) {
    static int grid = 0;
    if (grid == 0) {
        if (n_in != 22 || in_sizes[0] != M * D || out_size != M * D || ws_size < WS_END) { fprintf(stderr, "kernel_launch: unexpected shapes (n_in %d, in0 %d, out %d, ws %zu)\n", n_in, n_in > 0 ? in_sizes[0] : -1, out_size, ws_size); grid = -1; return; }
        int dev = 0, cus = 0, per_cu = 0;
        hipGetDevice(&dev); hipDeviceGetAttribute(&cus, hipDeviceAttributeMultiprocessorCount, dev);
        hipFuncSetAttribute((const void*)hymba_fwd, hipFuncAttributeMaxDynamicSharedMemorySize, LDS_BYTES);
        hipOccupancyMaxActiveBlocksPerMultiprocessor(&per_cu, (const void*)hymba_fwd, NWAVES * 64, LDS_BYTES);
        (void)hipGetLastError();
        if (per_cu < 1) per_cu = 1;
        grid = cus * per_cu; if (grid > 256) grid = 256;
        fprintf(stderr, "kernel_launch: cus %d per_cu %d grid %d\n", cus, per_cu, grid);
    }
    if (grid < 0) return;
    Args a{};
    for (int i = 0; i < 22; ++i) a.in[i] = (const float*)d_in[i];
    a.out = (float*)d_out; a.ws = (unsigned char*)d_ws;
#if MK_SPLIT
    for (int p = 0; p < N_PHASES; ++p) { a.ph_lo = p; a.ph_hi = p + 1; hipLaunchKernelGGL(hymba_fwd, dim3(grid), dim3(NWAVES * 64), LDS_BYTES, stream, a); }
#else
    a.ph_lo = 0; a.ph_hi = N_PHASES;
    (void)hipMemsetAsync((char*)d_ws + WS_CTL, 0, 16384, stream);
    void* kargs[] = {&a};
    hipError_t e = hipLaunchCooperativeKernel((const void*)hymba_fwd, dim3(grid), dim3(NWAVES * 64), kargs, LDS_BYTES, stream);
    if (e != hipSuccess) fprintf(stderr, "cooperative launch failed: %s (grid %d)\n", hipGetErrorString(e), grid);
#endif
}
```

```cpp
#include <hip/hip_runtime.h>
#include <hip/hip_cooperative_groups.h>
#include <cstdio>
#include <cstdint>
namespace pg8 {
#define PG8_LAS __attribute__((address_space(3)))
typedef unsigned short bf16_t;
typedef short bf16x8 __attribute__((ext_vector_type(8)));
typedef float f32x4 __attribute__((ext_vector_type(4)));
typedef unsigned u32x4 __attribute__((ext_vector_type(4)));
constexpr int BM = 256, BK = 64, HALF = 128, HTB = HALF * BK * 2  , STAGE_BYTES = 8 * HTB, NXCD = 8, WGM = 8;

__host__ __device__ __forceinline__ int lds_byte(int r, int c) { const int st = (r >> 4) * 2 + (c >> 5), rr = r & 15, cc = c & 31, ob = rr * 64 + cc * 2; return st * 1024 + (ob ^ (((ob >> 9) & 1) << 5)); }
__host__ __device__ __forceinline__ void stage_rc(int b, int& R, int& C) { const int st = b / 1024, sb = b % 1024, swz = sb ^ (((sb >> 9) & 1) << 5); R = (st >> 1) * 16 + swz / 64; C = (st & 1) * 32 + (swz % 64) / 2; }
__host__ __device__ __forceinline__ int perm32(int rho) { const int n = rho >> 4, i = rho & 15; return 8 * (i >> 2) + 4 * n + (i & 3); }

struct Unit { int pm, pn; };
struct Gemm { const bf16_t* A; const bf16_t* Bt; int M, N, K; };

struct StaticOrder {
    int nM, nN, nwg, G, c;
    __host__ __device__ void init(int M, int N, int G_, int c_) { nM = M / BM; nN = N / BM; nwg = nM * nN; G = G_; c = c_; }
    __host__ __device__ bool next(int i, Unit& u) const {
        const long L = (long)i * G + c; if (L >= nwg) return false;
        int wgid = (int)L; { const int q = nwg / NXCD, r = nwg % NXCD, xcd = wgid % NXCD, off = wgid / NXCD; wgid = (xcd < r ? xcd * (q + 1) : r * (q + 1) + (xcd - r) * q) + off; }
        const int nig = WGM * nN, gid = wgid / nig, fm = gid * WGM, gsz = (nM - fm) < WGM ? (nM - fm) : WGM;
        u.pm = fm + ((wgid % nig) % gsz); u.pn = (wgid % nig) / gsz; return true;
    }
    __device__ __forceinline__ void a_ready(const Unit&) const {}
    __device__ __forceinline__ void done(const Unit&) const {}
};

__device__ __forceinline__ unsigned cvt_pk_bf16(float lo, float hi) { unsigned r; asm volatile("v_cvt_pk_bf16_f32 %0, %1, %2" : "=v"(r) : "v"(lo), "v"(hi)); return r; }
typedef float f32x2 __attribute__((ext_vector_type(2)));
__device__ __forceinline__ f32x2 gelu_pk(f32x2 v) {
    const f32x2 av = __builtin_elementwise_abs(v), d = av * 0.2316418882f + 1.0f;
    f32x2 t; t.x = __builtin_amdgcn_rcpf(d.x); t.y = __builtin_amdgcn_rcpf(d.y);
    f32x2 q = t * 0.5307027145f + (-0.7265760135f); q = q * t + 0.7107068705f; q = q * t + (-0.142248368f); q = q * t + 0.127414796f; q = q * t;
    const f32x2 s = (v * v) * (-0.72134752044f);
    f32x2 e; e.x = __builtin_amdgcn_exp2f(s.x); e.y = __builtin_amdgcn_exp2f(s.y);
    const f32x2 m = v * (q * e), r = v - m;
    f32x2 o; o.x = v.x < 0.f ? m.x : r.x; o.y = v.y < 0.f ? m.y : r.y; return o;
}

template <int ACT  > struct EpiBf16 {
    static constexpr bool PERM = true, AFTER_DRAIN = false; static_assert(ACT == 0 || ACT == 1, "EpiBf16: ACT is 0 (none) or 1 (gelu_pk)");
    bf16_t* O; int ldc; const float* bias; int split_cols; size_t split_stride; float scale0;
    __device__ __forceinline__ void operator()(const f32x4 (&acc)[2][2][4][2], const Unit& u, int wr, int wc, int fr, int fq) const {
        const int row0 = u.pm * BM + wr * 64 + fr; int colt = u.pn * BM; bf16_t* base = O;
        float sc = 1.f; if (split_cols) { const int t = colt / split_cols; base += (size_t)t * split_stride; colt -= t * split_cols; if (t == 0) sc = scale0; }
        const int col0 = colt + wc * 32 + 8 * fq, bcol0 = u.pn * BM + wc * 32 + 8 * fq;
        f32x4 bv[2][2];
#pragma unroll
        for (int bj = 0; bj < 2; ++bj)
#pragma unroll
            for (int n = 0; n < 2; ++n) bv[bj][n] = bias ? *(const f32x4*)(bias + bcol0 + bj * HALF + 4 * n) : (f32x4){0.f, 0.f, 0.f, 0.f};
#pragma unroll
        for (int ai = 0; ai < 2; ++ai)
#pragma unroll
            for (int m = 0; m < 4; ++m) { bf16_t* rowp = base + (size_t)(row0 + ai * HALF + m * 16) * ldc + col0;
#pragma unroll
                for (int bj = 0; bj < 2; ++bj) { f32x4 v0 = acc[ai][bj][m][0] + bv[bj][0], v1 = acc[ai][bj][m][1] + bv[bj][1];
                    if (ACT == 1) { f32x2 a = gelu_pk((f32x2){v0[0], v0[1]}), b = gelu_pk((f32x2){v0[2], v0[3]}), c = gelu_pk((f32x2){v1[0], v1[1]}), d = gelu_pk((f32x2){v1[2], v1[3]});
                        v0 = (f32x4){a.x, a.y, b.x, b.y}; v1 = (f32x4){c.x, c.y, d.x, d.y}; }
                    v0 = v0 * sc; v1 = v1 * sc; u32x4 w; w.x = cvt_pk_bf16(v0[0], v0[1]); w.y = cvt_pk_bf16(v0[2], v0[3]); w.z = cvt_pk_bf16(v1[0], v1[1]); w.w = cvt_pk_bf16(v1[2], v1[3]);
                    *(u32x4*)(rowp + bj * HALF) = w; } }
    }
};
__device__ __forceinline__ float bf2f(unsigned short h) { return __uint_as_float(((unsigned)h) << 16); }
#define WT_RSRC(base, bytes) __builtin_amdgcn_make_buffer_rsrc((void*)(base), 0, (int)(bytes), 0x00020000)
#define WT_ST16(rsrc, byteoff, v) __builtin_amdgcn_raw_buffer_store_b128((v), (rsrc), (unsigned)(byteoff), 0, 16)
__device__ __forceinline__ float sigm(float v) { return __builtin_amdgcn_rcpf(1.0f + __builtin_amdgcn_exp2f(-1.4426950408889634f * v)); }
struct EpiInProj {
    static constexpr bool PERM = true, AFTER_DRAIN = false;
    bf16_t* O; const float* rope; float qscale; const float* rowss; unsigned* sucnt;
    __device__ __forceinline__ void operator()(const f32x4 (&acc)[2][2][4][2], const Unit& u, int wr, int wc, int fr, int fq) const {
        const int row0 = u.pm * BM + wr * 64 + fr, col0 = u.pn * BM + wc * 32 + 8 * fq;
        const bool ropewave = (u.pn >= 6 && u.pn < 10) && ((wc & 1) == 0);
        const float sc = (u.pn == 6 || u.pn == 7) ? qscale : 1.f;
        const float sgn = (fq == 0) ? -1.f : 1.f;
        const bool pub = (u.pn == 4);
        const __amdgpu_buffer_rsrc_t orsrc = WT_RSRC(O, 16384u * 3584u * 2u);
#pragma unroll
        for (int ai = 0; ai < 2; ++ai)
#pragma unroll
            for (int m = 0; m < 4; ++m) {
                const int row = row0 + ai * HALF + m * 16;
                bf16_t* rowp = O + (size_t)row * 3584 + col0;
                const float scr = rowss ? sc * __builtin_amdgcn_rsqf(rowss[row] * (1.0f / 1024.0f) + 1e-6f) : sc;
                f32x4 cs[4];
                if (ropewave) { const float* rp = rope + (size_t)(row & 8191) * 16;
#pragma unroll
                    for (int k = 0; k < 4; ++k) cs[k] = *(const f32x4*)(rp + 4 * k); }
#pragma unroll
                for (int bj = 0; bj < 2; ++bj) {
                    f32x4 v0 = acc[ai][bj][m][0], v1 = acc[ai][bj][m][1];
                    if (ropewave) {
                        float v[8] = {v0[0], v0[1], v0[2], v0[3], v1[0], v1[1], v1[2], v1[3]};
#pragma unroll
                        for (int j = 0; j < 8; ++j) {
                            const float p = __shfl_xor(v[j], 16);
                            const float c = cs[j >> 1][(j & 1) * 2], s = cs[j >> 1][(j & 1) * 2 + 1];
                            const float nv = v[j] * c + sgn * p * s;
                            v[j] = (fq < 2) ? nv : v[j];
                        }
                        v0 = (f32x4){v[0], v[1], v[2], v[3]}; v1 = (f32x4){v[4], v[5], v[6], v[7]};
                    }
                    v0 = v0 * scr; v1 = v1 * scr;
                    u32x4 w; w.x = cvt_pk_bf16(v0[0], v0[1]); w.y = cvt_pk_bf16(v0[2], v0[3]); w.z = cvt_pk_bf16(v1[0], v1[1]); w.w = cvt_pk_bf16(v1[2], v1[3]);
                    if (pub) WT_ST16(orsrc, ((size_t)row * 3584 + col0 + bj * HALF) * 2, w); else *(u32x4*)(rowp + bj * HALF) = w;
                }
                asm volatile("" ::: "memory");
            }
        if (pub) { asm volatile("s_waitcnt vmcnt(0)" ::: "memory"); if (fr == 0 && fq == 0) (void)__hip_atomic_fetch_add(sucnt, 1u, __ATOMIC_RELAXED, __HIP_MEMORY_SCOPE_AGENT); }
    }
};
template <bool NEXT> struct EpiRes {
    static constexpr bool PERM = false, AFTER_DRAIN = false;
    const float* base; float* out; float* rowss; const bf16_t* baseh; bf16_t* XN;
    __device__ __forceinline__ void operator()(const f32x4 (&acc)[2][2][4][2], const Unit& u, int wr, int wc, int fr, int fq) const {
        typedef unsigned u32x2 __attribute__((ext_vector_type(2)));
        const int col0 = u.pn * BM + wc * 32 + 4 * fq;
#pragma unroll
        for (int ai = 0; ai < 2; ++ai)
#pragma unroll
            for (int m = 0; m < 4; ++m) {
                const int row = u.pm * BM + ai * HALF + wr * 64 + m * 16 + fr;
                const size_t off = (size_t)row * 1024 + col0;
                float ss = 0.f;
#pragma unroll
                for (int bj = 0; bj < 2; ++bj)
#pragma unroll
                    for (int n = 0; n < 2; ++n) {
                        f32x4 bs;
                        { const u32x2 hb = *(const u32x2*)(baseh + off + bj * HALF + n * 16); bs = (f32x4){__uint_as_float(hb.x << 16), __uint_as_float(hb.x & 0xffff0000u), __uint_as_float(hb.y << 16), __uint_as_float(hb.y & 0xffff0000u)}; }
                        const f32x4 o = bs + acc[ai][bj][m][n];
                        if (NEXT) { ss += (o[0] * o[0] + o[1] * o[1]) + (o[2] * o[2] + o[3] * o[3]);
                            u32x2 w; w.x = cvt_pk_bf16(o[0], o[1]); w.y = cvt_pk_bf16(o[2], o[3]); *(u32x2*)(XN + off + bj * HALF + n * 16) = w; }
                        else *(f32x4*)(out + off + bj * HALF + n * 16) = o;
                    }
                if (NEXT) { ss += __shfl_xor(ss, 16); ss += __shfl_xor(ss, 32); if (fq == 0) atomicAdd(rowss + row, ss); }
                if (m & 1) asm volatile("" ::: "memory");
            }
    }
};
struct EpiResFinal {
    static constexpr bool PERM = false, AFTER_DRAIN = true;
    const bf16_t* baseh; float* out; float* rowss2; unsigned* cnt; const float* fw;
    __device__ __forceinline__ void operator()(const f32x4 (&)[2][2][4][2], const Unit&, int, int, int, int) const {}
    __device__ __forceinline__ void fused(f32x4 (&acc)[2][2][4][2], const Unit& u, int wr, int wc, int fr, int fq, PG8_LAS unsigned char*, int wid, int lane) const {
        typedef unsigned u32x2 __attribute__((ext_vector_type(2)));
        const int col0 = u.pn * BM + wc * 32 + 4 * fq;
#pragma unroll
        for (int ai = 0; ai < 2; ++ai)
#pragma unroll
            for (int m = 0; m < 4; ++m) {
                const int row = u.pm * BM + ai * HALF + wr * 64 + m * 16 + fr;
                const size_t off = (size_t)row * 1024 + col0;
                float ss = 0.f;
#pragma unroll
                for (int bj = 0; bj < 2; ++bj)
#pragma unroll
                    for (int n = 0; n < 2; ++n) { const u32x2 hb = *(const u32x2*)(baseh + off + bj * HALF + n * 16);
                        const f32x4 o = (f32x4){__uint_as_float(hb.x << 16), __uint_as_float(hb.x & 0xffff0000u), __uint_as_float(hb.y << 16), __uint_as_float(hb.y & 0xffff0000u)} + acc[ai][bj][m][n]; acc[ai][bj][m][n] = o;
                        ss += (o[0] * o[0] + o[1] * o[1]) + (o[2] * o[2] + o[3] * o[3]); }
                ss += __shfl_xor(ss, 16); ss += __shfl_xor(ss, 32);
                if (fq == 0) (void)__hip_atomic_fetch_add(rowss2 + row, ss, __ATOMIC_RELAXED, __HIP_MEMORY_SCOPE_AGENT);
                if (m & 1) asm volatile("" ::: "memory");
            }
        asm volatile("s_waitcnt vmcnt(0)" ::: "memory");
        __builtin_amdgcn_s_barrier(); asm volatile("" ::: "memory");
        if (wid == 0) {
            if (lane == 0) (void)__hip_atomic_fetch_add(cnt + u.pm, 1u, __ATOMIC_RELAXED, __HIP_MEMORY_SCOPE_AGENT);
            unsigned spins = 0;
            while ((unsigned)__builtin_amdgcn_readfirstlane(__hip_atomic_load(cnt + u.pm, __ATOMIC_RELAXED, __HIP_MEMORY_SCOPE_AGENT)) < 4u) { __builtin_amdgcn_s_sleep(4); if (++spins > (1u << 20)) break; }
            __builtin_amdgcn_fence(__ATOMIC_ACQUIRE, "agent");
            asm volatile("s_waitcnt vmcnt(0)" ::: "memory");
        }
        __builtin_amdgcn_s_barrier(); asm volatile("" ::: "memory");
        f32x4 wv[2][2];
#pragma unroll
        for (int bj = 0; bj < 2; ++bj)
#pragma unroll
            for (int n = 0; n < 2; ++n) wv[bj][n] = *(const f32x4*)(fw + col0 + bj * HALF + n * 16);
#pragma unroll
        for (int ai = 0; ai < 2; ++ai)
#pragma unroll
            for (int m = 0; m < 4; ++m) {
                const int row = u.pm * BM + ai * HALF + wr * 64 + m * 16 + fr;
                const size_t off = (size_t)row * 1024 + col0;
                const float rs = __builtin_amdgcn_rsqf(__hip_atomic_load(rowss2 + row, __ATOMIC_RELAXED, __HIP_MEMORY_SCOPE_AGENT) * (1.0f / 1024.0f) + 1e-6f);
#pragma unroll
                for (int bj = 0; bj < 2; ++bj)
#pragma unroll
                    for (int n = 0; n < 2; ++n) *(f32x4*)(out + off + bj * HALF + n * 16) = acc[ai][bj][m][n] * rs * wv[bj][n];
            }
    }
};
struct EpiGlu {
    static constexpr bool PERM = true, AFTER_DRAIN = false;
    const bf16_t* YGS; const float* bias; bf16_t* MIX;
    __device__ __forceinline__ void operator()(const f32x4 (&acc)[2][2][4][2], const Unit& u, int wr, int wc, int fr, int fq) const {
        typedef unsigned u32x2 __attribute__((ext_vector_type(2)));
        const int row0 = u.pm * BM + wr * 64 + fr, col0 = wc * 32 + 8 * fq;
#pragma unroll
        for (int bj = 0; bj < 2; ++bj)
#pragma unroll
            for (int n = 0; n < 2; ++n) {
                const int c = col0 + bj * HALF + 4 * n;
                const f32x4 bv = *(const f32x4*)(bias + c);
#pragma unroll
                for (int ai = 0; ai < 2; ++ai)
#pragma unroll
                    for (int m = 0; m < 4; ++m) {
                        const size_t row = (size_t)(row0 + ai * HALF + m * 16);
                        const f32x4 v = acc[ai][bj][m][n] + bv;
                        const u32x2 yv = *(const u32x2*)(YGS + row * 256 + c);
                        const float y0 = __uint_as_float(yv.x << 16), y1 = __uint_as_float(yv.x & 0xffff0000u), y2 = __uint_as_float(yv.y << 16), y3 = __uint_as_float(yv.y & 0xffff0000u);
                        u32x2 w; w.x = cvt_pk_bf16(y0 * sigm(v[0]), y1 * sigm(v[1])); w.y = cvt_pk_bf16(y2 * sigm(v[2]), y3 * sigm(v[3]));
                        *(u32x2*)(MIX + row * 1024 + 256 + c) = w;
                        if (m & 1) asm volatile("" ::: "memory");
                    }
            }
    }
};
template <class Epi, class Sched, bool ALIGN_EPI = false, bool SP2 = false>
__device__ __forceinline__ void gemm_phase(PG8_LAS unsigned char* lds, const Gemm g, const Sched& S, const Epi& E) {
    int tid_l = threadIdx.x; asm volatile("" : "+v"(tid_l));
    const int tid = tid_l, wid = __builtin_amdgcn_readfirstlane(tid >> 6), lane = tid & 63, wr = wid >> 2, wc = wid & 3, fr = lane & 15, fq = lane >> 4;
    const int K = g.K, nt = K / BK;
    unsigned voffA[2], voffB[2];
#pragma unroll
    for (int i = 0; i < 2; ++i) { int R, C; stage_rc(tid * 16 + i * 8192, R, C); const int Rb = Epi::PERM ? ((R & ~31) + perm32(R & 31)) : R;
        voffA[i] = (unsigned)(R * K + C) * 2u; voffB[i] = (unsigned)(Rb * K + C) * 2u; }
    const size_t kstep = (size_t)(BK * 2);
    const size_t hstep = (size_t)HALF * K * 2;
    const size_t tstep = 2 * hstep;
    const unsigned ldsw = (unsigned)wid * 1024u;
    const int aoff = lds_byte(wr * 64 + fr, fq * 8), boff = lds_byte(wc * 32 + fr, fq * 8);
#define PG8_SA(b, h) (((b) * 2 + (h)) * HTB)
#define PG8_SB(b, h) ((4 + (b) * 2 + (h)) * HTB)
#define PG8_STAGE(bufoff, gbase, voff) do { _Pragma("unroll") for (int _i = 0; _i < 2; ++_i) \
        __builtin_amdgcn_global_load_lds((const unsigned*)((const char*)(gbase) + (voff)[_i]), (PG8_LAS unsigned*)(lds + (bufoff) + ldsw + _i * 8192), 16, 0, 0); } while (0)
#define PG8_LDA(dst, b, h) do { _Pragma("unroll") for (int m = 0; m < 4; ++m) _Pragma("unroll") for (int k = 0; k < 2; ++k) dst[m][k] = *(const PG8_LAS bf16x8*)(lds + PG8_SA(b, h) + aoff + m * 2048 + k * 1024); } while (0)
#define PG8_LDB(dst, b, h) do { _Pragma("unroll") for (int n = 0; n < 2; ++n) _Pragma("unroll") for (int k = 0; k < 2; ++k) dst[n][k] = *(const PG8_LAS bf16x8*)(lds + PG8_SB(b, h) + boff + n * 2048 + k * 1024); } while (0)
#define PG8_MMA(ai, bj, At, Bt) do { __builtin_amdgcn_s_setprio(1); _Pragma("unroll") for (int m = 0; m < 4; ++m) _Pragma("unroll") for (int n = 0; n < 2; ++n) _Pragma("unroll") for (int k = 0; k < 2; ++k) \
        acc[ai][bj][m][n] = __builtin_amdgcn_mfma_f32_16x16x32_bf16(Bt[n][k], At[m][k], acc[ai][bj][m][n], 0, 0, 0); __builtin_amdgcn_s_setprio(0); } while (0)
#define PG8_WAIT_V(n) asm volatile("s_waitcnt vmcnt(" #n ")" ::: "memory")
#define PG8_WAIT_L(n) asm volatile("s_waitcnt lgkmcnt(" #n ")" ::: "memory")
#define PG8_BAR __builtin_amdgcn_s_barrier()
#define PG8_SCHED __builtin_amdgcn_sched_barrier(0)
    Unit cur, nxt; int ui = 0;
    if (!S.next(0, cur)) return;
    f32x4 acc[2][2][4][2];
#pragma unroll
    for (int a = 0; a < 2; ++a)
#pragma unroll
        for (int b = 0; b < 2; ++b)
#pragma unroll
            for (int m = 0; m < 4; ++m)
#pragma unroll
                for (int n = 0; n < 2; ++n) acc[a][b][m][n] = (f32x4){0.f, 0.f, 0.f, 0.f};
    bf16x8 At[4][2], B0[2][2], B1[2][2];
    const char* cA = (const char*)g.A + (size_t)cur.pm * tstep; const char* cB = (const char*)g.Bt + (size_t)cur.pn * tstep;
    S.a_ready(cur);
    if constexpr (SP2) {
        PG8_STAGE(PG8_SB(0, 0), cB, voffB); PG8_STAGE(PG8_SB(0, 1), cB + hstep, voffB); PG8_STAGE(PG8_SA(0, 0), cA, voffA); PG8_STAGE(PG8_SA(0, 1), cA + hstep, voffA);
        if (wr == 1) PG8_BAR;
        PG8_WAIT_V(2); PG8_BAR;
        PG8_STAGE(PG8_SB(1, 0), cB + kstep, voffB); PG8_STAGE(PG8_SA(1, 0), cA + kstep, voffA); PG8_STAGE(PG8_SB(1, 1), cB + hstep + kstep, voffB);
        PG8_WAIT_V(6); PG8_BAR;
    } else {
        PG8_STAGE(PG8_SB(0, 0), cB, voffB); PG8_STAGE(PG8_SA(0, 0), cA, voffA); PG8_STAGE(PG8_SB(0, 1), cB + hstep, voffB); PG8_STAGE(PG8_SA(0, 1), cA + hstep, voffA);
        if (wr == 1) PG8_BAR;
        PG8_WAIT_V(4); PG8_BAR;
        PG8_STAGE(PG8_SB(1, 0), cB + kstep, voffB); PG8_STAGE(PG8_SA(1, 0), cA + kstep, voffA); PG8_STAGE(PG8_SB(1, 1), cB + hstep + kstep, voffB);
        PG8_WAIT_V(6); PG8_BAR;
    }
    for (;;) {
        const bool has_next = S.next(ui + 1, nxt);
        const char* nA = has_next ? (const char*)g.A + (size_t)nxt.pm * tstep : cA; const char* nB = has_next ? (const char*)g.Bt + (size_t)nxt.pn * tstep : cB;
        for (int t = 0; t < nt; t += 2) {
            const bool last = (t == nt - 2);
            const char* a1 = cA + (size_t)(t + 1) * kstep;
            const char* a2 = last ? nA : cA + (size_t)(t + 2) * kstep; const char* b2 = last ? nB : cB + (size_t)(t + 2) * kstep;
            const char* a3 = a2 + kstep; const char* b3 = b2 + kstep;
            if (last && has_next) S.a_ready(nxt);
            if constexpr (SP2) {
            PG8_LDB(B0, 0, 0); PG8_LDB(B1, 0, 1); PG8_SCHED; PG8_LDA(At, 0, 0); PG8_STAGE(PG8_SA(1, 1), a1 + hstep, voffA);
            PG8_WAIT_V(8); PG8_WAIT_L(0); PG8_BAR; PG8_MMA(0, 0, At, B0); PG8_MMA(0, 1, At, B1); PG8_BAR; PG8_SCHED;
            PG8_LDA(At, 0, 1); PG8_STAGE(PG8_SB(0, 0), b2, voffB); PG8_STAGE(PG8_SB(0, 1), b2 + hstep, voffB); PG8_STAGE(PG8_SA(0, 0), a2, voffA);
            PG8_WAIT_V(8); PG8_WAIT_L(0); PG8_BAR; PG8_MMA(1, 0, At, B0); PG8_MMA(1, 1, At, B1); PG8_BAR; PG8_SCHED;
            PG8_LDB(B0, 1, 0); PG8_LDB(B1, 1, 1); PG8_SCHED; PG8_LDA(At, 1, 0); PG8_STAGE(PG8_SA(0, 1), a2 + hstep, voffA);
            PG8_WAIT_V(8); PG8_WAIT_L(0); PG8_BAR; PG8_MMA(0, 0, At, B0); PG8_MMA(0, 1, At, B1); PG8_BAR; PG8_SCHED;
            PG8_LDA(At, 1, 1); PG8_STAGE(PG8_SB(1, 0), b3, voffB); PG8_STAGE(PG8_SB(1, 1), b3 + hstep, voffB); PG8_STAGE(PG8_SA(1, 0), a3, voffA);
            PG8_WAIT_V(8); PG8_WAIT_L(0); PG8_BAR; PG8_MMA(1, 0, At, B0); PG8_MMA(1, 1, At, B1); PG8_BAR; PG8_SCHED;
            } else {
            PG8_LDB(B0, 0, 0); PG8_SCHED; PG8_LDA(At, 0, 0); PG8_STAGE(PG8_SA(1, 1), a1 + hstep, voffA);
            PG8_WAIT_L(8); PG8_BAR; PG8_WAIT_L(0); PG8_MMA(0, 0, At, B0); PG8_BAR; PG8_SCHED;
            PG8_LDB(B1, 0, 1); PG8_STAGE(PG8_SB(0, 0), b2, voffB);
            PG8_BAR; PG8_WAIT_L(0); PG8_MMA(0, 1, At, B1); PG8_BAR;
            PG8_LDA(At, 0, 1); PG8_STAGE(PG8_SA(0, 0), a2, voffA);
            PG8_BAR; PG8_WAIT_L(0); PG8_MMA(1, 0, At, B0); PG8_BAR; PG8_SCHED;
            PG8_STAGE(PG8_SB(0, 1), b2 + hstep, voffB);
            PG8_WAIT_V(6); PG8_BAR; PG8_MMA(1, 1, At, B1); PG8_BAR;
            PG8_LDB(B0, 1, 0); PG8_SCHED; PG8_LDA(At, 1, 0); PG8_STAGE(PG8_SA(0, 1), a2 + hstep, voffA);
            PG8_WAIT_L(8); PG8_BAR; PG8_WAIT_L(0); PG8_MMA(0, 0, At, B0); PG8_BAR; PG8_SCHED;
            PG8_LDB(B1, 1, 1); PG8_STAGE(PG8_SB(1, 0), b3, voffB);
            PG8_BAR; PG8_WAIT_L(0); PG8_MMA(0, 1, At, B1); PG8_BAR;
            PG8_LDA(At, 1, 1); PG8_STAGE(PG8_SA(1, 0), a3, voffA);
            PG8_BAR; PG8_WAIT_L(0); PG8_MMA(1, 0, At, B0); PG8_BAR; PG8_SCHED;
            PG8_STAGE(PG8_SB(1, 1), b3 + hstep, voffB);
            PG8_WAIT_V(6); PG8_BAR; PG8_MMA(1, 1, At, B1); PG8_BAR;
            }
        }
        if constexpr (ALIGN_EPI) { if (wr == 0) PG8_BAR; }
        if constexpr (!Epi::AFTER_DRAIN) { E(acc, cur, wr, wc, fr, fq); S.done(cur); }
        if (!has_next) break;
#pragma unroll
        for (int a = 0; a < 2; ++a)
#pragma unroll
            for (int b = 0; b < 2; ++b)
#pragma unroll
                for (int m = 0; m < 4; ++m)
#pragma unroll
                    for (int n = 0; n < 2; ++n) acc[a][b][m][n] = (f32x4){0.f, 0.f, 0.f, 0.f};
        cur = nxt; cA = nA; cB = nB; ++ui;
        if constexpr (ALIGN_EPI) { if (wr == 1) PG8_BAR; }
    }
    PG8_WAIT_V(0);
    if constexpr (!ALIGN_EPI) { if (wr == 0) PG8_BAR; }
    PG8_BAR;
    if constexpr (Epi::AFTER_DRAIN) { E.fused(acc, cur, wr, wc, fr, fq, lds, wid, lane); S.done(cur); }
#undef PG8_SA
#undef PG8_SB
#undef PG8_STAGE
#undef PG8_LDA
#undef PG8_LDB
#undef PG8_MMA
#undef PG8_WAIT_V
#undef PG8_WAIT_L
#undef PG8_BAR
#undef PG8_SCHED
}
}

#ifndef PG8_SP2
#define PG8_SP2 true
#endif
#ifndef PG8_ALIGN
#define PG8_ALIGN true
#endif
#include <hip/hip_bf16.h>
#include <cmath>
namespace attn_body {
using bf16=__hip_bfloat16;
using bf16x8=__attribute__((ext_vector_type(8)))short;
using s16x4=__attribute__((ext_vector_type(4)))short;
using f32x16=__attribute__((ext_vector_type(16)))float;
using u32x4=__attribute__((ext_vector_type(4)))unsigned;
constexpr int BATCH=2,NHEAD=16,SEQ=8192,D=64,DM=NHEAD*D;
constexpr int NW=8,QBLK=32,QB=QBLK*NW,KVBLK=64,NQB=SEQ/QB;
constexpr int ATTN_PITCH=DM, ATTN_UNIT_ROWS=QB;
constexpr int PQ=3584,QCOL=1536,KCOL=2048,VCOL=2560;
__device__ __forceinline__ int crow(int r,int hi){return (r&3)+8*(r>>2)+4*hi;}
#define SBAR() __builtin_amdgcn_sched_barrier(0)
__device__ __forceinline__ void cmask(f32x16&p0,f32x16&p1,int jb,int qrel,int hi){
  const float NEG=-INFINITY; int kb=64*jb+4*hi;
  #pragma unroll
  for(int r=0;r<16;++r){int kv=kb+(r&3)+8*(r>>2); if(kv>qrel)p0[r]=NEG; if(kv+32>qrel)p1[r]=NEG;}
}

constexpr int NSLOT=3, SLOTB=8192;
constexpr int LDS_K=0, LDS_V=NSLOT*SLOTB, LDS_WS=3*NSLOT*SLOTB, LDS_OST=LDS_WS+NW*64*4, LDS_BYTES=LDS_OST+NW*4096;
constexpr float C2=0.125f*1.4426950408889634f;
__device__ __forceinline__ void glds16(const void*gsrc,unsigned lds_dst){unsigned keep;
  asm volatile("s_mov_b32 %0, m0\n\ts_mov_b32 m0, %2\n\ts_nop 0\n\tglobal_load_lds_dwordx4 %1, off\n\ts_mov_b32 m0, %0":"=&s"(keep):"v"(gsrc),"s"(lds_dst):"memory");}
__device__ __forceinline__ float max3f(float a,float b,float c){float r;asm("v_max3_f32 %0, %1, %2, %3":"=v"(r):"v"(a),"v"(b),"v"(c));return r;}
__device__ __forceinline__ float max2f(float a,float b){float r;asm("v_max_f32_e32 %0, %1, %2":"=v"(r):"v"(a),"v"(b));return r;}
__device__ __forceinline__ float fadd_s(float a,float b){float r;asm("v_add_f32_e32 %0, %1, %2":"=v"(r):"v"(a),"v"(b));return r;}
__device__ __forceinline__ float fsub_s(float a,float b){float r;asm("v_sub_f32_e32 %0, %1, %2":"=v"(r):"v"(a),"v"(b));return r;}
typedef float f32x2_t __attribute__((ext_vector_type(2))); typedef __bf16 bf16x2_t __attribute__((ext_vector_type(2)));
__device__ __forceinline__ unsigned cvtpk_s(float lo,float hi){f32x2_t v={lo,hi};bf16x2_t b=__builtin_convertvector(v,bf16x2_t);return __builtin_bit_cast(unsigned,b);}
#define WAIT_BAR(N) asm volatile("s_waitcnt vmcnt(" #N ") lgkmcnt(0)\n\ts_barrier":::"memory")

__device__ __forceinline__ void qkt(f32x16&p0,f32x16&p1,const char*Kslot,const bf16x8*qr,const f32x16&negm,int r32,int hi){
  const char*kb=Kslot+hi*1024+r32*16;
  #pragma unroll
  for(int d0=0;d0<4;++d0){
    const bf16x8 b0=*reinterpret_cast<const bf16x8*>(kb+d0*2048);
    const bf16x8 b1=*reinterpret_cast<const bf16x8*>(kb+d0*2048+512);
    if(d0==0){p0=__builtin_amdgcn_mfma_f32_32x32x16_bf16(b0,qr[0],negm,0,0,0);p1=__builtin_amdgcn_mfma_f32_32x32x16_bf16(b1,qr[0],negm,0,0,0);}
    else{p0=__builtin_amdgcn_mfma_f32_32x32x16_bf16(b0,qr[d0],p0,0,0,0);p1=__builtin_amdgcn_mfma_f32_32x32x16_bf16(b1,qr[d0],p1,0,0,0);}}
}
typedef __attribute__((address_space(3))) const char* lds_cptr;
typedef short v4i16_t __attribute__((ext_vector_type(4)));
__device__ __forceinline__ void kload8(bf16x8*kf,lds_cptr kp){
  kf[0]=*(const __attribute__((address_space(3))) bf16x8*)(kp);      kf[1]=*(const __attribute__((address_space(3))) bf16x8*)(kp+512);
  kf[2]=*(const __attribute__((address_space(3))) bf16x8*)(kp+2048); kf[3]=*(const __attribute__((address_space(3))) bf16x8*)(kp+2560);
  kf[4]=*(const __attribute__((address_space(3))) bf16x8*)(kp+4096); kf[5]=*(const __attribute__((address_space(3))) bf16x8*)(kp+4608);
  kf[6]=*(const __attribute__((address_space(3))) bf16x8*)(kp+6144); kf[7]=*(const __attribute__((address_space(3))) bf16x8*)(kp+6656);
}
__device__ __forceinline__ void kload2(bf16x8*kf,lds_cptr kp,int j){ kf[2*j]=*(const __attribute__((address_space(3))) bf16x8*)(kp+j*2048); kf[2*j+1]=*(const __attribute__((address_space(3))) bf16x8*)(kp+j*2048+512); }
__device__ __forceinline__ s16x4 vtr(lds_cptr p){ return __builtin_bit_cast(s16x4,__builtin_amdgcn_ds_read_tr16_b64_v4i16((__attribute__((address_space(3))) v4i16_t*)p)); }
__device__ __forceinline__ float rowmax(const f32x16&p0,const f32x16&p1){
  float a=max3f(p0[0],p0[1],p1[0]),b=max3f(p0[2],p0[3],p1[1]);a=max3f(a,p1[2],p1[3]);
  #pragma unroll
  for(int r=4;r<16;r+=4){a=max3f(a,p0[r],p0[r+1]);b=max3f(b,p0[r+2],p0[r+3]);a=max3f(a,p1[r],p1[r+1]);b=max3f(b,p1[r+2],p1[r+3]);}
  const float m=max2f(a,b);
  auto rr=__builtin_amdgcn_permlane32_swap(__float_as_uint(m),__float_as_uint(m),false,false);
  return max2f(__uint_as_float(rr[0]),__uint_as_float(rr[1]));
}
__device__ __forceinline__ void pv(f32x16*o,int vb,bf16x8 pa0,bf16x8 pa1,bf16x8 pa2,bf16x8 pa3){
  #pragma unroll
  for(int d0=0;d0<2;++d0){s16x4 lo[4],hi[4];
    #pragma unroll
    for(int ks=0;ks<4;++ks){
      asm volatile("ds_read_b64_tr_b16 %0,%1 offset:%c2":"=&v"(lo[ks]):"v"(vb),"i"(d0*4096+ks*1024):"memory");
      asm volatile("ds_read_b64_tr_b16 %0,%1 offset:%c2":"=&v"(hi[ks]):"v"(vb),"i"(d0*4096+ks*1024+512):"memory");}
    asm volatile("s_waitcnt lgkmcnt(0)":::"memory");SBAR();
    #define PK(k) (bf16x8){lo[k][0],lo[k][1],lo[k][2],lo[k][3],hi[k][0],hi[k][1],hi[k][2],hi[k][3]}
    o[d0]=__builtin_amdgcn_mfma_f32_32x32x16_bf16(pa0,PK(0),o[d0],0,0,0);
    o[d0]=__builtin_amdgcn_mfma_f32_32x32x16_bf16(pa1,PK(1),o[d0],0,0,0);
    o[d0]=__builtin_amdgcn_mfma_f32_32x32x16_bf16(pa2,PK(2),o[d0],0,0,0);
    o[d0]=__builtin_amdgcn_mfma_f32_32x32x16_bf16(pa3,PK(3),o[d0],0,0,0);
    #undef PK
  }
}

#ifndef ATTN_STORE16
#define ATTN_STORE16(p,v) (*(u32x4*)(p)=(v))
#endif
template<int THRL> __device__ __forceinline__ void attn_unit(int b,int h,int qb,const bf16*Q,const bf16*__restrict__ K,const bf16*__restrict__ V,bf16*O,char*shm){
  int tid_l=threadIdx.x; asm volatile("":"+v"(tid_l)); const int tid=tid_l,lane=tid&63,r32=lane&31,hi=lane>>5; const int wid=__builtin_amdgcn_readfirstlane(tid>>6);
  const long rowbase=(long)b*SEQ; const int q0=qb*QB;
  const int hh_=h>>1,mm_=h&1; const bf16*Qw=Q+(rowbase+q0+wid*QBLK)*PQ+QCOL+hh_*128+mm_*64;
  const bf16*Kh=K+rowbase*PQ+KCOL+hh_*128+mm_*64,*Vh=V+rowbase*PQ+VCOL+hh_*128;
  const unsigned lds0=(unsigned)(uintptr_t)shm;
  float*wsf=(float*)(shm+LDS_WS)+wid*64;
  const bf16*ksrc=Kh+(long)lane*PQ+wid*8;
  const bf16*vsrc=Vh+(long)(16*(wid&3)+(lane>>2))*PQ+(wid>>2)*32+(lane&3)*8;
  const unsigned kdst=lds0+LDS_K+wid*1024, vdst=lds0+LDS_V+wid*1024;
  #define DMA_K(t,slot) glds16(ksrc+(long)(t)*KVBLK*PQ,(unsigned)__builtin_amdgcn_readfirstlane(kdst+(slot)))
  #define DMA_V(t,slot) do{ glds16(vsrc+(long)(t)*KVBLK*PQ,(unsigned)__builtin_amdgcn_readfirstlane(vdst+2*(slot))); glds16(vsrc+(long)(t)*KVBLK*PQ+64,(unsigned)__builtin_amdgcn_readfirstlane(vdst+2*(slot)+8192)); }while(0)
  const int vb0=(int)(lds0+LDS_V)+((lane>>4)&1)*32+(lane&3)*8+(4*hi+((lane&15)>>2))*64;
  const char*Kbase=shm+LDS_K; bf16x8 kf[8];
  const lds_cptr shm3=(lds_cptr)shm; const lds_cptr kp0=shm3+LDS_K+hi*1024+r32*16; const lds_cptr vp0=shm3+LDS_V+((lane>>4)&1)*32+(lane&3)*8+(4*hi+((lane&15)>>2))*64;
  const int NT=(q0+QB)/KVBLK;
  DMA_K(0,0);DMA_V(0,0);DMA_K(1,SLOTB);
  bf16x8 qr[4];
  #pragma unroll
  for(int d0=0;d0<4;++d0)qr[d0]=*reinterpret_cast<const bf16x8*>(&Qw[(long)r32*PQ+d0*16+hi*8]);
  float mhat=0.f,l_reg=0.f;f32x16 o[4];o[0]=f32x16{};o[1]=f32x16{};o[2]=f32x16{};o[3]=f32x16{};f32x16 negm=f32x16{};asm volatile("":"+v"(negm));
  const int qrel=wid*QBLK+r32;
  #define CMASK(P0,P1,t) do{int jb_=(t)-(NT-4); if(jb_>=0)cmask(P0,P1,jb_,qrel,hi);}while(0)
  bool resc=false;
  #define START(P0,P1) do{ const float rm=rowmax(P0,P1); resc=false; \
    { const float dl=rm; mhat=fadd_s(mhat,dl); \
      _Pragma("unroll") for(int r=0;r<16;++r){P0[r]=fsub_s(P0[r],dl);P1[r]=fsub_s(P1[r],dl);} \
      _Pragma("unroll") for(int r=0;r<16;++r)negm[r]=-mhat; asm volatile("":"+v"(negm)); } \
    _Pragma("unroll") for(int r=0;r<16;++r)P0[r]=__builtin_amdgcn_exp2f(P0[r]); }while(0)
  #define RESC() do{ if(resc){ asm volatile("s_waitcnt lgkmcnt(0)":::"memory"); \
      _Pragma("unroll") for(int d_=0;d_<4;++d_) _Pragma("unroll") for(int r=0;r<16;++r)o[d_][r]*=wsf[crow(r,hi)]; } }while(0)
  f32x16 pA0,pA1,pB0,pB1;
  int sl_prev=0,sl_cur=0,sl_next=SLOTB;
  #define ROT() do{sl_prev=sl_cur;sl_cur=sl_next;sl_next=(sl_next==(NSLOT-1)*SLOTB)?0:sl_next+SLOTB;}while(0)
  DMA_K(2,2*SLOTB);
  WAIT_BAR(3);
  qkt(pA0,pA1,Kbase,qr,negm,r32,hi);asm volatile("s_nop 15\n\ts_nop 7":"+v"(pA0),"+v"(pA1));CMASK(pA0,pA1,0);
  START(pA0,pA1);
  _Pragma("unroll") for(int r=0;r<16;++r)pA1[r]=__builtin_amdgcn_exp2f(pA1[r]);
  WAIT_BAR(0);
  DMA_K(3,0);DMA_V(1,SLOTB);
  ROT();
  kload8(kf,kp0+sl_cur);
  WAIT_BAR(3);
  s16x4 vlo[8],vhi[8],wlo[8],whi[8]; u32x4 pw0,pw1,pw2,pw3;
  #define PKW(P,B) cvtpk_s(P[B],P[B+1])
  #define PAF(k) __builtin_bit_cast(bf16x8,pw##k)
  #define VFR(i) (bf16x8){vlo[i][0],vlo[i][1],vlo[i][2],vlo[i][3],vhi[i][0],vhi[i][1],vhi[i][2],vhi[i][3]}
  #define PIN(x) asm volatile("":"+v"(x))
  #define MX3(a,b,c) __builtin_fmaxf(__builtin_fmaxf((a),(b)),(c))
  #define GAPA(MF,A0,A1,A2,A3,W0,W1,PW) do{ MF; sacc+=A0; sacc+=A1; sacc+=A2; sacc+=A3; PIN(sacc); W0; W1; PIN(PW); SBAR(); }while(0)
  #define EX(v) __builtin_amdgcn_exp2f(v)
  #define GAPB(MF,X,B) do{ MF; X[B]=EX(X[B]); X[B+1]=EX(X[B+1]); PIN(X); SBAR(); }while(0)
  #define VRD(i) do{ vlo[i]=vtr(vp_+(((i)>>2)*4096+((i)&3)*1024)); vhi[i]=vtr(vp_+(((i)>>2)*4096+((i)&3)*1024+512)); }while(0)
  #define VRD2(i) do{ wlo[i]=vtr(vp_+(8192+((i)>>2)*4096+((i)&3)*1024)); whi[i]=vtr(vp_+(8192+((i)>>2)*4096+((i)&3)*1024+512)); SBAR(); }while(0)
  #define WFR(i) (bf16x8){wlo[i][0],wlo[i][1],wlo[i][2],wlo[i][3],whi[i][0],whi[i][1],whi[i][2],whi[i][3]}
  #define GAPC(MF,X,B) do{ MF; X[B]=EX(X[B]); X[B+1]=EX(X[B+1]); PIN(X); SBAR(); }while(0)
  #define KRD(G,j) do{ if(G){ kload2(kf,kp0+sl_next,j); SBAR(); } }while(0)
  #define STEP(C0,C1,P0,P1,t,GK,GV,GL) do{ SBAR(); \
    const lds_cptr vp_=vp0+2*sl_prev; \
    VRD(0); SBAR(); float sacc=(P0[0]+P0[1]); \
    GAPA(C0=__builtin_amdgcn_mfma_f32_32x32x16_bf16(kf[0],qr[0],negm,0,0,0), P0[2],P0[3],P0[4],P0[5],     pw0[0]=PKW(P0,0), pw0[1]=PKW(P0,2), pw0); \
    VRD(4); SBAR(); GAPA(C1=__builtin_amdgcn_mfma_f32_32x32x16_bf16(kf[1],qr[0],negm,0,0,0), P0[6],P0[7],P0[8],P0[9],     pw0[2]=PKW(P0,4), pw0[3]=PKW(P0,6), pw0); \
    VRD(1); SBAR(); GAPA(C0=__builtin_amdgcn_mfma_f32_32x32x16_bf16(kf[2],qr[1],C0,0,0,0),   P0[10],P0[11],P0[12],P0[13], pw1[0]=PKW(P0,8), pw1[1]=PKW(P0,10), pw1); \
    VRD(5); SBAR(); GAPA(C1=__builtin_amdgcn_mfma_f32_32x32x16_bf16(kf[3],qr[1],C1,0,0,0),   P0[14],P0[15],P1[0],P1[1],   pw1[2]=PKW(P0,12),pw1[3]=PKW(P0,14), pw1); \
    VRD(2); SBAR(); GAPA(C0=__builtin_amdgcn_mfma_f32_32x32x16_bf16(kf[4],qr[2],C0,0,0,0),   P1[2],P1[3],P1[4],P1[5],     pw2[0]=PKW(P1,0), pw2[1]=PKW(P1,2), pw2); \
    VRD(6); SBAR(); GAPA(C1=__builtin_amdgcn_mfma_f32_32x32x16_bf16(kf[5],qr[2],C1,0,0,0),   P1[6],P1[7],P1[8],P1[9],     pw2[2]=PKW(P1,4), pw2[3]=PKW(P1,6), pw2); \
    VRD(3); SBAR(); GAPA(C0=__builtin_amdgcn_mfma_f32_32x32x16_bf16(kf[6],qr[3],C0,0,0,0),   P1[10],P1[11],P1[12],P1[13], pw3[0]=PKW(P1,8), pw3[1]=PKW(P1,10), pw3); \
    VRD(7); SBAR(); GAPA(C1=__builtin_amdgcn_mfma_f32_32x32x16_bf16(kf[7],qr[3],C1,0,0,0),   P1[14],P1[15],0.f,0.f,       pw3[2]=PKW(P1,12),pw3[3]=PKW(P1,14), pw3); \
    l_reg+=sacc; \
    if(GK){DMA_K((t)+3,sl_cur);} if(GV){DMA_V((t)+1,sl_next);} \
    CMASK(C0,C1,t); \
    { float a=MX3(C0[0],C0[1],C1[0]),b=MX3(C0[2],C0[3],C1[1]); a=MX3(a,C1[2],C1[3]); \
      _Pragma("unroll") for(int r=4;r<16;r+=4){a=MX3(a,C0[r],C0[r+1]);b=MX3(b,C0[r+2],C0[r+3]);a=MX3(a,C1[r],C1[r+1]);b=MX3(b,C1[r+2],C1[r+3]);} \
      float rm=__builtin_fmaxf(a,b); { auto rr=__builtin_amdgcn_permlane32_swap(__float_as_uint(rm),__float_as_uint(rm),false,false); rm=__builtin_fmaxf(__uint_as_float(rr[0]),__uint_as_float(rr[1])); } \
      resc=false; \
      if(__builtin_expect(__any(rm>(float)THRL),0)){ const float dl=__builtin_fmaxf(rm,0.f); mhat+=dl; \
        _Pragma("unroll") for(int r=0;r<16;++r){C0[r]-=dl;C1[r]-=dl;} \
        _Pragma("unroll") for(int r=0;r<16;++r)negm[r]=-mhat; asm volatile("":"+v"(negm)); \
        const float f=__builtin_amdgcn_exp2f(-dl); l_reg*=f; if(hi==0)wsf[r32]=f; resc=true; } } \
    SBAR(); \
    GAPB(o[0]=__builtin_amdgcn_mfma_f32_32x32x16_bf16(PAF(0),VFR(0),o[0],0,0,0), C0,0); VRD2(0); \
    GAPB(o[1]=__builtin_amdgcn_mfma_f32_32x32x16_bf16(PAF(0),VFR(4),o[1],0,0,0), C0,2); VRD2(4); \
    KRD(GL,0); GAPB(o[0]=__builtin_amdgcn_mfma_f32_32x32x16_bf16(PAF(1),VFR(1),o[0],0,0,0), C0,4); VRD2(1); \
    KRD(GL,1); GAPB(o[1]=__builtin_amdgcn_mfma_f32_32x32x16_bf16(PAF(1),VFR(5),o[1],0,0,0), C0,6); VRD2(5); \
    KRD(GL,2); GAPB(o[0]=__builtin_amdgcn_mfma_f32_32x32x16_bf16(PAF(2),VFR(2),o[0],0,0,0), C0,8); VRD2(2); \
    KRD(GL,3); GAPB(o[1]=__builtin_amdgcn_mfma_f32_32x32x16_bf16(PAF(2),VFR(6),o[1],0,0,0), C0,10); VRD2(6); \
    GAPB(o[0]=__builtin_amdgcn_mfma_f32_32x32x16_bf16(PAF(3),VFR(3),o[0],0,0,0), C0,12); VRD2(3); \
    GAPB(o[1]=__builtin_amdgcn_mfma_f32_32x32x16_bf16(PAF(3),VFR(7),o[1],0,0,0), C0,14); VRD2(7); \
    GAPC(o[2]=__builtin_amdgcn_mfma_f32_32x32x16_bf16(PAF(0),WFR(0),o[2],0,0,0), C1,0); \
    GAPC(o[3]=__builtin_amdgcn_mfma_f32_32x32x16_bf16(PAF(0),WFR(4),o[3],0,0,0), C1,2); \
    GAPC(o[2]=__builtin_amdgcn_mfma_f32_32x32x16_bf16(PAF(1),WFR(1),o[2],0,0,0), C1,4); \
    GAPC(o[3]=__builtin_amdgcn_mfma_f32_32x32x16_bf16(PAF(1),WFR(5),o[3],0,0,0), C1,6); \
    GAPC(o[2]=__builtin_amdgcn_mfma_f32_32x32x16_bf16(PAF(2),WFR(2),o[2],0,0,0), C1,8); \
    GAPC(o[3]=__builtin_amdgcn_mfma_f32_32x32x16_bf16(PAF(2),WFR(6),o[3],0,0,0), C1,10); \
    GAPC(o[2]=__builtin_amdgcn_mfma_f32_32x32x16_bf16(PAF(3),WFR(3),o[2],0,0,0), C1,12); \
    GAPC(o[3]=__builtin_amdgcn_mfma_f32_32x32x16_bf16(PAF(3),WFR(7),o[3],0,0,0), C1,14); \
    }while(0)
  int t=1;
  #undef CMASK
  #define CMASK(P0,P1,t) do{}while(0)
  for(;t+5<NT;t+=2){
    STEP(pB0,pB1,pA0,pA1,t,true,true,true);     WAIT_BAR(3); RESC(); ROT();
    STEP(pA0,pA1,pB0,pB1,t+1,true,true,true);   WAIT_BAR(3); RESC(); ROT();
  }
  #undef CMASK
  #define CMASK(P0,P1,t) do{int jb_=(t)-(NT-4); if(jb_>=0)cmask(P0,P1,jb_,qrel,hi);}while(0)
  #define ENDW(tt) do{ if((tt)+3<NT){WAIT_BAR(3);} else if((tt)+2<NT){WAIT_BAR(2);} else {WAIT_BAR(0);} }while(0)
  for(;t+1<NT;t+=2){
    STEP(pB0,pB1,pA0,pA1,t,(t+3<NT),(t+1<NT),(t+1<NT));       ENDW(t);   RESC(); ROT();
    STEP(pA0,pA1,pB0,pB1,t+1,(t+4<NT),(t+2<NT),(t+2<NT));     ENDW(t+1); RESC(); ROT();
  }
  STEP(pB0,pB1,pA0,pA1,NT-1,false,false,false); RESC();
  { float sacc=pB0[0]+pB0[1]; _Pragma("unroll") for(int r=2;r<16;++r)sacc+=pB0[r]; _Pragma("unroll") for(int r=0;r<16;++r)sacc+=pB1[r]; l_reg+=sacc;
    pw0=(u32x4){PKW(pB0,0),PKW(pB0,2),PKW(pB0,4),PKW(pB0,6)};pw1=(u32x4){PKW(pB0,8),PKW(pB0,10),PKW(pB0,12),PKW(pB0,14)};pw2=(u32x4){PKW(pB1,0),PKW(pB1,2),PKW(pB1,4),PKW(pB1,6)};pw3=(u32x4){PKW(pB1,8),PKW(pB1,10),PKW(pB1,12),PKW(pB1,14)};
    SBAR(); pv(o,vb0+2*sl_cur,PAF(0),PAF(1),PAF(2),PAF(3)); pv(o+2,vb0+2*sl_cur+8192,PAF(0),PAF(1),PAF(2),PAF(3)); }
  #undef PKW
  #undef PAF
  #undef VFR
  #undef PIN
  #undef MX3
  #undef GAPA
  #undef GAPB
  #undef EX
  #undef VRD
  #undef VRD2
  #undef WFR
  #undef GAPC
  #undef KRD
  #undef STEP
  #undef ENDW
  {auto rr=__builtin_amdgcn_permlane32_swap(__float_as_uint(l_reg),__float_as_uint(l_reg),false,false);l_reg=__uint_as_float(rr[0])+__uint_as_float(rr[1]);}
  if(hi==0)wsf[32+r32]=l_reg;asm volatile("s_waitcnt lgkmcnt(0)":::"memory");
  float rli[16];
  #pragma unroll
  for(int r=0;r<16;++r)rli[r]=__builtin_amdgcn_rcpf(wsf[32+crow(r,hi)]);
  bf16*Ow=O+(rowbase+q0+wid*QBLK)*DM+hh_*256+mm_*128;
  #pragma unroll
  for(int half=0;half<2;++half)
  { bf16*stg=(bf16*)(shm+LDS_OST)+wid*2048;
    #pragma unroll
    for(int r=0;r<16;++r){const int orow=crow(r,hi);
      #pragma unroll
      for(int d0=0;d0<2;++d0)stg[orow*64+d0*32+r32]=__float2bfloat16(o[2*half+d0][r]*rli[r]);}
    asm volatile("s_waitcnt lgkmcnt(0)":::"memory");
    #pragma unroll
    for(int i=0;i<4;++i){const int row=i*8+(lane>>3),ch=lane&7; const u32x4 v=*(const u32x4*)(stg+row*64+ch*8); ATTN_STORE16(Ow+(long)row*DM+half*64+ch*8,v);}
    asm volatile("s_waitcnt lgkmcnt(0)":::"memory"); }
  asm volatile("s_waitcnt lgkmcnt(0)\n\ts_barrier":::"memory");
  #undef DMA_K
  #undef DMA_V
  #undef CMASK
  #undef START
  #undef RESC
  #undef ROT
}
constexpr int ATTN_LDS_BYTES=LDS_BYTES;
struct AttnTensors { const bf16* Q; const bf16* K; const bf16* V; bf16* O; };
struct AttnUnit { int bh; int qb; };
struct StaticOrder {
  int vcu;
  __device__ __forceinline__ explicit StaticOrder(int v):vcu(v){}
  __device__ __forceinline__ bool next(int i,AttnUnit&u)const{ if(i>=2)return false; const int s=vcu&15; u.bh=vcu>>4; u.qb=(i==0)?31-s:s; return true; }
  __device__ __forceinline__ void a_ready(const AttnUnit&)const{}
  __device__ __forceinline__ void done(const AttnUnit&)const{}
};
template<class Sched,int THRL=8> __device__ __forceinline__ void attn_phase(char*lds,const AttnTensors&T,const Sched&S){
  AttnUnit u;
  for(int i=0;S.next(i,u);++i){ S.a_ready(u); attn_unit<THRL>(u.bh>>3,u.bh&7,u.qb,T.Q,T.K,T.V,T.O,lds); S.done(u); }
}
#undef SBAR
#undef WAIT_BAR
}
namespace cg = cooperative_groups;
constexpr int NWAVES = 8;
constexpr int BATCH = 2, T = 8192, D = 1024, DIN = 3584, M = BATCH * T, DEPTH = 2;
constexpr float EPS = 1e-6f;
constexpr size_t MiB = 1u << 20;
constexpr size_t WS_CTL = 0;
constexpr size_t WS_TAB = 64 * 1024;
constexpr size_t WS_ROWSS = 128 * 1024;
constexpr size_t WS_ROWSS2 = 192 * 1024;
constexpr size_t WS_PCNT = 14336;
constexpr size_t WS_SUCNT = 15616;
constexpr size_t WS_SCNT = 14592;
constexpr size_t WS_ROWSS0 = 256 * 1024;
constexpr size_t WS_WIN = 2 * MiB;
constexpr size_t WS_WOUT = 16 * MiB;
constexpr size_t WS_GLU = 20 * MiB;
constexpr size_t WS_ROPE = 20 * MiB + 512 * 1024;
constexpr size_t WS_S5A = 21 * MiB;
constexpr size_t WS_S5B = 21 * MiB + 64 * 1024;
constexpr size_t WS_S5C = 21 * MiB + 256 * 1024;
constexpr size_t WS_HU = 22 * MiB;
constexpr size_t WS_HA = 30 * MiB;
constexpr size_t WS_XLOC = 31 * MiB;
constexpr size_t WS_XN = 32 * MiB;
constexpr size_t WS_O = WS_XN;
constexpr size_t WS_PROJ = 64 * MiB;
constexpr size_t WS_MIX = 176 * MiB;
constexpr size_t WS_YG = 208 * MiB;
constexpr size_t WS_YGS = 216 * MiB;
constexpr size_t WS_HRES = 224 * MiB;
constexpr size_t WS_END = 256 * MiB;
constexpr int LDS_BYTES = 147456, RING_BYTES = 131072;

#define GAS __attribute__((address_space(1)))
#define LAS __attribute__((address_space(3)))
typedef unsigned short bf16;
typedef unsigned v4u __attribute__((ext_vector_type(4)));
typedef unsigned v2u __attribute__((ext_vector_type(2)));
typedef float f32x4 __attribute__((ext_vector_type(4)));
typedef short bf16x8 __attribute__((ext_vector_type(8)));
#define LDS_WAIT() asm volatile("s_waitcnt lgkmcnt(0)" ::: "memory")
__device__ __forceinline__ unsigned f2bf(float f) { unsigned u = __builtin_bit_cast(unsigned, f); return (u + 0x7fffu + ((u >> 16) & 1u)) >> 16; }
__device__ __forceinline__ unsigned pk2(float lo, float hi) { return f2bf(lo) | (f2bf(hi) << 16); }
__device__ __forceinline__ float bflo(unsigned w) { return __uint_as_float(w << 16); }
__device__ __forceinline__ float bfhi(unsigned w) { return __uint_as_float(w & 0xffff0000u); }
__device__ __forceinline__ float bf1(bf16 h) { return __uint_as_float(((unsigned)h) << 16); }
__device__ __forceinline__ float sigmf(float v) { return __builtin_amdgcn_rcpf(1.0f + __builtin_amdgcn_exp2f(-1.4426950408889634f * v)); }
__device__ __forceinline__ float siluf(float v) { return v * sigmf(v); }
__device__ __forceinline__ float wave_sum(float v) {
#pragma unroll
    for (int o = 1; o < 64; o <<= 1) v += __shfl_xor(v, o);
    return v;
}
__device__ __forceinline__ void p0_transpose_item(const float* W, int K, int N, bf16* WT, LAS float* scr, int item, int lane, const float* kscale = nullptr) {
    const int nblk = N / 32, kb = item / nblk, nb = item % nblk, k0 = 64 * kb, n0 = 32 * nb;
#pragma unroll 8
    for (int i = 0; i < 32; ++i) { const int kk = 2 * i + (lane >> 5); scr[kk * 33 + (lane & 31)] = __builtin_nontemporal_load(W + (size_t)(k0 + kk) * N + n0 + (lane & 31)) * (kscale ? kscale[k0 + kk] : 1.0f); }
    LDS_WAIT(); asm volatile("" ::: "memory");
    const int c = lane & 7;
#pragma unroll
    for (int j = 0; j < 4; ++j) { const int n = (lane >> 3) + 8 * j; const LAS float* s = scr + (8 * c) * 33 + n;
        v4u o; o.x = pk2(s[0 * 33], s[1 * 33]); o.y = pk2(s[2 * 33], s[3 * 33]); o.z = pk2(s[4 * 33], s[5 * 33]); o.w = pk2(s[6 * 33], s[7 * 33]);
        *(v4u*)(WT + (size_t)(n0 + n) * K + k0 + 8 * c) = o; }
    LDS_WAIT(); asm volatile("" ::: "memory");
}
template <bool OUTF> __device__ __forceinline__ void rms_row(const float* xrow, const float* w, bf16* orow, float* frow, int lane) {
    const f32x4* xr = (const f32x4*)xrow + lane; const f32x4* wr = (const f32x4*)w + lane;
    f32x4 v[4]; float s = 0.f;
#pragma unroll
    for (int j = 0; j < 4; ++j) { v[j] = xr[64 * j]; s += (v[j].x * v[j].x + v[j].y * v[j].y) + (v[j].z * v[j].z + v[j].w * v[j].w); }
    const float rs = 1.0f / sqrtf(wave_sum(s) * (1.f / D) + EPS);
#pragma unroll
    for (int j = 0; j < 4; ++j) { const f32x4 ww = wr[64 * j]; const f32x4 o = v[j] * rs * ww;
        if (OUTF) ((f32x4*)frow + lane)[64 * j] = o;
        else ((v2u*)orow + lane)[64 * j] = (v2u){pk2(o.x, o.y), pk2(o.z, o.w)}; }
}

typedef GAS unsigned gu32;
#define RLX_AGENT __ATOMIC_RELAXED, __HIP_MEMORY_SCOPE_AGENT
#define XB_TMO      128
#define XB_XCNT(j)  (256  + 64 * (j))
#define XB_XSUB(j)  (1280 + 64 * (j))
#define XB_XGEN(j)  (2304 + 64 * (j))
#define XB_TOP      3328
#define XB_TOPGEN   3392
#define XCD_BAR_WORDS 3456
#define XB_SPIN_CAP (1u << 18)

__device__ __forceinline__ unsigned xb_ld(unsigned* p)              { return __hip_atomic_load(p, __ATOMIC_RELAXED, __HIP_MEMORY_SCOPE_AGENT); }
__device__ __forceinline__ unsigned xb_add(unsigned* p, unsigned v) { return __hip_atomic_fetch_add(p, v, __ATOMIC_RELAXED, __HIP_MEMORY_SCOPE_AGENT); }
__device__ __forceinline__ unsigned xb_xcc_id() { return (unsigned)__builtin_amdgcn_s_getreg((3 << 11) | 20) & 0xFu; }
#define XB_SPIN(cond, bar) do { unsigned _sp = 0; while (cond) { __builtin_amdgcn_s_sleep(1); \
    if ((++_sp & 255u) == 0u) { if (xb_ld(&(bar)[XB_TMO])) break; if (_sp > XB_SPIN_CAP) { atomicAdd(&(bar)[XB_TMO], 1u); break; } } } } while (0)

struct XcdBarrier {
    unsigned* bar; unsigned x;
    volatile LAS unsigned* st;
};

__device__ __forceinline__ XcdBarrier xcd_barrier_post(unsigned* bar, volatile LAS unsigned* st) {
    XcdBarrier b; b.bar = bar; b.x = xb_xcc_id(); b.st = st;
    if (threadIdx.x == 0) (void)xb_add(&bar[XB_XCNT(b.x)], 1u);
    return b;
}
__device__ __forceinline__ void xcd_barrier_complete(unsigned* bar, unsigned x, unsigned& nloc, unsigned& nx) {
    const unsigned G = gridDim.x * gridDim.y * gridDim.z;
    unsigned sum, cnt, mine, sp = 0u;
    for (;;) {
        sum = 0u; cnt = 0u; mine = 0u;
#pragma unroll
        for (unsigned j = 0; j < 16; ++j) { const unsigned c = xb_ld(&bar[XB_XCNT(j)]); sum += c; cnt += (c > 0u) ? 1u : 0u; mine = (j == x) ? c : mine; }
        if (sum == G) break;
        __builtin_amdgcn_s_sleep(1);
        if ((++sp & 255u) == 0u) { if (xb_ld(&bar[XB_TMO])) break; if (sp > XB_SPIN_CAP) { atomicAdd(&bar[XB_TMO], 1u); break; } }
    }
    nloc = mine > 0u ? mine : 1u; nx = cnt > 0u ? cnt : 1u;
}

__device__ __forceinline__ void xcd_barrier(const XcdBarrier& b) {
    asm volatile("s_waitcnt vmcnt(0)" ::: "memory");
    __syncthreads();
    if (threadIdx.x == 0) {
        unsigned* bar = b.bar;
        __builtin_amdgcn_s_waitcnt(0);
        unsigned nloc = b.st[0], nx = b.st[1];
        if (nloc == 0u) { xcd_barrier_complete(bar, b.x, nloc, nx); b.st[0] = nloc; b.st[1] = nx; }
        const unsigned old = xb_add(&bar[XB_XSUB(b.x)], 1u);
        const unsigned gen = old / nloc;
        if (old + 1u == (gen + 1u) * nloc) {
            __builtin_amdgcn_fence(__ATOMIC_RELEASE, "agent");
            asm volatile("s_waitcnt vmcnt(0)" ::: "memory");
            const unsigned og = xb_add(&bar[XB_TOP], 1u);
            const unsigned tg = og / nx;
            if (og + 1u == (tg + 1u) * nx) xb_add(&bar[XB_TOPGEN], 1u);
            else XB_SPIN(xb_ld(&bar[XB_TOPGEN]) == tg, bar);
            __builtin_amdgcn_fence(__ATOMIC_ACQUIRE, "agent");
            xb_add(&bar[XB_XGEN(b.x)], 1u);
            asm volatile("s_waitcnt vmcnt(0)" ::: "memory");
        } else {
            XB_SPIN(xb_ld(&bar[XB_XGEN(b.x)]) == gen, bar);
            __builtin_amdgcn_fence(__ATOMIC_ACQUIRE, "agent");
            asm volatile("s_waitcnt vmcnt(0)" ::: "memory");
        }
    }
    __syncthreads();
}
struct Args { const float* in[22]; float* out; unsigned char* ws; int ph_lo, ph_hi; };
struct PA { const float* const* in; float* out; unsigned char* ws; };

__device__ __forceinline__ void s5_prep(const float* const* in, unsigned char* ws, int t0, int nthreads) {
    const double TWO_PI = 6.283185307179586476925;
    for (int ec = t0; ec < DEPTH * 16 * 64 * 16; ec += nthreads) {
        const int e = ec >> 4, c = ec & 15;
        const int l = e >> 10, g = (e >> 6) & 15, p = e & 63;
        const double dt = (double)expf(in[12][l * 16 + g]);
        const double are = (double)in[6][e], aim = (double)in[7][e];
        const double mag = (double)expf((float)(dt * are));
        double tt = dt * aim * (1.0 / TWO_PI); tt -= __builtin_floor(tt);
        const float ang = (float)(tt * TWO_PI);
        const double abr = mag * (double)cosf(ang), abi = mag * (double)sinf(ang);
        const double den = are * are + aim * aim, nr = abr - 1.0, ni = abi;
        const double zr = (nr * are + ni * aim) / den, zi = (ni * are - nr * aim) / den;
        if (c == 0) {
            double pr = abr, pi = abi;
#pragma unroll
            for (int q = 0; q < 7; ++q) { const double r2 = pr * pr - pi * pi, i2 = 2.0 * pr * pi; pr = r2; pi = i2; }
            float* sa = (float*)(ws + WS_S5A) + (size_t)(l * 16 + g) * 256;
            sa[p] = (float)abr; sa[64 + p] = (float)abi; sa[128 + p] = (float)pr; sa[192 + p] = (float)pi;
        }
        bf16* bm = (bf16*)(ws + WS_S5B) + (size_t)(l * 16 + g) * 2048;
        const double br = in[8][(size_t)e * 16 + c], bi = in[9][(size_t)e * 16 + c];
        bm[p * 16 + c] = (bf16)f2bf((float)(zr * br - zi * bi)); bm[(64 + p) * 16 + c] = (bf16)f2bf((float)(zr * bi + zi * br));
        bf16* cm = (bf16*)(ws + WS_S5C) + (size_t)(l * 16 + g) * 2048;
        cm[c * 128 + p] = (bf16)f2bf(in[10][(size_t)(l * 16 + g) * 1024 + c * 64 + p]); cm[c * 128 + 64 + p] = (bf16)f2bf(-in[11][(size_t)(l * 16 + g) * 1024 + c * 64 + p]);
    }
}
__device__ __forceinline__ void prologue(const Args& a, LAS unsigned char* lds, int vcu, int G, int wave, int lane) {
    const bool defer_s5 = false;
    unsigned char* ws = a.ws;
    LAS float* scr = (LAS float*)(lds + wave * 16384);
    const int gw = vcu * NWAVES + wave, NGW = G * NWAVES;
    constexpr int I_IN = (D / 64) * (DIN / 32), I_OUT = (D / 64) * (D / 32), I_GLU = (256 / 64) * (256 / 32);
    constexpr int NITEMS = DEPTH * (I_IN + I_OUT + I_GLU);
    for (int it = gw; it < NITEMS; it += NGW) {
        int r = it; const int l = r / (I_IN + I_OUT + I_GLU); r -= l * (I_IN + I_OUT + I_GLU);
        if (r < I_IN) { p0_transpose_item(a.in[2] + (size_t)l * D * DIN, D, DIN, (bf16*)(ws + WS_WIN) + (size_t)l * DIN * D, scr, r, lane, a.in[1] + (size_t)l * D); continue; } r -= I_IN;
        if (r < I_OUT) { p0_transpose_item(a.in[3] + (size_t)l * D * D, D, D, (bf16*)(ws + WS_WOUT) + (size_t)l * D * D, scr, r, lane); continue; } r -= I_OUT;
        p0_transpose_item(a.in[14] + (size_t)l * 65536, 256, 256, (bf16*)(ws + WS_GLU) + (size_t)l * 65536, scr, r, lane);
    }
    for (int m = gw; m < M; m += 2 * NGW) {
        const int m2 = m + NGW; const bool has2 = m2 < M;
        const f32x4* x1 = (const f32x4*)(a.in[0] + (size_t)m * D) + lane; const f32x4* x2 = (const f32x4*)(a.in[0] + (size_t)(has2 ? m2 : m) * D) + lane;
        f32x4 v1[4], v2[4]; float s1 = 0.f, s2 = 0.f;
#pragma unroll
        for (int j = 0; j < 4; ++j) { v1[j] = __builtin_nontemporal_load(x1 + 64 * j); v2[j] = __builtin_nontemporal_load(x2 + 64 * j); }
#pragma unroll
        for (int j = 0; j < 4; ++j) { s1 += (v1[j].x * v1[j].x + v1[j].y * v1[j].y) + (v1[j].z * v1[j].z + v1[j].w * v1[j].w); s2 += (v2[j].x * v2[j].x + v2[j].y * v2[j].y) + (v2[j].z * v2[j].z + v2[j].w * v2[j].w);
            ((v2u*)((bf16*)(ws + WS_HRES) + (size_t)m * D) + lane)[64 * j] = (v2u){pk2(v1[j].x, v1[j].y), pk2(v1[j].z, v1[j].w)};
            if (has2) ((v2u*)((bf16*)(ws + WS_HRES) + (size_t)m2 * D) + lane)[64 * j] = (v2u){pk2(v2[j].x, v2[j].y), pk2(v2[j].z, v2[j].w)}; }
        s1 = wave_sum(s1); s2 = wave_sum(s2);
        if (lane == 0) { ((float*)(ws + WS_ROWSS0))[m] = s1; if (has2) ((float*)(ws + WS_ROWSS0))[m2] = s2; }
        if (lane == 0) { ((float*)(ws + WS_ROWSS))[m] = 0.f; ((float*)(ws + WS_ROWSS2))[m] = 0.f; if (has2) { ((float*)(ws + WS_ROWSS))[m2] = 0.f; ((float*)(ws + WS_ROWSS2))[m2] = 0.f; } }
    }
    const int gt = gw * 64 + lane, NGT = NGW * 64;
    const double TWO_PI = 6.283185307179586476925;
    for (int e = gt; e < 8192 * 8; e += NGT) {
        const int pos = e >> 3, i = e & 7;
        const double invf[8] = {1.0, 0.19392274474868576, 0.03760603093086393, 0.007292664737217109, 0.001414213562373095, 0.0002742481756762073, 5.318295896944988e-05, 1.031338537721246e-05};
        double inv = invf[0];
#pragma unroll
        for (int q = 1; q < 8; ++q) inv = (i == q) ? invf[q] : inv;
        double tt = (double)pos * inv * (1.0 / TWO_PI); tt -= __builtin_floor(tt);
        const float ang = (float)(tt * TWO_PI);
        float* rp = (float*)(ws + WS_ROPE) + (size_t)e * 2; rp[0] = cosf(ang); rp[1] = sinf(ang);
    }
    if (!defer_s5) s5_prep(a.in, ws, gt, NGT);
}

template <bool OUT> __device__ __forceinline__ void hgrn_item(const PA& a, LAS unsigned char* lds, int layer, int bh, int c, int tid, int wave, int lane) {
    const int b = bh >> 2, h = bh & 3;
    const bf16* PROJ = (const bf16*)(a.ws + WS_PROJ);
    float* HU = (float*)(a.ws + WS_HU); float* HA = (float*)(a.ws + WS_HA);
    LAS float* Fs = (LAS float*)lds; LAS float* Ks = Fs + 4096; LAS float* Vs = Ks + 4096; LAS float* Qs = Vs + 4096; LAS float* Ps = Qs + 4096;
    const size_t row0 = (size_t)b * T + (size_t)c * 128;
    float S[8];
#pragma unroll
    for (int j = 0; j < 8; ++j) S[j] = 0.f;
    if (OUT) {
        int cp = 0;
        for (; cp + 4 <= c; cp += 4) {
            float uu[4][8], aa[4][8];
#pragma unroll
            for (int q = 0; q < 4; ++q) {
                const float* U = HU + (size_t)(bh * 64 + cp + q) * 4096 + (size_t)(wave * 8) * 64 + lane; const float* A = HA + (size_t)(bh * 64 + cp + q) * 64 + wave * 8;
#pragma unroll
                for (int j = 0; j < 8; ++j) { uu[q][j] = U[j * 64]; aa[q][j] = A[j]; }
            }
#pragma unroll
            for (int q = 0; q < 4; ++q)
#pragma unroll
                for (int j = 0; j < 8; ++j) S[j] = aa[q][j] * S[j] + uu[q][j];
        }
        for (; cp < c; ++cp) {
            const float* U = HU + (size_t)(bh * 64 + cp) * 4096 + (size_t)(wave * 8) * 64 + lane; const float* A = HA + (size_t)(bh * 64 + cp) * 64 + wave * 8;
#pragma unroll
            for (int j = 0; j < 8; ++j) S[j] = A[j] * S[j] + U[j * 64];
        }
    }
    const int fcol = h * 64 + (tid & 7) * 8;
    float lb[8];
#pragma unroll
    for (int j = 0; j < 8; ++j) lb[j] = (layer == 0) ? 0.f : sigmf(a.in[4][256 + fcol + j] - a.in[4][fcol + j]);
    const float gnw = a.in[5][layer * 64 + lane];
    float aprod = 1.f;
    for (int sub = 0; sub < 2; ++sub) {
        __syncthreads();
        { const int t = tid >> 3; const bf16* pr = PROJ + (row0 + sub * 64 + t) * DIN + fcol;
          const v4u fw = *(const v4u*)(pr + 256), vw = *(const v4u*)(pr + 512);
          const unsigned fa[4] = {fw.x, fw.y, fw.z, fw.w}, va[4] = {vw.x, vw.y, vw.z, vw.w};
          float fo[8], ko[8], vo[8];
#pragma unroll
          for (int j = 0; j < 8; ++j) { const float x = (j & 1) ? bfhi(fa[j >> 1]) : bflo(fa[j >> 1]); const float sg = sigmf(x);
              fo[j] = lb[j] + (1.f - lb[j]) * sg; ko[j] = (1.f - lb[j]) * (1.f - sg); vo[j] = (j & 1) ? bfhi(va[j >> 1]) : bflo(va[j >> 1]); }
          LAS f32x4* d;
          d = (LAS f32x4*)(Fs + t * 64 + (tid & 7) * 8); d[0] = (f32x4){fo[0], fo[1], fo[2], fo[3]}; d[1] = (f32x4){fo[4], fo[5], fo[6], fo[7]};
          d = (LAS f32x4*)(Ks + t * 64 + (tid & 7) * 8); d[0] = (f32x4){ko[0], ko[1], ko[2], ko[3]}; d[1] = (f32x4){ko[4], ko[5], ko[6], ko[7]};
          d = (LAS f32x4*)(Vs + t * 64 + (tid & 7) * 8); d[0] = (f32x4){vo[0], vo[1], vo[2], vo[3]}; d[1] = (f32x4){vo[4], vo[5], vo[6], vo[7]};
          if (OUT) { const v4u qw = *(const v4u*)(pr); const unsigned qa[4] = {qw.x, qw.y, qw.z, qw.w}; float qo[8];
#pragma unroll
              for (int j = 0; j < 8; ++j) qo[j] = siluf((j & 1) ? bfhi(qa[j >> 1]) : bflo(qa[j >> 1]));
              d = (LAS f32x4*)(Qs + t * 64 + (tid & 7) * 8); d[0] = (f32x4){qo[0], qo[1], qo[2], qo[3]}; d[1] = (f32x4){qo[4], qo[5], qo[6], qo[7]}; }
        }
        __syncthreads();
        if (!OUT && tid < 64) { for (int t = 0; t < 64; ++t) aprod *= Fs[t * 64 + tid]; }
        for (int tb = 0; tb < 4; ++tb) {
#pragma unroll 4
            for (int tt = 0; tt < 16; ++tt) {
                const int t = tb * 16 + tt;
                const f32x4 f0 = *(const LAS f32x4*)(Fs + t * 64 + wave * 8), f1 = *(const LAS f32x4*)(Fs + t * 64 + wave * 8 + 4);
                const f32x4 k0 = *(const LAS f32x4*)(Ks + t * 64 + wave * 8), k1 = *(const LAS f32x4*)(Ks + t * 64 + wave * 8 + 4);
                const float v = Vs[t * 64 + lane];
                S[0] = f0[0] * S[0] + k0[0] * v; S[1] = f0[1] * S[1] + k0[1] * v; S[2] = f0[2] * S[2] + k0[2] * v; S[3] = f0[3] * S[3] + k0[3] * v;
                S[4] = f1[0] * S[4] + k1[0] * v; S[5] = f1[1] * S[5] + k1[1] * v; S[6] = f1[2] * S[6] + k1[2] * v; S[7] = f1[3] * S[7] + k1[3] * v;
                if (OUT) {
                    const f32x4 q0 = *(const LAS f32x4*)(Qs + t * 64 + wave * 8), q1 = *(const LAS f32x4*)(Qs + t * 64 + wave * 8 + 4);
                    const float p = ((q0[0] * S[0] + q0[1] * S[1]) + (q0[2] * S[2] + q0[3] * S[3])) + ((q1[0] * S[4] + q1[1] * S[5]) + (q1[2] * S[6] + q1[3] * S[7]));
                    Ps[(wave * 16 + tt) * 64 + lane] = p;
                }
            }
            if (OUT) {
                __syncthreads();
#pragma unroll
                for (int r = 0; r < 2; ++r) {
                    const int tt = wave + 8 * r; float o = 0.f;
#pragma unroll
                    for (int w2 = 0; w2 < 8; ++w2) o += Ps[(w2 * 16 + tt) * 64 + lane];
                    const float rs = 1.0f / sqrtf(wave_sum(o * o) * (1.f / 64.f) + EPS);
                    const size_t row = row0 + sub * 64 + tb * 16 + tt;
                    const float gt = siluf(bf1(PROJ[row * DIN + 768 + h * 64 + lane]));
                    ((bf16*)(a.ws + WS_MIX))[row * 1024 + h * 64 + lane] = (bf16)f2bf(o * rs * gnw * gt);
                }
                __syncthreads();
            }
        }
    }
    if (!OUT) {
        float* U = HU + (size_t)(bh * 64 + c) * 4096 + (size_t)(wave * 8) * 64 + lane;
#pragma unroll
        for (int j = 0; j < 8; ++j) U[j * 64] = S[j];
        if (tid < 64) HA[(size_t)(bh * 64 + c) * 64 + tid] = aprod;
    }
}

typedef unsigned short u16;
__device__ __forceinline__ bf16x8 pk8(const float* v) { v4u w = {pk2(v[0], v[1]), pk2(v[2], v[3]), pk2(v[4], v[5]), pk2(v[6], v[7])}; return __builtin_bit_cast(bf16x8, w); }
struct HRaw { v4u f[2], v[2], q[2], g[2]; };
template <bool OUT> __device__ __forceinline__ HRaw hgrn_load(const PA& a, int bh, int c, int wave, int lane) {
    const bf16* pr = (const bf16*)(a.ws + WS_PROJ) + ((size_t)(bh >> 2) * T + (size_t)c * 128 + wave * 16 + (lane >> 3)) * DIN + (bh & 3) * 64 + (lane & 7) * 8;
    HRaw r;
#pragma unroll
    for (int k = 0; k < 2; ++k) { r.f[k] = *(const v4u*)(pr + (size_t)(8 * k) * DIN + 256); r.v[k] = *(const v4u*)(pr + (size_t)(8 * k) * DIN + 512);
        if (OUT) { r.q[k] = *(const v4u*)(pr + (size_t)(8 * k) * DIN); r.g[k] = *(const v4u*)(pr + (size_t)(8 * k) * DIN + 768); } }
    return r;
}
template <bool OUT> __device__ __forceinline__ void hgrn_item2(const PA& a, LAS unsigned char* lds, int layer, int bh, int c, int wave, int lane, const HRaw& raw) {
    const int b = bh >> 2, h = bh & 3, item = bh * 64 + c;
    float* HU = (float*)(a.ws + WS_HU); float* HA = (float*)(a.ws + WS_HA);
    LAS unsigned char* wb = lds + wave * 12288;
    LAS bf16* QT = (LAS bf16*)wb; LAS bf16* KT = (LAS bf16*)(wb + 2304); LAS bf16* KHT = (LAS bf16*)(wb + 4608); LAS bf16* VT = (LAS bf16*)(wb + 7680); LAS bf16* P = (LAS bf16*)(wb + 10752);
    LAS float* DL = (LAS float*)(wb + 11520); LAS float* E7L = (LAS float*)(wb + 11776);
    LAS bf16* RF = (LAS bf16*)wb; LAS bf16* RV = (LAS bf16*)(wb + 2304); LAS bf16* RQ = (LAS bf16*)(wb + 4608);
    LAS bf16* GT = KHT; LAS bf16* OT = VT;
    LAS float* SBUF = (LAS float*)(lds + 98304); LAS float* DALL = (LAS float*)(lds + 114688);
    const int l15 = lane & 15, q = lane >> 4;
    const size_t row0 = (size_t)b * T + (size_t)c * 128 + wave * 16;
    const bf16x8 zero8 = {0, 0, 0, 0, 0, 0, 0, 0};
    __syncthreads();
    {
        const int rr = lane >> 3, cc = (lane & 7) * 8;
#pragma unroll
        for (int k = 0; k < 2; ++k) { *(LAS v4u*)(RF + (rr + 8 * k) * 72 + cc) = raw.f[k]; *(LAS v4u*)(RV + (rr + 8 * k) * 72 + cc) = raw.v[k]; if (OUT) *(LAS v4u*)(RQ + (rr + 8 * k) * 72 + cc) = raw.q[k]; }
        LDS_WAIT();
        const float lb = (layer == 0) ? 0.f : sigmf(a.in[4][256 + h * 64 + lane] - a.in[4][h * 64 + lane]);
        u16 fr[16], vr[16], qr[16];
#pragma unroll
        for (int t = 0; t < 16; ++t) { fr[t] = RF[t * 72 + lane]; vr[t] = RV[t * 72 + lane]; if (OUT) qr[t] = RQ[t * 72 + lane]; }
        LDS_WAIT();
        float cum[16], kk[16]; float run = 0.f;
#pragma unroll
        for (int t = 0; t < 16; ++t) { const float sg = sigmf(bf1(fr[t])); const float f = lb + (1.f - lb) * sg; kk[t] = (1.f - lb) * (1.f - sg); run += fmaxf(__logf(f), -69.f); cum[t] = run; }
        const float cl = cum[15], c7 = cum[7];
        DL[lane] = __expf(cl);
        if (OUT) E7L[lane] = __expf(c7); else DALL[wave * 64 + lane] = cl;
        float kh[16];
#pragma unroll
        for (int t = 0; t < 16; ++t) kh[t] = kk[t] * __expf(cl - cum[t]);
        *(LAS bf16x8*)(KHT + lane * 24) = pk8(kh); *(LAS bf16x8*)(KHT + lane * 24 + 8) = pk8(kh + 8);
        { v4u w0 = {(unsigned)vr[0] | ((unsigned)vr[1] << 16), (unsigned)vr[2] | ((unsigned)vr[3] << 16), (unsigned)vr[4] | ((unsigned)vr[5] << 16), (unsigned)vr[6] | ((unsigned)vr[7] << 16)};
          v4u w1 = {(unsigned)vr[8] | ((unsigned)vr[9] << 16), (unsigned)vr[10] | ((unsigned)vr[11] << 16), (unsigned)vr[12] | ((unsigned)vr[13] << 16), (unsigned)vr[14] | ((unsigned)vr[15] << 16)};
          *(LAS v4u*)(VT + lane * 24) = w0; *(LAS v4u*)(VT + lane * 24 + 8) = w1; }
        if (OUT) {
#pragma unroll
            for (int t = 0; t < 16; ++t) {
                QT[t * 72 + lane] = (bf16)f2bf(siluf(bf1(qr[t])) * __expf(fminf(cum[t] - c7, 60.f)));
                KT[t * 72 + lane] = (bf16)f2bf(kk[t] * __expf(fminf(c7 - cum[t], 60.f)));
            }
        }
    }
    LDS_WAIT();
    bf16x8 vfr[4];
#pragma unroll
    for (int nt = 0; nt < 4; ++nt) vfr[nt] = (q < 2) ? *(const LAS bf16x8*)(VT + (16 * nt + l15) * 24 + q * 8) : zero8;
    f32x4 U[4][4];
#pragma unroll
    for (int mt = 0; mt < 4; ++mt) { const bf16x8 afr = (q < 2) ? *(const LAS bf16x8*)(KHT + (16 * mt + l15) * 24 + q * 8) : zero8;
#pragma unroll
        for (int nt = 0; nt < 4; ++nt) U[mt][nt] = __builtin_amdgcn_mfma_f32_16x16x32_bf16(afr, vfr[nt], (f32x4){0.f, 0.f, 0.f, 0.f}, 0, 0, 0); }
    f32x4 o[4]; bf16x8 qf[2];
    if (OUT) {
        LDS_WAIT();
        { const int rr = lane >> 3, cc = (lane & 7) * 8; *(LAS v4u*)(GT + rr * 72 + cc) = raw.g[0]; *(LAS v4u*)(GT + (rr + 8) * 72 + cc) = raw.g[1]; }
        f32x4 sc = {0.f, 0.f, 0.f, 0.f};
#pragma unroll
        for (int ks = 0; ks < 2; ++ks) {
            const v2u qa = *(const LAS v2u*)(QT + l15 * 72 + 32 * ks + 4 * q), qb = *(const LAS v2u*)(QT + l15 * 72 + 32 * ks + 16 + 4 * q);
            const v2u ka = *(const LAS v2u*)(KT + l15 * 72 + 32 * ks + 4 * q), kb = *(const LAS v2u*)(KT + l15 * 72 + 32 * ks + 16 + 4 * q);
            qf[ks] = __builtin_bit_cast(bf16x8, (v4u){qa.x, qa.y, qb.x, qb.y});
            const bf16x8 kf = __builtin_bit_cast(bf16x8, (v4u){ka.x, ka.y, kb.x, kb.y});
            sc = __builtin_amdgcn_mfma_f32_16x16x32_bf16(qf[ks], kf, sc, 0, 0, 0);
        }
#pragma unroll
        for (int j = 0; j < 4; ++j) { const int t = 4 * q + j; P[t * 24 + l15] = (bf16)f2bf((l15 <= t) ? sc[j] : 0.f); }
        LDS_WAIT();
        const bf16x8 pf = (q < 2) ? *(const LAS bf16x8*)(P + l15 * 24 + q * 8) : zero8;
#pragma unroll
        for (int nt = 0; nt < 4; ++nt) o[nt] = __builtin_amdgcn_mfma_f32_16x16x32_bf16(pf, vfr[nt], (f32x4){0.f, 0.f, 0.f, 0.f}, 0, 0, 0);
    }
    {
        float S8[8];
#pragma unroll
        for (int i = 0; i < 8; ++i) S8[i] = 0.f;
        if (OUT) {
            const f32x4 h0 = *(const f32x4*)(HU + (size_t)item * 4096 + (size_t)((2 * wave) * 64 + lane) * 4), h1 = *(const f32x4*)(HU + (size_t)item * 4096 + (size_t)((2 * wave + 1) * 64 + lane) * 4);
            S8[0] = h0[0]; S8[1] = h0[1]; S8[2] = h0[2]; S8[3] = h0[3]; S8[4] = h1[0]; S8[5] = h1[1]; S8[6] = h1[2]; S8[7] = h1[3];
        }
        *(LAS f32x4*)(SBUF + ((2 * wave) * 64 + lane) * 4) = (f32x4){S8[0], S8[1], S8[2], S8[3]}; *(LAS f32x4*)(SBUF + ((2 * wave + 1) * 64 + lane) * 4) = (f32x4){S8[4], S8[5], S8[6], S8[7]};
    }
    __syncthreads();
    f32x4 Sp[4][4];
#pragma unroll 1
    for (int step = 0; step < 8; ++step) {
        if (wave == step) {
#pragma unroll
            for (int mt = 0; mt < 4; ++mt) { const f32x4 Dv = *(const LAS f32x4*)(DL + 16 * mt + 4 * q);
#pragma unroll
                for (int nt = 0; nt < 4; ++nt) {
                    Sp[mt][nt] = *(const LAS f32x4*)(SBUF + ((mt * 4 + nt) * 64 + lane) * 4);
                    U[mt][nt] = Dv * Sp[mt][nt] + U[mt][nt];
                    *(LAS f32x4*)(SBUF + ((mt * 4 + nt) * 64 + lane) * 4) = U[mt][nt];
                } }
        }
        __syncthreads();
    }
    if (OUT) {
#pragma unroll
        for (int mt = 0; mt < 4; ++mt) { const f32x4 Ev = *(const LAS f32x4*)(E7L + 16 * mt + 4 * q);
#pragma unroll
            for (int nt = 0; nt < 4; ++nt) Sp[mt][nt] = Sp[mt][nt] * Ev; }
#pragma unroll
        for (int nt = 0; nt < 4; ++nt)
#pragma unroll
            for (int ks = 0; ks < 2; ++ks) {
                const f32x4 s0 = Sp[2 * ks][nt], s1 = Sp[2 * ks + 1][nt];
                const bf16x8 bfrag = __builtin_bit_cast(bf16x8, (v4u){pk2(s0[0], s0[1]), pk2(s0[2], s0[3]), pk2(s1[0], s1[1]), pk2(s1[2], s1[3])});
                o[nt] = __builtin_amdgcn_mfma_f32_16x16x32_bf16(qf[ks], bfrag, o[nt], 0, 0, 0);
            }
        float gn[4];
#pragma unroll
        for (int nt = 0; nt < 4; ++nt) gn[nt] = a.in[5][layer * 64 + 16 * nt + l15];
#pragma unroll
        for (int j = 0; j < 4; ++j) {
            float ss = (o[0][j] * o[0][j] + o[1][j] * o[1][j]) + (o[2][j] * o[2][j] + o[3][j] * o[3][j]);
            ss += __shfl_xor(ss, 1); ss += __shfl_xor(ss, 2); ss += __shfl_xor(ss, 4); ss += __shfl_xor(ss, 8);
            const float rs = __builtin_amdgcn_rsqf(ss * (1.f / 64.f) + EPS);
#pragma unroll
            for (int nt = 0; nt < 4; ++nt) { const float gt = siluf(bf1(GT[(4 * q + j) * 72 + 16 * nt + l15]));
                OT[(4 * q + j) * 72 + 16 * nt + l15] = (bf16)f2bf(o[nt][j] * rs * gn[nt] * gt); }
        }
        LDS_WAIT();
        { const int rr = lane >> 3, cc = (lane & 7) * 8; bf16* mp = (bf16*)(a.ws + WS_MIX) + (row0 + rr) * 1024 + h * 64 + cc;
          *(v4u*)mp = *(const LAS v4u*)(OT + rr * 72 + cc); *(v4u*)(mp + 8 * 1024) = *(const LAS v4u*)(OT + (rr + 8) * 72 + cc); }
    } else {
        if (wave == 7) {
#pragma unroll
            for (int mt = 0; mt < 4; ++mt)
#pragma unroll
                for (int nt = 0; nt < 4; ++nt)
                    *(f32x4*)(HU + (size_t)item * 4096 + (size_t)((mt * 4 + nt) * 64 + lane) * 4) = U[mt][nt];
            float s = 0.f;
#pragma unroll
            for (int w2 = 0; w2 < 8; ++w2) s += DALL[w2 * 64 + lane];
            HA[(size_t)item * 64 + lane] = __expf(s);
        }
    }
}

template <bool OUT> __device__ __forceinline__ HRaw hgrn_loadc(const PA& a, int bh, int c, int chunk, int lane) {
    const bf16* pr = (const bf16*)(a.ws + WS_PROJ) + ((size_t)(bh >> 2) * T + (size_t)c * 128 + chunk * 16 + (lane >> 3)) * DIN + (bh & 3) * 64 + (lane & 7) * 8;
    HRaw r;
#pragma unroll
    for (int k = 0; k < 2; ++k) { r.f[k] = *(const v4u*)(pr + (size_t)(8 * k) * DIN + 256); r.v[k] = *(const v4u*)(pr + (size_t)(8 * k) * DIN + 512);
        if (OUT) { r.q[k] = *(const v4u*)(pr + (size_t)(8 * k) * DIN); } }
    return r;
}
template <bool OUT> __device__ __forceinline__ void hgrn_chunk(const PA& a, LAS unsigned char* wb, LAS float* DLk, LAS float* E7k, LAS float* DALLk, int layer, int h, int lane, const HRaw& raw,
                                                                f32x4 (&U)[4][4], f32x4 (&o)[4], bf16x8 (&qf)[2]) {
    LAS bf16* QT = (LAS bf16*)wb; LAS bf16* KT = (LAS bf16*)(wb + 2304); LAS bf16* KHT = (LAS bf16*)(wb + 4608); LAS bf16* VT = (LAS bf16*)(wb + 7680); LAS bf16* P = (LAS bf16*)(wb + 10752);
    LAS bf16* RF = (LAS bf16*)wb; LAS bf16* RV = (LAS bf16*)(wb + 2304); LAS bf16* RQ = (LAS bf16*)(wb + 4608);
    const int l15 = lane & 15, q = lane >> 4;
    const bf16x8 zero8 = {0, 0, 0, 0, 0, 0, 0, 0};
    LDS_WAIT();
    {
        const int rr = lane >> 3, cc = (lane & 7) * 8;
#pragma unroll
        for (int k = 0; k < 2; ++k) { *(LAS v4u*)(RF + (rr + 8 * k) * 72 + cc) = raw.f[k]; *(LAS v4u*)(RV + (rr + 8 * k) * 72 + cc) = raw.v[k]; if (OUT) *(LAS v4u*)(RQ + (rr + 8 * k) * 72 + cc) = raw.q[k]; }
        LDS_WAIT();
        const float lb = (layer == 0) ? 0.f : sigmf(a.in[4][256 + h * 64 + lane] - a.in[4][h * 64 + lane]);
        {
            u16 vr[16];
#pragma unroll
            for (int t = 0; t < 16; ++t) vr[t] = RV[t * 72 + lane];
            const v4u w0 = {(unsigned)vr[0] | ((unsigned)vr[1] << 16), (unsigned)vr[2] | ((unsigned)vr[3] << 16), (unsigned)vr[4] | ((unsigned)vr[5] << 16), (unsigned)vr[6] | ((unsigned)vr[7] << 16)};
            const v4u w1 = {(unsigned)vr[8] | ((unsigned)vr[9] << 16), (unsigned)vr[10] | ((unsigned)vr[11] << 16), (unsigned)vr[12] | ((unsigned)vr[13] << 16), (unsigned)vr[14] | ((unsigned)vr[15] << 16)};
            *(LAS v4u*)(VT + lane * 24) = w0; *(LAS v4u*)(VT + lane * 24 + 8) = w1;
        }
        float cum[16], kk[16]; float run = 0.f;
#pragma unroll
        for (int t = 0; t < 16; ++t) { const float sg = sigmf(bf1(RF[t * 72 + lane])); const float f = lb + (1.f - lb) * sg; kk[t] = (1.f - lb) * (1.f - sg); run += fmaxf(__logf(f), -69.f); cum[t] = run; }
        const float cl = cum[15], c7 = cum[7];
        DLk[lane] = __expf(cl);
        if (OUT) E7k[lane] = __expf(c7); else DALLk[lane] = cl;
        if (OUT) {
            float qv[16];
#pragma unroll
            for (int t = 0; t < 16; ++t) qv[t] = bf1(RQ[t * 72 + lane]);
            LDS_WAIT();
#pragma unroll
            for (int t = 0; t < 16; ++t) {
                QT[t * 72 + lane] = (bf16)f2bf(siluf(qv[t]) * __expf(fminf(cum[t] - c7, 60.f)));
                KT[t * 72 + lane] = (bf16)f2bf(kk[t] * __expf(fminf(c7 - cum[t], 60.f)));
            }
        }
        LDS_WAIT();
        float kh[16];
#pragma unroll
        for (int t = 0; t < 16; ++t) kh[t] = kk[t] * __expf(cl - cum[t]);
        *(LAS bf16x8*)(KHT + lane * 24) = pk8(kh); *(LAS bf16x8*)(KHT + lane * 24 + 8) = pk8(kh + 8);
    }
    LDS_WAIT();
    bf16x8 vfr[4];
#pragma unroll
    for (int nt = 0; nt < 4; ++nt) vfr[nt] = (q < 2) ? *(const LAS bf16x8*)(VT + (16 * nt + l15) * 24 + q * 8) : zero8;
#pragma unroll
    for (int mt = 0; mt < 4; ++mt) { const bf16x8 afr = (q < 2) ? *(const LAS bf16x8*)(KHT + (16 * mt + l15) * 24 + q * 8) : zero8;
#pragma unroll
        for (int nt = 0; nt < 4; ++nt) U[mt][nt] = __builtin_amdgcn_mfma_f32_16x16x32_bf16(afr, vfr[nt], (f32x4){0.f, 0.f, 0.f, 0.f}, 0, 0, 0); }
    if (OUT) {
        f32x4 sc = {0.f, 0.f, 0.f, 0.f};
#pragma unroll
        for (int ks = 0; ks < 2; ++ks) {
            const v2u qa = *(const LAS v2u*)(QT + l15 * 72 + 32 * ks + 4 * q), qb = *(const LAS v2u*)(QT + l15 * 72 + 32 * ks + 16 + 4 * q);
            const v2u ka = *(const LAS v2u*)(KT + l15 * 72 + 32 * ks + 4 * q), kb = *(const LAS v2u*)(KT + l15 * 72 + 32 * ks + 16 + 4 * q);
            qf[ks] = __builtin_bit_cast(bf16x8, (v4u){qa.x, qa.y, qb.x, qb.y});
            const bf16x8 kf = __builtin_bit_cast(bf16x8, (v4u){ka.x, ka.y, kb.x, kb.y});
            sc = __builtin_amdgcn_mfma_f32_16x16x32_bf16(qf[ks], kf, sc, 0, 0, 0);
        }
#pragma unroll
        for (int j = 0; j < 4; ++j) { const int t = 4 * q + j; P[t * 24 + l15] = (bf16)f2bf((l15 <= t) ? sc[j] : 0.f); }
        LDS_WAIT();
        const bf16x8 pf = (q < 2) ? *(const LAS bf16x8*)(P + l15 * 24 + q * 8) : zero8;
#pragma unroll
        for (int nt = 0; nt < 4; ++nt) o[nt] = __builtin_amdgcn_mfma_f32_16x16x32_bf16(pf, vfr[nt], (f32x4){0.f, 0.f, 0.f, 0.f}, 0, 0, 0);
    }
}
__device__ __forceinline__ void hgrn_ointer(f32x4 (&o)[4], const bf16x8 (&qf)[2], const f32x4 (&S)[4][4], const f32x4 (&sc)[4]) {
#pragma unroll
    for (int nt = 0; nt < 4; ++nt)
#pragma unroll
        for (int ks = 0; ks < 2; ++ks) {
            const f32x4 s0 = S[2 * ks][nt] * sc[2 * ks], s1 = S[2 * ks + 1][nt] * sc[2 * ks + 1];
            const bf16x8 bfrag = __builtin_bit_cast(bf16x8, (v4u){pk2(s0[0], s0[1]), pk2(s0[2], s0[3]), pk2(s1[0], s1[1]), pk2(s1[2], s1[3])});
            o[nt] = __builtin_amdgcn_mfma_f32_16x16x32_bf16(qf[ks], bfrag, o[nt], 0, 0, 0);
        }
}
#define HG_LAUNDER() do { asm volatile("" : "+v"(lane)); l15 = lane & 15; q = lane >> 4; } while (0)
template <bool OUT> __device__ __forceinline__ void hgrn_pair(const PA& a, LAS unsigned char* lds, int layer, int bh, int s, int wave, int lane) {
    const int half = wave >> 2, wl = wave & 3, c = half ? 63 - s : s, b = bh >> 2, h = bh & 3, item = bh * 64 + c;
    float* HU = (float*)(a.ws + WS_HU); float* HA = (float*)(a.ws + WS_HA);
    LAS unsigned char* wb = lds + wave * 12800;
    LAS float* DLs = (LAS float*)(wb + 11520);
    LAS float* SBUF = (LAS float*)(lds + 102400 + half * 16384);
    LAS float* DALL = (LAS float*)(lds + 135168 + half * 2048);
    int l15 = lane & 15, q = lane >> 4;
    const size_t rowc0 = (size_t)b * T + (size_t)c * 128 + (size_t)(2 * wl) * 16;
    __syncthreads();
    f32x4 U0[4][4], Up[4][4], o[2][4]; bf16x8 qf[2][2];
    { const HRaw r0 = hgrn_loadc<OUT>(a, bh, c, 2 * wl, lane); hgrn_chunk<OUT>(a, wb, DLs, DLs + 128, DALL + (2 * wl) * 64, layer, h, lane, r0, U0, o[0], qf[0]); }
    asm volatile("" ::: "memory"); __builtin_amdgcn_sched_barrier(0); HG_LAUNDER();
    { const HRaw r1 = hgrn_loadc<OUT>(a, bh, c, 2 * wl + 1, lane); hgrn_chunk<OUT>(a, wb, DLs + 64, DLs + 192, DALL + (2 * wl + 1) * 64, layer, h, lane, r1, Up, o[1], qf[1]); }
    asm volatile("" ::: "memory"); __builtin_amdgcn_sched_barrier(0); HG_LAUNDER();
    LDS_WAIT();
    if (OUT) { f32x4 E1[4];
#pragma unroll
        for (int mt = 0; mt < 4; ++mt) E1[mt] = *(const LAS f32x4*)(DLs + 192 + 16 * mt + 4 * q);
        hgrn_ointer(o[1], qf[1], U0, E1); }
#pragma unroll
    for (int mt = 0; mt < 4; ++mt) { const f32x4 D1 = *(const LAS f32x4*)(DLs + 64 + 16 * mt + 4 * q);
#pragma unroll
        for (int nt = 0; nt < 4; ++nt) Up[mt][nt] = D1 * U0[mt][nt] + Up[mt][nt]; }
    HG_LAUNDER();
#pragma unroll
    for (int i = 0; i < 4; ++i) { f32x4 hv = {0.f, 0.f, 0.f, 0.f};
        if (OUT) hv = *(const f32x4*)(HU + (size_t)item * 4096 + (size_t)((4 * wl + i) * 64 + lane) * 4);
        *(LAS f32x4*)(SBUF + ((4 * wl + i) * 64 + lane) * 4) = hv; }
    v4u gq[2][2];
    if (OUT) { const bf16* gp = (const bf16*)(a.ws + WS_PROJ) + (rowc0 + (lane >> 3)) * DIN + 768 + h * 64 + (lane & 7) * 8;
#pragma unroll
        for (int k = 0; k < 2; ++k) { gq[k][0] = *(const v4u*)(gp + (size_t)(16 * k) * DIN); gq[k][1] = *(const v4u*)(gp + (size_t)(16 * k + 8) * DIN); } }
    __syncthreads();
    HG_LAUNDER();
    f32x4 Sin[4][4];
#pragma unroll 1
    for (int step = 0; step < 4; ++step) {
        if (wl == step) {
#pragma unroll
            for (int mt = 0; mt < 4; ++mt) { const f32x4 Dp = *(const LAS f32x4*)(DLs + 16 * mt + 4 * q) * *(const LAS f32x4*)(DLs + 64 + 16 * mt + 4 * q);
#pragma unroll
                for (int nt = 0; nt < 4; ++nt) {
                    Sin[mt][nt] = *(const LAS f32x4*)(SBUF + ((mt * 4 + nt) * 64 + lane) * 4);
                    Up[mt][nt] = Dp * Sin[mt][nt] + Up[mt][nt];
                    *(LAS f32x4*)(SBUF + ((mt * 4 + nt) * 64 + lane) * 4) = Up[mt][nt];
                } }
        }
        __syncthreads();
    }
    HG_LAUNDER();
    if (OUT) {
        { f32x4 E0[4];
#pragma unroll
          for (int mt = 0; mt < 4; ++mt) E0[mt] = *(const LAS f32x4*)(DLs + 128 + 16 * mt + 4 * q);
          hgrn_ointer(o[0], qf[0], Sin, E0);
#pragma unroll
          for (int mt = 0; mt < 4; ++mt) E0[mt] = *(const LAS f32x4*)(DLs + 192 + 16 * mt + 4 * q) * *(const LAS f32x4*)(DLs + 16 * mt + 4 * q);
          hgrn_ointer(o[1], qf[1], Sin, E0); }
        HG_LAUNDER();
        LAS bf16* GT = (LAS bf16*)(wb + 4608); LAS bf16* OT = (LAS bf16*)(wb + 7680);
        float gn[4];
#pragma unroll
        for (int nt = 0; nt < 4; ++nt) gn[nt] = a.in[5][layer * 64 + 16 * nt + l15];
#pragma unroll
        for (int k = 0; k < 2; ++k) {
            const int rr = lane >> 3, cc = (lane & 7) * 8;
            LDS_WAIT();
            *(LAS v4u*)(GT + rr * 72 + cc) = gq[k][0]; *(LAS v4u*)(GT + (rr + 8) * 72 + cc) = gq[k][1];
            LDS_WAIT();
#pragma unroll
            for (int j = 0; j < 4; ++j) {
                float ss = (o[k][0][j] * o[k][0][j] + o[k][1][j] * o[k][1][j]) + (o[k][2][j] * o[k][2][j] + o[k][3][j] * o[k][3][j]);
                ss += __shfl_xor(ss, 1); ss += __shfl_xor(ss, 2); ss += __shfl_xor(ss, 4); ss += __shfl_xor(ss, 8);
                const float rs = __builtin_amdgcn_rsqf(ss * (1.f / 64.f) + EPS);
#pragma unroll
                for (int nt = 0; nt < 4; ++nt) { const float gt = siluf(bf1(GT[(4 * q + j) * 72 + 16 * nt + l15]));
                    OT[(4 * q + j) * 72 + 16 * nt + l15] = (bf16)f2bf(o[k][nt][j] * rs * gn[nt] * gt); }
            }
            LDS_WAIT();
            bf16* mp = (bf16*)(a.ws + WS_MIX) + (rowc0 + k * 16 + rr) * 1024 + h * 64 + cc;
            *(v4u*)mp = *(const LAS v4u*)(OT + rr * 72 + cc); *(v4u*)(mp + 8 * 1024) = *(const LAS v4u*)(OT + (rr + 8) * 72 + cc);
        }
    } else {
        if (wl == 3) {
#pragma unroll
            for (int mt = 0; mt < 4; ++mt)
#pragma unroll
                for (int nt = 0; nt < 4; ++nt)
                    *(f32x4*)(HU + (size_t)item * 4096 + (size_t)((mt * 4 + nt) * 64 + lane) * 4) = Up[mt][nt];
            float sm = 0.f;
#pragma unroll
            for (int w2 = 0; w2 < 8; ++w2) sm += DALL[w2 * 64 + lane];
            HA[(size_t)item * 64 + lane] = __expf(sm);
        }
    }
}

__device__ __forceinline__ float gelu_tanh(float y) { const float z = 0.7978845608028654f * (y + 0.044715f * y * y * y); return y * sigmf(2.f * z); }
template <bool OUT> __device__ __forceinline__ void s5_item(const PA& a, LAS unsigned char* lds, int layer, int item, int wave, int lane) {
    const int b = item >> 10, g = (item >> 6) & 15, c = item & 63, lg = layer * 16 + g;
    const bf16* PROJ = (const bf16*)(a.ws + WS_PROJ);
    const float* sa = (const float*)(a.ws + WS_S5A) + (size_t)lg * 256;
    float* XL = (float*)(a.ws + WS_XLOC) + (size_t)((b * 16 + g) * 64) * 128;
    const float ar = sa[lane], ai = sa[64 + lane];
    float xr = 0.f, xi = 0.f;
    if (OUT) { xr = XL[c * 128 + lane]; xi = XL[c * 128 + 64 + lane]; }
    const int l15 = lane & 15, quad = lane >> 4;
    const bf16x8 zero8 = {0, 0, 0, 0, 0, 0, 0, 0};
    bf16x8 bfr[8];
#pragma unroll
    for (int nt = 0; nt < 8; ++nt) bfr[nt] = (quad < 2) ? *(const bf16x8*)((const bf16*)(a.ws + WS_S5B) + (size_t)lg * 2048 + (nt * 16 + l15) * 16 + quad * 8) : zero8;
    bf16x8 cfr[4];
    if (OUT) {
#pragma unroll
        for (int ks = 0; ks < 4; ++ks) cfr[ks] = *(const bf16x8*)((const bf16*)(a.ws + WS_S5C) + (size_t)lg * 2048 + l15 * 128 + ks * 32 + quad * 8);
    }
    const float dsk = a.in[13][layer * 256 + g * 16 + l15];
    LAS float* BU = (LAS float*)(lds + wave * 12800);
    LAS bf16* X = (LAS bf16*)(lds + wave * 12800 + 8448);
    const size_t rowb = (size_t)b * T + (size_t)c * 128;
    bf16x8 afr_n = (quad < 2) ? *(const bf16x8*)(PROJ + (rowb + l15) * DIN + 1024 + g * 16 + quad * 8) : zero8;
    bf16 ue_n[4] = {0, 0, 0, 0}, se_n[4] = {0, 0, 0, 0};
    if (OUT) {
#pragma unroll
        for (int j = 0; j < 4; ++j) { ue_n[j] = PROJ[(rowb + quad * 4 + j) * DIN + 1024 + g * 16 + l15]; se_n[j] = PROJ[(rowb + quad * 4 + j) * DIN + 1280 + g * 16 + l15]; }
    }
    f32x4 accn[8];
#pragma unroll
    for (int nt = 0; nt < 8; ++nt) accn[nt] = __builtin_amdgcn_mfma_f32_16x16x32_bf16(afr_n, bfr[nt], (f32x4){0.f, 0.f, 0.f, 0.f}, 0, 0, 0);
#pragma unroll
    for (int nt = 0; nt < 8; ++nt)
#pragma unroll
        for (int j = 0; j < 4; ++j) BU[(quad * 4 + j) * 132 + nt * 16 + l15] = accn[nt][j];
    afr_n = (quad < 2) ? *(const bf16x8*)(PROJ + (rowb + 16 + l15) * DIN + 1024 + g * 16 + quad * 8) : zero8;
    for (int blk = 0; blk < 8; ++blk) {
        const size_t row0 = rowb + blk * 16;
        bf16 ue[4], se[4];
#pragma unroll
        for (int j = 0; j < 4; ++j) { ue[j] = ue_n[j]; se[j] = se_n[j]; }
        if (blk + 1 < 8) {
#pragma unroll
            for (int nt = 0; nt < 8; ++nt) accn[nt] = __builtin_amdgcn_mfma_f32_16x16x32_bf16(afr_n, bfr[nt], (f32x4){0.f, 0.f, 0.f, 0.f}, 0, 0, 0);
            if (blk + 2 < 8) afr_n = (quad < 2) ? *(const bf16x8*)(PROJ + (row0 + 32 + l15) * DIN + 1024 + g * 16 + quad * 8) : zero8;
            if (OUT) {
#pragma unroll
                for (int j = 0; j < 4; ++j) { ue_n[j] = PROJ[(row0 + 16 + quad * 4 + j) * DIN + 1024 + g * 16 + l15]; se_n[j] = PROJ[(row0 + 16 + quad * 4 + j) * DIN + 1280 + g * 16 + l15]; }
            }
        }
#pragma unroll
        for (int t = 0; t < 16; ++t) {
            const float br = BU[t * 132 + lane], bi = BU[t * 132 + 64 + lane];
            const float nr = ar * xr - ai * xi + br, ni = ar * xi + ai * xr + bi; xr = nr; xi = ni;
            if (OUT) { X[t * 136 + lane] = (bf16)f2bf(xr); X[t * 136 + 64 + lane] = (bf16)f2bf(xi); }
        }
        if (blk + 1 < 8) {
#pragma unroll
            for (int nt = 0; nt < 8; ++nt)
#pragma unroll
                for (int j = 0; j < 4; ++j) BU[(quad * 4 + j) * 132 + nt * 16 + l15] = accn[nt][j];
        }
        if (OUT) {
            f32x4 acc = {0.f, 0.f, 0.f, 0.f};
#pragma unroll
            for (int ks = 0; ks < 4; ++ks) { const bf16x8 xa = *(const LAS bf16x8*)(X + l15 * 136 + ks * 32 + quad * 8); acc = __builtin_amdgcn_mfma_f32_16x16x32_bf16(xa, cfr[ks], acc, 0, 0, 0); }
#pragma unroll
            for (int j = 0; j < 4; ++j) { const size_t row = row0 + quad * 4 + j;
                const float u = bf1(ue[j]);
                const float yg = gelu_tanh(acc[j] + dsk * u);
                ((bf16*)(a.ws + WS_YG))[row * 256 + g * 16 + l15] = (bf16)f2bf(yg);
                ((bf16*)(a.ws + WS_YGS))[row * 256 + g * 16 + l15] = (bf16)f2bf(yg * siluf(bf1(se[j]))); }
        }
    }
    LDS_WAIT();
    if (!OUT) { XL[c * 128 + lane] = xr; XL[c * 128 + 64 + lane] = xi; }
}


__device__ __forceinline__ void hgrn_scan(const PA& a, int task, int lane) {
    float* HU = (float*)(a.ws + WS_HU); const float* HA = (const float*)(a.ws + WS_HA);
    const int bh = task >> 6, r = task & 63, dk = 16 * (r >> 4) + 4 * (r & 3) + (lane & 3);
    float* up = HU + (size_t)(bh * 64) * 4096 + (size_t)r * 64 + lane; const float* ap = HA + (size_t)(bh * 64) * 64 + dk;
    float S = 0.f;
#pragma unroll 1
    for (int c0 = 0; c0 < 64; c0 += 32) {
        float u[32], av[32];
#pragma unroll
        for (int i = 0; i < 32; ++i) { u[i] = up[(size_t)(c0 + i) * 4096]; av[i] = ap[(size_t)(c0 + i) * 64]; }
#pragma unroll
        for (int i = 0; i < 32; ++i) { __hip_atomic_store(up + (size_t)(c0 + i) * 4096, S, __ATOMIC_RELAXED, __HIP_MEMORY_SCOPE_AGENT); S = av[i] * S + u[i]; }
    }
}
__device__ __forceinline__ void s5_scan(const PA& a, int layer, int task, int lane) {
    const int g = task & 15;
    const float* sa = (const float*)(a.ws + WS_S5A) + (size_t)(layer * 16 + g) * 256;
    float* XL = (float*)(a.ws + WS_XLOC) + (size_t)(task * 64) * 128;
    const float Lr = sa[128 + lane], Li = sa[192 + lane];
    float xr = 0.f, xi = 0.f;
#pragma unroll 1
    for (int c0 = 0; c0 < 64; c0 += 32) {
        float lr[32], li[32];
#pragma unroll
        for (int i = 0; i < 32; ++i) { lr[i] = XL[(c0 + i) * 128 + lane]; li[i] = XL[(c0 + i) * 128 + 64 + lane]; }
#pragma unroll
        for (int i = 0; i < 32; ++i) { __hip_atomic_store(XL + (c0 + i) * 128 + lane, xr, __ATOMIC_RELAXED, __HIP_MEMORY_SCOPE_AGENT); __hip_atomic_store(XL + (c0 + i) * 128 + 64 + lane, xi, __ATOMIC_RELAXED, __HIP_MEMORY_SCOPE_AGENT);
            const float nr = Lr * xr - Li * xi + lr[i], ni = Lr * xi + Li * xr + li[i]; xr = nr; xi = ni; }
    }
}
template <int NR> __device__ __forceinline__ void combine_rows(const PA& a, int layer, float lam, float post, size_t row0, size_t rstride, int lane) {
    const bf16* O = (const bf16*)(a.ws + WS_O); const bf16* PROJ = (const bf16*)(a.ws + WS_PROJ);
    const int h = lane >> 4, e0 = (lane & 15) * 8, j = e0 >> 6, d = e0 & 63;
    v4u o0[NR], o1[NR], gv[NR];
#pragma unroll
    for (int r = 0; r < NR; ++r) { const size_t row = row0 + r * rstride;
        o0[r] = *(const v4u*)(O + row * 1024 + (h * 4 + j) * 64 + d); o1[r] = *(const v4u*)(O + row * 1024 + (h * 4 + 2 + j) * 64 + d); gv[r] = *(const v4u*)(PROJ + row * DIN + 3072 + h * 128 + e0); }
    const f32x4 sw0 = *(const f32x4*)(a.in[20] + layer * 128 + e0), sw1 = *(const f32x4*)(a.in[20] + layer * 128 + e0 + 4);
    const float sw[8] = {sw0[0], sw0[1], sw0[2], sw0[3], sw1[0], sw1[1], sw1[2], sw1[3]};
#pragma unroll
    for (int r = 0; r < NR; ++r) { const size_t row = row0 + r * rstride;
        const unsigned a0[4] = {o0[r].x, o0[r].y, o0[r].z, o0[r].w}, a1[4] = {o1[r].x, o1[r].y, o1[r].z, o1[r].w}, ga[4] = {gv[r].x, gv[r].y, gv[r].z, gv[r].w};
        float v[8]; float ss = 0.f;
#pragma unroll
        for (int q = 0; q < 8; ++q) { const float x0 = (q & 1) ? bfhi(a0[q >> 1]) : bflo(a0[q >> 1]), x1 = (q & 1) ? bfhi(a1[q >> 1]) : bflo(a1[q >> 1]); v[q] = x0 - lam * x1; ss += v[q] * v[q]; }
        ss += __shfl_xor(ss, 1); ss += __shfl_xor(ss, 2); ss += __shfl_xor(ss, 4); ss += __shfl_xor(ss, 8);
        const float rs = post * __builtin_amdgcn_rsqf(ss * (1.f / 128.f) + EPS);
        float o[8];
#pragma unroll
        for (int q = 0; q < 8; ++q) { const float gq = (q & 1) ? bfhi(ga[q >> 1]) : bflo(ga[q >> 1]); o[q] = v[q] * rs * sw[q] * siluf(gq); }
        *(v4u*)((bf16*)(a.ws + WS_MIX) + row * 1024 + 512 + h * 128 + e0) = (v4u){pk2(o[0], o[1]), pk2(o[2], o[3]), pk2(o[4], o[5]), pk2(o[6], o[7])};
    }
}

__global__ void __launch_bounds__(NWAVES * 64, 2) hymba_fwd(Args args) {
    extern __shared__ __attribute__((aligned(16))) unsigned char lds_raw[];
    LAS unsigned char* lds = (LAS unsigned char*)lds_raw;
    cg::grid_group grid = cg::this_grid();
    int tid = threadIdx.x, lane = tid & 63, wave = __builtin_amdgcn_readfirstlane(tid >> 6);
#define RELAUNDER() do { int t_ = threadIdx.x; asm volatile("" : "+v"(t_)); tid = t_; lane = tid & 63; wave = __builtin_amdgcn_readfirstlane(tid >> 6); } while (0)
    const int G = gridDim.x, bx = blockIdx.x, vcu = (G % 8 == 0) ? (bx % 8) * (G / 8) + bx / 8 : bx;
    unsigned char* ws = args.ws;
    const int lo = args.ph_lo, hi = args.ph_hi;
    volatile LAS unsigned* MISC = (volatile LAS unsigned*)(lds + LDS_BYTES - 256);
    if (tid < 32) MISC[tid] = 0u;
    __syncthreads();
    unsigned* barw = (unsigned*)(ws + WS_CTL);
    XcdBarrier bar; bar.bar = barw; bar.x = 0; bar.st = MISC + 8;
    int ph = 0;
#ifndef MK_DIS
#define MK_DIS 0
#endif
#define EN(bit) (!((MK_DIS >> (bit)) & 1))
#ifndef MK_REP
#define MK_REP 0
#endif
#define REPS(bit) for (int rep_ = 0; rep_ < 1 + ((MK_REP >> (bit)) & 1); ++rep_)
#define IN(k) (lo <= (k) && (k) < hi)
#define SEAM() do { if (IN(ph) && IN(ph + 1)) { xcd_barrier(bar); if ((MK_REP >> 10) & 1) xcd_barrier(bar); } ++ph; RELAUNDER(); } while (0)
    bf16* PROJ = (bf16*)(ws + WS_PROJ); bf16* XN = (bf16*)(ws + WS_XN); bf16* MIX = (bf16*)(ws + WS_MIX);
    const int NGW = G * NWAVES;
#define gw (vcu * NWAVES + wave)

    const float** tabw = (const float**)(ws + WS_TAB);
    bar = xcd_barrier_post(barw, MISC + 8);
    if (IN(ph) && EN(0)) { if (bx == 0) {
            if (tid == 0) {
#pragma unroll
                for (int i = 0; i < 22; ++i) tabw[i] = args.in[i]; } }
        REPS(0) { __syncthreads(); prologue(args, lds, vcu, G, wave, lane); } }
    const PA pa{(const float* const*)tabw, args.out, ws};
    if (lo < 0) grid.sync();
    SEAM();
    for (int layer = 0; layer < DEPTH; ++layer) {
        if (IN(ph) && EN(1)) REPS(1) {
            pg8::Gemm g{(const bf16*)(ws + WS_HRES), (const bf16*)(ws + WS_WIN) + (size_t)layer * DIN * D, M, DIN, D}; pg8::StaticOrder S; S.init(M, DIN, G, bx);
            pg8::EpiInProj E{PROJ, (const float*)(ws + WS_ROPE), attn_body::C2, layer == 0 ? (const float*)(ws + WS_ROWSS0) : (const float*)(ws + WS_ROWSS), (unsigned*)(ws + WS_SUCNT) + layer * 64};
            pg8::gemm_phase<pg8::EpiInProj, pg8::StaticOrder, PG8_ALIGN, PG8_SP2>(lds, g, S, E);
            if (G == 256 && bx >= 128) {
                __syncthreads();
                if (wave == 0) { unsigned* sucnt = (unsigned*)(ws + WS_SUCNT) + layer * 64; unsigned spins = 0;
                    while ((unsigned)__builtin_amdgcn_readfirstlane(__hip_atomic_load(sucnt, __ATOMIC_RELAXED, __HIP_MEMORY_SCOPE_AGENT)) < 512u) { __builtin_amdgcn_s_sleep(4); if (++spins > (1u << 22)) break; }
                    __builtin_amdgcn_fence(__ATOMIC_ACQUIRE, "agent"); asm volatile("s_waitcnt vmcnt(0)" ::: "memory"); }
                __syncthreads();
                RELAUNDER();
                for (int it = (bx - 128) * NWAVES + wave; it < 2048; it += 128 * NWAVES) s5_item<false>(pa, lds, layer, it, wave, lane);
            }
        }
        SEAM();
        if (IN(ph)) {
            if (EN(2) && G != 256) REPS(2) for (int it = gw; it < 2048; it += NGW) s5_item<false>(pa, lds, layer, it, wave, lane);
            RELAUNDER();
            if (EN(3)) REPS(3) for (int v = vcu; v < 256; v += G) hgrn_pair<false>(pa, lds, layer, v >> 5, v & 31, wave, lane);
            xcd_barrier(bar);
            unsigned* scnt = (unsigned*)(ws + WS_SCNT) + layer * 64;
            { unsigned ndone = 0;
              if (wave < 2) { for (int t2 = wave * G + vcu; t2 < 512; t2 += 2 * G) { hgrn_scan(pa, t2, lane); ++ndone; } }
              else if (wave == 2) { for (int t2 = vcu; t2 < 32; t2 += G) { s5_scan(pa, layer, t2, lane); ++ndone; } }
              if (ndone) { asm volatile("s_waitcnt vmcnt(0)" ::: "memory"); if (lane == 0) (void)__hip_atomic_fetch_add(scnt, ndone, __ATOMIC_RELAXED, __HIP_MEMORY_SCOPE_AGENT); } }
            __syncthreads();
            const attn_body::AttnTensors AT{(const attn_body::bf16*)PROJ, (const attn_body::bf16*)PROJ, (const attn_body::bf16*)PROJ, (attn_body::bf16*)(ws + WS_O)};
            if (EN(4)) REPS(4) for (int v = vcu; v < 256; v += G) { const attn_body::StaticOrder S(v); attn_body::attn_phase<attn_body::StaticOrder>((char*)lds_raw, AT, S); }
        }
        ++ph; RELAUNDER();
        if (IN(ph)) {
            __syncthreads();
            if (wave == 0) { unsigned* scnt = (unsigned*)(ws + WS_SCNT) + layer * 64; unsigned spins = 0;
                while ((unsigned)__builtin_amdgcn_readfirstlane(__hip_atomic_load(scnt, __ATOMIC_RELAXED, __HIP_MEMORY_SCOPE_AGENT)) < 544u) { __builtin_amdgcn_s_sleep(4); if (++spins > (1u << 22)) break; }
                __builtin_amdgcn_fence(__ATOMIC_ACQUIRE, "agent"); asm volatile("s_waitcnt vmcnt(0)" ::: "memory"); }
            __syncthreads();
            if (EN(5)) REPS(5) for (int it = gw; it < 2048; it += NGW) s5_item<true>(pa, lds, layer, it, wave, lane);
            RELAUNDER();
            if (EN(6)) REPS(6) for (int v = vcu; v < 256; v += G) { const int bh = v >> 5, s = v & 31; const HRaw r1 = hgrn_load<true>(pa, bh, s, wave, lane), r2 = hgrn_load<true>(pa, bh, 63 - s, wave, lane); hgrn_item2<true>(pa, lds, layer, bh, s, wave, lane, r1); hgrn_item2<true>(pa, lds, layer, bh, 63 - s, wave, lane, r2); }
        }
        SEAM();
        const int cb0 = (G > 64) ? 64 : 0;
        if (IN(ph) && bx >= cb0) {
            const float l1 = wave_sum(pa.in[16][layer * 64 + lane] * pa.in[17][layer * 64 + lane]), l2 = wave_sum(pa.in[18][layer * 64 + lane] * pa.in[19][layer * 64 + lane]);
            const float linit = (layer == 0) ? 0.2f : 0.35550906759096934f;
            const float lam = __expf(l1) - __expf(l2) + linit;
            if (EN(7)) REPS(7) { const int nw_ = (G - cb0) * NWAVES; int m = (bx - cb0) * NWAVES + wave;
                for (; m + 3 * nw_ < M; m += 4 * nw_) combine_rows<4>(pa, layer, lam, 1.f - linit, (size_t)m, (size_t)nw_, lane);
                for (; m < M; m += nw_) combine_rows<1>(pa, layer, lam, 1.f - linit, (size_t)m, 0, lane); }
        }
        if (IN(ph) && EN(8) && (bx < 64 || G <= 64)) REPS(8) {
            __syncthreads();
            int kglu = 256; asm volatile("" : "+s"(kglu));
            pg8::Gemm g{(const bf16*)(ws + WS_YG), (const bf16*)(ws + WS_GLU) + (size_t)layer * 65536, M, 256, kglu}; pg8::StaticOrder S; S.init(M, 256, G, bx);
            pg8::EpiGlu E{(const bf16*)(ws + WS_YGS), pa.in[15] + layer * 256, MIX};
            pg8::gemm_phase<pg8::EpiGlu, pg8::StaticOrder, PG8_ALIGN, PG8_SP2>(lds, g, S, E);
        }
        SEAM();
        if (IN(ph) && EN(9)) for (int rep_ = 0; rep_ < 1 + (((MK_REP >> 9) & 1) && layer == 0); ++rep_) {
            pg8::Gemm g{MIX, (const bf16*)(ws + WS_WOUT) + (size_t)layer * D * D, M, D, D}; pg8::StaticOrder S; S.init(M, D, G, bx);
            if (layer + 1 < DEPTH) { pg8::EpiRes<true> E{nullptr, nullptr, (float*)(ws + WS_ROWSS), (const bf16*)(ws + WS_HRES), (bf16*)(ws + WS_HRES)};
                pg8::gemm_phase<pg8::EpiRes<true>, pg8::StaticOrder, PG8_ALIGN, PG8_SP2>(lds, g, S, E); }
            else if (G == 256) { pg8::EpiResFinal E{(const bf16*)(ws + WS_HRES), pa.out, (float*)(ws + WS_ROWSS2), (unsigned*)(ws + WS_PCNT), pa.in[21]};
                pg8::gemm_phase<pg8::EpiResFinal, pg8::StaticOrder, false, PG8_SP2>(lds, g, S, E); }
            else { pg8::EpiRes<false> E{nullptr, pa.out, nullptr, (const bf16*)(ws + WS_HRES), nullptr};
                pg8::gemm_phase<pg8::EpiRes<false>, pg8::StaticOrder, PG8_ALIGN, PG8_SP2>(lds, g, S, E); }
        }
        if (layer + 1 < DEPTH) { SEAM(); continue; }
        if (G == 256) break;
        SEAM();
        if (IN(ph)) {
            for (int m = gw; m < M; m += NGW) rms_row<true>(pa.out + (size_t)m * D, pa.in[21], nullptr, pa.out + (size_t)m * D, lane);
        }
    }
#undef IN
#undef SEAM
}
constexpr int N_PHASES = 1 + DEPTH * 5 + 1;

#ifndef MK_SPLIT
#define MK_SPLIT 0
#endif
extern "C" void kernel_launch(void* const* d_in, const int* in_sizes, int n_in, void* d_out, int out_size, void* d_ws, size_t ws_size, hipStream_t stream) {
    static int grid = 0;
    if (grid == 0) {
        if (n_in != 22 || in_sizes[0] != M * D || out_size != M * D || ws_size < WS_END) { fprintf(stderr, "kernel_launch: unexpected shapes (n_in %d, in0 %d, out %d, ws %zu)\n", n_in, n_in > 0 ? in_sizes[0] : -1, out_size, ws_size); grid = -1; return; }
        int dev = 0, cus = 0, per_cu = 0;
        hipGetDevice(&dev); hipDeviceGetAttribute(&cus, hipDeviceAttributeMultiprocessorCount, dev);
        hipFuncSetAttribute((const void*)hymba_fwd, hipFuncAttributeMaxDynamicSharedMemorySize, LDS_BYTES);
        hipOccupancyMaxActiveBlocksPerMultiprocessor(&per_cu, (const void*)hymba_fwd, NWAVES * 64, LDS_BYTES);
        (void)hipGetLastError();
        if (per_cu < 1) per_cu = 1;
        grid = cus * per_cu; if (grid > 256) grid = 256;
        fprintf(stderr, "kernel_launch: cus %d per_cu %d grid %d\n", cus, per_cu, grid);
    }
    if (grid < 0) return;
    Args a{};
    for (int i = 0; i < 22; ++i) a.in[i] = (const float*)d_in[i];
    a.out = (float*)d_out; a.ws = (unsigned char*)d_ws;
#if MK_SPLIT
    for (int p = 0; p < N_PHASES; ++p) { a.ph_lo = p; a.ph_hi = p + 1; hipLaunchKernelGGL(hymba_fwd, dim3(grid), dim3(NWAVES * 64), LDS_BYTES, stream, a); }
#else
    a.ph_lo = 0; a.ph_hi = N_PHASES;
    (void)hipMemsetAsync((char*)d_ws + WS_CTL, 0, 16384, stream);
    void* kargs[] = {&a};
    hipError_t e = hipLaunchCooperativeKernel((const void*)hymba_fwd, dim3(grid), dim3(NWAVES * 64), kargs, LDS_BYTES, stream);
    if (e != hipSuccess) fprintf(stderr, "cooperative launch failed: %s (grid %d)\n", hipGetErrorString(e), grid);
#endif
}
```

```cpp
#include <hip/hip_runtime.h>
#include <hip/hip_cooperative_groups.h>
#include <cstdio>
#include <cstdint>
namespace pg8 {
#define PG8_LAS __attribute__((address_space(3)))
typedef unsigned short bf16_t;
typedef short bf16x8 __attribute__((ext_vector_type(8)));
typedef float f32x4 __attribute__((ext_vector_type(4)));
typedef unsigned u32x4 __attribute__((ext_vector_type(4)));
constexpr int BM = 256, BK = 64, HALF = 128, HTB = HALF * BK * 2  , STAGE_BYTES = 8 * HTB, NXCD = 8, WGM = 8;

__host__ __device__ __forceinline__ int lds_byte(int r, int c) { const int st = (r >> 4) * 2 + (c >> 5), rr = r & 15, cc = c & 31, ob = rr * 64 + cc * 2; return st * 1024 + (ob ^ (((ob >> 9) & 1) << 5)); }
__host__ __device__ __forceinline__ void stage_rc(int b, int& R, int& C) { const int st = b / 1024, sb = b % 1024, swz = sb ^ (((sb >> 9) & 1) << 5); R = (st >> 1) * 16 + swz / 64; C = (st & 1) * 32 + (swz % 64) / 2; }
__host__ __device__ __forceinline__ int perm32(int rho) { const int n = rho >> 4, i = rho & 15; return 8 * (i >> 2) + 4 * n + (i & 3); }

struct Unit { int pm, pn; };
struct Gemm { const bf16_t* A; const bf16_t* Bt; int M, N, K; };

struct StaticOrder {
    int nM, nN, nwg, G, c;
    __host__ __device__ void init(int M, int N, int G_, int c_) { nM = M / BM; nN = N / BM; nwg = nM * nN; G = G_; c = c_; }
    __host__ __device__ bool next(int i, Unit& u) const {
        const long L = (long)i * G + c; if (L >= nwg) return false;
        int wgid = (int)L; { const int q = nwg / NXCD, r = nwg % NXCD, xcd = wgid % NXCD, off = wgid / NXCD; wgid = (xcd < r ? xcd * (q + 1) : r * (q + 1) + (xcd - r) * q) + off; }
        const int nig = WGM * nN, gid = wgid / nig, fm = gid * WGM, gsz = (nM - fm) < WGM ? (nM - fm) : WGM;
        u.pm = fm + ((wgid % nig) % gsz); u.pn = (wgid % nig) / gsz; return true;
    }
    __device__ __forceinline__ void a_ready(const Unit&) const {}
    __device__ __forceinline__ void done(const Unit&) const {}
};

__device__ __forceinline__ unsigned cvt_pk_bf16(float lo, float hi) { unsigned r; asm volatile("v_cvt_pk_bf16_f32 %0, %1, %2" : "=v"(r) : "v"(lo), "v"(hi)); return r; }
typedef float f32x2 __attribute__((ext_vector_type(2)));
__device__ __forceinline__ f32x2 gelu_pk(f32x2 v) {
    const f32x2 av = __builtin_elementwise_abs(v), d = av * 0.2316418882f + 1.0f;
    f32x2 t; t.x = __builtin_amdgcn_rcpf(d.x); t.y = __builtin_amdgcn_rcpf(d.y);
    f32x2 q = t * 0.5307027145f + (-0.7265760135f); q = q * t + 0.7107068705f; q = q * t + (-0.142248368f); q = q * t + 0.127414796f; q = q * t;
    const f32x2 s = (v * v) * (-0.72134752044f);
    f32x2 e; e.x = __builtin_amdgcn_exp2f(s.x); e.y = __builtin_amdgcn_exp2f(s.y);
    const f32x2 m = v * (q * e), r = v - m;
    f32x2 o; o.x = v.x < 0.f ? m.x : r.x; o.y = v.y < 0.f ? m.y : r.y; return o;
}

template <int ACT  > struct EpiBf16 {
    static constexpr bool PERM = true, AFTER_DRAIN = false; static_assert(ACT == 0 || ACT == 1, "EpiBf16: ACT is 0 (none) or 1 (gelu_pk)");
    bf16_t* O; int ldc; const float* bias; int split_cols; size_t split_stride; float scale0;
    __device__ __forceinline__ void operator()(const f32x4 (&acc)[2][2][4][2], const Unit& u, int wr, int wc, int fr, int fq) const {
        const int row0 = u.pm * BM + wr * 64 + fr; int colt = u.pn * BM; bf16_t* base = O;
        float sc = 1.f; if (split_cols) { const int t = colt / split_cols; base += (size_t)t * split_stride; colt -= t * split_cols; if (t == 0) sc = scale0; }
        const int col0 = colt + wc * 32 + 8 * fq, bcol0 = u.pn * BM + wc * 32 + 8 * fq;
        f32x4 bv[2][2];
#pragma unroll
        for (int bj = 0; bj < 2; ++bj)
#pragma unroll
            for (int n = 0; n < 2; ++n) bv[bj][n] = bias ? *(const f32x4*)(bias + bcol0 + bj * HALF + 4 * n) : (f32x4){0.f, 0.f, 0.f, 0.f};
#pragma unroll
        for (int ai = 0; ai < 2; ++ai)
#pragma unroll
            for (int m = 0; m < 4; ++m) { bf16_t* rowp = base + (size_t)(row0 + ai * HALF + m * 16) * ldc + col0;
#pragma unroll
                for (int bj = 0; bj < 2; ++bj) { f32x4 v0 = acc[ai][bj][m][0] + bv[bj][0], v1 = acc[ai][bj][m][1] + bv[bj][1];
                    if (ACT == 1) { f32x2 a = gelu_pk((f32x2){v0[0], v0[1]}), b = gelu_pk((f32x2){v0[2], v0[3]}), c = gelu_pk((f32x2){v1[0], v1[1]}), d = gelu_pk((f32x2){v1[2], v1[3]});
                        v0 = (f32x4){a.x, a.y, b.x, b.y}; v1 = (f32x4){c.x, c.y, d.x, d.y}; }
                    v0 = v0 * sc; v1 = v1 * sc; u32x4 w; w.x = cvt_pk_bf16(v0[0], v0[1]); w.y = cvt_pk_bf16(v0[2], v0[3]); w.z = cvt_pk_bf16(v1[0], v1[1]); w.w = cvt_pk_bf16(v1[2], v1[3]);
                    *(u32x4*)(rowp + bj * HALF) = w; } }
    }
};
__device__ __forceinline__ float bf2f(unsigned short h) { return __uint_as_float(((unsigned)h) << 16); }
#define WT_RSRC(base, bytes) __builtin_amdgcn_make_buffer_rsrc((void*)(base), 0, (int)(bytes), 0x00020000)
#define WT_ST16(rsrc, byteoff, v) __builtin_amdgcn_raw_buffer_store_b128((v), (rsrc), (unsigned)(byteoff), 0, 16)
__device__ __forceinline__ float sigm(float v) { return __builtin_amdgcn_rcpf(1.0f + __builtin_amdgcn_exp2f(-1.4426950408889634f * v)); }
struct EpiInProj {
    static constexpr bool PERM = true, AFTER_DRAIN = false;
    bf16_t* O; const float* rope; float qscale; const float* rowss; unsigned* sucnt;
    __device__ __forceinline__ void operator()(const f32x4 (&acc)[2][2][4][2], const Unit& u, int wr, int wc, int fr, int fq) const {
        const int row0 = u.pm * BM + wr * 64 + fr, col0 = u.pn * BM + wc * 32 + 8 * fq;
        const bool ropewave = (u.pn >= 6 && u.pn < 10) && ((wc & 1) == 0);
        const float sc = (u.pn == 6 || u.pn == 7) ? qscale : 1.f;
        const float sgn = (fq == 0) ? -1.f : 1.f;
        const bool pub = (u.pn == 4);
        const __amdgpu_buffer_rsrc_t orsrc = WT_RSRC(O, 16384u * 3584u * 2u);
#pragma unroll
        for (int ai = 0; ai < 2; ++ai)
#pragma unroll
            for (int m = 0; m < 4; ++m) {
                const int row = row0 + ai * HALF + m * 16;
                bf16_t* rowp = O + (size_t)row * 3584 + col0;
                const float scr = rowss ? sc * __builtin_amdgcn_rsqf(rowss[row] * (1.0f / 1024.0f) + 1e-6f) : sc;
                f32x4 cs[4];
                if (ropewave) { const float* rp = rope + (size_t)(row & 8191) * 16;
#pragma unroll
                    for (int k = 0; k < 4; ++k) cs[k] = *(const f32x4*)(rp + 4 * k); }
#pragma unroll
                for (int bj = 0; bj < 2; ++bj) {
                    f32x4 v0 = acc[ai][bj][m][0], v1 = acc[ai][bj][m][1];
                    if (ropewave) {
                        float v[8] = {v0[0], v0[1], v0[2], v0[3], v1[0], v1[1], v1[2], v1[3]};
#pragma unroll
                        for (int j = 0; j < 8; ++j) {
                            const float p = __shfl_xor(v[j], 16);
                            const float c = cs[j >> 1][(j & 1) * 2], s = cs[j >> 1][(j & 1) * 2 + 1];
                            const float nv = v[j] * c + sgn * p * s;
                            v[j] = (fq < 2) ? nv : v[j];
                        }
                        v0 = (f32x4){v[0], v[1], v[2], v[3]}; v1 = (f32x4){v[4], v[5], v[6], v[7]};
                    }
                    v0 = v0 * scr; v1 = v1 * scr;
                    u32x4 w; w.x = cvt_pk_bf16(v0[0], v0[1]); w.y = cvt_pk_bf16(v0[2], v0[3]); w.z = cvt_pk_bf16(v1[0], v1[1]); w.w = cvt_pk_bf16(v1[2], v1[3]);
                    if (pub) WT_ST16(orsrc, ((size_t)row * 3584 + col0 + bj * HALF) * 2, w); else *(u32x4*)(rowp + bj * HALF) = w;
                }
                asm volatile("" ::: "memory");
            }
        if (pub) { asm volatile("s_waitcnt vmcnt(0)" ::: "memory"); if (fr == 0 && fq == 0) (void)__hip_atomic_fetch_add(sucnt, 1u, __ATOMIC_RELAXED, __HIP_MEMORY_SCOPE_AGENT); }
    }
};
template <bool NEXT> struct EpiRes {
    static constexpr bool PERM = false, AFTER_DRAIN = false;
    const float* base; float* out; float* rowss; const bf16_t* baseh; bf16_t* XN;
    __device__ __forceinline__ void operator()(const f32x4 (&acc)[2][2][4][2], const Unit& u, int wr, int wc, int fr, int fq) const {
        typedef unsigned u32x2 __attribute__((ext_vector_type(2)));
        const int col0 = u.pn * BM + wc * 32 + 4 * fq;
#pragma unroll
        for (int ai = 0; ai < 2; ++ai)
#pragma unroll
            for (int m = 0; m < 4; ++m) {
                const int row = u.pm * BM + ai * HALF + wr * 64 + m * 16 + fr;
                const size_t off = (size_t)row * 1024 + col0;
                float ss = 0.f;
#pragma unroll
                for (int bj = 0; bj < 2; ++bj)
#pragma unroll
                    for (int n = 0; n < 2; ++n) {
                        f32x4 bs;
                        { const u32x2 hb = *(const u32x2*)(baseh + off + bj * HALF + n * 16); bs = (f32x4){__uint_as_float(hb.x << 16), __uint_as_float(hb.x & 0xffff0000u), __uint_as_float(hb.y << 16), __uint_as_float(hb.y & 0xffff0000u)}; }
                        const f32x4 o = bs + acc[ai][bj][m][n];
                        if (NEXT) { ss += (o[0] * o[0] + o[1] * o[1]) + (o[2] * o[2] + o[3] * o[3]);
                            u32x2 w; w.x = cvt_pk_bf16(o[0], o[1]); w.y = cvt_pk_bf16(o[2], o[3]); *(u32x2*)(XN + off + bj * HALF + n * 16) = w; }
                        else *(f32x4*)(out + off + bj * HALF + n * 16) = o;
                    }
                if (NEXT) { ss += __shfl_xor(ss, 16); ss += __shfl_xor(ss, 32); if (fq == 0) atomicAdd(rowss + row, ss); }
                if (m & 1) asm volatile("" ::: "memory");
            }
    }
};
struct EpiResFinal {
    static constexpr bool PERM = false, AFTER_DRAIN = true;
    const bf16_t* baseh; float* out; float* rowss2; unsigned* cnt; const float* fw;
    __device__ __forceinline__ void operator()(const f32x4 (&)[2][2][4][2], const Unit&, int, int, int, int) const {}
    __device__ __forceinline__ void fused(f32x4 (&acc)[2][2][4][2], const Unit& u, int wr, int wc, int fr, int fq, PG8_LAS unsigned char*, int wid, int lane) const {
        typedef unsigned u32x2 __attribute__((ext_vector_type(2)));
        const int col0 = u.pn * BM + wc * 32 + 4 * fq;
#pragma unroll
        for (int ai = 0; ai < 2; ++ai)
#pragma unroll
            for (int m = 0; m < 4; ++m) {
                const int row = u.pm * BM + ai * HALF + wr * 64 + m * 16 + fr;
                const size_t off = (size_t)row * 1024 + col0;
                float ss = 0.f;
#pragma unroll
                for (int bj = 0; bj < 2; ++bj)
#pragma unroll
                    for (int n = 0; n < 2; ++n) { const u32x2 hb = *(const u32x2*)(baseh + off + bj * HALF + n * 16);
                        const f32x4 o = (f32x4){__uint_as_float(hb.x << 16), __uint_as_float(hb.x & 0xffff0000u), __uint_as_float(hb.y << 16), __uint_as_float(hb.y & 0xffff0000u)} + acc[ai][bj][m][n]; acc[ai][bj][m][n] = o;
                        ss += (o[0] * o[0] + o[1] * o[1]) + (o[2] * o[2] + o[3] * o[3]); }
                ss += __shfl_xor(ss, 16); ss += __shfl_xor(ss, 32);
                if (fq == 0) (void)__hip_atomic_fetch_add(rowss2 + row, ss, __ATOMIC_RELAXED, __HIP_MEMORY_SCOPE_AGENT);
                if (m & 1) asm volatile("" ::: "memory");
            }
        asm volatile("s_waitcnt vmcnt(0)" ::: "memory");
        __builtin_amdgcn_s_barrier(); asm volatile("" ::: "memory");
        if (wid == 0) {
            if (lane == 0) (void)__hip_atomic_fetch_add(cnt + u.pm, 1u, __ATOMIC_RELAXED, __HIP_MEMORY_SCOPE_AGENT);
            unsigned spins = 0;
            while ((unsigned)__builtin_amdgcn_readfirstlane(__hip_atomic_load(cnt + u.pm, __ATOMIC_RELAXED, __HIP_MEMORY_SCOPE_AGENT)) < 4u) { __builtin_amdgcn_s_sleep(4); if (++spins > (1u << 20)) break; }
            __builtin_amdgcn_fence(__ATOMIC_ACQUIRE, "agent");
            asm volatile("s_waitcnt vmcnt(0)" ::: "memory");
        }
        __builtin_amdgcn_s_barrier(); asm volatile("" ::: "memory");
        f32x4 wv[2][2];
#pragma unroll
        for (int bj = 0; bj < 2; ++bj)
#pragma unroll
            for (int n = 0; n < 2; ++n) wv[bj][n] = *(const f32x4*)(fw + col0 + bj * HALF + n * 16);
#pragma unroll
        for (int ai = 0; ai < 2; ++ai)
#pragma unroll
            for (int m = 0; m < 4; ++m) {
                const int row = u.pm * BM + ai * HALF + wr * 64 + m * 16 + fr;
                const size_t off = (size_t)row * 1024 + col0;
                const float rs = __builtin_amdgcn_rsqf(__hip_atomic_load(rowss2 + row, __ATOMIC_RELAXED, __HIP_MEMORY_SCOPE_AGENT) * (1.0f / 1024.0f) + 1e-6f);
#pragma unroll
                for (int bj = 0; bj < 2; ++bj)
#pragma unroll
                    for (int n = 0; n < 2; ++n) *(f32x4*)(out + off + bj * HALF + n * 16) = acc[ai][bj][m][n] * rs * wv[bj][n];
            }
    }
};
struct EpiGlu {
    static constexpr bool PERM = true, AFTER_DRAIN = false;
    const bf16_t* YGS; const float* bias; bf16_t* MIX;
    __device__ __forceinline__ void operator()(const f32x4 (&acc)[2][2][4][2], const Unit& u, int wr, int wc, int fr, int fq) const {
        typedef unsigned u32x2 __attribute__((ext_vector_type(2)));
        const int row0 = u.pm * BM + wr * 64 + fr, col0 = wc * 32 + 8 * fq;
#pragma unroll
        for (int bj = 0; bj < 2; ++bj)
#pragma unroll
            for (int n = 0; n < 2; ++n) {
                const int c = col0 + bj * HALF + 4 * n;
                const f32x4 bv = *(const f32x4*)(bias + c);
#pragma unroll
                for (int ai = 0; ai < 2; ++ai)
#pragma unroll
                    for (int m = 0; m < 4; ++m) {
                        const size_t row = (size_t)(row0 + ai * HALF + m * 16);
                        const f32x4 v = acc[ai][bj][m][n] + bv;
                        const u32x2 yv = *(const u32x2*)(YGS + row * 256 + c);
                        const float y0 = __uint_as_float(yv.x << 16), y1 = __uint_as_float(yv.x & 0xffff0000u), y2 = __uint_as_float(yv.y << 16), y3 = __uint_as_float(yv.y & 0xffff0000u);
                        u32x2 w; w.x = cvt_pk_bf16(y0 * sigm(v[0]), y1 * sigm(v[1])); w.y = cvt_pk_bf16(y2 * sigm(v[2]), y3 * sigm(v[3]));
                        *(u32x2*)(MIX + row * 1024 + 256 + c) = w;
                        if (m & 1) asm volatile("" ::: "memory");
                    }
            }
    }
};
template <class Epi, class Sched, bool ALIGN_EPI = false, bool SP2 = false>
__device__ __forceinline__ void gemm_phase(PG8_LAS unsigned char* lds, const Gemm g, const Sched& S, const Epi& E) {
    int tid_l = threadIdx.x; asm volatile("" : "+v"(tid_l));
    const int tid = tid_l, wid = __builtin_amdgcn_readfirstlane(tid >> 6), lane = tid & 63, wr = wid >> 2, wc = wid & 3, fr = lane & 15, fq = lane >> 4;
    const int K = g.K, nt = K / BK;
    unsigned voffA[2], voffB[2];
#pragma unroll
    for (int i = 0; i < 2; ++i) { int R, C; stage_rc(tid * 16 + i * 8192, R, C); const int Rb = Epi::PERM ? ((R & ~31) + perm32(R & 31)) : R;
        voffA[i] = (unsigned)(R * K + C) * 2u; voffB[i] = (unsigned)(Rb * K + C) * 2u; }
    const size_t kstep = (size_t)(BK * 2);
    const size_t hstep = (size_t)HALF * K * 2;
    const size_t tstep = 2 * hstep;
    const unsigned ldsw = (unsigned)wid * 1024u;
    const int aoff = lds_byte(wr * 64 + fr, fq * 8), boff = lds_byte(wc * 32 + fr, fq * 8);
#define PG8_SA(b, h) (((b) * 2 + (h)) * HTB)
#define PG8_SB(b, h) ((4 + (b) * 2 + (h)) * HTB)
#define PG8_STAGE(bufoff, gbase, voff) do { _Pragma("unroll") for (int _i = 0; _i < 2; ++_i) \
        __builtin_amdgcn_global_load_lds((const unsigned*)((const char*)(gbase) + (voff)[_i]), (PG8_LAS unsigned*)(lds + (bufoff) + ldsw + _i * 8192), 16, 0, 0); } while (0)
#define PG8_LDA(dst, b, h) do { _Pragma("unroll") for (int m = 0; m < 4; ++m) _Pragma("unroll") for (int k = 0; k < 2; ++k) dst[m][k] = *(const PG8_LAS bf16x8*)(lds + PG8_SA(b, h) + aoff + m * 2048 + k * 1024); } while (0)
#define PG8_LDB(dst, b, h) do { _Pragma("unroll") for (int n = 0; n < 2; ++n) _Pragma("unroll") for (int k = 0; k < 2; ++k) dst[n][k] = *(const PG8_LAS bf16x8*)(lds + PG8_SB(b, h) + boff + n * 2048 + k * 1024); } while (0)
#define PG8_MMA(ai, bj, At, Bt) do { __builtin_amdgcn_s_setprio(1); _Pragma("unroll") for (int m = 0; m < 4; ++m) _Pragma("unroll") for (int n = 0; n < 2; ++n) _Pragma("unroll") for (int k = 0; k < 2; ++k) \
        acc[ai][bj][m][n] = __builtin_amdgcn_mfma_f32_16x16x32_bf16(Bt[n][k], At[m][k], acc[ai][bj][m][n], 0, 0, 0); __builtin_amdgcn_s_setprio(0); } while (0)
#define PG8_WAIT_V(n) asm volatile("s_waitcnt vmcnt(" #n ")" ::: "memory")
#define PG8_WAIT_L(n) asm volatile("s_waitcnt lgkmcnt(" #n ")" ::: "memory")
#define PG8_BAR __builtin_amdgcn_s_barrier()
#define PG8_SCHED __builtin_amdgcn_sched_barrier(0)
    Unit cur, nxt; int ui = 0;
    if (!S.next(0, cur)) return;
    f32x4 acc[2][2][4][2];
#pragma unroll
    for (int a = 0; a < 2; ++a)
#pragma unroll
        for (int b = 0; b < 2; ++b)
#pragma unroll
            for (int m = 0; m < 4; ++m)
#pragma unroll
                for (int n = 0; n < 2; ++n) acc[a][b][m][n] = (f32x4){0.f, 0.f, 0.f, 0.f};
    bf16x8 At[4][2], B0[2][2], B1[2][2];
    const char* cA = (const char*)g.A + (size_t)cur.pm * tstep; const char* cB = (const char*)g.Bt + (size_t)cur.pn * tstep;
    S.a_ready(cur);
    if constexpr (SP2) {
        PG8_STAGE(PG8_SB(0, 0), cB, voffB); PG8_STAGE(PG8_SB(0, 1), cB + hstep, voffB); PG8_STAGE(PG8_SA(0, 0), cA, voffA); PG8_STAGE(PG8_SA(0, 1), cA + hstep, voffA);
        if (wr == 1) PG8_BAR;
        PG8_WAIT_V(2); PG8_BAR;
        PG8_STAGE(PG8_SB(1, 0), cB + kstep, voffB); PG8_STAGE(PG8_SA(1, 0), cA + kstep, voffA); PG8_STAGE(PG8_SB(1, 1), cB + hstep + kstep, voffB);
        PG8_WAIT_V(6); PG8_BAR;
    } else {
        PG8_STAGE(PG8_SB(0, 0), cB, voffB); PG8_STAGE(PG8_SA(0, 0), cA, voffA); PG8_STAGE(PG8_SB(0, 1), cB + hstep, voffB); PG8_STAGE(PG8_SA(0, 1), cA + hstep, voffA);
        if (wr == 1) PG8_BAR;
        PG8_WAIT_V(4); PG8_BAR;
        PG8_STAGE(PG8_SB(1, 0), cB + kstep, voffB); PG8_STAGE(PG8_SA(1, 0), cA + kstep, voffA); PG8_STAGE(PG8_SB(1, 1), cB + hstep + kstep, voffB);
        PG8_WAIT_V(6); PG8_BAR;
    }
    for (;;) {
        const bool has_next = S.next(ui + 1, nxt);
        const char* nA = has_next ? (const char*)g.A + (size_t)nxt.pm * tstep : cA; const char* nB = has_next ? (const char*)g.Bt + (size_t)nxt.pn * tstep : cB;
        for (int t = 0; t < nt; t += 2) {
            const bool last = (t == nt - 2);
            const char* a1 = cA + (size_t)(t + 1) * kstep;
            const char* a2 = last ? nA : cA + (size_t)(t + 2) * kstep; const char* b2 = last ? nB : cB + (size_t)(t + 2) * kstep;
            const char* a3 = a2 + kstep; const char* b3 = b2 + kstep;
            if (last && has_next) S.a_ready(nxt);
            if constexpr (SP2) {
            PG8_LDB(B0, 0, 0); PG8_LDB(B1, 0, 1); PG8_SCHED; PG8_LDA(At, 0, 0); PG8_STAGE(PG8_SA(1, 1), a1 + hstep, voffA);
            PG8_WAIT_V(8); PG8_WAIT_L(0); PG8_BAR; PG8_MMA(0, 0, At, B0); PG8_MMA(0, 1, At, B1); PG8_BAR; PG8_SCHED;
            PG8_LDA(At, 0, 1); PG8_STAGE(PG8_SB(0, 0), b2, voffB); PG8_STAGE(PG8_SB(0, 1), b2 + hstep, voffB); PG8_STAGE(PG8_SA(0, 0), a2, voffA);
            PG8_WAIT_V(8); PG8_WAIT_L(0); PG8_BAR; PG8_MMA(1, 0, At, B0); PG8_MMA(1, 1, At, B1); PG8_BAR; PG8_SCHED;
            PG8_LDB(B0, 1, 0); PG8_LDB(B1, 1, 1); PG8_SCHED; PG8_LDA(At, 1, 0); PG8_STAGE(PG8_SA(0, 1), a2 + hstep, voffA);
            PG8_WAIT_V(8); PG8_WAIT_L(0); PG8_BAR; PG8_MMA(0, 0, At, B0); PG8_MMA(0, 1, At, B1); PG8_BAR; PG8_SCHED;
            PG8_LDA(At, 1, 1); PG8_STAGE(PG8_SB(1, 0), b3, voffB); PG8_STAGE(PG8_SB(1, 1), b3 + hstep, voffB); PG8_STAGE(PG8_SA(1, 0), a3, voffA);
            PG8_WAIT_V(8); PG8_WAIT_L(0); PG8_BAR; PG8_MMA(1, 0, At, B0); PG8_MMA(1, 1, At, B1); PG8_BAR; PG8_SCHED;
            } else {
            PG8_LDB(B0, 0, 0); PG8_SCHED; PG8_LDA(At, 0, 0); PG8_STAGE(PG8_SA(1, 1), a1 + hstep, voffA);
            PG8_WAIT_L(8); PG8_BAR; PG8_WAIT_L(0); PG8_MMA(0, 0, At, B0); PG8_BAR; PG8_SCHED;
            PG8_LDB(B1, 0, 1); PG8_STAGE(PG8_SB(0, 0), b2, voffB);
            PG8_BAR; PG8_WAIT_L(0); PG8_MMA(0, 1, At, B1); PG8_BAR;
            PG8_LDA(At, 0, 1); PG8_STAGE(PG8_SA(0, 0), a2, voffA);
            PG8_BAR; PG8_WAIT_L(0); PG8_MMA(1, 0, At, B0); PG8_BAR; PG8_SCHED;
            PG8_STAGE(PG8_SB(0, 1), b2 + hstep, voffB);
            PG8_WAIT_V(6); PG8_BAR; PG8_MMA(1, 1, At, B1); PG8_BAR;
            PG8_LDB(B0, 1, 0); PG8_SCHED; PG8_LDA(At, 1, 0); PG8_STAGE(PG8_SA(0, 1), a2 + hstep, voffA);
            PG8_WAIT_L(8); PG8_BAR; PG8_WAIT_L(0); PG8_MMA(0, 0, At, B0); PG8_BAR; PG8_SCHED;
            PG8_LDB(B1, 1, 1); PG8_STAGE(PG8_SB(1, 0), b3, voffB);
            PG8_BAR; PG8_WAIT_L(0); PG8_MMA(0, 1, At, B1); PG8_BAR;
            PG8_LDA(At, 1, 1); PG8_STAGE(PG8_SA(1, 0), a3, voffA);
            PG8_BAR; PG8_WAIT_L(0); PG8_MMA(1, 0, At, B0); PG8_BAR; PG8_SCHED;
            PG8_STAGE(PG8_SB(1, 1), b3 + hstep, voffB);
            PG8_WAIT_V(6); PG8_BAR; PG8_MMA(1, 1, At, B1); PG8_BAR;
            }
        }
        if constexpr (ALIGN_EPI) { if (wr == 0) PG8_BAR; }
        if constexpr (!Epi::AFTER_DRAIN) { E(acc, cur, wr, wc, fr, fq); S.done(cur); }
        if (!has_next) break;
#pragma unroll
        for (int a = 0; a < 2; ++a)
#pragma unroll
            for (int b = 0; b < 2; ++b)
#pragma unroll
                for (int m = 0; m < 4; ++m)
#pragma unroll
                    for (int n = 0; n < 2; ++n) acc[a][b][m][n] = (f32x4){0.f, 0.f, 0.f, 0.f};
        cur = nxt; cA = nA; cB = nB; ++ui;
        if constexpr (ALIGN_EPI) { if (wr == 1) PG8_BAR; }
    }
    PG8_WAIT_V(0);
    if constexpr (!ALIGN_EPI) { if (wr == 0) PG8_BAR; }
    PG8_BAR;
    if constexpr (Epi::AFTER_DRAIN) { E.fused(acc, cur, wr, wc, fr, fq, lds, wid, lane); S.done(cur); }
#undef PG8_SA
#undef PG8_SB
#undef PG8_STAGE
#undef PG8_LDA
#undef PG8_LDB
#undef PG8_MMA
#undef PG8_WAIT_V
#undef PG8_WAIT_L
#undef PG8_BAR
#undef PG8_SCHED
}
}

#ifndef PG8_SP2
#define PG8_SP2 true
#endif
#ifndef PG8_ALIGN
#define PG8_ALIGN true
#endif
#include <hip/hip_bf16.h>
#include <cmath>
namespace attn_body {
using bf16=__hip_bfloat16;
using bf16x8=__attribute__((ext_vector_type(8)))short;
using s16x4=__attribute__((ext_vector_type(4)))short;
using f32x16=__attribute__((ext_vector_type(16)))float;
using u32x4=__attribute__((ext_vector_type(4)))unsigned;
constexpr int BATCH=2,NHEAD=16,SEQ=8192,D=64,DM=NHEAD*D;
constexpr int NW=8,QBLK=32,QB=QBLK*NW,KVBLK=64,NQB=SEQ/QB;
constexpr int ATTN_PITCH=DM, ATTN_UNIT_ROWS=QB;
constexpr int PQ=3584,QCOL=1536,KCOL=2048,VCOL=2560;
__device__ __forceinline__ int crow(int r,int hi){return (r&3)+8*(r>>2)+4*hi;}
#define SBAR() __builtin_amdgcn_sched_barrier(0)
__device__ __forceinline__ void cmask(f32x16&p0,f32x16&p1,int jb,int qrel,int hi){
  const float NEG=-INFINITY; int kb=64*jb+4*hi;
  #pragma unroll
  for(int r=0;r<16;++r){int kv=kb+(r&3)+8*(r>>2); if(kv>qrel)p0[r]=NEG; if(kv+32>qrel)p1[r]=NEG;}
}

constexpr int NSLOT=3, SLOTB=8192;
constexpr int LDS_K=0, LDS_V=NSLOT*SLOTB, LDS_WS=3*NSLOT*SLOTB, LDS_OST=LDS_WS+NW*64*4, LDS_BYTES=LDS_OST+NW*4096;
constexpr float C2=0.125f*1.4426950408889634f;
__device__ __forceinline__ void glds16(const void*gsrc,unsigned lds_dst){unsigned keep;
  asm volatile("s_mov_b32 %0, m0\n\ts_mov_b32 m0, %2\n\ts_nop 0\n\tglobal_load_lds_dwordx4 %1, off\n\ts_mov_b32 m0, %0":"=&s"(keep):"v"(gsrc),"s"(lds_dst):"memory");}
__device__ __forceinline__ float max3f(float a,float b,float c){float r;asm("v_max3_f32 %0, %1, %2, %3":"=v"(r):"v"(a),"v"(b),"v"(c));return r;}
__device__ __forceinline__ float max2f(float a,float b){float r;asm("v_max_f32_e32 %0, %1, %2":"=v"(r):"v"(a),"v"(b));return r;}
__device__ __forceinline__ float fadd_s(float a,float b){float r;asm("v_add_f32_e32 %0, %1, %2":"=v"(r):"v"(a),"v"(b));return r;}
__device__ __forceinline__ float fsub_s(float a,float b){float r;asm("v_sub_f32_e32 %0, %1, %2":"=v"(r):"v"(a),"v"(b));return r;}
typedef float f32x2_t __attribute__((ext_vector_type(2))); typedef __bf16 bf16x2_t __attribute__((ext_vector_type(2)));
__device__ __forceinline__ unsigned cvtpk_s(float lo,float hi){f32x2_t v={lo,hi};bf16x2_t b=__builtin_convertvector(v,bf16x2_t);return __builtin_bit_cast(unsigned,b);}
#define WAIT_BAR(N) asm volatile("s_waitcnt vmcnt(" #N ") lgkmcnt(0)\n\ts_barrier":::"memory")

__device__ __forceinline__ void qkt(f32x16&p0,f32x16&p1,const char*Kslot,const bf16x8*qr,const f32x16&negm,int r32,int hi){
  const char*kb=Kslot+hi*1024+r32*16;
  #pragma unroll
  for(int d0=0;d0<4;++d0){
    const bf16x8 b0=*reinterpret_cast<const bf16x8*>(kb+d0*2048);
    const bf16x8 b1=*reinterpret_cast<const bf16x8*>(kb+d0*2048+512);
    if(d0==0){p0=__builtin_amdgcn_mfma_f32_32x32x16_bf16(b0,qr[0],negm,0,0,0);p1=__builtin_amdgcn_mfma_f32_32x32x16_bf16(b1,qr[0],negm,0,0,0);}
    else{p0=__builtin_amdgcn_mfma_f32_32x32x16_bf16(b0,qr[d0],p0,0,0,0);p1=__builtin_amdgcn_mfma_f32_32x32x16_bf16(b1,qr[d0],p1,0,0,0);}}
}
typedef __attribute__((address_space(3))) const char* lds_cptr;
typedef short v4i16_t __attribute__((ext_vector_type(4)));
__device__ __forceinline__ void kload8(bf16x8*kf,lds_cptr kp){
  kf[0]=*(const __attribute__((address_space(3))) bf16x8*)(kp);      kf[1]=*(const __attribute__((address_space(3))) bf16x8*)(kp+512);
  kf[2]=*(const __attribute__((address_space(3))) bf16x8*)(kp+2048); kf[3]=*(const __attribute__((address_space(3))) bf16x8*)(kp+2560);
  kf[4]=*(const __attribute__((address_space(3))) bf16x8*)(kp+4096); kf[5]=*(const __attribute__((address_space(3))) bf16x8*)(kp+4608);
  kf[6]=*(const __attribute__((address_space(3))) bf16x8*)(kp+6144); kf[7]=*(const __attribute__((address_space(3))) bf16x8*)(kp+6656);
}
__device__ __forceinline__ void kload2(bf16x8*kf,lds_cptr kp,int j){ kf[2*j]=*(const __attribute__((address_space(3))) bf16x8*)(kp+j*2048); kf[2*j+1]=*(const __attribute__((address_space(3))) bf16x8*)(kp+j*2048+512); }
__device__ __forceinline__ s16x4 vtr(lds_cptr p){ return __builtin_bit_cast(s16x4,__builtin_amdgcn_ds_read_tr16_b64_v4i16((__attribute__((address_space(3))) v4i16_t*)p)); }
__device__ __forceinline__ float rowmax(const f32x16&p0,const f32x16&p1){
  float a=max3f(p0[0],p0[1],p1[0]),b=max3f(p0[2],p0[3],p1[1]);a=max3f(a,p1[2],p1[3]);
  #pragma unroll
  for(int r=4;r<16;r+=4){a=max3f(a,p0[r],p0[r+1]);b=max3f(b,p0[r+2],p0[r+3]);a=max3f(a,p1[r],p1[r+1]);b=max3f(b,p1[r+2],p1[r+3]);}
  const float m=max2f(a,b);
  auto rr=__builtin_amdgcn_permlane32_swap(__float_as_uint(m),__float_as_uint(m),false,false);
  return max2f(__uint_as_float(rr[0]),__uint_as_float(rr[1]));
}
__device__ __forceinline__ void pv(f32x16*o,int vb,bf16x8 pa0,bf16x8 pa1,bf16x8 pa2,bf16x8 pa3){
  #pragma unroll
  for(int d0=0;d0<2;++d0){s16x4 lo[4],hi[4];
    #pragma unroll
    for(int ks=0;ks<4;++ks){
      asm volatile("ds_read_b64_tr_b16 %0,%1 offset:%c2":"=&v"(lo[ks]):"v"(vb),"i"(d0*4096+ks*1024):"memory");
      asm volatile("ds_read_b64_tr_b16 %0,%1 offset:%c2":"=&v"(hi[ks]):"v"(vb),"i"(d0*4096+ks*1024+512):"memory");}
    asm volatile("s_waitcnt lgkmcnt(0)":::"memory");SBAR();
    #define PK(k) (bf16x8){lo[k][0],lo[k][1],lo[k][2],lo[k][3],hi[k][0],hi[k][1],hi[k][2],hi[k][3]}
    o[d0]=__builtin_amdgcn_mfma_f32_32x32x16_bf16(pa0,PK(0),o[d0],0,0,0);
    o[d0]=__builtin_amdgcn_mfma_f32_32x32x16_bf16(pa1,PK(1),o[d0],0,0,0);
    o[d0]=__builtin_amdgcn_mfma_f32_32x32x16_bf16(pa2,PK(2),o[d0],0,0,0);
    o[d0]=__builtin_amdgcn_mfma_f32_32x32x16_bf16(pa3,PK(3),o[d0],0,0,0);
    #undef PK
  }
}

#ifndef ATTN_STORE16
#define ATTN_STORE16(p,v) (*(u32x4*)(p)=(v))
#endif
template<int THRL> __device__ __forceinline__ void attn_unit(int b,int h,int qb,const bf16*Q,const bf16*__restrict__ K,const bf16*__restrict__ V,bf16*O,char*shm){
  int tid_l=threadIdx.x; asm volatile("":"+v"(tid_l)); const int tid=tid_l,lane=tid&63,r32=lane&31,hi=lane>>5; const int wid=__builtin_amdgcn_readfirstlane(tid>>6);
  const long rowbase=(long)b*SEQ; const int q0=qb*QB;
  const int hh_=h>>1,mm_=h&1; const bf16*Qw=Q+(rowbase+q0+wid*QBLK)*PQ+QCOL+hh_*128+mm_*64;
  const bf16*Kh=K+rowbase*PQ+KCOL+hh_*128+mm_*64,*Vh=V+rowbase*PQ+VCOL+hh_*128;
  const unsigned lds0=(unsigned)(uintptr_t)shm;
  float*wsf=(float*)(shm+LDS_WS)+wid*64;
  const bf16*ksrc=Kh+(long)lane*PQ+wid*8;
  const bf16*vsrc=Vh+(long)(16*(wid&3)+(lane>>2))*PQ+(wid>>2)*32+(lane&3)*8;
  const unsigned kdst=lds0+LDS_K+wid*1024, vdst=lds0+LDS_V+wid*1024;
  #define DMA_K(t,slot) glds16(ksrc+(long)(t)*KVBLK*PQ,(unsigned)__builtin_amdgcn_readfirstlane(kdst+(slot)))
  #define DMA_V(t,slot) do{ glds16(vsrc+(long)(t)*KVBLK*PQ,(unsigned)__builtin_amdgcn_readfirstlane(vdst+2*(slot))); glds16(vsrc+(long)(t)*KVBLK*PQ+64,(unsigned)__builtin_amdgcn_readfirstlane(vdst+2*(slot)+8192)); }while(0)
  const int vb0=(int)(lds0+LDS_V)+((lane>>4)&1)*32+(lane&3)*8+(4*hi+((lane&15)>>2))*64;
  const char*Kbase=shm+LDS_K; bf16x8 kf[8];
  const lds_cptr shm3=(lds_cptr)shm; const lds_cptr kp0=shm3+LDS_K+hi*1024+r32*16; const lds_cptr vp0=shm3+LDS_V+((lane>>4)&1)*32+(lane&3)*8+(4*hi+((lane&15)>>2))*64;
  const int NT=(q0+QB)/KVBLK;
  DMA_K(0,0);DMA_V(0,0);DMA_K(1,SLOTB);
  bf16x8 qr[4];
  #pragma unroll
  for(int d0=0;d0<4;++d0)qr[d0]=*reinterpret_cast<const bf16x8*>(&Qw[(long)r32*PQ+d0*16+hi*8]);
  float mhat=0.f,l_reg=0.f;f32x16 o[4];o[0]=f32x16{};o[1]=f32x16{};o[2]=f32x16{};o[3]=f32x16{};f32x16 negm=f32x16{};asm volatile("":"+v"(negm));
  const int qrel=wid*QBLK+r32;
  #define CMASK(P0,P1,t) do{int jb_=(t)-(NT-4); if(jb_>=0)cmask(P0,P1,jb_,qrel,hi);}while(0)
  bool resc=false;
  #define START(P0,P1) do{ const float rm=rowmax(P0,P1); resc=false; \
    { const float dl=rm; mhat=fadd_s(mhat,dl); \
      _Pragma("unroll") for(int r=0;r<16;++r){P0[r]=fsub_s(P0[r],dl);P1[r]=fsub_s(P1[r],dl);} \
      _Pragma("unroll") for(int r=0;r<16;++r)negm[r]=-mhat; asm volatile("":"+v"(negm)); } \
    _Pragma("unroll") for(int r=0;r<16;++r)P0[r]=__builtin_amdgcn_exp2f(P0[r]); }while(0)
  #define RESC() do{ if(resc){ asm volatile("s_waitcnt lgkmcnt(0)":::"memory"); \
      _Pragma("unroll") for(int d_=0;d_<4;++d_) _Pragma("unroll") for(int r=0;r<16;++r)o[d_][r]*=wsf[crow(r,hi)]; } }while(0)
  f32x16 pA0,pA1,pB0,pB1;
  int sl_prev=0,sl_cur=0,sl_next=SLOTB;
  #define ROT() do{sl_prev=sl_cur;sl_cur=sl_next;sl_next=(sl_next==(NSLOT-1)*SLOTB)?0:sl_next+SLOTB;}while(0)
  DMA_K(2,2*SLOTB);
  WAIT_BAR(3);
  qkt(pA0,pA1,Kbase,qr,negm,r32,hi);asm volatile("s_nop 15\n\ts_nop 7":"+v"(pA0),"+v"(pA1));CMASK(pA0,pA1,0);
  START(pA0,pA1);
  _Pragma("unroll") for(int r=0;r<16;++r)pA1[r]=__builtin_amdgcn_exp2f(pA1[r]);
  WAIT_BAR(0);
  DMA_K(3,0);DMA_V(1,SLOTB);
  ROT();
  kload8(kf,kp0+sl_cur);
  WAIT_BAR(3);
  s16x4 vlo[8],vhi[8],wlo[8],whi[8]; u32x4 pw0,pw1,pw2,pw3;
  #define PKW(P,B) cvtpk_s(P[B],P[B+1])
  #define PAF(k) __builtin_bit_cast(bf16x8,pw##k)
  #define VFR(i) (bf16x8){vlo[i][0],vlo[i][1],vlo[i][2],vlo[i][3],vhi[i][0],vhi[i][1],vhi[i][2],vhi[i][3]}
  #define PIN(x) asm volatile("":"+v"(x))
  #define MX3(a,b,c) __builtin_fmaxf(__builtin_fmaxf((a),(b)),(c))
  #define GAPA(MF,A0,A1,A2,A3,W0,W1,PW) do{ MF; sacc+=A0; sacc+=A1; sacc+=A2; sacc+=A3; PIN(sacc); W0; W1; PIN(PW); SBAR(); }while(0)
  #define EX(v) __builtin_amdgcn_exp2f(v)
  #define GAPB(MF,X,B) do{ MF; X[B]=EX(X[B]); X[B+1]=EX(X[B+1]); PIN(X); SBAR(); }while(0)
  #define VRD(i) do{ vlo[i]=vtr(vp_+(((i)>>2)*4096+((i)&3)*1024)); vhi[i]=vtr(vp_+(((i)>>2)*4096+((i)&3)*1024+512)); }while(0)
  #define VRD2(i) do{ wlo[i]=vtr(vp_+(8192+((i)>>2)*4096+((i)&3)*1024)); whi[i]=vtr(vp_+(8192+((i)>>2)*4096+((i)&3)*1024+512)); SBAR(); }while(0)
  #define WFR(i) (bf16x8){wlo[i][0],wlo[i][1],wlo[i][2],wlo[i][3],whi[i][0],whi[i][1],whi[i][2],whi[i][3]}
  #define GAPC(MF,X,B) do{ MF; X[B]=EX(X[B]); X[B+1]=EX(X[B+1]); PIN(X); SBAR(); }while(0)
  #define KRD(G,j) do{ if(G){ kload2(kf,kp0+sl_next,j); SBAR(); } }while(0)
  #define STEP(C0,C1,P0,P1,t,GK,GV,GL) do{ SBAR(); \
    const lds_cptr vp_=vp0+2*sl_prev; \
    VRD(0); SBAR(); float sacc=(P0[0]+P0[1]); \
    GAPA(C0=__builtin_amdgcn_mfma_f32_32x32x16_bf16(kf[0],qr[0],negm,0,0,0), P0[2],P0[3],P0[4],P0[5],     pw0[0]=PKW(P0,0), pw0[1]=PKW(P0,2), pw0); \
    VRD(4); SBAR(); GAPA(C1=__builtin_amdgcn_mfma_f32_32x32x16_bf16(kf[1],qr[0],negm,0,0,0), P0[6],P0[7],P0[8],P0[9],     pw0[2]=PKW(P0,4), pw0[3]=PKW(P0,6), pw0); \
    VRD(1); SBAR(); GAPA(C0=__builtin_amdgcn_mfma_f32_32x32x16_bf16(kf[2],qr[1],C0,0,0,0),   P0[10],P0[11],P0[12],P0[13], pw1[0]=PKW(P0,8), pw1[1]=PKW(P0,10), pw1); \
    VRD(5); SBAR(); GAPA(C1=__builtin_amdgcn_mfma_f32_32x32x16_bf16(kf[3],qr[1],C1,0,0,0),   P0[14],P0[15],P1[0],P1[1],   pw1[2]=PKW(P0,12),pw1[3]=PKW(P0,14), pw1); \
    VRD(2); SBAR(); GAPA(C0=__builtin_amdgcn_mfma_f32_32x32x16_bf16(kf[4],qr[2],C0,0,0,0),   P1[2],P1[3],P1[4],P1[5],     pw2[0]=PKW(P1,0), pw2[1]=PKW(P1,2), pw2); \
    VRD(6); SBAR(); GAPA(C1=__builtin_amdgcn_mfma_f32_32x32x16_bf16(kf[5],qr[2],C1,0,0,0),   P1[6],P1[7],P1[8],P1[9],     pw2[2]=PKW(P1,4), pw2[3]=PKW(P1,6), pw2); \
    VRD(3); SBAR(); GAPA(C0=__builtin_amdgcn_mfma_f32_32x32x16_bf16(kf[6],qr[3],C0,0,0,0),   P1[10],P1[11],P1[12],P1[13], pw3[0]=PKW(P1,8), pw3[1]=PKW(P1,10), pw3); \
    VRD(7); SBAR(); GAPA(C1=__builtin_amdgcn_mfma_f32_32x32x16_bf16(kf[7],qr[3],C1,0,0,0),   P1[14],P1[15],0.f,0.f,       pw3[2]=PKW(P1,12),pw3[3]=PKW(P1,14), pw3); \
    l_reg+=sacc; \
    if(GK){DMA_K((t)+3,sl_cur);} if(GV){DMA_V((t)+1,sl_next);} \
    CMASK(C0,C1,t); \
    { float a=MX3(C0[0],C0[1],C1[0]),b=MX3(C0[2],C0[3],C1[1]); a=MX3(a,C1[2],C1[3]); \
      _Pragma("unroll") for(int r=4;r<16;r+=4){a=MX3(a,C0[r],C0[r+1]);b=MX3(b,C0[r+2],C0[r+3]);a=MX3(a,C1[r],C1[r+1]);b=MX3(b,C1[r+2],C1[r+3]);} \
      float rm=__builtin_fmaxf(a,b); { auto rr=__builtin_amdgcn_permlane32_swap(__float_as_uint(rm),__float_as_uint(rm),false,false); rm=__builtin_fmaxf(__uint_as_float(rr[0]),__uint_as_float(rr[1])); } \
      resc=false; \
      if(__builtin_expect(__any(rm>(float)THRL),0)){ const float dl=__builtin_fmaxf(rm,0.f); mhat+=dl; \
        _Pragma("unroll") for(int r=0;r<16;++r){C0[r]-=dl;C1[r]-=dl;} \
        _Pragma("unroll") for(int r=0;r<16;++r)negm[r]=-mhat; asm volatile("":"+v"(negm)); \
        const float f=__builtin_amdgcn_exp2f(-dl); l_reg*=f; if(hi==0)wsf[r32]=f; resc=true; } } \
    SBAR(); \
    GAPB(o[0]=__builtin_amdgcn_mfma_f32_32x32x16_bf16(PAF(0),VFR(0),o[0],0,0,0), C0,0); VRD2(0); \
    GAPB(o[1]=__builtin_amdgcn_mfma_f32_32x32x16_bf16(PAF(0),VFR(4),o[1],0,0,0), C0,2); VRD2(4); \
    KRD(GL,0); GAPB(o[0]=__builtin_amdgcn_mfma_f32_32x32x16_bf16(PAF(1),VFR(1),o[0],0,0,0), C0,4); VRD2(1); \
    KRD(GL,1); GAPB(o[1]=__builtin_amdgcn_mfma_f32_32x32x16_bf16(PAF(1),VFR(5),o[1],0,0,0), C0,6); VRD2(5); \
    KRD(GL,2); GAPB(o[0]=__builtin_amdgcn_mfma_f32_32x32x16_bf16(PAF(2),VFR(2),o[0],0,0,0), C0,8); VRD2(2); \
    KRD(GL,3); GAPB(o[1]=__builtin_amdgcn_mfma_f32_32x32x16_bf16(PAF(2),VFR(6),o[1],0,0,0), C0,10); VRD2(6); \
    GAPB(o[0]=__builtin_amdgcn_mfma_f32_32x32x16_bf16(PAF(3),VFR(3),o[0],0,0,0), C0,12); VRD2(3); \
    GAPB(o[1]=__builtin_amdgcn_mfma_f32_32x32x16_bf16(PAF(3),VFR(7),o[1],0,0,0), C0,14); VRD2(7); \
    GAPC(o[2]=__builtin_amdgcn_mfma_f32_32x32x16_bf16(PAF(0),WFR(0),o[2],0,0,0), C1,0); \
    GAPC(o[3]=__builtin_amdgcn_mfma_f32_32x32x16_bf16(PAF(0),WFR(4),o[3],0,0,0), C1,2); \
    GAPC(o[2]=__builtin_amdgcn_mfma_f32_32x32x16_bf16(PAF(1),WFR(1),o[2],0,0,0), C1,4); \
    GAPC(o[3]=__builtin_amdgcn_mfma_f32_32x32x16_bf16(PAF(1),WFR(5),o[3],0,0,0), C1,6); \
    GAPC(o[2]=__builtin_amdgcn_mfma_f32_32x32x16_bf16(PAF(2),WFR(2),o[2],0,0,0), C1,8); \
    GAPC(o[3]=__builtin_amdgcn_mfma_f32_32x32x16_bf16(PAF(2),WFR(6),o[3],0,0,0), C1,10); \
    GAPC(o[2]=__builtin_amdgcn_mfma_f32_32x32x16_bf16(PAF(3),WFR(3),o[2],0,0,0), C1,12); \
    GAPC(o[3]=__builtin_amdgcn_mfma_f32_32x32x16_bf16(PAF(3),WFR(7),o[3],0,0,0), C1,14); \
    }while(0)
  int t=1;
  #undef CMASK
  #define CMASK(P0,P1,t) do{}while(0)
  for(;t+5<NT;t+=2){
    STEP(pB0,pB1,pA0,pA1,t,true,true,true);     WAIT_BAR(3); RESC(); ROT();
    STEP(pA0,pA1,pB0,pB1,t+1,true,true,true);   WAIT_BAR(3); RESC(); ROT();
  }
  #undef CMASK
  #define CMASK(P0,P1,t) do{int jb_=(t)-(NT-4); if(jb_>=0)cmask(P0,P1,jb_,qrel,hi);}while(0)
  #define ENDW(tt) do{ if((tt)+3<NT){WAIT_BAR(3);} else if((tt)+2<NT){WAIT_BAR(2);} else {WAIT_BAR(0);} }while(0)
  for(;t+1<NT;t+=2){
    STEP(pB0,pB1,pA0,pA1,t,(t+3<NT),(t+1<NT),(t+1<NT));       ENDW(t);   RESC(); ROT();
    STEP(pA0,pA1,pB0,pB1,t+1,(t+4<NT),(t+2<NT),(t+2<NT));     ENDW(t+1); RESC(); ROT();
  }
  STEP(pB0,pB1,pA0,pA1,NT-1,false,false,false); RESC();
  { float sacc=pB0[0]+pB0[1]; _Pragma("unroll") for(int r=2;r<16;++r)sacc+=pB0[r]; _Pragma("unroll") for(int r=0;r<16;++r)sacc+=pB1[r]; l_reg+=sacc;
    pw0=(u32x4){PKW(pB0,0),PKW(pB0,2),PKW(pB0,4),PKW(pB0,6)};pw1=(u32x4){PKW(pB0,8),PKW(pB0,10),PKW(pB0,12),PKW(pB0,14)};pw2=(u32x4){PKW(pB1,0),PKW(pB1,2),PKW(pB1,4),PKW(pB1,6)};pw3=(u32x4){PKW(pB1,8),PKW(pB1,10),PKW(pB1,12),PKW(pB1,14)};
    SBAR(); pv(o,vb0+2*sl_cur,PAF(0),PAF(1),PAF(2),PAF(3)); pv(o+2,vb0+2*sl_cur+8192,PAF(0),PAF(1),PAF(2),PAF(3)); }
  #undef PKW
  #undef PAF
  #undef VFR
  #undef PIN
  #undef MX3
  #undef GAPA
  #undef GAPB
  #undef EX
  #undef VRD
  #undef VRD2
  #undef WFR
  #undef GAPC
  #undef KRD
  #undef STEP
  #undef ENDW
  {auto rr=__builtin_amdgcn_permlane32_swap(__float_as_uint(l_reg),__float_as_uint(l_reg),false,false);l_reg=__uint_as_float(rr[0])+__uint_as_float(rr[1]);}
  if(hi==0)wsf[32+r32]=l_reg;asm volatile("s_waitcnt lgkmcnt(0)":::"memory");
  float rli[16];
  #pragma unroll
  for(int r=0;r<16;++r)rli[r]=__builtin_amdgcn_rcpf(wsf[32+crow(r,hi)]);
  bf16*Ow=O+(rowbase+q0+wid*QBLK)*DM+hh_*256+mm_*128;
  #pragma unroll
  for(int half=0;half<2;++half)
  { bf16*stg=(bf16*)(shm+LDS_OST)+wid*2048;
    #pragma unroll
    for(int r=0;r<16;++r){const int orow=crow(r,hi);
      #pragma unroll
      for(int d0=0;d0<2;++d0)stg[orow*64+d0*32+r32]=__float2bfloat16(o[2*half+d0][r]*rli[r]);}
    asm volatile("s_waitcnt lgkmcnt(0)":::"memory");
    #pragma unroll
    for(int i=0;i<4;++i){const int row=i*8+(lane>>3),ch=lane&7; const u32x4 v=*(const u32x4*)(stg+row*64+ch*8); ATTN_STORE16(Ow+(long)row*DM+half*64+ch*8,v);}
    asm volatile("s_waitcnt lgkmcnt(0)":::"memory"); }
  asm volatile("s_waitcnt lgkmcnt(0)\n\ts_barrier":::"memory");
  #undef DMA_K
  #undef DMA_V
  #undef CMASK
  #undef START
  #undef RESC
  #undef ROT
}
constexpr int ATTN_LDS_BYTES=LDS_BYTES;
struct AttnTensors { const bf16* Q; const bf16* K; const bf16* V; bf16* O; };
struct AttnUnit { int bh; int qb; };
struct StaticOrder {
  int vcu;
  __device__ __forceinline__ explicit StaticOrder(int v):vcu(v){}
  __device__ __forceinline__ bool next(int i,AttnUnit&u)const{ if(i>=2)return false; const int s=vcu&15; u.bh=vcu>>4; u.qb=(i==0)?31-s:s; return true; }
  __device__ __forceinline__ void a_ready(const AttnUnit&)const{}
  __device__ __forceinline__ void done(const AttnUnit&)const{}
};
template<class Sched,int THRL=8> __device__ __forceinline__ void attn_phase(char*lds,const AttnTensors&T,const Sched&S){
  AttnUnit u;
  for(int i=0;S.next(i,u);++i){ S.a_ready(u); attn_unit<THRL>(u.bh>>3,u.bh&7,u.qb,T.Q,T.K,T.V,T.O,lds); S.done(u); }
}
#undef SBAR
#undef WAIT_BAR
}
namespace cg = cooperative_groups;
constexpr int NWAVES = 8;
constexpr int BATCH = 2, T = 8192, D = 1024, DIN = 3584, M = BATCH * T, DEPTH = 2;
constexpr float EPS = 1e-6f;
constexpr size_t MiB = 1u << 20;
constexpr size_t WS_CTL = 0;
constexpr size_t WS_TAB = 64 * 1024;
constexpr size_t WS_ROWSS = 128 * 1024;
constexpr size_t WS_ROWSS2 = 192 * 1024;
constexpr size_t WS_PCNT = 14336;
constexpr size_t WS_SUCNT = 15616;
constexpr size_t WS_SCNT = 14592;
constexpr size_t WS_ROWSS0 = 256 * 1024;
constexpr size_t WS_WIN = 2 * MiB;
constexpr size_t WS_WOUT = 16 * MiB;
constexpr size_t WS_GLU = 20 * MiB;
constexpr size_t WS_ROPE = 20 * MiB + 512 * 1024;
constexpr size_t WS_S5A = 21 * MiB;
constexpr size_t WS_S5B = 21 * MiB + 64 * 1024;
constexpr size_t WS_S5C = 21 * MiB + 256 * 1024;
constexpr size_t WS_HU = 22 * MiB;
constexpr size_t WS_HA = 30 * MiB;
constexpr size_t WS_XLOC = 31 * MiB;
constexpr size_t WS_XN = 32 * MiB;
constexpr size_t WS_O = WS_XN;
constexpr size_t WS_PROJ = 64 * MiB;
constexpr size_t WS_MIX = 176 * MiB;
constexpr size_t WS_YG = 208 * MiB;
constexpr size_t WS_YGS = 216 * MiB;
constexpr size_t WS_HRES = 224 * MiB;
constexpr size_t WS_END = 256 * MiB;
constexpr int LDS_BYTES = 147456, RING_BYTES = 131072;

#define GAS __attribute__((address_space(1)))
#define LAS __attribute__((address_space(3)))
typedef unsigned short bf16;
typedef unsigned v4u __attribute__((ext_vector_type(4)));
typedef unsigned v2u __attribute__((ext_vector_type(2)));
typedef float f32x4 __attribute__((ext_vector_type(4)));
typedef short bf16x8 __attribute__((ext_vector_type(8)));
#define LDS_WAIT() asm volatile("s_waitcnt lgkmcnt(0)" ::: "memory")
__device__ __forceinline__ unsigned f2bf(float f) { unsigned u = __builtin_bit_cast(unsigned, f); return (u + 0x7fffu + ((u >> 16) & 1u)) >> 16; }
__device__ __forceinline__ unsigned pk2(float lo, float hi) { return f2bf(lo) | (f2bf(hi) << 16); }
__device__ __forceinline__ float bflo(unsigned w) { return __uint_as_float(w << 16); }
__device__ __forceinline__ float bfhi(unsigned w) { return __uint_as_float(w & 0xffff0000u); }
__device__ __forceinline__ float bf1(bf16 h) { return __uint_as_float(((unsigned)h) << 16); }
__device__ __forceinline__ float sigmf(float v) { return __builtin_amdgcn_rcpf(1.0f + __builtin_amdgcn_exp2f(-1.4426950408889634f * v)); }
__device__ __forceinline__ float siluf(float v) { return v * sigmf(v); }
__device__ __forceinline__ float wave_sum(float v) {
#pragma unroll
    for (int o = 1; o < 64; o <<= 1) v += __shfl_xor(v, o);
    return v;
}
__device__ __forceinline__ void p0_transpose_item(const float* W, int K, int N, bf16* WT, LAS float* scr_f, int item, int lane, const float* kscale = nullptr) {
    LAS bf16* scr = (LAS bf16*)scr_f;
    const int nblk = N / 64, kb = item / nblk, nb = item % nblk, k0 = 64 * kb, n0 = 64 * nb;
    f32x4 v[16];
#pragma unroll
    for (int i = 0; i < 16; ++i) v[i] = __builtin_nontemporal_load((const f32x4*)(W + (size_t)(k0 + 4 * i + (lane >> 4)) * N + n0 + (lane & 15) * 4));
#pragma unroll
    for (int i = 0; i < 16; ++i) { const float sc = kscale ? kscale[k0 + 4 * i + (lane >> 4)] : 1.0f;
        *(LAS v2u*)(scr + (4 * i + (lane >> 4)) * 68 + (lane & 15) * 4) = (v2u){pk2(v[i].x * sc, v[i].y * sc), pk2(v[i].z * sc, v[i].w * sc)}; }
    LDS_WAIT(); asm volatile("" ::: "memory");
    const int c = lane & 7;
#pragma unroll
    for (int j = 0; j < 8; ++j) { const int n = (lane >> 3) + 8 * j; const LAS bf16* t = scr + (8 * c) * 68 + n;
        v4u o; o.x = (unsigned)t[0] | ((unsigned)t[68] << 16); o.y = (unsigned)t[2 * 68] | ((unsigned)t[3 * 68] << 16); o.z = (unsigned)t[4 * 68] | ((unsigned)t[5 * 68] << 16); o.w = (unsigned)t[6 * 68] | ((unsigned)t[7 * 68] << 16);
        *(v4u*)(WT + (size_t)(n0 + n) * K + k0 + 8 * c) = o; }
    LDS_WAIT(); asm volatile("" ::: "memory");
}
template <bool OUTF> __device__ __forceinline__ void rms_row(const float* xrow, const float* w, bf16* orow, float* frow, int lane) {
    const f32x4* xr = (const f32x4*)xrow + lane; const f32x4* wr = (const f32x4*)w + lane;
    f32x4 v[4]; float s = 0.f;
#pragma unroll
    for (int j = 0; j < 4; ++j) { v[j] = xr[64 * j]; s += (v[j].x * v[j].x + v[j].y * v[j].y) + (v[j].z * v[j].z + v[j].w * v[j].w); }
    const float rs = 1.0f / sqrtf(wave_sum(s) * (1.f / D) + EPS);
#pragma unroll
    for (int j = 0; j < 4; ++j) { const f32x4 ww = wr[64 * j]; const f32x4 o = v[j] * rs * ww;
        if (OUTF) ((f32x4*)frow + lane)[64 * j] = o;
        else ((v2u*)orow + lane)[64 * j] = (v2u){pk2(o.x, o.y), pk2(o.z, o.w)}; }
}

typedef GAS unsigned gu32;
#define RLX_AGENT __ATOMIC_RELAXED, __HIP_MEMORY_SCOPE_AGENT
#define XB_TMO      128
#define XB_XCNT(j)  (256  + 64 * (j))
#define XB_XSUB(j)  (1280 + 64 * (j))
#define XB_XGEN(j)  (2304 + 64 * (j))
#define XB_TOP      3328
#define XB_TOPGEN   3392
#define XCD_BAR_WORDS 3456
#define XB_SPIN_CAP (1u << 18)

__device__ __forceinline__ unsigned xb_ld(unsigned* p)              { return __hip_atomic_load(p, __ATOMIC_RELAXED, __HIP_MEMORY_SCOPE_AGENT); }
__device__ __forceinline__ unsigned xb_add(unsigned* p, unsigned v) { return __hip_atomic_fetch_add(p, v, __ATOMIC_RELAXED, __HIP_MEMORY_SCOPE_AGENT); }
__device__ __forceinline__ unsigned xb_xcc_id() { return (unsigned)__builtin_amdgcn_s_getreg((3 << 11) | 20) & 0xFu; }
#define XB_SPIN(cond, bar) do { unsigned _sp = 0; while (cond) { __builtin_amdgcn_s_sleep(1); \
    if ((++_sp & 255u) == 0u) { if (xb_ld(&(bar)[XB_TMO])) break; if (_sp > XB_SPIN_CAP) { atomicAdd(&(bar)[XB_TMO], 1u); break; } } } } while (0)

struct XcdBarrier {
    unsigned* bar; unsigned x;
    volatile LAS unsigned* st;
};

__device__ __forceinline__ XcdBarrier xcd_barrier_post(unsigned* bar, volatile LAS unsigned* st) {
    XcdBarrier b; b.bar = bar; b.x = xb_xcc_id(); b.st = st;
    if (threadIdx.x == 0) (void)xb_add(&bar[XB_XCNT(b.x)], 1u);
    return b;
}
__device__ __forceinline__ void xcd_barrier_complete(unsigned* bar, unsigned x, unsigned& nloc, unsigned& nx) {
    const unsigned G = gridDim.x * gridDim.y * gridDim.z;
    unsigned sum, cnt, mine, sp = 0u;
    for (;;) {
        sum = 0u; cnt = 0u; mine = 0u;
#pragma unroll
        for (unsigned j = 0; j < 16; ++j) { const unsigned c = xb_ld(&bar[XB_XCNT(j)]); sum += c; cnt += (c > 0u) ? 1u : 0u; mine = (j == x) ? c : mine; }
        if (sum == G) break;
        __builtin_amdgcn_s_sleep(1);
        if ((++sp & 255u) == 0u) { if (xb_ld(&bar[XB_TMO])) break; if (sp > XB_SPIN_CAP) { atomicAdd(&bar[XB_TMO], 1u); break; } }
    }
    nloc = mine > 0u ? mine : 1u; nx = cnt > 0u ? cnt : 1u;
}

__device__ __forceinline__ void xcd_barrier(const XcdBarrier& b) {
    asm volatile("s_waitcnt vmcnt(0)" ::: "memory");
    __syncthreads();
    if (threadIdx.x == 0) {
        unsigned* bar = b.bar;
        __builtin_amdgcn_s_waitcnt(0);
        unsigned nloc = b.st[0], nx = b.st[1];
        if (nloc == 0u) { xcd_barrier_complete(bar, b.x, nloc, nx); b.st[0] = nloc; b.st[1] = nx; }
        const unsigned old = xb_add(&bar[XB_XSUB(b.x)], 1u);
        const unsigned gen = old / nloc;
        if (old + 1u == (gen + 1u) * nloc) {
            __builtin_amdgcn_fence(__ATOMIC_RELEASE, "agent");
            asm volatile("s_waitcnt vmcnt(0)" ::: "memory");
            const unsigned og = xb_add(&bar[XB_TOP], 1u);
            const unsigned tg = og / nx;
            if (og + 1u == (tg + 1u) * nx) xb_add(&bar[XB_TOPGEN], 1u);
            else XB_SPIN(xb_ld(&bar[XB_TOPGEN]) == tg, bar);
            __builtin_amdgcn_fence(__ATOMIC_ACQUIRE, "agent");
            xb_add(&bar[XB_XGEN(b.x)], 1u);
            asm volatile("s_waitcnt vmcnt(0)" ::: "memory");
        } else {
            XB_SPIN(xb_ld(&bar[XB_XGEN(b.x)]) == gen, bar);
            __builtin_amdgcn_fence(__ATOMIC_ACQUIRE, "agent");
            asm volatile("s_waitcnt vmcnt(0)" ::: "memory");
        }
    }
    __syncthreads();
}
struct Args { const float* in[22]; float* out; unsigned char* ws; int ph_lo, ph_hi; };
struct PA { const float* const* in; float* out; unsigned char* ws; };

__device__ __forceinline__ void s5_prep(const float* const* in, unsigned char* ws, int t0, int nthreads) {
    const double TWO_PI = 6.283185307179586476925;
    for (int ec = t0; ec < DEPTH * 16 * 64 * 16; ec += nthreads) {
        const int e = ec >> 4, c = ec & 15;
        const int l = e >> 10, g = (e >> 6) & 15, p = e & 63;
        const double dt = (double)expf(in[12][l * 16 + g]);
        const double are = (double)in[6][e], aim = (double)in[7][e];
        const double mag = (double)expf((float)(dt * are));
        double tt = dt * aim * (1.0 / TWO_PI); tt -= __builtin_floor(tt);
        const float ang = (float)(tt * TWO_PI);
        const double abr = mag * (double)cosf(ang), abi = mag * (double)sinf(ang);
        const double den = are * are + aim * aim, nr = abr - 1.0, ni = abi;
        const double zr = (nr * are + ni * aim) / den, zi = (ni * are - nr * aim) / den;
        if (c == 0) {
            double pr = abr, pi = abi;
#pragma unroll
            for (int q = 0; q < 7; ++q) { const double r2 = pr * pr - pi * pi, i2 = 2.0 * pr * pi; pr = r2; pi = i2; }
            float* sa = (float*)(ws + WS_S5A) + (size_t)(l * 16 + g) * 256;
            sa[p] = (float)abr; sa[64 + p] = (float)abi; sa[128 + p] = (float)pr; sa[192 + p] = (float)pi;
        }
        bf16* bm = (bf16*)(ws + WS_S5B) + (size_t)(l * 16 + g) * 2048;
        const double br = in[8][(size_t)e * 16 + c], bi = in[9][(size_t)e * 16 + c];
        bm[p * 16 + c] = (bf16)f2bf((float)(zr * br - zi * bi)); bm[(64 + p) * 16 + c] = (bf16)f2bf((float)(zr * bi + zi * br));
        bf16* cm = (bf16*)(ws + WS_S5C) + (size_t)(l * 16 + g) * 2048;
        cm[c * 128 + p] = (bf16)f2bf(in[10][(size_t)(l * 16 + g) * 1024 + c * 64 + p]); cm[c * 128 + 64 + p] = (bf16)f2bf(-in[11][(size_t)(l * 16 + g) * 1024 + c * 64 + p]);
    }
}
__device__ __forceinline__ void prologue(const Args& a, LAS unsigned char* lds, int vcu, int G, int wave, int lane) {
    const bool defer_s5 = false;
    unsigned char* ws = a.ws;
    LAS float* scr = (LAS float*)(lds + wave * 16384);
    const int gw = vcu * NWAVES + wave, NGW = G * NWAVES;
    constexpr int I_IN = (D / 64) * (DIN / 64), I_OUT = (D / 64) * (D / 64), I_GLU = (256 / 64) * (256 / 64);
    constexpr int NITEMS = DEPTH * (I_IN + I_OUT + I_GLU);
    for (int it = gw; it < NITEMS; it += NGW) {
        int r = it; const int l = r / (I_IN + I_OUT + I_GLU); r -= l * (I_IN + I_OUT + I_GLU);
        if (r < I_IN) { p0_transpose_item(a.in[2] + (size_t)l * D * DIN, D, DIN, (bf16*)(ws + WS_WIN) + (size_t)l * DIN * D, scr, r, lane, a.in[1] + (size_t)l * D); continue; } r -= I_IN;
        if (r < I_OUT) { p0_transpose_item(a.in[3] + (size_t)l * D * D, D, D, (bf16*)(ws + WS_WOUT) + (size_t)l * D * D, scr, r, lane); continue; } r -= I_OUT;
        p0_transpose_item(a.in[14] + (size_t)l * 65536, 256, 256, (bf16*)(ws + WS_GLU) + (size_t)l * 65536, scr, r, lane);
    }
    for (int m = gw; m < M; m += 2 * NGW) {
        const int m2 = m + NGW; const bool has2 = m2 < M;
        const f32x4* x1 = (const f32x4*)(a.in[0] + (size_t)m * D) + lane; const f32x4* x2 = (const f32x4*)(a.in[0] + (size_t)(has2 ? m2 : m) * D) + lane;
        f32x4 v1[4], v2[4]; float s1 = 0.f, s2 = 0.f;
#pragma unroll
        for (int j = 0; j < 4; ++j) { v1[j] = __builtin_nontemporal_load(x1 + 64 * j); v2[j] = __builtin_nontemporal_load(x2 + 64 * j); }
#pragma unroll
        for (int j = 0; j < 4; ++j) { s1 += (v1[j].x * v1[j].x + v1[j].y * v1[j].y) + (v1[j].z * v1[j].z + v1[j].w * v1[j].w); s2 += (v2[j].x * v2[j].x + v2[j].y * v2[j].y) + (v2[j].z * v2[j].z + v2[j].w * v2[j].w);
            ((v2u*)((bf16*)(ws + WS_HRES) + (size_t)m * D) + lane)[64 * j] = (v2u){pk2(v1[j].x, v1[j].y), pk2(v1[j].z, v1[j].w)};
            if (has2) ((v2u*)((bf16*)(ws + WS_HRES) + (size_t)m2 * D) + lane)[64 * j] = (v2u){pk2(v2[j].x, v2[j].y), pk2(v2[j].z, v2[j].w)}; }
        s1 = wave_sum(s1); s2 = wave_sum(s2);
        if (lane == 0) { ((float*)(ws + WS_ROWSS0))[m] = s1; if (has2) ((float*)(ws + WS_ROWSS0))[m2] = s2; }
        if (lane == 0) { ((float*)(ws + WS_ROWSS))[m] = 0.f; ((float*)(ws + WS_ROWSS2))[m] = 0.f; if (has2) { ((float*)(ws + WS_ROWSS))[m2] = 0.f; ((float*)(ws + WS_ROWSS2))[m2] = 0.f; } }
    }
    const int gt = gw * 64 + lane, NGT = NGW * 64;
    const double TWO_PI = 6.283185307179586476925;
    for (int e = gt; e < 8192 * 8; e += NGT) {
        const int pos = e >> 3, i = e & 7;
        const double invf[8] = {1.0, 0.19392274474868576, 0.03760603093086393, 0.007292664737217109, 0.001414213562373095, 0.0002742481756762073, 5.318295896944988e-05, 1.031338537721246e-05};
        double inv = invf[0];
#pragma unroll
        for (int q = 1; q < 8; ++q) inv = (i == q) ? invf[q] : inv;
        double tt = (double)pos * inv * (1.0 / TWO_PI); tt -= __builtin_floor(tt);
        const float ang = (float)(tt * TWO_PI);
        float* rp = (float*)(ws + WS_ROPE) + (size_t)e * 2; rp[0] = cosf(ang); rp[1] = sinf(ang);
    }
    if (!defer_s5) s5_prep(a.in, ws, gt, NGT);
}

template <bool OUT> __device__ __forceinline__ void hgrn_item(const PA& a, LAS unsigned char* lds, int layer, int bh, int c, int tid, int wave, int lane) {
    const int b = bh >> 2, h = bh & 3;
    const bf16* PROJ = (const bf16*)(a.ws + WS_PROJ);
    float* HU = (float*)(a.ws + WS_HU); float* HA = (float*)(a.ws + WS_HA);
    LAS float* Fs = (LAS float*)lds; LAS float* Ks = Fs + 4096; LAS float* Vs = Ks + 4096; LAS float* Qs = Vs + 4096; LAS float* Ps = Qs + 4096;
    const size_t row0 = (size_t)b * T + (size_t)c * 128;
    float S[8];
#pragma unroll
    for (int j = 0; j < 8; ++j) S[j] = 0.f;
    if (OUT) {
        int cp = 0;
        for (; cp + 4 <= c; cp += 4) {
            float uu[4][8], aa[4][8];
#pragma unroll
            for (int q = 0; q < 4; ++q) {
                const float* U = HU + (size_t)(bh * 64 + cp + q) * 4096 + (size_t)(wave * 8) * 64 + lane; const float* A = HA + (size_t)(bh * 64 + cp + q) * 64 + wave * 8;
#pragma unroll
                for (int j = 0; j < 8; ++j) { uu[q][j] = U[j * 64]; aa[q][j] = A[j]; }
            }
#pragma unroll
            for (int q = 0; q < 4; ++q)
#pragma unroll
                for (int j = 0; j < 8; ++j) S[j] = aa[q][j] * S[j] + uu[q][j];
        }
        for (; cp < c; ++cp) {
            const float* U = HU + (size_t)(bh * 64 + cp) * 4096 + (size_t)(wave * 8) * 64 + lane; const float* A = HA + (size_t)(bh * 64 + cp) * 64 + wave * 8;
#pragma unroll
            for (int j = 0; j < 8; ++j) S[j] = A[j] * S[j] + U[j * 64];
        }
    }
    const int fcol = h * 64 + (tid & 7) * 8;
    float lb[8];
#pragma unroll
    for (int j = 0; j < 8; ++j) lb[j] = (layer == 0) ? 0.f : sigmf(a.in[4][256 + fcol + j] - a.in[4][fcol + j]);
    const float gnw = a.in[5][layer * 64 + lane];
    float aprod = 1.f;
    for (int sub = 0; sub < 2; ++sub) {
        __syncthreads();
        { const int t = tid >> 3; const bf16* pr = PROJ + (row0 + sub * 64 + t) * DIN + fcol;
          const v4u fw = *(const v4u*)(pr + 256), vw = *(const v4u*)(pr + 512);
          const unsigned fa[4] = {fw.x, fw.y, fw.z, fw.w}, va[4] = {vw.x, vw.y, vw.z, vw.w};
          float fo[8], ko[8], vo[8];
#pragma unroll
          for (int j = 0; j < 8; ++j) { const float x = (j & 1) ? bfhi(fa[j >> 1]) : bflo(fa[j >> 1]); const float sg = sigmf(x);
              fo[j] = lb[j] + (1.f - lb[j]) * sg; ko[j] = (1.f - lb[j]) * (1.f - sg); vo[j] = (j & 1) ? bfhi(va[j >> 1]) : bflo(va[j >> 1]); }
          LAS f32x4* d;
          d = (LAS f32x4*)(Fs + t * 64 + (tid & 7) * 8); d[0] = (f32x4){fo[0], fo[1], fo[2], fo[3]}; d[1] = (f32x4){fo[4], fo[5], fo[6], fo[7]};
          d = (LAS f32x4*)(Ks + t * 64 + (tid & 7) * 8); d[0] = (f32x4){ko[0], ko[1], ko[2], ko[3]}; d[1] = (f32x4){ko[4], ko[5], ko[6], ko[7]};
          d = (LAS f32x4*)(Vs + t * 64 + (tid & 7) * 8); d[0] = (f32x4){vo[0], vo[1], vo[2], vo[3]}; d[1] = (f32x4){vo[4], vo[5], vo[6], vo[7]};
          if (OUT) { const v4u qw = *(const v4u*)(pr); const unsigned qa[4] = {qw.x, qw.y, qw.z, qw.w}; float qo[8];
#pragma unroll
              for (int j = 0; j < 8; ++j) qo[j] = siluf((j & 1) ? bfhi(qa[j >> 1]) : bflo(qa[j >> 1]));
              d = (LAS f32x4*)(Qs + t * 64 + (tid & 7) * 8); d[0] = (f32x4){qo[0], qo[1], qo[2], qo[3]}; d[1] = (f32x4){qo[4], qo[5], qo[6], qo[7]}; }
        }
        __syncthreads();
        if (!OUT && tid < 64) { for (int t = 0; t < 64; ++t) aprod *= Fs[t * 64 + tid]; }
        for (int tb = 0; tb < 4; ++tb) {
#pragma unroll 4
            for (int tt = 0; tt < 16; ++tt) {
                const int t = tb * 16 + tt;
                const f32x4 f0 = *(const LAS f32x4*)(Fs + t * 64 + wave * 8), f1 = *(const LAS f32x4*)(Fs + t * 64 + wave * 8 + 4);
                const f32x4 k0 = *(const LAS f32x4*)(Ks + t * 64 + wave * 8), k1 = *(const LAS f32x4*)(Ks + t * 64 + wave * 8 + 4);
                const float v = Vs[t * 64 + lane];
                S[0] = f0[0] * S[0] + k0[0] * v; S[1] = f0[1] * S[1] + k0[1] * v; S[2] = f0[2] * S[2] + k0[2] * v; S[3] = f0[3] * S[3] + k0[3] * v;
                S[4] = f1[0] * S[4] + k1[0] * v; S[5] = f1[1] * S[5] + k1[1] * v; S[6] = f1[2] * S[6] + k1[2] * v; S[7] = f1[3] * S[7] + k1[3] * v;
                if (OUT) {
                    const f32x4 q0 = *(const LAS f32x4*)(Qs + t * 64 + wave * 8), q1 = *(const LAS f32x4*)(Qs + t * 64 + wave * 8 + 4);
                    const float p = ((q0[0] * S[0] + q0[1] * S[1]) + (q0[2] * S[2] + q0[3] * S[3])) + ((q1[0] * S[4] + q1[1] * S[5]) + (q1[2] * S[6] + q1[3] * S[7]));
                    Ps[(wave * 16 + tt) * 64 + lane] = p;
                }
            }
            if (OUT) {
                __syncthreads();
#pragma unroll
                for (int r = 0; r < 2; ++r) {
                    const int tt = wave + 8 * r; float o = 0.f;
#pragma unroll
                    for (int w2 = 0; w2 < 8; ++w2) o += Ps[(w2 * 16 + tt) * 64 + lane];
                    const float rs = 1.0f / sqrtf(wave_sum(o * o) * (1.f / 64.f) + EPS);
                    const size_t row = row0 + sub * 64 + tb * 16 + tt;
                    const float gt = siluf(bf1(PROJ[row * DIN + 768 + h * 64 + lane]));
                    ((bf16*)(a.ws + WS_MIX))[row * 1024 + h * 64 + lane] = (bf16)f2bf(o * rs * gnw * gt);
                }
                __syncthreads();
            }
        }
    }
    if (!OUT) {
        float* U = HU + (size_t)(bh * 64 + c) * 4096 + (size_t)(wave * 8) * 64 + lane;
#pragma unroll
        for (int j = 0; j < 8; ++j) U[j * 64] = S[j];
        if (tid < 64) HA[(size_t)(bh * 64 + c) * 64 + tid] = aprod;
    }
}

typedef unsigned short u16;
__device__ __forceinline__ bf16x8 pk8(const float* v) { v4u w = {pk2(v[0], v[1]), pk2(v[2], v[3]), pk2(v[4], v[5]), pk2(v[6], v[7])}; return __builtin_bit_cast(bf16x8, w); }
struct HRaw { v4u f[2], v[2], q[2], g[2]; };
template <bool OUT> __device__ __forceinline__ HRaw hgrn_load(const PA& a, int bh, int c, int wave, int lane) {
    const bf16* pr = (const bf16*)(a.ws + WS_PROJ) + ((size_t)(bh >> 2) * T + (size_t)c * 128 + wave * 16 + (lane >> 3)) * DIN + (bh & 3) * 64 + (lane & 7) * 8;
    HRaw r;
#pragma unroll
    for (int k = 0; k < 2; ++k) { r.f[k] = *(const v4u*)(pr + (size_t)(8 * k) * DIN + 256); r.v[k] = *(const v4u*)(pr + (size_t)(8 * k) * DIN + 512);
        if (OUT) { r.q[k] = *(const v4u*)(pr + (size_t)(8 * k) * DIN); r.g[k] = *(const v4u*)(pr + (size_t)(8 * k) * DIN + 768); } }
    return r;
}
template <bool OUT> __device__ __forceinline__ void hgrn_item2(const PA& a, LAS unsigned char* lds, int layer, int bh, int c, int wave, int lane, const HRaw& raw) {
    const int b = bh >> 2, h = bh & 3, item = bh * 64 + c;
    float* HU = (float*)(a.ws + WS_HU); float* HA = (float*)(a.ws + WS_HA);
    LAS unsigned char* wb = lds + wave * 12288;
    LAS bf16* QT = (LAS bf16*)wb; LAS bf16* KT = (LAS bf16*)(wb + 2304); LAS bf16* KHT = (LAS bf16*)(wb + 4608); LAS bf16* VT = (LAS bf16*)(wb + 7680); LAS bf16* P = (LAS bf16*)(wb + 10752);
    LAS float* DL = (LAS float*)(wb + 11520); LAS float* E7L = (LAS float*)(wb + 11776);
    LAS bf16* RF = (LAS bf16*)wb; LAS bf16* RV = (LAS bf16*)(wb + 2304); LAS bf16* RQ = (LAS bf16*)(wb + 4608);
    LAS bf16* GT = KHT; LAS bf16* OT = VT;
    LAS float* SBUF = (LAS float*)(lds + 98304); LAS float* DALL = (LAS float*)(lds + 114688);
    const int l15 = lane & 15, q = lane >> 4;
    const size_t row0 = (size_t)b * T + (size_t)c * 128 + wave * 16;
    const bf16x8 zero8 = {0, 0, 0, 0, 0, 0, 0, 0};
    __syncthreads();
    {
        const int rr = lane >> 3, cc = (lane & 7) * 8;
#pragma unroll
        for (int k = 0; k < 2; ++k) { *(LAS v4u*)(RF + (rr + 8 * k) * 72 + cc) = raw.f[k]; *(LAS v4u*)(RV + (rr + 8 * k) * 72 + cc) = raw.v[k]; if (OUT) *(LAS v4u*)(RQ + (rr + 8 * k) * 72 + cc) = raw.q[k]; }
        LDS_WAIT();
        const float lb = (layer == 0) ? 0.f : sigmf(a.in[4][256 + h * 64 + lane] - a.in[4][h * 64 + lane]);
        u16 fr[16], vr[16], qr[16];
#pragma unroll
        for (int t = 0; t < 16; ++t) { fr[t] = RF[t * 72 + lane]; vr[t] = RV[t * 72 + lane]; if (OUT) qr[t] = RQ[t * 72 + lane]; }
        LDS_WAIT();
        float cum[16], kk[16]; float run = 0.f;
#pragma unroll
        for (int t = 0; t < 16; ++t) { const float sg = sigmf(bf1(fr[t])); const float f = lb + (1.f - lb) * sg; kk[t] = (1.f - lb) * (1.f - sg); run += fmaxf(__logf(f), -69.f); cum[t] = run; }
        const float cl = cum[15], c7 = cum[7];
        DL[lane] = __expf(cl);
        if (OUT) E7L[lane] = __expf(c7); else DALL[wave * 64 + lane] = cl;
        float kh[16];
#pragma unroll
        for (int t = 0; t < 16; ++t) kh[t] = kk[t] * __expf(cl - cum[t]);
        *(LAS bf16x8*)(KHT + lane * 24) = pk8(kh); *(LAS bf16x8*)(KHT + lane * 24 + 8) = pk8(kh + 8);
        { v4u w0 = {(unsigned)vr[0] | ((unsigned)vr[1] << 16), (unsigned)vr[2] | ((unsigned)vr[3] << 16), (unsigned)vr[4] | ((unsigned)vr[5] << 16), (unsigned)vr[6] | ((unsigned)vr[7] << 16)};
          v4u w1 = {(unsigned)vr[8] | ((unsigned)vr[9] << 16), (unsigned)vr[10] | ((unsigned)vr[11] << 16), (unsigned)vr[12] | ((unsigned)vr[13] << 16), (unsigned)vr[14] | ((unsigned)vr[15] << 16)};
          *(LAS v4u*)(VT + lane * 24) = w0; *(LAS v4u*)(VT + lane * 24 + 8) = w1; }
        if (OUT) {
#pragma unroll
            for (int t = 0; t < 16; ++t) {
                QT[t * 72 + lane] = (bf16)f2bf(siluf(bf1(qr[t])) * __expf(fminf(cum[t] - c7, 60.f)));
                KT[t * 72 + lane] = (bf16)f2bf(kk[t] * __expf(fminf(c7 - cum[t], 60.f)));
            }
        }
    }
    LDS_WAIT();
    bf16x8 vfr[4];
#pragma unroll
    for (int nt = 0; nt < 4; ++nt) vfr[nt] = (q < 2) ? *(const LAS bf16x8*)(VT + (16 * nt + l15) * 24 + q * 8) : zero8;
    f32x4 U[4][4];
#pragma unroll
    for (int mt = 0; mt < 4; ++mt) { const bf16x8 afr = (q < 2) ? *(const LAS bf16x8*)(KHT + (16 * mt + l15) * 24 + q * 8) : zero8;
#pragma unroll
        for (int nt = 0; nt < 4; ++nt) U[mt][nt] = __builtin_amdgcn_mfma_f32_16x16x32_bf16(afr, vfr[nt], (f32x4){0.f, 0.f, 0.f, 0.f}, 0, 0, 0); }
    f32x4 o[4]; bf16x8 qf[2];
    if (OUT) {
        LDS_WAIT();
        { const int rr = lane >> 3, cc = (lane & 7) * 8; *(LAS v4u*)(GT + rr * 72 + cc) = raw.g[0]; *(LAS v4u*)(GT + (rr + 8) * 72 + cc) = raw.g[1]; }
        f32x4 sc = {0.f, 0.f, 0.f, 0.f};
#pragma unroll
        for (int ks = 0; ks < 2; ++ks) {
            const v2u qa = *(const LAS v2u*)(QT + l15 * 72 + 32 * ks + 4 * q), qb = *(const LAS v2u*)(QT + l15 * 72 + 32 * ks + 16 + 4 * q);
            const v2u ka = *(const LAS v2u*)(KT + l15 * 72 + 32 * ks + 4 * q), kb = *(const LAS v2u*)(KT + l15 * 72 + 32 * ks + 16 + 4 * q);
            qf[ks] = __builtin_bit_cast(bf16x8, (v4u){qa.x, qa.y, qb.x, qb.y});
            const bf16x8 kf = __builtin_bit_cast(bf16x8, (v4u){ka.x, ka.y, kb.x, kb.y});
            sc = __builtin_amdgcn_mfma_f32_16x16x32_bf16(qf[ks], kf, sc, 0, 0, 0);
        }
#pragma unroll
        for (int j = 0; j < 4; ++j) { const int t = 4 * q + j; P[t * 24 + l15] = (bf16)f2bf((l15 <= t) ? sc[j] : 0.f); }
        LDS_WAIT();
        const bf16x8 pf = (q < 2) ? *(const LAS bf16x8*)(P + l15 * 24 + q * 8) : zero8;
#pragma unroll
        for (int nt = 0; nt < 4; ++nt) o[nt] = __builtin_amdgcn_mfma_f32_16x16x32_bf16(pf, vfr[nt], (f32x4){0.f, 0.f, 0.f, 0.f}, 0, 0, 0);
    }
    {
        float S8[8];
#pragma unroll
        for (int i = 0; i < 8; ++i) S8[i] = 0.f;
        if (OUT) {
            const f32x4 h0 = *(const f32x4*)(HU + (size_t)item * 4096 + (size_t)((2 * wave) * 64 + lane) * 4), h1 = *(const f32x4*)(HU + (size_t)item * 4096 + (size_t)((2 * wave + 1) * 64 + lane) * 4);
            S8[0] = h0[0]; S8[1] = h0[1]; S8[2] = h0[2]; S8[3] = h0[3]; S8[4] = h1[0]; S8[5] = h1[1]; S8[6] = h1[2]; S8[7] = h1[3];
        }
        *(LAS f32x4*)(SBUF + ((2 * wave) * 64 + lane) * 4) = (f32x4){S8[0], S8[1], S8[2], S8[3]}; *(LAS f32x4*)(SBUF + ((2 * wave + 1) * 64 + lane) * 4) = (f32x4){S8[4], S8[5], S8[6], S8[7]};
    }
    __syncthreads();
    f32x4 Sp[4][4];
#pragma unroll 1
    for (int step = 0; step < 8; ++step) {
        if (wave == step) {
#pragma unroll
            for (int mt = 0; mt < 4; ++mt) { const f32x4 Dv = *(const LAS f32x4*)(DL + 16 * mt + 4 * q);
#pragma unroll
                for (int nt = 0; nt < 4; ++nt) {
                    Sp[mt][nt] = *(const LAS f32x4*)(SBUF + ((mt * 4 + nt) * 64 + lane) * 4);
                    U[mt][nt] = Dv * Sp[mt][nt] + U[mt][nt];
                    *(LAS f32x4*)(SBUF + ((mt * 4 + nt) * 64 + lane) * 4) = U[mt][nt];
                } }
        }
        __syncthreads();
    }
    if (OUT) {
#pragma unroll
        for (int mt = 0; mt < 4; ++mt) { const f32x4 Ev = *(const LAS f32x4*)(E7L + 16 * mt + 4 * q);
#pragma unroll
            for (int nt = 0; nt < 4; ++nt) Sp[mt][nt] = Sp[mt][nt] * Ev; }
#pragma unroll
        for (int nt = 0; nt < 4; ++nt)
#pragma unroll
            for (int ks = 0; ks < 2; ++ks) {
                const f32x4 s0 = Sp[2 * ks][nt], s1 = Sp[2 * ks + 1][nt];
                const bf16x8 bfrag = __builtin_bit_cast(bf16x8, (v4u){pk2(s0[0], s0[1]), pk2(s0[2], s0[3]), pk2(s1[0], s1[1]), pk2(s1[2], s1[3])});
                o[nt] = __builtin_amdgcn_mfma_f32_16x16x32_bf16(qf[ks], bfrag, o[nt], 0, 0, 0);
            }
        float gn[4];
#pragma unroll
        for (int nt = 0; nt < 4; ++nt) gn[nt] = a.in[5][layer * 64 + 16 * nt + l15];
#pragma unroll
        for (int j = 0; j < 4; ++j) {
            float ss = (o[0][j] * o[0][j] + o[1][j] * o[1][j]) + (o[2][j] * o[2][j] + o[3][j] * o[3][j]);
            ss += __shfl_xor(ss, 1); ss += __shfl_xor(ss, 2); ss += __shfl_xor(ss, 4); ss += __shfl_xor(ss, 8);
            const float rs = __builtin_amdgcn_rsqf(ss * (1.f / 64.f) + EPS);
#pragma unroll
            for (int nt = 0; nt < 4; ++nt) { const float gt = siluf(bf1(GT[(4 * q + j) * 72 + 16 * nt + l15]));
                OT[(4 * q + j) * 72 + 16 * nt + l15] = (bf16)f2bf(o[nt][j] * rs * gn[nt] * gt); }
        }
        LDS_WAIT();
        { const int rr = lane >> 3, cc = (lane & 7) * 8; bf16* mp = (bf16*)(a.ws + WS_MIX) + (row0 + rr) * 1024 + h * 64 + cc;
          *(v4u*)mp = *(const LAS v4u*)(OT + rr * 72 + cc); *(v4u*)(mp + 8 * 1024) = *(const LAS v4u*)(OT + (rr + 8) * 72 + cc); }
    } else {
        if (wave == 7) {
#pragma unroll
            for (int mt = 0; mt < 4; ++mt)
#pragma unroll
                for (int nt = 0; nt < 4; ++nt)
                    *(f32x4*)(HU + (size_t)item * 4096 + (size_t)((mt * 4 + nt) * 64 + lane) * 4) = U[mt][nt];
            float s = 0.f;
#pragma unroll
            for (int w2 = 0; w2 < 8; ++w2) s += DALL[w2 * 64 + lane];
            HA[(size_t)item * 64 + lane] = __expf(s);
        }
    }
}

template <bool OUT> __device__ __forceinline__ HRaw hgrn_loadc(const PA& a, int bh, int c, int chunk, int lane) {
    const bf16* pr = (const bf16*)(a.ws + WS_PROJ) + ((size_t)(bh >> 2) * T + (size_t)c * 128 + chunk * 16 + (lane >> 3)) * DIN + (bh & 3) * 64 + (lane & 7) * 8;
    HRaw r;
#pragma unroll
    for (int k = 0; k < 2; ++k) { r.f[k] = *(const v4u*)(pr + (size_t)(8 * k) * DIN + 256); r.v[k] = *(const v4u*)(pr + (size_t)(8 * k) * DIN + 512);
        if (OUT) { r.q[k] = *(const v4u*)(pr + (size_t)(8 * k) * DIN); } }
    return r;
}
template <bool OUT> __device__ __forceinline__ void hgrn_chunk(const PA& a, LAS unsigned char* wb, LAS float* DLk, LAS float* E7k, LAS float* DALLk, int layer, int h, int lane, const HRaw& raw,
                                                                f32x4 (&U)[4][4], f32x4 (&o)[4], bf16x8 (&qf)[2]) {
    LAS bf16* QT = (LAS bf16*)wb; LAS bf16* KT = (LAS bf16*)(wb + 2304); LAS bf16* KHT = (LAS bf16*)(wb + 4608); LAS bf16* VT = (LAS bf16*)(wb + 7680); LAS bf16* P = (LAS bf16*)(wb + 10752);
    LAS bf16* RF = (LAS bf16*)wb; LAS bf16* RV = (LAS bf16*)(wb + 2304); LAS bf16* RQ = (LAS bf16*)(wb + 4608);
    const int l15 = lane & 15, q = lane >> 4;
    const bf16x8 zero8 = {0, 0, 0, 0, 0, 0, 0, 0};
    LDS_WAIT();
    {
        const int rr = lane >> 3, cc = (lane & 7) * 8;
#pragma unroll
        for (int k = 0; k < 2; ++k) { *(LAS v4u*)(RF + (rr + 8 * k) * 72 + cc) = raw.f[k]; *(LAS v4u*)(RV + (rr + 8 * k) * 72 + cc) = raw.v[k]; if (OUT) *(LAS v4u*)(RQ + (rr + 8 * k) * 72 + cc) = raw.q[k]; }
        LDS_WAIT();
        const float lb = (layer == 0) ? 0.f : sigmf(a.in[4][256 + h * 64 + lane] - a.in[4][h * 64 + lane]);
        {
            u16 vr[16];
#pragma unroll
            for (int t = 0; t < 16; ++t) vr[t] = RV[t * 72 + lane];
            const v4u w0 = {(unsigned)vr[0] | ((unsigned)vr[1] << 16), (unsigned)vr[2] | ((unsigned)vr[3] << 16), (unsigned)vr[4] | ((unsigned)vr[5] << 16), (unsigned)vr[6] | ((unsigned)vr[7] << 16)};
            const v4u w1 = {(unsigned)vr[8] | ((unsigned)vr[9] << 16), (unsigned)vr[10] | ((unsigned)vr[11] << 16), (unsigned)vr[12] | ((unsigned)vr[13] << 16), (unsigned)vr[14] | ((unsigned)vr[15] << 16)};
            *(LAS v4u*)(VT + lane * 24) = w0; *(LAS v4u*)(VT + lane * 24 + 8) = w1;
        }
        float cum[16], kk[16]; float run = 0.f;
#pragma unroll
        for (int t = 0; t < 16; ++t) { const float sg = sigmf(bf1(RF[t * 72 + lane])); const float f = lb + (1.f - lb) * sg; kk[t] = (1.f - lb) * (1.f - sg); run += fmaxf(__logf(f), -69.f); cum[t] = run; }
        const float cl = cum[15], c7 = cum[7];
        DLk[lane] = __expf(cl);
        if (OUT) E7k[lane] = __expf(c7); else DALLk[lane] = cl;
        if (OUT) {
            float qv[16];
#pragma unroll
            for (int t = 0; t < 16; ++t) qv[t] = bf1(RQ[t * 72 + lane]);
            LDS_WAIT();
#pragma unroll
            for (int t = 0; t < 16; ++t) {
                QT[t * 72 + lane] = (bf16)f2bf(siluf(qv[t]) * __expf(fminf(cum[t] - c7, 60.f)));
                KT[t * 72 + lane] = (bf16)f2bf(kk[t] * __expf(fminf(c7 - cum[t], 60.f)));
            }
        }
        LDS_WAIT();
        float kh[16];
#pragma unroll
        for (int t = 0; t < 16; ++t) kh[t] = kk[t] * __expf(cl - cum[t]);
        *(LAS bf16x8*)(KHT + lane * 24) = pk8(kh); *(LAS bf16x8*)(KHT + lane * 24 + 8) = pk8(kh + 8);
    }
    LDS_WAIT();
    bf16x8 vfr[4];
#pragma unroll
    for (int nt = 0; nt < 4; ++nt) vfr[nt] = (q < 2) ? *(const LAS bf16x8*)(VT + (16 * nt + l15) * 24 + q * 8) : zero8;
#pragma unroll
    for (int mt = 0; mt < 4; ++mt) { const bf16x8 afr = (q < 2) ? *(const LAS bf16x8*)(KHT + (16 * mt + l15) * 24 + q * 8) : zero8;
#pragma unroll
        for (int nt = 0; nt < 4; ++nt) U[mt][nt] = __builtin_amdgcn_mfma_f32_16x16x32_bf16(afr, vfr[nt], (f32x4){0.f, 0.f, 0.f, 0.f}, 0, 0, 0); }
    if (OUT) {
        f32x4 sc = {0.f, 0.f, 0.f, 0.f};
#pragma unroll
        for (int ks = 0; ks < 2; ++ks) {
            const v2u qa = *(const LAS v2u*)(QT + l15 * 72 + 32 * ks + 4 * q), qb = *(const LAS v2u*)(QT + l15 * 72 + 32 * ks + 16 + 4 * q);
            const v2u ka = *(const LAS v2u*)(KT + l15 * 72 + 32 * ks + 4 * q), kb = *(const LAS v2u*)(KT + l15 * 72 + 32 * ks + 16 + 4 * q);
            qf[ks] = __builtin_bit_cast(bf16x8, (v4u){qa.x, qa.y, qb.x, qb.y});
            const bf16x8 kf = __builtin_bit_cast(bf16x8, (v4u){ka.x, ka.y, kb.x, kb.y});
            sc = __builtin_amdgcn_mfma_f32_16x16x32_bf16(qf[ks], kf, sc, 0, 0, 0);
        }
#pragma unroll
        for (int j = 0; j < 4; ++j) { const int t = 4 * q + j; P[t * 24 + l15] = (bf16)f2bf((l15 <= t) ? sc[j] : 0.f); }
        LDS_WAIT();
        const bf16x8 pf = (q < 2) ? *(const LAS bf16x8*)(P + l15 * 24 + q * 8) : zero8;
#pragma unroll
        for (int nt = 0; nt < 4; ++nt) o[nt] = __builtin_amdgcn_mfma_f32_16x16x32_bf16(pf, vfr[nt], (f32x4){0.f, 0.f, 0.f, 0.f}, 0, 0, 0);
    }
}
__device__ __forceinline__ void hgrn_ointer(f32x4 (&o)[4], const bf16x8 (&qf)[2], const f32x4 (&S)[4][4], const f32x4 (&sc)[4]) {
#pragma unroll
    for (int nt = 0; nt < 4; ++nt)
#pragma unroll
        for (int ks = 0; ks < 2; ++ks) {
            const f32x4 s0 = S[2 * ks][nt] * sc[2 * ks], s1 = S[2 * ks + 1][nt] * sc[2 * ks + 1];
            const bf16x8 bfrag = __builtin_bit_cast(bf16x8, (v4u){pk2(s0[0], s0[1]), pk2(s0[2], s0[3]), pk2(s1[0], s1[1]), pk2(s1[2], s1[3])});
            o[nt] = __builtin_amdgcn_mfma_f32_16x16x32_bf16(qf[ks], bfrag, o[nt], 0, 0, 0);
        }
}
#define HG_LAUNDER() do { asm volatile("" : "+v"(lane)); l15 = lane & 15; q = lane >> 4; } while (0)
template <bool OUT> __device__ __forceinline__ void hgrn_pair(const PA& a, LAS unsigned char* lds, int layer, int bh, int s, int wave, int lane) {
    const int half = wave >> 2, wl = wave & 3, c = half ? 63 - s : s, b = bh >> 2, h = bh & 3, item = bh * 64 + c;
    float* HU = (float*)(a.ws + WS_HU); float* HA = (float*)(a.ws + WS_HA);
    LAS unsigned char* wb = lds + wave * 12800;
    LAS float* DLs = (LAS float*)(wb + 11520);
    LAS float* SBUF = (LAS float*)(lds + 102400 + half * 16384);
    LAS float* DALL = (LAS float*)(lds + 135168 + half * 2048);
    int l15 = lane & 15, q = lane >> 4;
    const size_t rowc0 = (size_t)b * T + (size_t)c * 128 + (size_t)(2 * wl) * 16;
    __syncthreads();
    f32x4 U0[4][4], Up[4][4], o[2][4]; bf16x8 qf[2][2];
    { const HRaw r0 = hgrn_loadc<OUT>(a, bh, c, 2 * wl, lane); hgrn_chunk<OUT>(a, wb, DLs, DLs + 128, DALL + (2 * wl) * 64, layer, h, lane, r0, U0, o[0], qf[0]); }
    asm volatile("" ::: "memory"); __builtin_amdgcn_sched_barrier(0); HG_LAUNDER();
    { const HRaw r1 = hgrn_loadc<OUT>(a, bh, c, 2 * wl + 1, lane); hgrn_chunk<OUT>(a, wb, DLs + 64, DLs + 192, DALL + (2 * wl + 1) * 64, layer, h, lane, r1, Up, o[1], qf[1]); }
    asm volatile("" ::: "memory"); __builtin_amdgcn_sched_barrier(0); HG_LAUNDER();
    LDS_WAIT();
    if (OUT) { f32x4 E1[4];
#pragma unroll
        for (int mt = 0; mt < 4; ++mt) E1[mt] = *(const LAS f32x4*)(DLs + 192 + 16 * mt + 4 * q);
        hgrn_ointer(o[1], qf[1], U0, E1); }
#pragma unroll
    for (int mt = 0; mt < 4; ++mt) { const f32x4 D1 = *(const LAS f32x4*)(DLs + 64 + 16 * mt + 4 * q);
#pragma unroll
        for (int nt = 0; nt < 4; ++nt) Up[mt][nt] = D1 * U0[mt][nt] + Up[mt][nt]; }
    HG_LAUNDER();
#pragma unroll
    for (int i = 0; i < 4; ++i) { f32x4 hv = {0.f, 0.f, 0.f, 0.f};
        if (OUT) hv = *(const f32x4*)(HU + (size_t)item * 4096 + (size_t)((4 * wl + i) * 64 + lane) * 4);
        *(LAS f32x4*)(SBUF + ((4 * wl + i) * 64 + lane) * 4) = hv; }
    v4u gq[2][2];
    if (OUT) { const bf16* gp = (const bf16*)(a.ws + WS_PROJ) + (rowc0 + (lane >> 3)) * DIN + 768 + h * 64 + (lane & 7) * 8;
#pragma unroll
        for (int k = 0; k < 2; ++k) { gq[k][0] = *(const v4u*)(gp + (size_t)(16 * k) * DIN); gq[k][1] = *(const v4u*)(gp + (size_t)(16 * k + 8) * DIN); } }
    __syncthreads();
    HG_LAUNDER();
    f32x4 Sin[4][4];
#pragma unroll 1
    for (int step = 0; step < 4; ++step) {
        if (wl == step) {
#pragma unroll
            for (int mt = 0; mt < 4; ++mt) { const f32x4 Dp = *(const LAS f32x4*)(DLs + 16 * mt + 4 * q) * *(const LAS f32x4*)(DLs + 64 + 16 * mt + 4 * q);
#pragma unroll
                for (int nt = 0; nt < 4; ++nt) {
                    Sin[mt][nt] = *(const LAS f32x4*)(SBUF + ((mt * 4 + nt) * 64 + lane) * 4);
                    Up[mt][nt] = Dp * Sin[mt][nt] + Up[mt][nt];
                    *(LAS f32x4*)(SBUF + ((mt * 4 + nt) * 64 + lane) * 4) = Up[mt][nt];
                } }
        }
        __syncthreads();
    }
    HG_LAUNDER();
    if (OUT) {
        { f32x4 E0[4];
#pragma unroll
          for (int mt = 0; mt < 4; ++mt) E0[mt] = *(const LAS f32x4*)(DLs + 128 + 16 * mt + 4 * q);
          hgrn_ointer(o[0], qf[0], Sin, E0);
#pragma unroll
          for (int mt = 0; mt < 4; ++mt) E0[mt] = *(const LAS f32x4*)(DLs + 192 + 16 * mt + 4 * q) * *(const LAS f32x4*)(DLs + 16 * mt + 4 * q);
          hgrn_ointer(o[1], qf[1], Sin, E0); }
        HG_LAUNDER();
        LAS bf16* GT = (LAS bf16*)(wb + 4608); LAS bf16* OT = (LAS bf16*)(wb + 7680);
        float gn[4];
#pragma unroll
        for (int nt = 0; nt < 4; ++nt) gn[nt] = a.in[5][layer * 64 + 16 * nt + l15];
#pragma unroll
        for (int k = 0; k < 2; ++k) {
            const int rr = lane >> 3, cc = (lane & 7) * 8;
            LDS_WAIT();
            *(LAS v4u*)(GT + rr * 72 + cc) = gq[k][0]; *(LAS v4u*)(GT + (rr + 8) * 72 + cc) = gq[k][1];
            LDS_WAIT();
#pragma unroll
            for (int j = 0; j < 4; ++j) {
                float ss = (o[k][0][j] * o[k][0][j] + o[k][1][j] * o[k][1][j]) + (o[k][2][j] * o[k][2][j] + o[k][3][j] * o[k][3][j]);
                ss += __shfl_xor(ss, 1); ss += __shfl_xor(ss, 2); ss += __shfl_xor(ss, 4); ss += __shfl_xor(ss, 8);
                const float rs = __builtin_amdgcn_rsqf(ss * (1.f / 64.f) + EPS);
#pragma unroll
                for (int nt = 0; nt < 4; ++nt) { const float gt = siluf(bf1(GT[(4 * q + j) * 72 + 16 * nt + l15]));
                    OT[(4 * q + j) * 72 + 16 * nt + l15] = (bf16)f2bf(o[k][nt][j] * rs * gn[nt] * gt); }
            }
            LDS_WAIT();
            bf16* mp = (bf16*)(a.ws + WS_MIX) + (rowc0 + k * 16 + rr) * 1024 + h * 64 + cc;
            *(v4u*)mp = *(const LAS v4u*)(OT + rr * 72 + cc); *(v4u*)(mp + 8 * 1024) = *(const LAS v4u*)(OT + (rr + 8) * 72 + cc);
        }
    } else {
        if (wl == 3) {
#pragma unroll
            for (int mt = 0; mt < 4; ++mt)
#pragma unroll
                for (int nt = 0; nt < 4; ++nt)
                    *(f32x4*)(HU + (size_t)item * 4096 + (size_t)((mt * 4 + nt) * 64 + lane) * 4) = Up[mt][nt];
            float sm = 0.f;
#pragma unroll
            for (int w2 = 0; w2 < 8; ++w2) sm += DALL[w2 * 64 + lane];
            HA[(size_t)item * 64 + lane] = __expf(sm);
        }
    }
}

__device__ __forceinline__ float gelu_tanh(float y) { const float z = 0.7978845608028654f * (y + 0.044715f * y * y * y); return y * sigmf(2.f * z); }
template <bool OUT> __device__ __forceinline__ void s5_item(const PA& a, LAS unsigned char* lds, int layer, int item, int wave, int lane) {
    const int b = item >> 10, g = (item >> 6) & 15, c = item & 63, lg = layer * 16 + g;
    const bf16* PROJ = (const bf16*)(a.ws + WS_PROJ);
    const float* sa = (const float*)(a.ws + WS_S5A) + (size_t)lg * 256;
    float* XL = (float*)(a.ws + WS_XLOC) + (size_t)((b * 16 + g) * 64) * 128;
    const float ar = sa[lane], ai = sa[64 + lane];
    float xr = 0.f, xi = 0.f;
    if (OUT) { xr = XL[c * 128 + lane]; xi = XL[c * 128 + 64 + lane]; }
    const int l15 = lane & 15, quad = lane >> 4;
    const bf16x8 zero8 = {0, 0, 0, 0, 0, 0, 0, 0};
    bf16x8 bfr[8];
#pragma unroll
    for (int nt = 0; nt < 8; ++nt) bfr[nt] = (quad < 2) ? *(const bf16x8*)((const bf16*)(a.ws + WS_S5B) + (size_t)lg * 2048 + (nt * 16 + l15) * 16 + quad * 8) : zero8;
    bf16x8 cfr[4];
    if (OUT) {
#pragma unroll
        for (int ks = 0; ks < 4; ++ks) cfr[ks] = *(const bf16x8*)((const bf16*)(a.ws + WS_S5C) + (size_t)lg * 2048 + l15 * 128 + ks * 32 + quad * 8);
    }
    const float dsk = a.in[13][layer * 256 + g * 16 + l15];
    LAS float* BU = (LAS float*)(lds + wave * 12800);
    LAS bf16* X = (LAS bf16*)(lds + wave * 12800 + 8448);
    const size_t rowb = (size_t)b * T + (size_t)c * 128;
    bf16x8 afr_n = (quad < 2) ? *(const bf16x8*)(PROJ + (rowb + l15) * DIN + 1024 + g * 16 + quad * 8) : zero8;
    bf16 ue_n[4] = {0, 0, 0, 0}, se_n[4] = {0, 0, 0, 0};
    if (OUT) {
#pragma unroll
        for (int j = 0; j < 4; ++j) { ue_n[j] = PROJ[(rowb + quad * 4 + j) * DIN + 1024 + g * 16 + l15]; se_n[j] = PROJ[(rowb + quad * 4 + j) * DIN + 1280 + g * 16 + l15]; }
    }
    f32x4 accn[8];
#pragma unroll
    for (int nt = 0; nt < 8; ++nt) accn[nt] = __builtin_amdgcn_mfma_f32_16x16x32_bf16(afr_n, bfr[nt], (f32x4){0.f, 0.f, 0.f, 0.f}, 0, 0, 0);
#pragma unroll
    for (int nt = 0; nt < 8; ++nt)
#pragma unroll
        for (int j = 0; j < 4; ++j) BU[(quad * 4 + j) * 132 + nt * 16 + l15] = accn[nt][j];
    afr_n = (quad < 2) ? *(const bf16x8*)(PROJ + (rowb + 16 + l15) * DIN + 1024 + g * 16 + quad * 8) : zero8;
    for (int blk = 0; blk < 8; ++blk) {
        const size_t row0 = rowb + blk * 16;
        bf16 ue[4], se[4];
#pragma unroll
        for (int j = 0; j < 4; ++j) { ue[j] = ue_n[j]; se[j] = se_n[j]; }
        if (blk + 1 < 8) {
#pragma unroll
            for (int nt = 0; nt < 8; ++nt) accn[nt] = __builtin_amdgcn_mfma_f32_16x16x32_bf16(afr_n, bfr[nt], (f32x4){0.f, 0.f, 0.f, 0.f}, 0, 0, 0);
            if (blk + 2 < 8) afr_n = (quad < 2) ? *(const bf16x8*)(PROJ + (row0 + 32 + l15) * DIN + 1024 + g * 16 + quad * 8) : zero8;
            if (OUT) {
#pragma unroll
                for (int j = 0; j < 4; ++j) { ue_n[j] = PROJ[(row0 + 16 + quad * 4 + j) * DIN + 1024 + g * 16 + l15]; se_n[j] = PROJ[(row0 + 16 + quad * 4 + j) * DIN + 1280 + g * 16 + l15]; }
            }
        }
#pragma unroll
        for (int t = 0; t < 16; ++t) {
            const float br = BU[t * 132 + lane], bi = BU[t * 132 + 64 + lane];
            const float nr = ar * xr - ai * xi + br, ni = ar * xi + ai * xr + bi; xr = nr; xi = ni;
            if (OUT) { X[t * 136 + lane] = (bf16)f2bf(xr); X[t * 136 + 64 + lane] = (bf16)f2bf(xi); }
        }
        if (blk + 1 < 8) {
#pragma unroll
            for (int nt = 0; nt < 8; ++nt)
#pragma unroll
                for (int j = 0; j < 4; ++j) BU[(quad * 4 + j) * 132 + nt * 16 + l15] = accn[nt][j];
        }
        if (OUT) {
            f32x4 acc = {0.f, 0.f, 0.f, 0.f};
#pragma unroll
            for (int ks = 0; ks < 4; ++ks) { const bf16x8 xa = *(const LAS bf16x8*)(X + l15 * 136 + ks * 32 + quad * 8); acc = __builtin_amdgcn_mfma_f32_16x16x32_bf16(xa, cfr[ks], acc, 0, 0, 0); }
#pragma unroll
            for (int j = 0; j < 4; ++j) { const size_t row = row0 + quad * 4 + j;
                const float u = bf1(ue[j]);
                const float yg = gelu_tanh(acc[j] + dsk * u);
                ((bf16*)(a.ws + WS_YG))[row * 256 + g * 16 + l15] = (bf16)f2bf(yg);
                ((bf16*)(a.ws + WS_YGS))[row * 256 + g * 16 + l15] = (bf16)f2bf(yg * siluf(bf1(se[j]))); }
        }
    }
    LDS_WAIT();
    if (!OUT) { XL[c * 128 + lane] = xr; XL[c * 128 + 64 + lane] = xi; }
}


__device__ __forceinline__ void hgrn_scan(const PA& a, int task, int lane) {
    float* HU = (float*)(a.ws + WS_HU); const float* HA = (const float*)(a.ws + WS_HA);
    const int bh = task >> 6, r = task & 63, dk = 16 * (r >> 4) + 4 * (r & 3) + (lane & 3);
    float* up = HU + (size_t)(bh * 64) * 4096 + (size_t)r * 64 + lane; const float* ap = HA + (size_t)(bh * 64) * 64 + dk;
    float S = 0.f;
#pragma unroll 1
    for (int c0 = 0; c0 < 64; c0 += 32) {
        float u[32], av[32];
#pragma unroll
        for (int i = 0; i < 32; ++i) { u[i] = up[(size_t)(c0 + i) * 4096]; av[i] = ap[(size_t)(c0 + i) * 64]; }
#pragma unroll
        for (int i = 0; i < 32; ++i) { __hip_atomic_store(up + (size_t)(c0 + i) * 4096, S, __ATOMIC_RELAXED, __HIP_MEMORY_SCOPE_AGENT); S = av[i] * S + u[i]; }
    }
}
__device__ __forceinline__ void s5_scan(const PA& a, int layer, int task, int lane) {
    const int g = task & 15;
    const float* sa = (const float*)(a.ws + WS_S5A) + (size_t)(layer * 16 + g) * 256;
    float* XL = (float*)(a.ws + WS_XLOC) + (size_t)(task * 64) * 128;
    const float Lr = sa[128 + lane], Li = sa[192 + lane];
    float xr = 0.f, xi = 0.f;
#pragma unroll 1
    for (int c0 = 0; c0 < 64; c0 += 32) {
        float lr[32], li[32];
#pragma unroll
        for (int i = 0; i < 32; ++i) { lr[i] = XL[(c0 + i) * 128 + lane]; li[i] = XL[(c0 + i) * 128 + 64 + lane]; }
#pragma unroll
        for (int i = 0; i < 32; ++i) { __hip_atomic_store(XL + (c0 + i) * 128 + lane, xr, __ATOMIC_RELAXED, __HIP_MEMORY_SCOPE_AGENT); __hip_atomic_store(XL + (c0 + i) * 128 + 64 + lane, xi, __ATOMIC_RELAXED, __HIP_MEMORY_SCOPE_AGENT);
            const float nr = Lr * xr - Li * xi + lr[i], ni = Lr * xi + Li * xr + li[i]; xr = nr; xi = ni; }
    }
}
template <int NR> __device__ __forceinline__ void combine_rows(const PA& a, int layer, float lam, float post, size_t row0, size_t rstride, int lane) {
    const bf16* O = (const bf16*)(a.ws + WS_O); const bf16* PROJ = (const bf16*)(a.ws + WS_PROJ);
    const int h = lane >> 4, e0 = (lane & 15) * 8, j = e0 >> 6, d = e0 & 63;
    v4u o0[NR], o1[NR], gv[NR];
#pragma unroll
    for (int r = 0; r < NR; ++r) { const size_t row = row0 + r * rstride;
        o0[r] = *(const v4u*)(O + row * 1024 + (h * 4 + j) * 64 + d); o1[r] = *(const v4u*)(O + row * 1024 + (h * 4 + 2 + j) * 64 + d); gv[r] = *(const v4u*)(PROJ + row * DIN + 3072 + h * 128 + e0); }
    const f32x4 sw0 = *(const f32x4*)(a.in[20] + layer * 128 + e0), sw1 = *(const f32x4*)(a.in[20] + layer * 128 + e0 + 4);
    const float sw[8] = {sw0[0], sw0[1], sw0[2], sw0[3], sw1[0], sw1[1], sw1[2], sw1[3]};
#pragma unroll
    for (int r = 0; r < NR; ++r) { const size_t row = row0 + r * rstride;
        const unsigned a0[4] = {o0[r].x, o0[r].y, o0[r].z, o0[r].w}, a1[4] = {o1[r].x, o1[r].y, o1[r].z, o1[r].w}, ga[4] = {gv[r].x, gv[r].y, gv[r].z, gv[r].w};
        float v[8]; float ss = 0.f;
#pragma unroll
        for (int q = 0; q < 8; ++q) { const float x0 = (q & 1) ? bfhi(a0[q >> 1]) : bflo(a0[q >> 1]), x1 = (q & 1) ? bfhi(a1[q >> 1]) : bflo(a1[q >> 1]); v[q] = x0 - lam * x1; ss += v[q] * v[q]; }
        ss += __shfl_xor(ss, 1); ss += __shfl_xor(ss, 2); ss += __shfl_xor(ss, 4); ss += __shfl_xor(ss, 8);
        const float rs = post * __builtin_amdgcn_rsqf(ss * (1.f / 128.f) + EPS);
        float o[8];
#pragma unroll
        for (int q = 0; q < 8; ++q) { const float gq = (q & 1) ? bfhi(ga[q >> 1]) : bflo(ga[q >> 1]); o[q] = v[q] * rs * sw[q] * siluf(gq); }
        *(v4u*)((bf16*)(a.ws + WS_MIX) + row * 1024 + 512 + h * 128 + e0) = (v4u){pk2(o[0], o[1]), pk2(o[2], o[3]), pk2(o[4], o[5]), pk2(o[6], o[7])};
    }
}

__global__ void __launch_bounds__(NWAVES * 64, 2) hymba_fwd(Args args) {
    extern __shared__ __attribute__((aligned(16))) unsigned char lds_raw[];
    LAS unsigned char* lds = (LAS unsigned char*)lds_raw;
    cg::grid_group grid = cg::this_grid();
    int tid = threadIdx.x, lane = tid & 63, wave = __builtin_amdgcn_readfirstlane(tid >> 6);
#define RELAUNDER() do { int t_ = threadIdx.x; asm volatile("" : "+v"(t_)); tid = t_; lane = tid & 63; wave = __builtin_amdgcn_readfirstlane(tid >> 6); } while (0)
    const int G = gridDim.x, bx = blockIdx.x, vcu = (G % 8 == 0) ? (bx % 8) * (G / 8) + bx / 8 : bx;
    unsigned char* ws = args.ws;
    const int lo = args.ph_lo, hi = args.ph_hi;
    volatile LAS unsigned* MISC = (volatile LAS unsigned*)(lds + LDS_BYTES - 256);
    if (tid < 32) MISC[tid] = 0u;
    __syncthreads();
    unsigned* barw = (unsigned*)(ws + WS_CTL);
    XcdBarrier bar; bar.bar = barw; bar.x = 0; bar.st = MISC + 8;
    int ph = 0;
#ifndef MK_DIS
#define MK_DIS 0
#endif
#define EN(bit) (!((MK_DIS >> (bit)) & 1))
#ifndef MK_REP
#define MK_REP 0
#endif
#define REPS(bit) for (int rep_ = 0; rep_ < 1 + ((MK_REP >> (bit)) & 1); ++rep_)
#define IN(k) (lo <= (k) && (k) < hi)
#define SEAM() do { if (IN(ph) && IN(ph + 1)) { xcd_barrier(bar); if ((MK_REP >> 10) & 1) xcd_barrier(bar); } ++ph; RELAUNDER(); } while (0)
    bf16* PROJ = (bf16*)(ws + WS_PROJ); bf16* XN = (bf16*)(ws + WS_XN); bf16* MIX = (bf16*)(ws + WS_MIX);
    const int NGW = G * NWAVES;
#define gw (vcu * NWAVES + wave)

    const float** tabw = (const float**)(ws + WS_TAB);
    bar = xcd_barrier_post(barw, MISC + 8);
    if (IN(ph) && EN(0)) { if (bx == 0) {
            if (tid == 0) {
#pragma unroll
                for (int i = 0; i < 22; ++i) tabw[i] = args.in[i]; } }
        REPS(0) { __syncthreads(); prologue(args, lds, vcu, G, wave, lane); } }
    const PA pa{(const float* const*)tabw, args.out, ws};
    if (lo < 0) grid.sync();
    SEAM();
    for (int layer = 0; layer < DEPTH; ++layer) {
        if (IN(ph) && EN(1)) REPS(1) {
            pg8::Gemm g{(const bf16*)(ws + WS_HRES), (const bf16*)(ws + WS_WIN) + (size_t)layer * DIN * D, M, DIN, D}; pg8::StaticOrder S; S.init(M, DIN, G, bx);
            pg8::EpiInProj E{PROJ, (const float*)(ws + WS_ROPE), attn_body::C2, layer == 0 ? (const float*)(ws + WS_ROWSS0) : (const float*)(ws + WS_ROWSS), (unsigned*)(ws + WS_SUCNT) + layer * 64};
            pg8::gemm_phase<pg8::EpiInProj, pg8::StaticOrder, PG8_ALIGN, PG8_SP2>(lds, g, S, E);
            if (G == 256 && bx >= 128) {
                __syncthreads();
                if (wave == 0) { unsigned* sucnt = (unsigned*)(ws + WS_SUCNT) + layer * 64; unsigned spins = 0;
                    while ((unsigned)__builtin_amdgcn_readfirstlane(__hip_atomic_load(sucnt, __ATOMIC_RELAXED, __HIP_MEMORY_SCOPE_AGENT)) < 512u) { __builtin_amdgcn_s_sleep(4); if (++spins > (1u << 22)) break; }
                    __builtin_amdgcn_fence(__ATOMIC_ACQUIRE, "agent"); asm volatile("s_waitcnt vmcnt(0)" ::: "memory"); }
                __syncthreads();
                RELAUNDER();
                for (int it = (bx - 128) * NWAVES + wave; it < 2048; it += 128 * NWAVES) s5_item<false>(pa, lds, layer, it, wave, lane);
            }
        }
        SEAM();
        if (IN(ph)) {
            if (EN(2) && G != 256) REPS(2) for (int it = gw; it < 2048; it += NGW) s5_item<false>(pa, lds, layer, it, wave, lane);
            RELAUNDER();
            if (EN(3)) REPS(3) for (int v = vcu; v < 256; v += G) hgrn_pair<false>(pa, lds, layer, v >> 5, v & 31, wave, lane);
            xcd_barrier(bar);
            unsigned* scnt = (unsigned*)(ws + WS_SCNT) + layer * 64;
            { unsigned ndone = 0;
              if (wave < 2) { for (int t2 = wave * G + vcu; t2 < 512; t2 += 2 * G) { hgrn_scan(pa, t2, lane); ++ndone; } }
              else if (wave == 2) { for (int t2 = vcu; t2 < 32; t2 += G) { s5_scan(pa, layer, t2, lane); ++ndone; } }
              if (ndone) { asm volatile("s_waitcnt vmcnt(0)" ::: "memory"); if (lane == 0) (void)__hip_atomic_fetch_add(scnt, ndone, __ATOMIC_RELAXED, __HIP_MEMORY_SCOPE_AGENT); } }
            __syncthreads();
            const attn_body::AttnTensors AT{(const attn_body::bf16*)PROJ, (const attn_body::bf16*)PROJ, (const attn_body::bf16*)PROJ, (attn_body::bf16*)(ws + WS_O)};
            if (EN(4)) REPS(4) for (int v = vcu; v < 256; v += G) { const attn_body::StaticOrder S(v); attn_body::attn_phase<attn_body::StaticOrder>((char*)lds_raw, AT, S); }
        }
        ++ph; RELAUNDER();
        if (IN(ph)) {
            __syncthreads();
            if (wave == 0) { unsigned* scnt = (unsigned*)(ws + WS_SCNT) + layer * 64; unsigned spins = 0;
                while ((unsigned)__builtin_amdgcn_readfirstlane(__hip_atomic_load(scnt, __ATOMIC_RELAXED, __HIP_MEMORY_SCOPE_AGENT)) < 544u) { __builtin_amdgcn_s_sleep(4); if (++spins > (1u << 22)) break; }
                __builtin_amdgcn_fence(__ATOMIC_ACQUIRE, "agent"); asm volatile("s_waitcnt vmcnt(0)" ::: "memory"); }
            __syncthreads();
            if (EN(5)) REPS(5) for (int it = gw; it < 2048; it += NGW) s5_item<true>(pa, lds, layer, it, wave, lane);
            RELAUNDER();
            if (EN(6)) REPS(6) for (int v = vcu; v < 256; v += G) { const int bh = v >> 5, s = v & 31; const HRaw r1 = hgrn_load<true>(pa, bh, s, wave, lane), r2 = hgrn_load<true>(pa, bh, 63 - s, wave, lane); hgrn_item2<true>(pa, lds, layer, bh, s, wave, lane, r1); hgrn_item2<true>(pa, lds, layer, bh, 63 - s, wave, lane, r2); }
        }
        SEAM();
        const int cb0 = (G > 64) ? 64 : 0;
        if (IN(ph) && bx >= cb0) {
            const float l1 = wave_sum(pa.in[16][layer * 64 + lane] * pa.in[17][layer * 64 + lane]), l2 = wave_sum(pa.in[18][layer * 64 + lane] * pa.in[19][layer * 64 + lane]);
            const float linit = (layer == 0) ? 0.2f : 0.35550906759096934f;
            const float lam = __expf(l1) - __expf(l2) + linit;
            if (EN(7)) REPS(7) { const int nw_ = (G - cb0) * NWAVES; int m = (bx - cb0) * NWAVES + wave;
                for (; m + 3 * nw_ < M; m += 4 * nw_) combine_rows<4>(pa, layer, lam, 1.f - linit, (size_t)m, (size_t)nw_, lane);
                for (; m < M; m += nw_) combine_rows<1>(pa, layer, lam, 1.f - linit, (size_t)m, 0, lane); }
        }
        if (IN(ph) && EN(8) && (bx < 64 || G <= 64)) REPS(8) {
            __syncthreads();
            int kglu = 256; asm volatile("" : "+s"(kglu));
            pg8::Gemm g{(const bf16*)(ws + WS_YG), (const bf16*)(ws + WS_GLU) + (size_t)layer * 65536, M, 256, kglu}; pg8::StaticOrder S; S.init(M, 256, G, bx);
            pg8::EpiGlu E{(const bf16*)(ws + WS_YGS), pa.in[15] + layer * 256, MIX};
            pg8::gemm_phase<pg8::EpiGlu, pg8::StaticOrder, PG8_ALIGN, PG8_SP2>(lds, g, S, E);
        }
        SEAM();
        if (IN(ph) && EN(9)) for (int rep_ = 0; rep_ < 1 + (((MK_REP >> 9) & 1) && layer == 0); ++rep_) {
            pg8::Gemm g{MIX, (const bf16*)(ws + WS_WOUT) + (size_t)layer * D * D, M, D, D}; pg8::StaticOrder S; S.init(M, D, G, bx);
            if (layer + 1 < DEPTH) { pg8::EpiRes<true> E{nullptr, nullptr, (float*)(ws + WS_ROWSS), (const bf16*)(ws + WS_HRES), (bf16*)(ws + WS_HRES)};
                pg8::gemm_phase<pg8::EpiRes<true>, pg8::StaticOrder, PG8_ALIGN, PG8_SP2>(lds, g, S, E); }
            else if (G == 256) { pg8::EpiResFinal E{(const bf16*)(ws + WS_HRES), pa.out, (float*)(ws + WS_ROWSS2), (unsigned*)(ws + WS_PCNT), pa.in[21]};
                pg8::gemm_phase<pg8::EpiResFinal, pg8::StaticOrder, false, PG8_SP2>(lds, g, S, E); }
            else { pg8::EpiRes<false> E{nullptr, pa.out, nullptr, (const bf16*)(ws + WS_HRES), nullptr};
                pg8::gemm_phase<pg8::EpiRes<false>, pg8::StaticOrder, PG8_ALIGN, PG8_SP2>(lds, g, S, E); }
        }
        if (layer + 1 < DEPTH) { SEAM(); continue; }
        if (G == 256) break;
        SEAM();
        if (IN(ph)) {
            for (int m = gw; m < M; m += NGW) rms_row<true>(pa.out + (size_t)m * D, pa.in[21], nullptr, pa.out + (size_t)m * D, lane);
        }
    }
#undef IN
#undef SEAM
}
constexpr int N_PHASES = 1 + DEPTH * 5 + 1;

#ifndef MK_SPLIT
#define MK_SPLIT 0
#endif
extern "C" void kernel_launch(void* const* d_in, const int* in_sizes, int n_in, void* d_out, int out_size, void* d_ws, size_t ws_size, hipStream_t stream) {
    static int grid = 0;
    if (grid == 0) {
        if (n_in != 22 || in_sizes[0] != M * D || out_size != M * D || ws_size < WS_END) { fprintf(stderr, "kernel_launch: unexpected shapes (n_in %d, in0 %d, out %d, ws %zu)\n", n_in, n_in > 0 ? in_sizes[0] : -1, out_size, ws_size); grid = -1; return; }
        int dev = 0, cus = 0, per_cu = 0;
        hipGetDevice(&dev); hipDeviceGetAttribute(&cus, hipDeviceAttributeMultiprocessorCount, dev);
        hipFuncSetAttribute((const void*)hymba_fwd, hipFuncAttributeMaxDynamicSharedMemorySize, LDS_BYTES);
        hipOccupancyMaxActiveBlocksPerMultiprocessor(&per_cu, (const void*)hymba_fwd, NWAVES * 64, LDS_BYTES);
        (void)hipGetLastError();
        if (per_cu < 1) per_cu = 1;
        grid = cus * per_cu; if (grid > 256) grid = 256;
        fprintf(stderr, "kernel_launch: cus %d per_cu %d grid %d\n", cus, per_cu, grid);
    }
    if (grid < 0) return;
    Args a{};
    for (int i = 0; i < 22; ++i) a.in[i] = (const float*)d_in[i];
    a.out = (float*)d_out; a.ws = (unsigned char*)d_ws;
#if MK_SPLIT
    for (int p = 0; p < N_PHASES; ++p) { a.ph_lo = p; a.ph_hi = p + 1; hipLaunchKernelGGL(hymba_fwd, dim3(grid), dim3(NWAVES * 64), LDS_BYTES, stream, a); }
#else
    a.ph_lo = 0; a.ph_hi = N_PHASES;
    (void)hipMemsetAsync((char*)d_ws + WS_CTL, 0, 16384, stream);
    void* kargs[] = {&a};
    hipError_t e = hipLaunchCooperativeKernel((const void*)hymba_fwd, dim3(grid), dim3(NWAVES * 64), kargs, LDS_BYTES, stream);
    if (e != hipSuccess) fprintf(stderr, "cooperative launch failed: %s (grid %d)\n", hipGetErrorString(e), grid);
#endif
}
```

```cpp
#include <hip/hip_runtime.h>
#include <hip/hip_cooperative_groups.h>
#include <cstdio>
#include <cstdint>
namespace pg8 {
#define PG8_LAS __attribute__((address_space(3)))
typedef unsigned short bf16_t;
typedef short bf16x8 __attribute__((ext_vector_type(8)));
typedef float f32x4 __attribute__((ext_vector_type(4)));
typedef unsigned u32x4 __attribute__((ext_vector_type(4)));
constexpr int BM = 256, BK = 64, HALF = 128, HTB = HALF * BK * 2  , STAGE_BYTES = 8 * HTB, NXCD = 8, WGM = 8;

__host__ __device__ __forceinline__ int lds_byte(int r, int c) { const int st = (r >> 4) * 2 + (c >> 5), rr = r & 15, cc = c & 31, ob = rr * 64 + cc * 2; return st * 1024 + (ob ^ (((ob >> 9) & 1) << 5)); }
__host__ __device__ __forceinline__ void stage_rc(int b, int& R, int& C) { const int st = b / 1024, sb = b % 1024, swz = sb ^ (((sb >> 9) & 1) << 5); R = (st >> 1) * 16 + swz / 64; C = (st & 1) * 32 + (swz % 64) / 2; }
__host__ __device__ __forceinline__ int perm32(int rho) { const int n = rho >> 4, i = rho & 15; return 8 * (i >> 2) + 4 * n + (i & 3); }

struct Unit { int pm, pn; };
struct Gemm { const bf16_t* A; const bf16_t* Bt; int M, N, K; };

struct StaticOrder {
    int nM, nN, nwg, G, c;
    __host__ __device__ void init(int M, int N, int G_, int c_) { nM = M / BM; nN = N / BM; nwg = nM * nN; G = G_; c = c_; }
    __host__ __device__ bool next(int i, Unit& u) const {
        const long L = (long)i * G + c; if (L >= nwg) return false;
        int wgid = (int)L; { const int q = nwg / NXCD, r = nwg % NXCD, xcd = wgid % NXCD, off = wgid / NXCD; wgid = (xcd < r ? xcd * (q + 1) : r * (q + 1) + (xcd - r) * q) + off; }
        const int nig = WGM * nN, gid = wgid / nig, fm = gid * WGM, gsz = (nM - fm) < WGM ? (nM - fm) : WGM;
        u.pm = fm + ((wgid % nig) % gsz); u.pn = (wgid % nig) / gsz; return true;
    }
    __device__ __forceinline__ void a_ready(const Unit&) const {}
    __device__ __forceinline__ void done(const Unit&) const {}
};

__device__ __forceinline__ unsigned cvt_pk_bf16(float lo, float hi) { unsigned r; asm volatile("v_cvt_pk_bf16_f32 %0, %1, %2" : "=v"(r) : "v"(lo), "v"(hi)); return r; }
typedef float f32x2 __attribute__((ext_vector_type(2)));
__device__ __forceinline__ f32x2 gelu_pk(f32x2 v) {
    const f32x2 av = __builtin_elementwise_abs(v), d = av * 0.2316418882f + 1.0f;
    f32x2 t; t.x = __builtin_amdgcn_rcpf(d.x); t.y = __builtin_amdgcn_rcpf(d.y);
    f32x2 q = t * 0.5307027145f + (-0.7265760135f); q = q * t + 0.7107068705f; q = q * t + (-0.142248368f); q = q * t + 0.127414796f; q = q * t;
    const f32x2 s = (v * v) * (-0.72134752044f);
    f32x2 e; e.x = __builtin_amdgcn_exp2f(s.x); e.y = __builtin_amdgcn_exp2f(s.y);
    const f32x2 m = v * (q * e), r = v - m;
    f32x2 o; o.x = v.x < 0.f ? m.x : r.x; o.y = v.y < 0.f ? m.y : r.y; return o;
}

template <int ACT  > struct EpiBf16 {
    static constexpr bool PERM = true, AFTER_DRAIN = false; static_assert(ACT == 0 || ACT == 1, "EpiBf16: ACT is 0 (none) or 1 (gelu_pk)");
    bf16_t* O; int ldc; const float* bias; int split_cols; size_t split_stride; float scale0;
    __device__ __forceinline__ void operator()(const f32x4 (&acc)[2][2][4][2], const Unit& u, int wr, int wc, int fr, int fq) const {
        const int row0 = u.pm * BM + wr * 64 + fr; int colt = u.pn * BM; bf16_t* base = O;
        float sc = 1.f; if (split_cols) { const int t = colt / split_cols; base += (size_t)t * split_stride; colt -= t * split_cols; if (t == 0) sc = scale0; }
        const int col0 = colt + wc * 32 + 8 * fq, bcol0 = u.pn * BM + wc * 32 + 8 * fq;
        f32x4 bv[2][2];
#pragma unroll
        for (int bj = 0; bj < 2; ++bj)
#pragma unroll
            for (int n = 0; n < 2; ++n) bv[bj][n] = bias ? *(const f32x4*)(bias + bcol0 + bj * HALF + 4 * n) : (f32x4){0.f, 0.f, 0.f, 0.f};
#pragma unroll
        for (int ai = 0; ai < 2; ++ai)
#pragma unroll
            for (int m = 0; m < 4; ++m) { bf16_t* rowp = base + (size_t)(row0 + ai * HALF + m * 16) * ldc + col0;
#pragma unroll
                for (int bj = 0; bj < 2; ++bj) { f32x4 v0 = acc[ai][bj][m][0] + bv[bj][0], v1 = acc[ai][bj][m][1] + bv[bj][1];
                    if (ACT == 1) { f32x2 a = gelu_pk((f32x2){v0[0], v0[1]}), b = gelu_pk((f32x2){v0[2], v0[3]}), c = gelu_pk((f32x2){v1[0], v1[1]}), d = gelu_pk((f32x2){v1[2], v1[3]});
                        v0 = (f32x4){a.x, a.y, b.x, b.y}; v1 = (f32x4){c.x, c.y, d.x, d.y}; }
                    v0 = v0 * sc; v1 = v1 * sc; u32x4 w; w.x = cvt_pk_bf16(v0[0], v0[1]); w.y = cvt_pk_bf16(v0[2], v0[3]); w.z = cvt_pk_bf16(v1[0], v1[1]); w.w = cvt_pk_bf16(v1[2], v1[3]);
                    *(u32x4*)(rowp + bj * HALF) = w; } }
    }
};
__device__ __forceinline__ float bf2f(unsigned short h) { return __uint_as_float(((unsigned)h) << 16); }
#define WT_RSRC(base, bytes) __builtin_amdgcn_make_buffer_rsrc((void*)(base), 0, (int)(bytes), 0x00020000)
#define WT_ST16(rsrc, byteoff, v) __builtin_amdgcn_raw_buffer_store_b128((v), (rsrc), (unsigned)(byteoff), 0, 16)
__device__ __forceinline__ float sigm(float v) { return __builtin_amdgcn_rcpf(1.0f + __builtin_amdgcn_exp2f(-1.4426950408889634f * v)); }
struct EpiInProj {
    static constexpr bool PERM = true, AFTER_DRAIN = false;
    bf16_t* O; const float* rope; float qscale; const float* rowss; unsigned* sucnt;
    __device__ __forceinline__ void operator()(const f32x4 (&acc)[2][2][4][2], const Unit& u, int wr, int wc, int fr, int fq) const {
        const int row0 = u.pm * BM + wr * 64 + fr, col0 = u.pn * BM + wc * 32 + 8 * fq;
        const bool ropewave = (u.pn >= 6 && u.pn < 10) && ((wc & 1) == 0);
        const float sc = (u.pn == 6 || u.pn == 7) ? qscale : 1.f;
        const float sgn = (fq == 0) ? -1.f : 1.f;
        const bool pub = (u.pn == 4);
        const __amdgpu_buffer_rsrc_t orsrc = WT_RSRC(O, 16384u * 3584u * 2u);
        float rsv[2][4];
#pragma unroll
        for (int ai = 0; ai < 2; ++ai)
#pragma unroll
            for (int m = 0; m < 4; ++m) rsv[ai][m] = rowss ? rowss[row0 + ai * HALF + m * 16] : 0.f;
#pragma unroll
        for (int ai = 0; ai < 2; ++ai)
#pragma unroll
            for (int m = 0; m < 4; ++m) {
                const int row = row0 + ai * HALF + m * 16;
                bf16_t* rowp = O + (size_t)row * 3584 + col0;
                const float scr = rowss ? sc * __builtin_amdgcn_rsqf(rsv[ai][m] * (1.0f / 1024.0f) + 1e-6f) : sc;
                f32x4 cs[4];
                if (ropewave) { const float* rp = rope + (size_t)(row & 8191) * 16;
#pragma unroll
                    for (int k = 0; k < 4; ++k) cs[k] = *(const f32x4*)(rp + 4 * k); }
#pragma unroll
                for (int bj = 0; bj < 2; ++bj) {
                    f32x4 v0 = acc[ai][bj][m][0], v1 = acc[ai][bj][m][1];
                    if (ropewave) {
                        float v[8] = {v0[0], v0[1], v0[2], v0[3], v1[0], v1[1], v1[2], v1[3]};
#pragma unroll
                        for (int j = 0; j < 8; ++j) {
                            const float p = __shfl_xor(v[j], 16);
                            const float c = cs[j >> 1][(j & 1) * 2], s = cs[j >> 1][(j & 1) * 2 + 1];
                            const float nv = v[j] * c + sgn * p * s;
                            v[j] = (fq < 2) ? nv : v[j];
                        }
                        v0 = (f32x4){v[0], v[1], v[2], v[3]}; v1 = (f32x4){v[4], v[5], v[6], v[7]};
                    }
                    v0 = v0 * scr; v1 = v1 * scr;
                    u32x4 w; w.x = cvt_pk_bf16(v0[0], v0[1]); w.y = cvt_pk_bf16(v0[2], v0[3]); w.z = cvt_pk_bf16(v1[0], v1[1]); w.w = cvt_pk_bf16(v1[2], v1[3]);
                    if (pub) WT_ST16(orsrc, ((size_t)row * 3584 + col0 + bj * HALF) * 2, w); else *(u32x4*)(rowp + bj * HALF) = w;
                }
                asm volatile("" ::: "memory");
            }
        if (pub) { asm volatile("s_waitcnt vmcnt(0)" ::: "memory"); if (fr == 0 && fq == 0) (void)__hip_atomic_fetch_add(sucnt, 1u, __ATOMIC_RELAXED, __HIP_MEMORY_SCOPE_AGENT); }
    }
};
template <bool NEXT> struct EpiRes {
    static constexpr bool PERM = false, AFTER_DRAIN = false;
    const float* base; float* out; float* rowss; const bf16_t* baseh; bf16_t* XN;
    __device__ __forceinline__ void operator()(const f32x4 (&acc)[2][2][4][2], const Unit& u, int wr, int wc, int fr, int fq) const {
        typedef unsigned u32x2 __attribute__((ext_vector_type(2)));
        const int col0 = u.pn * BM + wc * 32 + 4 * fq;
#pragma unroll
        for (int ai = 0; ai < 2; ++ai)
#pragma unroll
            for (int m = 0; m < 4; ++m) {
                const int row = u.pm * BM + ai * HALF + wr * 64 + m * 16 + fr;
                const size_t off = (size_t)row * 1024 + col0;
                float ss = 0.f;
#pragma unroll
                for (int bj = 0; bj < 2; ++bj)
#pragma unroll
                    for (int n = 0; n < 2; ++n) {
                        f32x4 bs;
                        { const u32x2 hb = *(const u32x2*)(baseh + off + bj * HALF + n * 16); bs = (f32x4){__uint_as_float(hb.x << 16), __uint_as_float(hb.x & 0xffff0000u), __uint_as_float(hb.y << 16), __uint_as_float(hb.y & 0xffff0000u)}; }
                        const f32x4 o = bs + acc[ai][bj][m][n];
                        if (NEXT) { ss += (o[0] * o[0] + o[1] * o[1]) + (o[2] * o[2] + o[3] * o[3]);
                            u32x2 w; w.x = cvt_pk_bf16(o[0], o[1]); w.y = cvt_pk_bf16(o[2], o[3]); *(u32x2*)(XN + off + bj * HALF + n * 16) = w; }
                        else *(f32x4*)(out + off + bj * HALF + n * 16) = o;
                    }
                if (NEXT) { ss += __shfl_xor(ss, 16); ss += __shfl_xor(ss, 32); if (fq == 0) atomicAdd(rowss + row, ss); }
                if (m & 1) asm volatile("" ::: "memory");
            }
    }
};
struct EpiResFinal {
    static constexpr bool PERM = false, AFTER_DRAIN = true;
    const bf16_t* baseh; float* out; float* rowss2; unsigned* cnt; const float* fw;
    __device__ __forceinline__ void operator()(const f32x4 (&)[2][2][4][2], const Unit&, int, int, int, int) const {}
    __device__ __forceinline__ void fused(f32x4 (&acc)[2][2][4][2], const Unit& u, int wr, int wc, int fr, int fq, PG8_LAS unsigned char*, int wid, int lane) const {
        typedef unsigned u32x2 __attribute__((ext_vector_type(2)));
        const int col0 = u.pn * BM + wc * 32 + 4 * fq;
#pragma unroll
        for (int ai = 0; ai < 2; ++ai)
#pragma unroll
            for (int m = 0; m < 4; ++m) {
                const int row = u.pm * BM + ai * HALF + wr * 64 + m * 16 + fr;
                const size_t off = (size_t)row * 1024 + col0;
                float ss = 0.f;
#pragma unroll
                for (int bj = 0; bj < 2; ++bj)
#pragma unroll
                    for (int n = 0; n < 2; ++n) { const u32x2 hb = *(const u32x2*)(baseh + off + bj * HALF + n * 16);
                        const f32x4 o = (f32x4){__uint_as_float(hb.x << 16), __uint_as_float(hb.x & 0xffff0000u), __uint_as_float(hb.y << 16), __uint_as_float(hb.y & 0xffff0000u)} + acc[ai][bj][m][n]; acc[ai][bj][m][n] = o;
                        ss += (o[0] * o[0] + o[1] * o[1]) + (o[2] * o[2] + o[3] * o[3]); }
                ss += __shfl_xor(ss, 16); ss += __shfl_xor(ss, 32);
                if (fq == 0) (void)__hip_atomic_fetch_add(rowss2 + row, ss, __ATOMIC_RELAXED, __HIP_MEMORY_SCOPE_AGENT);
                if (m & 1) asm volatile("" ::: "memory");
            }
        asm volatile("s_waitcnt vmcnt(0)" ::: "memory");
        __builtin_amdgcn_s_barrier(); asm volatile("" ::: "memory");
        if (wid == 0) {
            if (lane == 0) (void)__hip_atomic_fetch_add(cnt + u.pm, 1u, __ATOMIC_RELAXED, __HIP_MEMORY_SCOPE_AGENT);
            unsigned spins = 0;
            while ((unsigned)__builtin_amdgcn_readfirstlane(__hip_atomic_load(cnt + u.pm, __ATOMIC_RELAXED, __HIP_MEMORY_SCOPE_AGENT)) < 4u) { __builtin_amdgcn_s_sleep(4); if (++spins > (1u << 20)) break; }
            __builtin_amdgcn_fence(__ATOMIC_ACQUIRE, "agent");
            asm volatile("s_waitcnt vmcnt(0)" ::: "memory");
        }
        __builtin_amdgcn_s_barrier(); asm volatile("" ::: "memory");
        f32x4 wv[2][2];
#pragma unroll
        for (int bj = 0; bj < 2; ++bj)
#pragma unroll
            for (int n = 0; n < 2; ++n) wv[bj][n] = *(const f32x4*)(fw + col0 + bj * HALF + n * 16);
#pragma unroll
        for (int ai = 0; ai < 2; ++ai)
#pragma unroll
            for (int m = 0; m < 4; ++m) {
                const int row = u.pm * BM + ai * HALF + wr * 64 + m * 16 + fr;
                const size_t off = (size_t)row * 1024 + col0;
                const float rs = __builtin_amdgcn_rsqf(__hip_atomic_load(rowss2 + row, __ATOMIC_RELAXED, __HIP_MEMORY_SCOPE_AGENT) * (1.0f / 1024.0f) + 1e-6f);
#pragma unroll
                for (int bj = 0; bj < 2; ++bj)
#pragma unroll
                    for (int n = 0; n < 2; ++n) *(f32x4*)(out + off + bj * HALF + n * 16) = acc[ai][bj][m][n] * rs * wv[bj][n];
            }
    }
};
struct EpiGlu {
    static constexpr bool PERM = true, AFTER_DRAIN = false;
    const bf16_t* YGS; const float* bias; bf16_t* MIX;
    __device__ __forceinline__ void operator()(const f32x4 (&acc)[2][2][4][2], const Unit& u, int wr, int wc, int fr, int fq) const {
        typedef unsigned u32x2 __attribute__((ext_vector_type(2)));
        const int row0 = u.pm * BM + wr * 64 + fr, col0 = wc * 32 + 8 * fq;
#pragma unroll
        for (int bj = 0; bj < 2; ++bj)
#pragma unroll
            for (int n = 0; n < 2; ++n) {
                const int c = col0 + bj * HALF + 4 * n;
                const f32x4 bv = *(const f32x4*)(bias + c);
#pragma unroll
                for (int ai = 0; ai < 2; ++ai)
#pragma unroll
                    for (int m = 0; m < 4; ++m) {
                        const size_t row = (size_t)(row0 + ai * HALF + m * 16);
                        const f32x4 v = acc[ai][bj][m][n] + bv;
                        const u32x2 yv = *(const u32x2*)(YGS + row * 256 + c);
                        const float y0 = __uint_as_float(yv.x << 16), y1 = __uint_as_float(yv.x & 0xffff0000u), y2 = __uint_as_float(yv.y << 16), y3 = __uint_as_float(yv.y & 0xffff0000u);
                        u32x2 w; w.x = cvt_pk_bf16(y0 * sigm(v[0]), y1 * sigm(v[1])); w.y = cvt_pk_bf16(y2 * sigm(v[2]), y3 * sigm(v[3]));
                        *(u32x2*)(MIX + row * 1024 + 256 + c) = w;
                        if (m & 1) asm volatile("" ::: "memory");
                    }
            }
    }
};
template <class Epi, class Sched, bool ALIGN_EPI = false, bool SP2 = false>
__device__ __forceinline__ void gemm_phase(PG8_LAS unsigned char* lds, const Gemm g, const Sched& S, const Epi& E) {
    int tid_l = threadIdx.x; asm volatile("" : "+v"(tid_l));
    const int tid = tid_l, wid = __builtin_amdgcn_readfirstlane(tid >> 6), lane = tid & 63, wr = wid >> 2, wc = wid & 3, fr = lane & 15, fq = lane >> 4;
    const int K = g.K, nt = K / BK;
    unsigned voffA[2], voffB[2];
#pragma unroll
    for (int i = 0; i < 2; ++i) { int R, C; stage_rc(tid * 16 + i * 8192, R, C); const int Rb = Epi::PERM ? ((R & ~31) + perm32(R & 31)) : R;
        voffA[i] = (unsigned)(R * K + C) * 2u; voffB[i] = (unsigned)(Rb * K + C) * 2u; }
    const size_t kstep = (size_t)(BK * 2);
    const size_t hstep = (size_t)HALF * K * 2;
    const size_t tstep = 2 * hstep;
    const unsigned ldsw = (unsigned)wid * 1024u;
    const int aoff = lds_byte(wr * 64 + fr, fq * 8), boff = lds_byte(wc * 32 + fr, fq * 8);
#define PG8_SA(b, h) (((b) * 2 + (h)) * HTB)
#define PG8_SB(b, h) ((4 + (b) * 2 + (h)) * HTB)
#define PG8_STAGE(bufoff, gbase, voff) do { _Pragma("unroll") for (int _i = 0; _i < 2; ++_i) \
        __builtin_amdgcn_global_load_lds((const unsigned*)((const char*)(gbase) + (voff)[_i]), (PG8_LAS unsigned*)(lds + (bufoff) + ldsw + _i * 8192), 16, 0, 0); } while (0)
#define PG8_LDA(dst, b, h) do { _Pragma("unroll") for (int m = 0; m < 4; ++m) _Pragma("unroll") for (int k = 0; k < 2; ++k) dst[m][k] = *(const PG8_LAS bf16x8*)(lds + PG8_SA(b, h) + aoff + m * 2048 + k * 1024); } while (0)
#define PG8_LDB(dst, b, h) do { _Pragma("unroll") for (int n = 0; n < 2; ++n) _Pragma("unroll") for (int k = 0; k < 2; ++k) dst[n][k] = *(const PG8_LAS bf16x8*)(lds + PG8_SB(b, h) + boff + n * 2048 + k * 1024); } while (0)
#define PG8_MMA(ai, bj, At, Bt) do { __builtin_amdgcn_s_setprio(1); _Pragma("unroll") for (int m = 0; m < 4; ++m) _Pragma("unroll") for (int n = 0; n < 2; ++n) _Pragma("unroll") for (int k = 0; k < 2; ++k) \
        acc[ai][bj][m][n] = __builtin_amdgcn_mfma_f32_16x16x32_bf16(Bt[n][k], At[m][k], acc[ai][bj][m][n], 0, 0, 0); __builtin_amdgcn_s_setprio(0); } while (0)
#define PG8_WAIT_V(n) asm volatile("s_waitcnt vmcnt(" #n ")" ::: "memory")
#define PG8_WAIT_L(n) asm volatile("s_waitcnt lgkmcnt(" #n ")" ::: "memory")
#define PG8_BAR __builtin_amdgcn_s_barrier()
#define PG8_SCHED __builtin_amdgcn_sched_barrier(0)
    Unit cur, nxt; int ui = 0;
    if (!S.next(0, cur)) return;
    f32x4 acc[2][2][4][2];
#pragma unroll
    for (int a = 0; a < 2; ++a)
#pragma unroll
        for (int b = 0; b < 2; ++b)
#pragma unroll
            for (int m = 0; m < 4; ++m)
#pragma unroll
                for (int n = 0; n < 2; ++n) acc[a][b][m][n] = (f32x4){0.f, 0.f, 0.f, 0.f};
    bf16x8 At[4][2], B0[2][2], B1[2][2];
    const char* cA = (const char*)g.A + (size_t)cur.pm * tstep; const char* cB = (const char*)g.Bt + (size_t)cur.pn * tstep;
    S.a_ready(cur);
    if constexpr (SP2) {
        PG8_STAGE(PG8_SB(0, 0), cB, voffB); PG8_STAGE(PG8_SB(0, 1), cB + hstep, voffB); PG8_STAGE(PG8_SA(0, 0), cA, voffA); PG8_STAGE(PG8_SA(0, 1), cA + hstep, voffA);
        if (wr == 1) PG8_BAR;
        PG8_WAIT_V(2); PG8_BAR;
        PG8_STAGE(PG8_SB(1, 0), cB + kstep, voffB); PG8_STAGE(PG8_SA(1, 0), cA + kstep, voffA); PG8_STAGE(PG8_SB(1, 1), cB + hstep + kstep, voffB);
        PG8_WAIT_V(6); PG8_BAR;
    } else {
        PG8_STAGE(PG8_SB(0, 0), cB, voffB); PG8_STAGE(PG8_SA(0, 0), cA, voffA); PG8_STAGE(PG8_SB(0, 1), cB + hstep, voffB); PG8_STAGE(PG8_SA(0, 1), cA + hstep, voffA);
        if (wr == 1) PG8_BAR;
        PG8_WAIT_V(4); PG8_BAR;
        PG8_STAGE(PG8_SB(1, 0), cB + kstep, voffB); PG8_STAGE(PG8_SA(1, 0), cA + kstep, voffA); PG8_STAGE(PG8_SB(1, 1), cB + hstep + kstep, voffB);
        PG8_WAIT_V(6); PG8_BAR;
    }
    for (;;) {
        const bool has_next = S.next(ui + 1, nxt);
        const char* nA = has_next ? (const char*)g.A + (size_t)nxt.pm * tstep : cA; const char* nB = has_next ? (const char*)g.Bt + (size_t)nxt.pn * tstep : cB;
        for (int t = 0; t < nt; t += 2) {
            const bool last = (t == nt - 2);
            const char* a1 = cA + (size_t)(t + 1) * kstep;
            const char* a2 = last ? nA : cA + (size_t)(t + 2) * kstep; const char* b2 = last ? nB : cB + (size_t)(t + 2) * kstep;
            const char* a3 = a2 + kstep; const char* b3 = b2 + kstep;
            if (last && has_next) S.a_ready(nxt);
            if constexpr (SP2) {
            PG8_LDB(B0, 0, 0); PG8_LDB(B1, 0, 1); PG8_SCHED; PG8_LDA(At, 0, 0); PG8_STAGE(PG8_SA(1, 1), a1 + hstep, voffA);
            PG8_WAIT_V(8); PG8_WAIT_L(0); PG8_BAR; PG8_MMA(0, 0, At, B0); PG8_MMA(0, 1, At, B1); PG8_BAR; PG8_SCHED;
            PG8_LDA(At, 0, 1); PG8_STAGE(PG8_SB(0, 0), b2, voffB); PG8_STAGE(PG8_SB(0, 1), b2 + hstep, voffB); PG8_STAGE(PG8_SA(0, 0), a2, voffA);
            PG8_WAIT_V(8); PG8_WAIT_L(0); PG8_BAR; PG8_MMA(1, 0, At, B0); PG8_MMA(1, 1, At, B1); PG8_BAR; PG8_SCHED;
            PG8_LDB(B0, 1, 0); PG8_LDB(B1, 1, 1); PG8_SCHED; PG8_LDA(At, 1, 0); PG8_STAGE(PG8_SA(0, 1), a2 + hstep, voffA);
            PG8_WAIT_V(8); PG8_WAIT_L(0); PG8_BAR; PG8_MMA(0, 0, At, B0); PG8_MMA(0, 1, At, B1); PG8_BAR; PG8_SCHED;
            PG8_LDA(At, 1, 1); PG8_STAGE(PG8_SB(1, 0), b3, voffB); PG8_STAGE(PG8_SB(1, 1), b3 + hstep, voffB); PG8_STAGE(PG8_SA(1, 0), a3, voffA);
            PG8_WAIT_V(8); PG8_WAIT_L(0); PG8_BAR; PG8_MMA(1, 0, At, B0); PG8_MMA(1, 1, At, B1); PG8_BAR; PG8_SCHED;
            } else {
            PG8_LDB(B0, 0, 0); PG8_SCHED; PG8_LDA(At, 0, 0); PG8_STAGE(PG8_SA(1, 1), a1 + hstep, voffA);
            PG8_WAIT_L(8); PG8_BAR; PG8_WAIT_L(0); PG8_MMA(0, 0, At, B0); PG8_BAR; PG8_SCHED;
            PG8_LDB(B1, 0, 1); PG8_STAGE(PG8_SB(0, 0), b2, voffB);
            PG8_BAR; PG8_WAIT_L(0); PG8_MMA(0, 1, At, B1); PG8_BAR;
            PG8_LDA(At, 0, 1); PG8_STAGE(PG8_SA(0, 0), a2, voffA);
            PG8_BAR; PG8_WAIT_L(0); PG8_MMA(1, 0, At, B0); PG8_BAR; PG8_SCHED;
            PG8_STAGE(PG8_SB(0, 1), b2 + hstep, voffB);
            PG8_WAIT_V(6); PG8_BAR; PG8_MMA(1, 1, At, B1); PG8_BAR;
            PG8_LDB(B0, 1, 0); PG8_SCHED; PG8_LDA(At, 1, 0); PG8_STAGE(PG8_SA(0, 1), a2 + hstep, voffA);
            PG8_WAIT_L(8); PG8_BAR; PG8_WAIT_L(0); PG8_MMA(0, 0, At, B0); PG8_BAR; PG8_SCHED;
            PG8_LDB(B1, 1, 1); PG8_STAGE(PG8_SB(1, 0), b3, voffB);
            PG8_BAR; PG8_WAIT_L(0); PG8_MMA(0, 1, At, B1); PG8_BAR;
            PG8_LDA(At, 1, 1); PG8_STAGE(PG8_SA(1, 0), a3, voffA);
            PG8_BAR; PG8_WAIT_L(0); PG8_MMA(1, 0, At, B0); PG8_BAR; PG8_SCHED;
            PG8_STAGE(PG8_SB(1, 1), b3 + hstep, voffB);
            PG8_WAIT_V(6); PG8_BAR; PG8_MMA(1, 1, At, B1); PG8_BAR;
            }
        }
        if constexpr (ALIGN_EPI) { if (wr == 0) PG8_BAR; }
        if constexpr (!Epi::AFTER_DRAIN) { E(acc, cur, wr, wc, fr, fq); S.done(cur); }
        if (!has_next) break;
#pragma unroll
        for (int a = 0; a < 2; ++a)
#pragma unroll
            for (int b = 0; b < 2; ++b)
#pragma unroll
                for (int m = 0; m < 4; ++m)
#pragma unroll
                    for (int n = 0; n < 2; ++n) acc[a][b][m][n] = (f32x4){0.f, 0.f, 0.f, 0.f};
        cur = nxt; cA = nA; cB = nB; ++ui;
        if constexpr (ALIGN_EPI) { if (wr == 1) PG8_BAR; }
    }
    PG8_WAIT_V(0);
    if constexpr (!ALIGN_EPI) { if (wr == 0) PG8_BAR; }
    PG8_BAR;
    if constexpr (Epi::AFTER_DRAIN) { E.fused(acc, cur, wr, wc, fr, fq, lds, wid, lane); S.done(cur); }
#undef PG8_SA
#undef PG8_SB
#undef PG8_STAGE
#undef PG8_LDA
#undef PG8_LDB
#undef PG8_MMA
#undef PG8_WAIT_V
#undef PG8_WAIT_L
#undef PG8_BAR
#undef PG8_SCHED
}
}

#ifndef PG8_SP2
#define PG8_SP2 true
#endif
#ifndef PG8_ALIGN
#define PG8_ALIGN true
#endif
#include <hip/hip_bf16.h>
#include <cmath>
namespace attn_body {
using bf16=__hip_bfloat16;
using bf16x8=__attribute__((ext_vector_type(8)))short;
using s16x4=__attribute__((ext_vector_type(4)))short;
using f32x16=__attribute__((ext_vector_type(16)))float;
using u32x4=__attribute__((ext_vector_type(4)))unsigned;
constexpr int BATCH=2,NHEAD=16,SEQ=8192,D=64,DM=NHEAD*D;
constexpr int NW=8,QBLK=32,QB=QBLK*NW,KVBLK=64,NQB=SEQ/QB;
constexpr int ATTN_PITCH=DM, ATTN_UNIT_ROWS=QB;
constexpr int PQ=3584,QCOL=1536,KCOL=2048,VCOL=2560;
__device__ __forceinline__ int crow(int r,int hi){return (r&3)+8*(r>>2)+4*hi;}
#define SBAR() __builtin_amdgcn_sched_barrier(0)
__device__ __forceinline__ void cmask(f32x16&p0,f32x16&p1,int jb,int qrel,int hi){
  const float NEG=-INFINITY; int kb=64*jb+4*hi;
  #pragma unroll
  for(int r=0;r<16;++r){int kv=kb+(r&3)+8*(r>>2); if(kv>qrel)p0[r]=NEG; if(kv+32>qrel)p1[r]=NEG;}
}

constexpr int NSLOT=3, SLOTB=8192;
constexpr int LDS_K=0, LDS_V=NSLOT*SLOTB, LDS_WS=3*NSLOT*SLOTB, LDS_OST=LDS_WS+NW*64*4, LDS_BYTES=LDS_OST+NW*4096;
constexpr float C2=0.125f*1.4426950408889634f;
__device__ __forceinline__ void glds16(const void*gsrc,unsigned lds_dst){unsigned keep;
  asm volatile("s_mov_b32 %0, m0\n\ts_mov_b32 m0, %2\n\ts_nop 0\n\tglobal_load_lds_dwordx4 %1, off\n\ts_mov_b32 m0, %0":"=&s"(keep):"v"(gsrc),"s"(lds_dst):"memory");}
__device__ __forceinline__ float max3f(float a,float b,float c){float r;asm("v_max3_f32 %0, %1, %2, %3":"=v"(r):"v"(a),"v"(b),"v"(c));return r;}
__device__ __forceinline__ float max2f(float a,float b){float r;asm("v_max_f32_e32 %0, %1, %2":"=v"(r):"v"(a),"v"(b));return r;}
__device__ __forceinline__ float fadd_s(float a,float b){float r;asm("v_add_f32_e32 %0, %1, %2":"=v"(r):"v"(a),"v"(b));return r;}
__device__ __forceinline__ float fsub_s(float a,float b){float r;asm("v_sub_f32_e32 %0, %1, %2":"=v"(r):"v"(a),"v"(b));return r;}
typedef float f32x2_t __attribute__((ext_vector_type(2))); typedef __bf16 bf16x2_t __attribute__((ext_vector_type(2)));
__device__ __forceinline__ unsigned cvtpk_s(float lo,float hi){f32x2_t v={lo,hi};bf16x2_t b=__builtin_convertvector(v,bf16x2_t);return __builtin_bit_cast(unsigned,b);}
#define WAIT_BAR(N) asm volatile("s_waitcnt vmcnt(" #N ") lgkmcnt(0)\n\ts_barrier":::"memory")

__device__ __forceinline__ void qkt(f32x16&p0,f32x16&p1,const char*Kslot,const bf16x8*qr,const f32x16&negm,int r32,int hi){
  const char*kb=Kslot+hi*1024+r32*16;
  #pragma unroll
  for(int d0=0;d0<4;++d0){
    const bf16x8 b0=*reinterpret_cast<const bf16x8*>(kb+d0*2048);
    const bf16x8 b1=*reinterpret_cast<const bf16x8*>(kb+d0*2048+512);
    if(d0==0){p0=__builtin_amdgcn_mfma_f32_32x32x16_bf16(b0,qr[0],negm,0,0,0);p1=__builtin_amdgcn_mfma_f32_32x32x16_bf16(b1,qr[0],negm,0,0,0);}
    else{p0=__builtin_amdgcn_mfma_f32_32x32x16_bf16(b0,qr[d0],p0,0,0,0);p1=__builtin_amdgcn_mfma_f32_32x32x16_bf16(b1,qr[d0],p1,0,0,0);}}
}
typedef __attribute__((address_space(3))) const char* lds_cptr;
typedef short v4i16_t __attribute__((ext_vector_type(4)));
__device__ __forceinline__ void kload8(bf16x8*kf,lds_cptr kp){
  kf[0]=*(const __attribute__((address_space(3))) bf16x8*)(kp);      kf[1]=*(const __attribute__((address_space(3))) bf16x8*)(kp+512);
  kf[2]=*(const __attribute__((address_space(3))) bf16x8*)(kp+2048); kf[3]=*(const __attribute__((address_space(3))) bf16x8*)(kp+2560);
  kf[4]=*(const __attribute__((address_space(3))) bf16x8*)(kp+4096); kf[5]=*(const __attribute__((address_space(3))) bf16x8*)(kp+4608);
  kf[6]=*(const __attribute__((address_space(3))) bf16x8*)(kp+6144); kf[7]=*(const __attribute__((address_space(3))) bf16x8*)(kp+6656);
}
__device__ __forceinline__ void kload2(bf16x8*kf,lds_cptr kp,int j){ kf[2*j]=*(const __attribute__((address_space(3))) bf16x8*)(kp+j*2048); kf[2*j+1]=*(const __attribute__((address_space(3))) bf16x8*)(kp+j*2048+512); }
__device__ __forceinline__ s16x4 vtr(lds_cptr p){ return __builtin_bit_cast(s16x4,__builtin_amdgcn_ds_read_tr16_b64_v4i16((__attribute__((address_space(3))) v4i16_t*)p)); }
__device__ __forceinline__ float rowmax(const f32x16&p0,const f32x16&p1){
  float a=max3f(p0[0],p0[1],p1[0]),b=max3f(p0[2],p0[3],p1[1]);a=max3f(a,p1[2],p1[3]);
  #pragma unroll
  for(int r=4;r<16;r+=4){a=max3f(a,p0[r],p0[r+1]);b=max3f(b,p0[r+2],p0[r+3]);a=max3f(a,p1[r],p1[r+1]);b=max3f(b,p1[r+2],p1[r+3]);}
  const float m=max2f(a,b);
  auto rr=__builtin_amdgcn_permlane32_swap(__float_as_uint(m),__float_as_uint(m),false,false);
  return max2f(__uint_as_float(rr[0]),__uint_as_float(rr[1]));
}
__device__ __forceinline__ void pv(f32x16*o,int vb,bf16x8 pa0,bf16x8 pa1,bf16x8 pa2,bf16x8 pa3){
  #pragma unroll
  for(int d0=0;d0<2;++d0){s16x4 lo[4],hi[4];
    #pragma unroll
    for(int ks=0;ks<4;++ks){
      asm volatile("ds_read_b64_tr_b16 %0,%1 offset:%c2":"=&v"(lo[ks]):"v"(vb),"i"(d0*4096+ks*1024):"memory");
      asm volatile("ds_read_b64_tr_b16 %0,%1 offset:%c2":"=&v"(hi[ks]):"v"(vb),"i"(d0*4096+ks*1024+512):"memory");}
    asm volatile("s_waitcnt lgkmcnt(0)":::"memory");SBAR();
    #define PK(k) (bf16x8){lo[k][0],lo[k][1],lo[k][2],lo[k][3],hi[k][0],hi[k][1],hi[k][2],hi[k][3]}
    o[d0]=__builtin_amdgcn_mfma_f32_32x32x16_bf16(pa0,PK(0),o[d0],0,0,0);
    o[d0]=__builtin_amdgcn_mfma_f32_32x32x16_bf16(pa1,PK(1),o[d0],0,0,0);
    o[d0]=__builtin_amdgcn_mfma_f32_32x32x16_bf16(pa2,PK(2),o[d0],0,0,0);
    o[d0]=__builtin_amdgcn_mfma_f32_32x32x16_bf16(pa3,PK(3),o[d0],0,0,0);
    #undef PK
  }
}

#ifndef ATTN_STORE16
#define ATTN_STORE16(p,v) (*(u32x4*)(p)=(v))
#endif
template<int THRL> __device__ __forceinline__ void attn_unit(int b,int h,int qb,const bf16*Q,const bf16*__restrict__ K,const bf16*__restrict__ V,bf16*O,char*shm){
  int tid_l=threadIdx.x; asm volatile("":"+v"(tid_l)); const int tid=tid_l,lane=tid&63,r32=lane&31,hi=lane>>5; const int wid=__builtin_amdgcn_readfirstlane(tid>>6);
  const long rowbase=(long)b*SEQ; const int q0=qb*QB;
  const int hh_=h>>1,mm_=h&1; const bf16*Qw=Q+(rowbase+q0+wid*QBLK)*PQ+QCOL+hh_*128+mm_*64;
  const bf16*Kh=K+rowbase*PQ+KCOL+hh_*128+mm_*64,*Vh=V+rowbase*PQ+VCOL+hh_*128;
  const unsigned lds0=(unsigned)(uintptr_t)shm;
  float*wsf=(float*)(shm+LDS_WS)+wid*64;
  const bf16*ksrc=Kh+(long)lane*PQ+wid*8;
  const bf16*vsrc=Vh+(long)(16*(wid&3)+(lane>>2))*PQ+(wid>>2)*32+(lane&3)*8;
  const unsigned kdst=lds0+LDS_K+wid*1024, vdst=lds0+LDS_V+wid*1024;
  #define DMA_K(t,slot) glds16(ksrc+(long)(t)*KVBLK*PQ,(unsigned)__builtin_amdgcn_readfirstlane(kdst+(slot)))
  #define DMA_V(t,slot) do{ glds16(vsrc+(long)(t)*KVBLK*PQ,(unsigned)__builtin_amdgcn_readfirstlane(vdst+2*(slot))); glds16(vsrc+(long)(t)*KVBLK*PQ+64,(unsigned)__builtin_amdgcn_readfirstlane(vdst+2*(slot)+8192)); }while(0)
  const int vb0=(int)(lds0+LDS_V)+((lane>>4)&1)*32+(lane&3)*8+(4*hi+((lane&15)>>2))*64;
  const char*Kbase=shm+LDS_K; bf16x8 kf[8];
  const lds_cptr shm3=(lds_cptr)shm; const lds_cptr kp0=shm3+LDS_K+hi*1024+r32*16; const lds_cptr vp0=shm3+LDS_V+((lane>>4)&1)*32+(lane&3)*8+(4*hi+((lane&15)>>2))*64;
  const int NT=(q0+QB)/KVBLK;
  DMA_K(0,0);DMA_V(0,0);DMA_K(1,SLOTB);
  bf16x8 qr[4];
  #pragma unroll
  for(int d0=0;d0<4;++d0)qr[d0]=*reinterpret_cast<const bf16x8*>(&Qw[(long)r32*PQ+d0*16+hi*8]);
  float mhat=0.f,l_reg=0.f;f32x16 o[4];o[0]=f32x16{};o[1]=f32x16{};o[2]=f32x16{};o[3]=f32x16{};f32x16 negm=f32x16{};asm volatile("":"+v"(negm));
  const int qrel=wid*QBLK+r32;
  #define CMASK(P0,P1,t) do{int jb_=(t)-(NT-4); if(jb_>=0)cmask(P0,P1,jb_,qrel,hi);}while(0)
  bool resc=false;
  #define START(P0,P1) do{ const float rm=rowmax(P0,P1); resc=false; \
    { const float dl=rm; mhat=fadd_s(mhat,dl); \
      _Pragma("unroll") for(int r=0;r<16;++r){P0[r]=fsub_s(P0[r],dl);P1[r]=fsub_s(P1[r],dl);} \
      _Pragma("unroll") for(int r=0;r<16;++r)negm[r]=-mhat; asm volatile("":"+v"(negm)); } \
    _Pragma("unroll") for(int r=0;r<16;++r)P0[r]=__builtin_amdgcn_exp2f(P0[r]); }while(0)
  #define RESC() do{ if(resc){ asm volatile("s_waitcnt lgkmcnt(0)":::"memory"); \
      _Pragma("unroll") for(int d_=0;d_<4;++d_) _Pragma("unroll") for(int r=0;r<16;++r)o[d_][r]*=wsf[crow(r,hi)]; } }while(0)
  f32x16 pA0,pA1,pB0,pB1;
  int sl_prev=0,sl_cur=0,sl_next=SLOTB;
  #define ROT() do{sl_prev=sl_cur;sl_cur=sl_next;sl_next=(sl_next==(NSLOT-1)*SLOTB)?0:sl_next+SLOTB;}while(0)
  DMA_K(2,2*SLOTB);
  WAIT_BAR(3);
  qkt(pA0,pA1,Kbase,qr,negm,r32,hi);asm volatile("s_nop 15\n\ts_nop 7":"+v"(pA0),"+v"(pA1));CMASK(pA0,pA1,0);
  START(pA0,pA1);
  _Pragma("unroll") for(int r=0;r<16;++r)pA1[r]=__builtin_amdgcn_exp2f(pA1[r]);
  WAIT_BAR(0);
  DMA_K(3,0);DMA_V(1,SLOTB);
  ROT();
  kload8(kf,kp0+sl_cur);
  WAIT_BAR(3);
  s16x4 vlo[8],vhi[8],wlo[8],whi[8]; u32x4 pw0,pw1,pw2,pw3;
  #define PKW(P,B) cvtpk_s(P[B],P[B+1])
  #define PAF(k) __builtin_bit_cast(bf16x8,pw##k)
  #define VFR(i) (bf16x8){vlo[i][0],vlo[i][1],vlo[i][2],vlo[i][3],vhi[i][0],vhi[i][1],vhi[i][2],vhi[i][3]}
  #define PIN(x) asm volatile("":"+v"(x))
  #define MX3(a,b,c) __builtin_fmaxf(__builtin_fmaxf((a),(b)),(c))
  #define GAPA(MF,A0,A1,A2,A3,W0,W1,PW) do{ MF; sacc+=A0; sacc+=A1; sacc+=A2; sacc+=A3; PIN(sacc); W0; W1; PIN(PW); SBAR(); }while(0)
  #define EX(v) __builtin_amdgcn_exp2f(v)
  #define GAPB(MF,X,B) do{ MF; X[B]=EX(X[B]); X[B+1]=EX(X[B+1]); PIN(X); SBAR(); }while(0)
  #define VRD(i) do{ vlo[i]=vtr(vp_+(((i)>>2)*4096+((i)&3)*1024)); vhi[i]=vtr(vp_+(((i)>>2)*4096+((i)&3)*1024+512)); }while(0)
  #define VRD2(i) do{ wlo[i]=vtr(vp_+(8192+((i)>>2)*4096+((i)&3)*1024)); whi[i]=vtr(vp_+(8192+((i)>>2)*4096+((i)&3)*1024+512)); SBAR(); }while(0)
  #define WFR(i) (bf16x8){wlo[i][0],wlo[i][1],wlo[i][2],wlo[i][3],whi[i][0],whi[i][1],whi[i][2],whi[i][3]}
  #define GAPC(MF,X,B) do{ MF; X[B]=EX(X[B]); X[B+1]=EX(X[B+1]); PIN(X); SBAR(); }while(0)
  #define KRD(G,j) do{ if(G){ kload2(kf,kp0+sl_next,j); SBAR(); } }while(0)
  #define STEP(C0,C1,P0,P1,t,GK,GV,GL) do{ SBAR(); \
    const lds_cptr vp_=vp0+2*sl_prev; \
    VRD(0); SBAR(); float sacc=(P0[0]+P0[1]); \
    GAPA(C0=__builtin_amdgcn_mfma_f32_32x32x16_bf16(kf[0],qr[0],negm,0,0,0), P0[2],P0[3],P0[4],P0[5],     pw0[0]=PKW(P0,0), pw0[1]=PKW(P0,2), pw0); \
    VRD(4); SBAR(); GAPA(C1=__builtin_amdgcn_mfma_f32_32x32x16_bf16(kf[1],qr[0],negm,0,0,0), P0[6],P0[7],P0[8],P0[9],     pw0[2]=PKW(P0,4), pw0[3]=PKW(P0,6), pw0); \
    VRD(1); SBAR(); GAPA(C0=__builtin_amdgcn_mfma_f32_32x32x16_bf16(kf[2],qr[1],C0,0,0,0),   P0[10],P0[11],P0[12],P0[13], pw1[0]=PKW(P0,8), pw1[1]=PKW(P0,10), pw1); \
    VRD(5); SBAR(); GAPA(C1=__builtin_amdgcn_mfma_f32_32x32x16_bf16(kf[3],qr[1],C1,0,0,0),   P0[14],P0[15],P1[0],P1[1],   pw1[2]=PKW(P0,12),pw1[3]=PKW(P0,14), pw1); \
    VRD(2); SBAR(); GAPA(C0=__builtin_amdgcn_mfma_f32_32x32x16_bf16(kf[4],qr[2],C0,0,0,0),   P1[2],P1[3],P1[4],P1[5],     pw2[0]=PKW(P1,0), pw2[1]=PKW(P1,2), pw2); \
    VRD(6); SBAR(); GAPA(C1=__builtin_amdgcn_mfma_f32_32x32x16_bf16(kf[5],qr[2],C1,0,0,0),   P1[6],P1[7],P1[8],P1[9],     pw2[2]=PKW(P1,4), pw2[3]=PKW(P1,6), pw2); \
    VRD(3); SBAR(); GAPA(C0=__builtin_amdgcn_mfma_f32_32x32x16_bf16(kf[6],qr[3],C0,0,0,0),   P1[10],P1[11],P1[12],P1[13], pw3[0]=PKW(P1,8), pw3[1]=PKW(P1,10), pw3); \
    VRD(7); SBAR(); GAPA(C1=__builtin_amdgcn_mfma_f32_32x32x16_bf16(kf[7],qr[3],C1,0,0,0),   P1[14],P1[15],0.f,0.f,       pw3[2]=PKW(P1,12),pw3[3]=PKW(P1,14), pw3); \
    l_reg+=sacc; \
    if(GK){DMA_K((t)+3,sl_cur);} if(GV){DMA_V((t)+1,sl_next);} \
    CMASK(C0,C1,t); \
    { float a=MX3(C0[0],C0[1],C1[0]),b=MX3(C0[2],C0[3],C1[1]); a=MX3(a,C1[2],C1[3]); \
      _Pragma("unroll") for(int r=4;r<16;r+=4){a=MX3(a,C0[r],C0[r+1]);b=MX3(b,C0[r+2],C0[r+3]);a=MX3(a,C1[r],C1[r+1]);b=MX3(b,C1[r+2],C1[r+3]);} \
      float rm=__builtin_fmaxf(a,b); { auto rr=__builtin_amdgcn_permlane32_swap(__float_as_uint(rm),__float_as_uint(rm),false,false); rm=__builtin_fmaxf(__uint_as_float(rr[0]),__uint_as_float(rr[1])); } \
      resc=false; \
      if(__builtin_expect(__any(rm>(float)THRL),0)){ const float dl=__builtin_fmaxf(rm,0.f); mhat+=dl; \
        _Pragma("unroll") for(int r=0;r<16;++r){C0[r]-=dl;C1[r]-=dl;} \
        _Pragma("unroll") for(int r=0;r<16;++r)negm[r]=-mhat; asm volatile("":"+v"(negm)); \
        const float f=__builtin_amdgcn_exp2f(-dl); l_reg*=f; if(hi==0)wsf[r32]=f; resc=true; } } \
    SBAR(); \
    GAPB(o[0]=__builtin_amdgcn_mfma_f32_32x32x16_bf16(PAF(0),VFR(0),o[0],0,0,0), C0,0); VRD2(0); \
    GAPB(o[1]=__builtin_amdgcn_mfma_f32_32x32x16_bf16(PAF(0),VFR(4),o[1],0,0,0), C0,2); VRD2(4); \
    KRD(GL,0); GAPB(o[0]=__builtin_amdgcn_mfma_f32_32x32x16_bf16(PAF(1),VFR(1),o[0],0,0,0), C0,4); VRD2(1); \
    KRD(GL,1); GAPB(o[1]=__builtin_amdgcn_mfma_f32_32x32x16_bf16(PAF(1),VFR(5),o[1],0,0,0), C0,6); VRD2(5); \
    KRD(GL,2); GAPB(o[0]=__builtin_amdgcn_mfma_f32_32x32x16_bf16(PAF(2),VFR(2),o[0],0,0,0), C0,8); VRD2(2); \
    KRD(GL,3); GAPB(o[1]=__builtin_amdgcn_mfma_f32_32x32x16_bf16(PAF(2),VFR(6),o[1],0,0,0), C0,10); VRD2(6); \
    GAPB(o[0]=__builtin_amdgcn_mfma_f32_32x32x16_bf16(PAF(3),VFR(3),o[0],0,0,0), C0,12); VRD2(3); \
    GAPB(o[1]=__builtin_amdgcn_mfma_f32_32x32x16_bf16(PAF(3),VFR(7),o[1],0,0,0), C0,14); VRD2(7); \
    GAPC(o[2]=__builtin_amdgcn_mfma_f32_32x32x16_bf16(PAF(0),WFR(0),o[2],0,0,0), C1,0); \
    GAPC(o[3]=__builtin_amdgcn_mfma_f32_32x32x16_bf16(PAF(0),WFR(4),o[3],0,0,0), C1,2); \
    GAPC(o[2]=__builtin_amdgcn_mfma_f32_32x32x16_bf16(PAF(1),WFR(1),o[2],0,0,0), C1,4); \
    GAPC(o[3]=__builtin_amdgcn_mfma_f32_32x32x16_bf16(PAF(1),WFR(5),o[3],0,0,0), C1,6); \
    GAPC(o[2]=__builtin_amdgcn_mfma_f32_32x32x16_bf16(PAF(2),WFR(2),o[2],0,0,0), C1,8); \
    GAPC(o[3]=__builtin_amdgcn_mfma_f32_32x32x16_bf16(PAF(2),WFR(6),o[3],0,0,0), C1,10); \
    GAPC(o[2]=__builtin_amdgcn_mfma_f32_32x32x16_bf16(PAF(3),WFR(3),o[2],0,0,0), C1,12); \
    GAPC(o[3]=__builtin_amdgcn_mfma_f32_32x32x16_bf16(PAF(3),WFR(7),o[3],0,0,0), C1,14); \
    }while(0)
  int t=1;
  #undef CMASK
  #define CMASK(P0,P1,t) do{}while(0)
  for(;t+5<NT;t+=2){
    STEP(pB0,pB1,pA0,pA1,t,true,true,true);     WAIT_BAR(3); RESC(); ROT();
    STEP(pA0,pA1,pB0,pB1,t+1,true,true,true);   WAIT_BAR(3); RESC(); ROT();
  }
  #undef CMASK
  #define CMASK(P0,P1,t) do{int jb_=(t)-(NT-4); if(jb_>=0)cmask(P0,P1,jb_,qrel,hi);}while(0)
  #define ENDW(tt) do{ if((tt)+3<NT){WAIT_BAR(3);} else if((tt)+2<NT){WAIT_BAR(2);} else {WAIT_BAR(0);} }while(0)
  for(;t+1<NT;t+=2){
    STEP(pB0,pB1,pA0,pA1,t,(t+3<NT),(t+1<NT),(t+1<NT));       ENDW(t);   RESC(); ROT();
    STEP(pA0,pA1,pB0,pB1,t+1,(t+4<NT),(t+2<NT),(t+2<NT));     ENDW(t+1); RESC(); ROT();
  }
  STEP(pB0,pB1,pA0,pA1,NT-1,false,false,false); RESC();
  { float sacc=pB0[0]+pB0[1]; _Pragma("unroll") for(int r=2;r<16;++r)sacc+=pB0[r]; _Pragma("unroll") for(int r=0;r<16;++r)sacc+=pB1[r]; l_reg+=sacc;
    pw0=(u32x4){PKW(pB0,0),PKW(pB0,2),PKW(pB0,4),PKW(pB0,6)};pw1=(u32x4){PKW(pB0,8),PKW(pB0,10),PKW(pB0,12),PKW(pB0,14)};pw2=(u32x4){PKW(pB1,0),PKW(pB1,2),PKW(pB1,4),PKW(pB1,6)};pw3=(u32x4){PKW(pB1,8),PKW(pB1,10),PKW(pB1,12),PKW(pB1,14)};
    SBAR(); pv(o,vb0+2*sl_cur,PAF(0),PAF(1),PAF(2),PAF(3)); pv(o+2,vb0+2*sl_cur+8192,PAF(0),PAF(1),PAF(2),PAF(3)); }
  #undef PKW
  #undef PAF
  #undef VFR
  #undef PIN
  #undef MX3
  #undef GAPA
  #undef GAPB
  #undef EX
  #undef VRD
  #undef VRD2
  #undef WFR
  #undef GAPC
  #undef KRD
  #undef STEP
  #undef ENDW
  {auto rr=__builtin_amdgcn_permlane32_swap(__float_as_uint(l_reg),__float_as_uint(l_reg),false,false);l_reg=__uint_as_float(rr[0])+__uint_as_float(rr[1]);}
  if(hi==0)wsf[32+r32]=l_reg;asm volatile("s_waitcnt lgkmcnt(0)":::"memory");
  float rli[16];
  #pragma unroll
  for(int r=0;r<16;++r)rli[r]=__builtin_amdgcn_rcpf(wsf[32+crow(r,hi)]);
  bf16*Ow=O+(rowbase+q0+wid*QBLK)*DM+hh_*256+mm_*128;
  #pragma unroll
  for(int half=0;half<2;++half)
  { bf16*stg=(bf16*)(shm+LDS_OST)+wid*2048;
    #pragma unroll
    for(int r=0;r<16;++r){const int orow=crow(r,hi);
      #pragma unroll
      for(int d0=0;d0<2;++d0)stg[orow*64+d0*32+r32]=__float2bfloat16(o[2*half+d0][r]*rli[r]);}
    asm volatile("s_waitcnt lgkmcnt(0)":::"memory");
    #pragma unroll
    for(int i=0;i<4;++i){const int row=i*8+(lane>>3),ch=lane&7; const u32x4 v=*(const u32x4*)(stg+row*64+ch*8); ATTN_STORE16(Ow+(long)row*DM+half*64+ch*8,v);}
    asm volatile("s_waitcnt lgkmcnt(0)":::"memory"); }
  asm volatile("s_waitcnt lgkmcnt(0)\n\ts_barrier":::"memory");
  #undef DMA_K
  #undef DMA_V
  #undef CMASK
  #undef START
  #undef RESC
  #undef ROT
}
constexpr int ATTN_LDS_BYTES=LDS_BYTES;
struct AttnTensors { const bf16* Q; const bf16* K; const bf16* V; bf16* O; };
struct AttnUnit { int bh; int qb; };
struct StaticOrder {
  int vcu;
  __device__ __forceinline__ explicit StaticOrder(int v):vcu(v){}
  __device__ __forceinline__ bool next(int i,AttnUnit&u)const{ if(i>=2)return false; const int s=vcu&15; u.bh=vcu>>4; u.qb=(i==0)?31-s:s; return true; }
  __device__ __forceinline__ void a_ready(const AttnUnit&)const{}
  __device__ __forceinline__ void done(const AttnUnit&)const{}
};
template<class Sched,int THRL=8> __device__ __forceinline__ void attn_phase(char*lds,const AttnTensors&T,const Sched&S){
  AttnUnit u;
  for(int i=0;S.next(i,u);++i){ S.a_ready(u); attn_unit<THRL>(u.bh>>3,u.bh&7,u.qb,T.Q,T.K,T.V,T.O,lds); S.done(u); }
}
#undef SBAR
#undef WAIT_BAR
}
namespace cg = cooperative_groups;
constexpr int NWAVES = 8;
constexpr int BATCH = 2, T = 8192, D = 1024, DIN = 3584, M = BATCH * T, DEPTH = 2;
constexpr float EPS = 1e-6f;
constexpr size_t MiB = 1u << 20;
constexpr size_t WS_CTL = 0;
constexpr size_t WS_TAB = 64 * 1024;
constexpr size_t WS_ROWSS = 128 * 1024;
constexpr size_t WS_ROWSS2 = 192 * 1024;
constexpr size_t WS_PCNT = 14336;
constexpr size_t WS_SUCNT = 15616;
constexpr size_t WS_SCNT = 14592;
constexpr size_t WS_ROWSS0 = 256 * 1024;
constexpr size_t WS_WIN = 2 * MiB;
constexpr size_t WS_WOUT = 16 * MiB;
constexpr size_t WS_GLU = 20 * MiB;
constexpr size_t WS_ROPE = 20 * MiB + 512 * 1024;
constexpr size_t WS_S5A = 21 * MiB;
constexpr size_t WS_S5B = 21 * MiB + 64 * 1024;
constexpr size_t WS_S5C = 21 * MiB + 256 * 1024;
constexpr size_t WS_HU = 22 * MiB;
constexpr size_t WS_HA = 30 * MiB;
constexpr size_t WS_XLOC = 31 * MiB;
constexpr size_t WS_XN = 32 * MiB;
constexpr size_t WS_O = WS_XN;
constexpr size_t WS_PROJ = 64 * MiB;
constexpr size_t WS_MIX = 176 * MiB;
constexpr size_t WS_YG = 208 * MiB;
constexpr size_t WS_YGS = 216 * MiB;
constexpr size_t WS_HRES = 224 * MiB;
constexpr size_t WS_END = 256 * MiB;
constexpr int LDS_BYTES = 147456, RING_BYTES = 131072;

#define GAS __attribute__((address_space(1)))
#define LAS __attribute__((address_space(3)))
typedef unsigned short bf16;
typedef unsigned v4u __attribute__((ext_vector_type(4)));
typedef unsigned v2u __attribute__((ext_vector_type(2)));
typedef float f32x4 __attribute__((ext_vector_type(4)));
typedef short bf16x8 __attribute__((ext_vector_type(8)));
#define LDS_WAIT() asm volatile("s_waitcnt lgkmcnt(0)" ::: "memory")
__device__ __forceinline__ unsigned f2bf(float f) { unsigned u = __builtin_bit_cast(unsigned, f); return (u + 0x7fffu + ((u >> 16) & 1u)) >> 16; }
__device__ __forceinline__ unsigned pk2(float lo, float hi) { return f2bf(lo) | (f2bf(hi) << 16); }
__device__ __forceinline__ float bflo(unsigned w) { return __uint_as_float(w << 16); }
__device__ __forceinline__ float bfhi(unsigned w) { return __uint_as_float(w & 0xffff0000u); }
__device__ __forceinline__ float bf1(bf16 h) { return __uint_as_float(((unsigned)h) << 16); }
__device__ __forceinline__ float sigmf(float v) { return __builtin_amdgcn_rcpf(1.0f + __builtin_amdgcn_exp2f(-1.4426950408889634f * v)); }
__device__ __forceinline__ float siluf(float v) { return v * sigmf(v); }
__device__ __forceinline__ float wave_sum(float v) {
#pragma unroll
    for (int o = 1; o < 64; o <<= 1) v += __shfl_xor(v, o);
    return v;
}
__device__ __forceinline__ void p0_transpose_item(const float* W, int K, int N, bf16* WT, LAS float* scr_f, int item, int lane, const float* kscale = nullptr) {
    LAS bf16* scr = (LAS bf16*)scr_f;
    const int nblk = N / 64, kb = item / nblk, nb = item % nblk, k0 = 64 * kb, n0 = 64 * nb;
    f32x4 v[16];
#pragma unroll
    for (int i = 0; i < 16; ++i) v[i] = __builtin_nontemporal_load((const f32x4*)(W + (size_t)(k0 + 4 * i + (lane >> 4)) * N + n0 + (lane & 15) * 4));
#pragma unroll
    for (int i = 0; i < 16; ++i) { const float sc = kscale ? kscale[k0 + 4 * i + (lane >> 4)] : 1.0f;
        *(LAS v2u*)(scr + (4 * i + (lane >> 4)) * 68 + (lane & 15) * 4) = (v2u){pk2(v[i].x * sc, v[i].y * sc), pk2(v[i].z * sc, v[i].w * sc)}; }
    LDS_WAIT(); asm volatile("" ::: "memory");
    const int c = lane & 7;
#pragma unroll
    for (int j = 0; j < 8; ++j) { const int n = (lane >> 3) + 8 * j; const LAS bf16* t = scr + (8 * c) * 68 + n;
        v4u o; o.x = (unsigned)t[0] | ((unsigned)t[68] << 16); o.y = (unsigned)t[2 * 68] | ((unsigned)t[3 * 68] << 16); o.z = (unsigned)t[4 * 68] | ((unsigned)t[5 * 68] << 16); o.w = (unsigned)t[6 * 68] | ((unsigned)t[7 * 68] << 16);
        *(v4u*)(WT + (size_t)(n0 + n) * K + k0 + 8 * c) = o; }
    LDS_WAIT(); asm volatile("" ::: "memory");
}
template <bool OUTF> __device__ __forceinline__ void rms_row(const float* xrow, const float* w, bf16* orow, float* frow, int lane) {
    const f32x4* xr = (const f32x4*)xrow + lane; const f32x4* wr = (const f32x4*)w + lane;
    f32x4 v[4]; float s = 0.f;
#pragma unroll
    for (int j = 0; j < 4; ++j) { v[j] = xr[64 * j]; s += (v[j].x * v[j].x + v[j].y * v[j].y) + (v[j].z * v[j].z + v[j].w * v[j].w); }
    const float rs = 1.0f / sqrtf(wave_sum(s) * (1.f / D) + EPS);
#pragma unroll
    for (int j = 0; j < 4; ++j) { const f32x4 ww = wr[64 * j]; const f32x4 o = v[j] * rs * ww;
        if (OUTF) ((f32x4*)frow + lane)[64 * j] = o;
        else ((v2u*)orow + lane)[64 * j] = (v2u){pk2(o.x, o.y), pk2(o.z, o.w)}; }
}

typedef GAS unsigned gu32;
#define RLX_AGENT __ATOMIC_RELAXED, __HIP_MEMORY_SCOPE_AGENT
#define XB_TMO      128
#define XB_XCNT(j)  (256  + 64 * (j))
#define XB_XSUB(j)  (1280 + 64 * (j))
#define XB_XGEN(j)  (2304 + 64 * (j))
#define XB_TOP      3328
#define XB_TOPGEN   3392
#define XCD_BAR_WORDS 3456
#define XB_SPIN_CAP (1u << 18)

__device__ __forceinline__ unsigned xb_ld(unsigned* p)              { return __hip_atomic_load(p, __ATOMIC_RELAXED, __HIP_MEMORY_SCOPE_AGENT); }
__device__ __forceinline__ unsigned xb_add(unsigned* p, unsigned v) { return __hip_atomic_fetch_add(p, v, __ATOMIC_RELAXED, __HIP_MEMORY_SCOPE_AGENT); }
__device__ __forceinline__ unsigned xb_xcc_id() { return (unsigned)__builtin_amdgcn_s_getreg((3 << 11) | 20) & 0xFu; }
#define XB_SPIN(cond, bar) do { unsigned _sp = 0; while (cond) { __builtin_amdgcn_s_sleep(1); \
    if ((++_sp & 255u) == 0u) { if (xb_ld(&(bar)[XB_TMO])) break; if (_sp > XB_SPIN_CAP) { atomicAdd(&(bar)[XB_TMO], 1u); break; } } } } while (0)

struct XcdBarrier {
    unsigned* bar; unsigned x;
    volatile LAS unsigned* st;
};

__device__ __forceinline__ XcdBarrier xcd_barrier_post(unsigned* bar, volatile LAS unsigned* st) {
    XcdBarrier b; b.bar = bar; b.x = xb_xcc_id(); b.st = st;
    if (threadIdx.x == 0) (void)xb_add(&bar[XB_XCNT(b.x)], 1u);
    return b;
}
__device__ __forceinline__ void xcd_barrier_complete(unsigned* bar, unsigned x, unsigned& nloc, unsigned& nx) {
    const unsigned G = gridDim.x * gridDim.y * gridDim.z;
    unsigned sum, cnt, mine, sp = 0u;
    for (;;) {
        sum = 0u; cnt = 0u; mine = 0u;
#pragma unroll
        for (unsigned j = 0; j < 16; ++j) { const unsigned c = xb_ld(&bar[XB_XCNT(j)]); sum += c; cnt += (c > 0u) ? 1u : 0u; mine = (j == x) ? c : mine; }
        if (sum == G) break;
        __builtin_amdgcn_s_sleep(1);
        if ((++sp & 255u) == 0u) { if (xb_ld(&bar[XB_TMO])) break; if (sp > XB_SPIN_CAP) { atomicAdd(&bar[XB_TMO], 1u); break; } }
    }
    nloc = mine > 0u ? mine : 1u; nx = cnt > 0u ? cnt : 1u;
}

__device__ __forceinline__ void xcd_barrier(const XcdBarrier& b) {
    asm volatile("s_waitcnt vmcnt(0)" ::: "memory");
    __syncthreads();
    if (threadIdx.x == 0) {
        unsigned* bar = b.bar;
        __builtin_amdgcn_s_waitcnt(0);
        unsigned nloc = b.st[0], nx = b.st[1];
        if (nloc == 0u) { xcd_barrier_complete(bar, b.x, nloc, nx); b.st[0] = nloc; b.st[1] = nx; }
        const unsigned old = xb_add(&bar[XB_XSUB(b.x)], 1u);
        const unsigned gen = old / nloc;
        if (old + 1u == (gen + 1u) * nloc) {
            __builtin_amdgcn_fence(__ATOMIC_RELEASE, "agent");
            asm volatile("s_waitcnt vmcnt(0)" ::: "memory");
            const unsigned og = xb_add(&bar[XB_TOP], 1u);
            const unsigned tg = og / nx;
            if (og + 1u == (tg + 1u) * nx) xb_add(&bar[XB_TOPGEN], 1u);
            else XB_SPIN(xb_ld(&bar[XB_TOPGEN]) == tg, bar);
            __builtin_amdgcn_fence(__ATOMIC_ACQUIRE, "agent");
            xb_add(&bar[XB_XGEN(b.x)], 1u);
            asm volatile("s_waitcnt vmcnt(0)" ::: "memory");
        } else {
            XB_SPIN(xb_ld(&bar[XB_XGEN(b.x)]) == gen, bar);
            __builtin_amdgcn_fence(__ATOMIC_ACQUIRE, "agent");
            asm volatile("s_waitcnt vmcnt(0)" ::: "memory");
        }
    }
    __syncthreads();
}
struct Args { const float* in[22]; float* out; unsigned char* ws; int ph_lo, ph_hi; };
struct PA { const float* const* in; float* out; unsigned char* ws; };

__device__ __forceinline__ void s5_prep(const float* const* in, unsigned char* ws, int t0, int nthreads) {
    const double TWO_PI = 6.283185307179586476925;
    for (int ec = t0; ec < DEPTH * 16 * 64 * 16; ec += nthreads) {
        const int e = ec >> 4, c = ec & 15;
        const int l = e >> 10, g = (e >> 6) & 15, p = e & 63;
        const double dt = (double)expf(in[12][l * 16 + g]);
        const double are = (double)in[6][e], aim = (double)in[7][e];
        const double mag = (double)expf((float)(dt * are));
        double tt = dt * aim * (1.0 / TWO_PI); tt -= __builtin_floor(tt);
        const float ang = (float)(tt * TWO_PI);
        const double abr = mag * (double)cosf(ang), abi = mag * (double)sinf(ang);
        const double den = are * are + aim * aim, nr = abr - 1.0, ni = abi;
        const double zr = (nr * are + ni * aim) / den, zi = (ni * are - nr * aim) / den;
        if (c == 0) {
            double pr = abr, pi = abi;
#pragma unroll
            for (int q = 0; q < 7; ++q) { const double r2 = pr * pr - pi * pi, i2 = 2.0 * pr * pi; pr = r2; pi = i2; }
            float* sa = (float*)(ws + WS_S5A) + (size_t)(l * 16 + g) * 256;
            sa[p] = (float)abr; sa[64 + p] = (float)abi; sa[128 + p] = (float)pr; sa[192 + p] = (float)pi;
        }
        bf16* bm = (bf16*)(ws + WS_S5B) + (size_t)(l * 16 + g) * 2048;
        const double br = in[8][(size_t)e * 16 + c], bi = in[9][(size_t)e * 16 + c];
        bm[p * 16 + c] = (bf16)f2bf((float)(zr * br - zi * bi)); bm[(64 + p) * 16 + c] = (bf16)f2bf((float)(zr * bi + zi * br));
        bf16* cm = (bf16*)(ws + WS_S5C) + (size_t)(l * 16 + g) * 2048;
        cm[c * 128 + p] = (bf16)f2bf(in[10][(size_t)(l * 16 + g) * 1024 + c * 64 + p]); cm[c * 128 + 64 + p] = (bf16)f2bf(-in[11][(size_t)(l * 16 + g) * 1024 + c * 64 + p]);
    }
}
__device__ __forceinline__ void prologue(const Args& a, LAS unsigned char* lds, int vcu, int G, int wave, int lane) {
    const bool defer_s5 = false;
    unsigned char* ws = a.ws;
    LAS float* scr = (LAS float*)(lds + wave * 16384);
    const int gw = vcu * NWAVES + wave, NGW = G * NWAVES;
    constexpr int I_IN = (D / 64) * (DIN / 64), I_OUT = (D / 64) * (D / 64), I_GLU = (256 / 64) * (256 / 64);
    constexpr int NITEMS = DEPTH * (I_IN + I_OUT + I_GLU);
    for (int it = gw; it < NITEMS; it += NGW) {
        int r = it; const int l = r / (I_IN + I_OUT + I_GLU); r -= l * (I_IN + I_OUT + I_GLU);
        if (r < I_IN) { p0_transpose_item(a.in[2] + (size_t)l * D * DIN, D, DIN, (bf16*)(ws + WS_WIN) + (size_t)l * DIN * D, scr, r, lane, a.in[1] + (size_t)l * D); continue; } r -= I_IN;
        if (r < I_OUT) { p0_transpose_item(a.in[3] + (size_t)l * D * D, D, D, (bf16*)(ws + WS_WOUT) + (size_t)l * D * D, scr, r, lane); continue; } r -= I_OUT;
        p0_transpose_item(a.in[14] + (size_t)l * 65536, 256, 256, (bf16*)(ws + WS_GLU) + (size_t)l * 65536, scr, r, lane);
    }
    for (int m = gw; m < M; m += 2 * NGW) {
        const int m2 = m + NGW; const bool has2 = m2 < M;
        const f32x4* x1 = (const f32x4*)(a.in[0] + (size_t)m * D) + lane; const f32x4* x2 = (const f32x4*)(a.in[0] + (size_t)(has2 ? m2 : m) * D) + lane;
        f32x4 v1[4], v2[4]; float s1 = 0.f, s2 = 0.f;
#pragma unroll
        for (int j = 0; j < 4; ++j) { v1[j] = __builtin_nontemporal_load(x1 + 64 * j); v2[j] = __builtin_nontemporal_load(x2 + 64 * j); }
#pragma unroll
        for (int j = 0; j < 4; ++j) { s1 += (v1[j].x * v1[j].x + v1[j].y * v1[j].y) + (v1[j].z * v1[j].z + v1[j].w * v1[j].w); s2 += (v2[j].x * v2[j].x + v2[j].y * v2[j].y) + (v2[j].z * v2[j].z + v2[j].w * v2[j].w);
            ((v2u*)((bf16*)(ws + WS_HRES) + (size_t)m * D) + lane)[64 * j] = (v2u){pk2(v1[j].x, v1[j].y), pk2(v1[j].z, v1[j].w)};
            if (has2) ((v2u*)((bf16*)(ws + WS_HRES) + (size_t)m2 * D) + lane)[64 * j] = (v2u){pk2(v2[j].x, v2[j].y), pk2(v2[j].z, v2[j].w)}; }
        s1 = wave_sum(s1); s2 = wave_sum(s2);
        if (lane == 0) { ((float*)(ws + WS_ROWSS0))[m] = s1; if (has2) ((float*)(ws + WS_ROWSS0))[m2] = s2; }
        if (lane == 0) { ((float*)(ws + WS_ROWSS))[m] = 0.f; ((float*)(ws + WS_ROWSS2))[m] = 0.f; if (has2) { ((float*)(ws + WS_ROWSS))[m2] = 0.f; ((float*)(ws + WS_ROWSS2))[m2] = 0.f; } }
    }
    const int gt = gw * 64 + lane, NGT = NGW * 64;
    const double TWO_PI = 6.283185307179586476925;
    for (int e = gt; e < 8192 * 8; e += NGT) {
        const int pos = e >> 3, i = e & 7;
        const double invf[8] = {1.0, 0.19392274474868576, 0.03760603093086393, 0.007292664737217109, 0.001414213562373095, 0.0002742481756762073, 5.318295896944988e-05, 1.031338537721246e-05};
        double inv = invf[0];
#pragma unroll
        for (int q = 1; q < 8; ++q) inv = (i == q) ? invf[q] : inv;
        double tt = (double)pos * inv * (1.0 / TWO_PI); tt -= __builtin_floor(tt);
        const float ang = (float)(tt * TWO_PI);
        float* rp = (float*)(ws + WS_ROPE) + (size_t)e * 2; rp[0] = cosf(ang); rp[1] = sinf(ang);
    }
    if (!defer_s5) s5_prep(a.in, ws, gt, NGT);
}

template <bool OUT> __device__ __forceinline__ void hgrn_item(const PA& a, LAS unsigned char* lds, int layer, int bh, int c, int tid, int wave, int lane) {
    const int b = bh >> 2, h = bh & 3;
    const bf16* PROJ = (const bf16*)(a.ws + WS_PROJ);
    float* HU = (float*)(a.ws + WS_HU); float* HA = (float*)(a.ws + WS_HA);
    LAS float* Fs = (LAS float*)lds; LAS float* Ks = Fs + 4096; LAS float* Vs = Ks + 4096; LAS float* Qs = Vs + 4096; LAS float* Ps = Qs + 4096;
    const size_t row0 = (size_t)b * T + (size_t)c * 128;
    float S[8];
#pragma unroll
    for (int j = 0; j < 8; ++j) S[j] = 0.f;
    if (OUT) {
        int cp = 0;
        for (; cp + 4 <= c; cp += 4) {
            float uu[4][8], aa[4][8];
#pragma unroll
            for (int q = 0; q < 4; ++q) {
                const float* U = HU + (size_t)(bh * 64 + cp + q) * 4096 + (size_t)(wave * 8) * 64 + lane; const float* A = HA + (size_t)(bh * 64 + cp + q) * 64 + wave * 8;
#pragma unroll
                for (int j = 0; j < 8; ++j) { uu[q][j] = U[j * 64]; aa[q][j] = A[j]; }
            }
#pragma unroll
            for (int q = 0; q < 4; ++q)
#pragma unroll
                for (int j = 0; j < 8; ++j) S[j] = aa[q][j] * S[j] + uu[q][j];
        }
        for (; cp < c; ++cp) {
            const float* U = HU + (size_t)(bh * 64 + cp) * 4096 + (size_t)(wave * 8) * 64 + lane; const float* A = HA + (size_t)(bh * 64 + cp) * 64 + wave * 8;
#pragma unroll
            for (int j = 0; j < 8; ++j) S[j] = A[j] * S[j] + U[j * 64];
        }
    }
    const int fcol = h * 64 + (tid & 7) * 8;
    float lb[8];
#pragma unroll
    for (int j = 0; j < 8; ++j) lb[j] = (layer == 0) ? 0.f : sigmf(a.in[4][256 + fcol + j] - a.in[4][fcol + j]);
    const float gnw = a.in[5][layer * 64 + lane];
    float aprod = 1.f;
    for (int sub = 0; sub < 2; ++sub) {
        __syncthreads();
        { const int t = tid >> 3; const bf16* pr = PROJ + (row0 + sub * 64 + t) * DIN + fcol;
          const v4u fw = *(const v4u*)(pr + 256), vw = *(const v4u*)(pr + 512);
          const unsigned fa[4] = {fw.x, fw.y, fw.z, fw.w}, va[4] = {vw.x, vw.y, vw.z, vw.w};
          float fo[8], ko[8], vo[8];
#pragma unroll
          for (int j = 0; j < 8; ++j) { const float x = (j & 1) ? bfhi(fa[j >> 1]) : bflo(fa[j >> 1]); const float sg = sigmf(x);
              fo[j] = lb[j] + (1.f - lb[j]) * sg; ko[j] = (1.f - lb[j]) * (1.f - sg); vo[j] = (j & 1) ? bfhi(va[j >> 1]) : bflo(va[j >> 1]); }
          LAS f32x4* d;
          d = (LAS f32x4*)(Fs + t * 64 + (tid & 7) * 8); d[0] = (f32x4){fo[0], fo[1], fo[2], fo[3]}; d[1] = (f32x4){fo[4], fo[5], fo[6], fo[7]};
          d = (LAS f32x4*)(Ks + t * 64 + (tid & 7) * 8); d[0] = (f32x4){ko[0], ko[1], ko[2], ko[3]}; d[1] = (f32x4){ko[4], ko[5], ko[6], ko[7]};
          d = (LAS f32x4*)(Vs + t * 64 + (tid & 7) * 8); d[0] = (f32x4){vo[0], vo[1], vo[2], vo[3]}; d[1] = (f32x4){vo[4], vo[5], vo[6], vo[7]};
          if (OUT) { const v4u qw = *(const v4u*)(pr); const unsigned qa[4] = {qw.x, qw.y, qw.z, qw.w}; float qo[8];
#pragma unroll
              for (int j = 0; j < 8; ++j) qo[j] = siluf((j & 1) ? bfhi(qa[j >> 1]) : bflo(qa[j >> 1]));
              d = (LAS f32x4*)(Qs + t * 64 + (tid & 7) * 8); d[0] = (f32x4){qo[0], qo[1], qo[2], qo[3]}; d[1] = (f32x4){qo[4], qo[5], qo[6], qo[7]}; }
        }
        __syncthreads();
        if (!OUT && tid < 64) { for (int t = 0; t < 64; ++t) aprod *= Fs[t * 64 + tid]; }
        for (int tb = 0; tb < 4; ++tb) {
#pragma unroll 4
            for (int tt = 0; tt < 16; ++tt) {
                const int t = tb * 16 + tt;
                const f32x4 f0 = *(const LAS f32x4*)(Fs + t * 64 + wave * 8), f1 = *(const LAS f32x4*)(Fs + t * 64 + wave * 8 + 4);
                const f32x4 k0 = *(const LAS f32x4*)(Ks + t * 64 + wave * 8), k1 = *(const LAS f32x4*)(Ks + t * 64 + wave * 8 + 4);
                const float v = Vs[t * 64 + lane];
                S[0] = f0[0] * S[0] + k0[0] * v; S[1] = f0[1] * S[1] + k0[1] * v; S[2] = f0[2] * S[2] + k0[2] * v; S[3] = f0[3] * S[3] + k0[3] * v;
                S[4] = f1[0] * S[4] + k1[0] * v; S[5] = f1[1] * S[5] + k1[1] * v; S[6] = f1[2] * S[6] + k1[2] * v; S[7] = f1[3] * S[7] + k1[3] * v;
                if (OUT) {
                    const f32x4 q0 = *(const LAS f32x4*)(Qs + t * 64 + wave * 8), q1 = *(const LAS f32x4*)(Qs + t * 64 + wave * 8 + 4);
                    const float p = ((q0[0] * S[0] + q0[1] * S[1]) + (q0[2] * S[2] + q0[3] * S[3])) + ((q1[0] * S[4] + q1[1] * S[5]) + (q1[2] * S[6] + q1[3] * S[7]));
                    Ps[(wave * 16 + tt) * 64 + lane] = p;
                }
            }
            if (OUT) {
                __syncthreads();
#pragma unroll
                for (int r = 0; r < 2; ++r) {
                    const int tt = wave + 8 * r; float o = 0.f;
#pragma unroll
                    for (int w2 = 0; w2 < 8; ++w2) o += Ps[(w2 * 16 + tt) * 64 + lane];
                    const float rs = 1.0f / sqrtf(wave_sum(o * o) * (1.f / 64.f) + EPS);
                    const size_t row = row0 + sub * 64 + tb * 16 + tt;
                    const float gt = siluf(bf1(PROJ[row * DIN + 768 + h * 64 + lane]));
                    ((bf16*)(a.ws + WS_MIX))[row * 1024 + h * 64 + lane] = (bf16)f2bf(o * rs * gnw * gt);
                }
                __syncthreads();
            }
        }
    }
    if (!OUT) {
        float* U = HU + (size_t)(bh * 64 + c) * 4096 + (size_t)(wave * 8) * 64 + lane;
#pragma unroll
        for (int j = 0; j < 8; ++j) U[j * 64] = S[j];
        if (tid < 64) HA[(size_t)(bh * 64 + c) * 64 + tid] = aprod;
    }
}

typedef unsigned short u16;
__device__ __forceinline__ bf16x8 pk8(const float* v) { v4u w = {pk2(v[0], v[1]), pk2(v[2], v[3]), pk2(v[4], v[5]), pk2(v[6], v[7])}; return __builtin_bit_cast(bf16x8, w); }
struct HRaw { v4u f[2], v[2], q[2], g[2]; };
template <bool OUT> __device__ __forceinline__ HRaw hgrn_load(const PA& a, int bh, int c, int wave, int lane) {
    const bf16* pr = (const bf16*)(a.ws + WS_PROJ) + ((size_t)(bh >> 2) * T + (size_t)c * 128 + wave * 16 + (lane >> 3)) * DIN + (bh & 3) * 64 + (lane & 7) * 8;
    HRaw r;
#pragma unroll
    for (int k = 0; k < 2; ++k) { r.f[k] = *(const v4u*)(pr + (size_t)(8 * k) * DIN + 256); r.v[k] = *(const v4u*)(pr + (size_t)(8 * k) * DIN + 512);
        if (OUT) { r.q[k] = *(const v4u*)(pr + (size_t)(8 * k) * DIN); r.g[k] = *(const v4u*)(pr + (size_t)(8 * k) * DIN + 768); } }
    return r;
}
template <bool OUT> __device__ __forceinline__ void hgrn_item2(const PA& a, LAS unsigned char* lds, int layer, int bh, int c, int wave, int lane, const HRaw& raw) {
    const int b = bh >> 2, h = bh & 3, item = bh * 64 + c;
    float* HU = (float*)(a.ws + WS_HU); float* HA = (float*)(a.ws + WS_HA);
    LAS unsigned char* wb = lds + wave * 12288;
    LAS bf16* QT = (LAS bf16*)wb; LAS bf16* KT = (LAS bf16*)(wb + 2304); LAS bf16* KHT = (LAS bf16*)(wb + 4608); LAS bf16* VT = (LAS bf16*)(wb + 7680); LAS bf16* P = (LAS bf16*)(wb + 10752);
    LAS float* DL = (LAS float*)(wb + 11520); LAS float* E7L = (LAS float*)(wb + 11776);
    LAS bf16* RF = (LAS bf16*)wb; LAS bf16* RV = (LAS bf16*)(wb + 2304); LAS bf16* RQ = (LAS bf16*)(wb + 4608);
    LAS bf16* GT = KHT; LAS bf16* OT = VT;
    LAS float* SBUF = (LAS float*)(lds + 98304); LAS float* DALL = (LAS float*)(lds + 114688);
    const int l15 = lane & 15, q = lane >> 4;
    const size_t row0 = (size_t)b * T + (size_t)c * 128 + wave * 16;
    const bf16x8 zero8 = {0, 0, 0, 0, 0, 0, 0, 0};
    __syncthreads();
    {
        const int rr = lane >> 3, cc = (lane & 7) * 8;
#pragma unroll
        for (int k = 0; k < 2; ++k) { *(LAS v4u*)(RF + (rr + 8 * k) * 72 + cc) = raw.f[k]; *(LAS v4u*)(RV + (rr + 8 * k) * 72 + cc) = raw.v[k]; if (OUT) *(LAS v4u*)(RQ + (rr + 8 * k) * 72 + cc) = raw.q[k]; }
        LDS_WAIT();
        const float lb = (layer == 0) ? 0.f : sigmf(a.in[4][256 + h * 64 + lane] - a.in[4][h * 64 + lane]);
        u16 fr[16], vr[16], qr[16];
#pragma unroll
        for (int t = 0; t < 16; ++t) { fr[t] = RF[t * 72 + lane]; vr[t] = RV[t * 72 + lane]; if (OUT) qr[t] = RQ[t * 72 + lane]; }
        LDS_WAIT();
        float cum[16], kk[16]; float run = 0.f;
#pragma unroll
        for (int t = 0; t < 16; ++t) { const float sg = sigmf(bf1(fr[t])); const float f = lb + (1.f - lb) * sg; kk[t] = (1.f - lb) * (1.f - sg); run += fmaxf(__logf(f), -69.f); cum[t] = run; }
        const float cl = cum[15], c7 = cum[7];
        DL[lane] = __expf(cl);
        if (OUT) E7L[lane] = __expf(c7); else DALL[wave * 64 + lane] = cl;
        float kh[16];
#pragma unroll
        for (int t = 0; t < 16; ++t) kh[t] = kk[t] * __expf(cl - cum[t]);
        *(LAS bf16x8*)(KHT + lane * 24) = pk8(kh); *(LAS bf16x8*)(KHT + lane * 24 + 8) = pk8(kh + 8);
        { v4u w0 = {(unsigned)vr[0] | ((unsigned)vr[1] << 16), (unsigned)vr[2] | ((unsigned)vr[3] << 16), (unsigned)vr[4] | ((unsigned)vr[5] << 16), (unsigned)vr[6] | ((unsigned)vr[7] << 16)};
          v4u w1 = {(unsigned)vr[8] | ((unsigned)vr[9] << 16), (unsigned)vr[10] | ((unsigned)vr[11] << 16), (unsigned)vr[12] | ((unsigned)vr[13] << 16), (unsigned)vr[14] | ((unsigned)vr[15] << 16)};
          *(LAS v4u*)(VT + lane * 24) = w0; *(LAS v4u*)(VT + lane * 24 + 8) = w1; }
        if (OUT) {
#pragma unroll
            for (int t = 0; t < 16; ++t) {
                QT[t * 72 + lane] = (bf16)f2bf(siluf(bf1(qr[t])) * __expf(fminf(cum[t] - c7, 60.f)));
                KT[t * 72 + lane] = (bf16)f2bf(kk[t] * __expf(fminf(c7 - cum[t], 60.f)));
            }
        }
    }
    LDS_WAIT();
    bf16x8 vfr[4];
#pragma unroll
    for (int nt = 0; nt < 4; ++nt) vfr[nt] = (q < 2) ? *(const LAS bf16x8*)(VT + (16 * nt + l15) * 24 + q * 8) : zero8;
    f32x4 U[4][4];
#pragma unroll
    for (int mt = 0; mt < 4; ++mt) { const bf16x8 afr = (q < 2) ? *(const LAS bf16x8*)(KHT + (16 * mt + l15) * 24 + q * 8) : zero8;
#pragma unroll
        for (int nt = 0; nt < 4; ++nt) U[mt][nt] = __builtin_amdgcn_mfma_f32_16x16x32_bf16(afr, vfr[nt], (f32x4){0.f, 0.f, 0.f, 0.f}, 0, 0, 0); }
    f32x4 o[4]; bf16x8 qf[2];
    if (OUT) {
        LDS_WAIT();
        { const int rr = lane >> 3, cc = (lane & 7) * 8; *(LAS v4u*)(GT + rr * 72 + cc) = raw.g[0]; *(LAS v4u*)(GT + (rr + 8) * 72 + cc) = raw.g[1]; }
        f32x4 sc = {0.f, 0.f, 0.f, 0.f};
#pragma unroll
        for (int ks = 0; ks < 2; ++ks) {
            const v2u qa = *(const LAS v2u*)(QT + l15 * 72 + 32 * ks + 4 * q), qb = *(const LAS v2u*)(QT + l15 * 72 + 32 * ks + 16 + 4 * q);
            const v2u ka = *(const LAS v2u*)(KT + l15 * 72 + 32 * ks + 4 * q), kb = *(const LAS v2u*)(KT + l15 * 72 + 32 * ks + 16 + 4 * q);
            qf[ks] = __builtin_bit_cast(bf16x8, (v4u){qa.x, qa.y, qb.x, qb.y});
            const bf16x8 kf = __builtin_bit_cast(bf16x8, (v4u){ka.x, ka.y, kb.x, kb.y});
            sc = __builtin_amdgcn_mfma_f32_16x16x32_bf16(qf[ks], kf, sc, 0, 0, 0);
        }
#pragma unroll
        for (int j = 0; j < 4; ++j) { const int t = 4 * q + j; P[t * 24 + l15] = (bf16)f2bf((l15 <= t) ? sc[j] : 0.f); }
        LDS_WAIT();
        const bf16x8 pf = (q < 2) ? *(const LAS bf16x8*)(P + l15 * 24 + q * 8) : zero8;
#pragma unroll
        for (int nt = 0; nt < 4; ++nt) o[nt] = __builtin_amdgcn_mfma_f32_16x16x32_bf16(pf, vfr[nt], (f32x4){0.f, 0.f, 0.f, 0.f}, 0, 0, 0);
    }
    {
        float S8[8];
#pragma unroll
        for (int i = 0; i < 8; ++i) S8[i] = 0.f;
        if (OUT) {
            const f32x4 h0 = *(const f32x4*)(HU + (size_t)item * 4096 + (size_t)((2 * wave) * 64 + lane) * 4), h1 = *(const f32x4*)(HU + (size_t)item * 4096 + (size_t)((2 * wave + 1) * 64 + lane) * 4);
            S8[0] = h0[0]; S8[1] = h0[1]; S8[2] = h0[2]; S8[3] = h0[3]; S8[4] = h1[0]; S8[5] = h1[1]; S8[6] = h1[2]; S8[7] = h1[3];
        }
        *(LAS f32x4*)(SBUF + ((2 * wave) * 64 + lane) * 4) = (f32x4){S8[0], S8[1], S8[2], S8[3]}; *(LAS f32x4*)(SBUF + ((2 * wave + 1) * 64 + lane) * 4) = (f32x4){S8[4], S8[5], S8[6], S8[7]};
    }
    __syncthreads();
    f32x4 Sp[4][4];
#pragma unroll 1
    for (int step = 0; step < 8; ++step) {
        if (wave == step) {
#pragma unroll
            for (int mt = 0; mt < 4; ++mt) { const f32x4 Dv = *(const LAS f32x4*)(DL + 16 * mt + 4 * q);
#pragma unroll
                for (int nt = 0; nt < 4; ++nt) {
                    Sp[mt][nt] = *(const LAS f32x4*)(SBUF + ((mt * 4 + nt) * 64 + lane) * 4);
                    U[mt][nt] = Dv * Sp[mt][nt] + U[mt][nt];
                    *(LAS f32x4*)(SBUF + ((mt * 4 + nt) * 64 + lane) * 4) = U[mt][nt];
                } }
        }
        __syncthreads();
    }
    if (OUT) {
#pragma unroll
        for (int mt = 0; mt < 4; ++mt) { const f32x4 Ev = *(const LAS f32x4*)(E7L + 16 * mt + 4 * q);
#pragma unroll
            for (int nt = 0; nt < 4; ++nt) Sp[mt][nt] = Sp[mt][nt] * Ev; }
#pragma unroll
        for (int nt = 0; nt < 4; ++nt)
#pragma unroll
            for (int ks = 0; ks < 2; ++ks) {
                const f32x4 s0 = Sp[2 * ks][nt], s1 = Sp[2 * ks + 1][nt];
                const bf16x8 bfrag = __builtin_bit_cast(bf16x8, (v4u){pk2(s0[0], s0[1]), pk2(s0[2], s0[3]), pk2(s1[0], s1[1]), pk2(s1[2], s1[3])});
                o[nt] = __builtin_amdgcn_mfma_f32_16x16x32_bf16(qf[ks], bfrag, o[nt], 0, 0, 0);
            }
        float gn[4];
#pragma unroll
        for (int nt = 0; nt < 4; ++nt) gn[nt] = a.in[5][layer * 64 + 16 * nt + l15];
#pragma unroll
        for (int j = 0; j < 4; ++j) {
            float ss = (o[0][j] * o[0][j] + o[1][j] * o[1][j]) + (o[2][j] * o[2][j] + o[3][j] * o[3][j]);
            ss += __shfl_xor(ss, 1); ss += __shfl_xor(ss, 2); ss += __shfl_xor(ss, 4); ss += __shfl_xor(ss, 8);
            const float rs = __builtin_amdgcn_rsqf(ss * (1.f / 64.f) + EPS);
#pragma unroll
            for (int nt = 0; nt < 4; ++nt) { const float gt = siluf(bf1(GT[(4 * q + j) * 72 + 16 * nt + l15]));
                OT[(4 * q + j) * 72 + 16 * nt + l15] = (bf16)f2bf(o[nt][j] * rs * gn[nt] * gt); }
        }
        LDS_WAIT();
        { const int rr = lane >> 3, cc = (lane & 7) * 8; bf16* mp = (bf16*)(a.ws + WS_MIX) + (row0 + rr) * 1024 + h * 64 + cc;
          *(v4u*)mp = *(const LAS v4u*)(OT + rr * 72 + cc); *(v4u*)(mp + 8 * 1024) = *(const LAS v4u*)(OT + (rr + 8) * 72 + cc); }
    } else {
        if (wave == 7) {
#pragma unroll
            for (int mt = 0; mt < 4; ++mt)
#pragma unroll
                for (int nt = 0; nt < 4; ++nt)
                    *(f32x4*)(HU + (size_t)item * 4096 + (size_t)((mt * 4 + nt) * 64 + lane) * 4) = U[mt][nt];
            float s = 0.f;
#pragma unroll
            for (int w2 = 0; w2 < 8; ++w2) s += DALL[w2 * 64 + lane];
            HA[(size_t)item * 64 + lane] = __expf(s);
        }
    }
}

template <bool OUT> __device__ __forceinline__ HRaw hgrn_loadc(const PA& a, int bh, int c, int chunk, int lane) {
    const bf16* pr = (const bf16*)(a.ws + WS_PROJ) + ((size_t)(bh >> 2) * T + (size_t)c * 128 + chunk * 16 + (lane >> 3)) * DIN + (bh & 3) * 64 + (lane & 7) * 8;
    HRaw r;
#pragma unroll
    for (int k = 0; k < 2; ++k) { r.f[k] = *(const v4u*)(pr + (size_t)(8 * k) * DIN + 256); r.v[k] = *(const v4u*)(pr + (size_t)(8 * k) * DIN + 512);
        if (OUT) { r.q[k] = *(const v4u*)(pr + (size_t)(8 * k) * DIN); } }
    return r;
}
template <bool OUT> __device__ __forceinline__ void hgrn_chunk(const PA& a, LAS unsigned char* wb, LAS float* DLk, LAS float* E7k, LAS float* DALLk, int layer, int h, int lane, const HRaw& raw,
                                                                f32x4 (&U)[4][4], f32x4 (&o)[4], bf16x8 (&qf)[2]) {
    LAS bf16* QT = (LAS bf16*)wb; LAS bf16* KT = (LAS bf16*)(wb + 2304); LAS bf16* KHT = (LAS bf16*)(wb + 4608); LAS bf16* VT = (LAS bf16*)(wb + 7680); LAS bf16* P = (LAS bf16*)(wb + 10752);
    LAS bf16* RF = (LAS bf16*)wb; LAS bf16* RV = (LAS bf16*)(wb + 2304); LAS bf16* RQ = (LAS bf16*)(wb + 4608);
    const int l15 = lane & 15, q = lane >> 4;
    const bf16x8 zero8 = {0, 0, 0, 0, 0, 0, 0, 0};
    LDS_WAIT();
    {
        const int rr = lane >> 3, cc = (lane & 7) * 8;
#pragma unroll
        for (int k = 0; k < 2; ++k) { *(LAS v4u*)(RF + (rr + 8 * k) * 72 + cc) = raw.f[k]; *(LAS v4u*)(RV + (rr + 8 * k) * 72 + cc) = raw.v[k]; if (OUT) *(LAS v4u*)(RQ + (rr + 8 * k) * 72 + cc) = raw.q[k]; }
        LDS_WAIT();
        const float lb = (layer == 0) ? 0.f : sigmf(a.in[4][256 + h * 64 + lane] - a.in[4][h * 64 + lane]);
        {
            u16 vr[16];
#pragma unroll
            for (int t = 0; t < 16; ++t) vr[t] = RV[t * 72 + lane];
            const v4u w0 = {(unsigned)vr[0] | ((unsigned)vr[1] << 16), (unsigned)vr[2] | ((unsigned)vr[3] << 16), (unsigned)vr[4] | ((unsigned)vr[5] << 16), (unsigned)vr[6] | ((unsigned)vr[7] << 16)};
            const v4u w1 = {(unsigned)vr[8] | ((unsigned)vr[9] << 16), (unsigned)vr[10] | ((unsigned)vr[11] << 16), (unsigned)vr[12] | ((unsigned)vr[13] << 16), (unsigned)vr[14] | ((unsigned)vr[15] << 16)};
            *(LAS v4u*)(VT + lane * 24) = w0; *(LAS v4u*)(VT + lane * 24 + 8) = w1;
        }
        float cum[16], kk[16]; float run = 0.f;
#pragma unroll
        for (int t = 0; t < 16; ++t) { const float sg = sigmf(bf1(RF[t * 72 + lane])); const float f = lb + (1.f - lb) * sg; kk[t] = (1.f - lb) * (1.f - sg); run += fmaxf(__logf(f), -69.f); cum[t] = run; }
        const float cl = cum[15], c7 = cum[7];
        DLk[lane] = __expf(cl);
        if (OUT) E7k[lane] = __expf(c7); else DALLk[lane] = cl;
        if (OUT) {
            float qv[16];
#pragma unroll
            for (int t = 0; t < 16; ++t) qv[t] = bf1(RQ[t * 72 + lane]);
            LDS_WAIT();
#pragma unroll
            for (int t = 0; t < 16; ++t) {
                QT[t * 72 + lane] = (bf16)f2bf(siluf(qv[t]) * __expf(fminf(cum[t] - c7, 60.f)));
                KT[t * 72 + lane] = (bf16)f2bf(kk[t] * __expf(fminf(c7 - cum[t], 60.f)));
            }
        }
        LDS_WAIT();
        float kh[16];
#pragma unroll
        for (int t = 0; t < 16; ++t) kh[t] = kk[t] * __expf(cl - cum[t]);
        *(LAS bf16x8*)(KHT + lane * 24) = pk8(kh); *(LAS bf16x8*)(KHT + lane * 24 + 8) = pk8(kh + 8);
    }
    LDS_WAIT();
    bf16x8 vfr[4];
#pragma unroll
    for (int nt = 0; nt < 4; ++nt) vfr[nt] = (q < 2) ? *(const LAS bf16x8*)(VT + (16 * nt + l15) * 24 + q * 8) : zero8;
#pragma unroll
    for (int mt = 0; mt < 4; ++mt) { const bf16x8 afr = (q < 2) ? *(const LAS bf16x8*)(KHT + (16 * mt + l15) * 24 + q * 8) : zero8;
#pragma unroll
        for (int nt = 0; nt < 4; ++nt) U[mt][nt] = __builtin_amdgcn_mfma_f32_16x16x32_bf16(afr, vfr[nt], (f32x4){0.f, 0.f, 0.f, 0.f}, 0, 0, 0); }
    if (OUT) {
        f32x4 sc = {0.f, 0.f, 0.f, 0.f};
#pragma unroll
        for (int ks = 0; ks < 2; ++ks) {
            const v2u qa = *(const LAS v2u*)(QT + l15 * 72 + 32 * ks + 4 * q), qb = *(const LAS v2u*)(QT + l15 * 72 + 32 * ks + 16 + 4 * q);
            const v2u ka = *(const LAS v2u*)(KT + l15 * 72 + 32 * ks + 4 * q), kb = *(const LAS v2u*)(KT + l15 * 72 + 32 * ks + 16 + 4 * q);
            qf[ks] = __builtin_bit_cast(bf16x8, (v4u){qa.x, qa.y, qb.x, qb.y});
            const bf16x8 kf = __builtin_bit_cast(bf16x8, (v4u){ka.x, ka.y, kb.x, kb.y});
            sc = __builtin_amdgcn_mfma_f32_16x16x32_bf16(qf[ks], kf, sc, 0, 0, 0);
        }
#pragma unroll
        for (int j = 0; j < 4; ++j) { const int t = 4 * q + j; P[t * 24 + l15] = (bf16)f2bf((l15 <= t) ? sc[j] : 0.f); }
        LDS_WAIT();
        const bf16x8 pf = (q < 2) ? *(const LAS bf16x8*)(P + l15 * 24 + q * 8) : zero8;
#pragma unroll
        for (int nt = 0; nt < 4; ++nt) o[nt] = __builtin_amdgcn_mfma_f32_16x16x32_bf16(pf, vfr[nt], (f32x4){0.f, 0.f, 0.f, 0.f}, 0, 0, 0);
    }
}
__device__ __forceinline__ void hgrn_ointer(f32x4 (&o)[4], const bf16x8 (&qf)[2], const f32x4 (&S)[4][4], const f32x4 (&sc)[4]) {
#pragma unroll
    for (int nt = 0; nt < 4; ++nt)
#pragma unroll
        for (int ks = 0; ks < 2; ++ks) {
            const f32x4 s0 = S[2 * ks][nt] * sc[2 * ks], s1 = S[2 * ks + 1][nt] * sc[2 * ks + 1];
            const bf16x8 bfrag = __builtin_bit_cast(bf16x8, (v4u){pk2(s0[0], s0[1]), pk2(s0[2], s0[3]), pk2(s1[0], s1[1]), pk2(s1[2], s1[3])});
            o[nt] = __builtin_amdgcn_mfma_f32_16x16x32_bf16(qf[ks], bfrag, o[nt], 0, 0, 0);
        }
}
#define HG_LAUNDER() do { asm volatile("" : "+v"(lane)); l15 = lane & 15; q = lane >> 4; } while (0)
template <bool OUT> __device__ __forceinline__ void hgrn_pair(const PA& a, LAS unsigned char* lds, int layer, int bh, int s, int wave, int lane) {
    const int half = wave >> 2, wl = wave & 3, c = half ? 63 - s : s, b = bh >> 2, h = bh & 3, item = bh * 64 + c;
    float* HU = (float*)(a.ws + WS_HU); float* HA = (float*)(a.ws + WS_HA);
    LAS unsigned char* wb = lds + wave * 12800;
    LAS float* DLs = (LAS float*)(wb + 11520);
    LAS float* SBUF = (LAS float*)(lds + 102400 + half * 16384);
    LAS float* DALL = (LAS float*)(lds + 135168 + half * 2048);
    int l15 = lane & 15, q = lane >> 4;
    const size_t rowc0 = (size_t)b * T + (size_t)c * 128 + (size_t)(2 * wl) * 16;
    __syncthreads();
    f32x4 U0[4][4], Up[4][4], o[2][4]; bf16x8 qf[2][2];
    { const HRaw r0 = hgrn_loadc<OUT>(a, bh, c, 2 * wl, lane); hgrn_chunk<OUT>(a, wb, DLs, DLs + 128, DALL + (2 * wl) * 64, layer, h, lane, r0, U0, o[0], qf[0]); }
    asm volatile("" ::: "memory"); __builtin_amdgcn_sched_barrier(0); HG_LAUNDER();
    { const HRaw r1 = hgrn_loadc<OUT>(a, bh, c, 2 * wl + 1, lane); hgrn_chunk<OUT>(a, wb, DLs + 64, DLs + 192, DALL + (2 * wl + 1) * 64, layer, h, lane, r1, Up, o[1], qf[1]); }
    asm volatile("" ::: "memory"); __builtin_amdgcn_sched_barrier(0); HG_LAUNDER();
    LDS_WAIT();
    if (OUT) { f32x4 E1[4];
#pragma unroll
        for (int mt = 0; mt < 4; ++mt) E1[mt] = *(const LAS f32x4*)(DLs + 192 + 16 * mt + 4 * q);
        hgrn_ointer(o[1], qf[1], U0, E1); }
#pragma unroll
    for (int mt = 0; mt < 4; ++mt) { const f32x4 D1 = *(const LAS f32x4*)(DLs + 64 + 16 * mt + 4 * q);
#pragma unroll
        for (int nt = 0; nt < 4; ++nt) Up[mt][nt] = D1 * U0[mt][nt] + Up[mt][nt]; }
    HG_LAUNDER();
#pragma unroll
    for (int i = 0; i < 4; ++i) { f32x4 hv = {0.f, 0.f, 0.f, 0.f};
        if (OUT) hv = *(const f32x4*)(HU + (size_t)item * 4096 + (size_t)((4 * wl + i) * 64 + lane) * 4);
        *(LAS f32x4*)(SBUF + ((4 * wl + i) * 64 + lane) * 4) = hv; }
    v4u gq[2][2];
    if (OUT) { const bf16* gp = (const bf16*)(a.ws + WS_PROJ) + (rowc0 + (lane >> 3)) * DIN + 768 + h * 64 + (lane & 7) * 8;
#pragma unroll
        for (int k = 0; k < 2; ++k) { gq[k][0] = *(const v4u*)(gp + (size_t)(16 * k) * DIN); gq[k][1] = *(const v4u*)(gp + (size_t)(16 * k + 8) * DIN); } }
    __syncthreads();
    HG_LAUNDER();
    f32x4 Sin[4][4];
#pragma unroll 1
    for (int step = 0; step < 4; ++step) {
        if (wl == step) {
#pragma unroll
            for (int mt = 0; mt < 4; ++mt) { const f32x4 Dp = *(const LAS f32x4*)(DLs + 16 * mt + 4 * q) * *(const LAS f32x4*)(DLs + 64 + 16 * mt + 4 * q);
#pragma unroll
                for (int nt = 0; nt < 4; ++nt) {
                    Sin[mt][nt] = *(const LAS f32x4*)(SBUF + ((mt * 4 + nt) * 64 + lane) * 4);
                    Up[mt][nt] = Dp * Sin[mt][nt] + Up[mt][nt];
                    *(LAS f32x4*)(SBUF + ((mt * 4 + nt) * 64 + lane) * 4) = Up[mt][nt];
                } }
        }
        __syncthreads();
    }
    HG_LAUNDER();
    if (OUT) {
        { f32x4 E0[4];
#pragma unroll
          for (int mt = 0; mt < 4; ++mt) E0[mt] = *(const LAS f32x4*)(DLs + 128 + 16 * mt + 4 * q);
          hgrn_ointer(o[0], qf[0], Sin, E0);
#pragma unroll
          for (int mt = 0; mt < 4; ++mt) E0[mt] = *(const LAS f32x4*)(DLs + 192 + 16 * mt + 4 * q) * *(const LAS f32x4*)(DLs + 16 * mt + 4 * q);
          hgrn_ointer(o[1], qf[1], Sin, E0); }
        HG_LAUNDER();
        LAS bf16* GT = (LAS bf16*)(wb + 4608); LAS bf16* OT = (LAS bf16*)(wb + 7680);
        float gn[4];
#pragma unroll
        for (int nt = 0; nt < 4; ++nt) gn[nt] = a.in[5][layer * 64 + 16 * nt + l15];
#pragma unroll
        for (int k = 0; k < 2; ++k) {
            const int rr = lane >> 3, cc = (lane & 7) * 8;
            LDS_WAIT();
            *(LAS v4u*)(GT + rr * 72 + cc) = gq[k][0]; *(LAS v4u*)(GT + (rr + 8) * 72 + cc) = gq[k][1];
            LDS_WAIT();
#pragma unroll
            for (int j = 0; j < 4; ++j) {
                float ss = (o[k][0][j] * o[k][0][j] + o[k][1][j] * o[k][1][j]) + (o[k][2][j] * o[k][2][j] + o[k][3][j] * o[k][3][j]);
                ss += __shfl_xor(ss, 1); ss += __shfl_xor(ss, 2); ss += __shfl_xor(ss, 4); ss += __shfl_xor(ss, 8);
                const float rs = __builtin_amdgcn_rsqf(ss * (1.f / 64.f) + EPS);
#pragma unroll
                for (int nt = 0; nt < 4; ++nt) { const float gt = siluf(bf1(GT[(4 * q + j) * 72 + 16 * nt + l15]));
                    OT[(4 * q + j) * 72 + 16 * nt + l15] = (bf16)f2bf(o[k][nt][j] * rs * gn[nt] * gt); }
            }
            LDS_WAIT();
            bf16* mp = (bf16*)(a.ws + WS_MIX) + (rowc0 + k * 16 + rr) * 1024 + h * 64 + cc;
            *(v4u*)mp = *(const LAS v4u*)(OT + rr * 72 + cc); *(v4u*)(mp + 8 * 1024) = *(const LAS v4u*)(OT + (rr + 8) * 72 + cc);
        }
    } else {
        if (wl == 3) {
#pragma unroll
            for (int mt = 0; mt < 4; ++mt)
#pragma unroll
                for (int nt = 0; nt < 4; ++nt)
                    *(f32x4*)(HU + (size_t)item * 4096 + (size_t)((mt * 4 + nt) * 64 + lane) * 4) = Up[mt][nt];
            float sm = 0.f;
#pragma unroll
            for (int w2 = 0; w2 < 8; ++w2) sm += DALL[w2 * 64 + lane];
            HA[(size_t)item * 64 + lane] = __expf(sm);
        }
    }
}

__device__ __forceinline__ float gelu_tanh(float y) { const float z = 0.7978845608028654f * (y + 0.044715f * y * y * y); return y * sigmf(2.f * z); }
template <bool OUT> __device__ __forceinline__ void s5_item(const PA& a, LAS unsigned char* lds, int layer, int item, int wave, int lane) {
    const int b = item >> 10, g = (item >> 6) & 15, c = item & 63, lg = layer * 16 + g;
    const bf16* PROJ = (const bf16*)(a.ws + WS_PROJ);
    const float* sa = (const float*)(a.ws + WS_S5A) + (size_t)lg * 256;
    float* XL = (float*)(a.ws + WS_XLOC) + (size_t)((b * 16 + g) * 64) * 128;
    const float ar = sa[lane], ai = sa[64 + lane];
    float xr = 0.f, xi = 0.f;
    if (OUT) { xr = XL[c * 128 + lane]; xi = XL[c * 128 + 64 + lane]; }
    const int l15 = lane & 15, quad = lane >> 4;
    const bf16x8 zero8 = {0, 0, 0, 0, 0, 0, 0, 0};
    bf16x8 bfr[8];
#pragma unroll
    for (int nt = 0; nt < 8; ++nt) bfr[nt] = (quad < 2) ? *(const bf16x8*)((const bf16*)(a.ws + WS_S5B) + (size_t)lg * 2048 + (nt * 16 + l15) * 16 + quad * 8) : zero8;
    bf16x8 cfr[4];
    if (OUT) {
#pragma unroll
        for (int ks = 0; ks < 4; ++ks) cfr[ks] = *(const bf16x8*)((const bf16*)(a.ws + WS_S5C) + (size_t)lg * 2048 + l15 * 128 + ks * 32 + quad * 8);
    }
    const float dsk = a.in[13][layer * 256 + g * 16 + l15];
    LAS float* BU = (LAS float*)(lds + wave * 12800);
    LAS bf16* X = (LAS bf16*)(lds + wave * 12800 + 8448);
    const size_t rowb = (size_t)b * T + (size_t)c * 128;
    bf16x8 afr_n = (quad < 2) ? *(const bf16x8*)(PROJ + (rowb + l15) * DIN + 1024 + g * 16 + quad * 8) : zero8;
    bf16 ue_n[4] = {0, 0, 0, 0}, se_n[4] = {0, 0, 0, 0};
    if (OUT) {
#pragma unroll
        for (int j = 0; j < 4; ++j) { ue_n[j] = PROJ[(rowb + quad * 4 + j) * DIN + 1024 + g * 16 + l15]; se_n[j] = PROJ[(rowb + quad * 4 + j) * DIN + 1280 + g * 16 + l15]; }
    }
    f32x4 accn[8];
#pragma unroll
    for (int nt = 0; nt < 8; ++nt) accn[nt] = __builtin_amdgcn_mfma_f32_16x16x32_bf16(afr_n, bfr[nt], (f32x4){0.f, 0.f, 0.f, 0.f}, 0, 0, 0);
#pragma unroll
    for (int nt = 0; nt < 8; ++nt)
#pragma unroll
        for (int j = 0; j < 4; ++j) BU[(quad * 4 + j) * 132 + nt * 16 + l15] = accn[nt][j];
    afr_n = (quad < 2) ? *(const bf16x8*)(PROJ + (rowb + 16 + l15) * DIN + 1024 + g * 16 + quad * 8) : zero8;
    for (int blk = 0; blk < 8; ++blk) {
        const size_t row0 = rowb + blk * 16;
        bf16 ue[4], se[4];
#pragma unroll
        for (int j = 0; j < 4; ++j) { ue[j] = ue_n[j]; se[j] = se_n[j]; }
        if (blk + 1 < 8) {
#pragma unroll
            for (int nt = 0; nt < 8; ++nt) accn[nt] = __builtin_amdgcn_mfma_f32_16x16x32_bf16(afr_n, bfr[nt], (f32x4){0.f, 0.f, 0.f, 0.f}, 0, 0, 0);
            if (blk + 2 < 8) afr_n = (quad < 2) ? *(const bf16x8*)(PROJ + (row0 + 32 + l15) * DIN + 1024 + g * 16 + quad * 8) : zero8;
            if (OUT) {
#pragma unroll
                for (int j = 0; j < 4; ++j) { ue_n[j] = PROJ[(row0 + 16 + quad * 4 + j) * DIN + 1024 + g * 16 + l15]; se_n[j] = PROJ[(row0 + 16 + quad * 4 + j) * DIN + 1280 + g * 16 + l15]; }
            }
        }
#pragma unroll
        for (int t = 0; t < 16; ++t) {
            const float br = BU[t * 132 + lane], bi = BU[t * 132 + 64 + lane];
            const float nr = ar * xr - ai * xi + br, ni = ar * xi + ai * xr + bi; xr = nr; xi = ni;
            if (OUT) { X[t * 136 + lane] = (bf16)f2bf(xr); X[t * 136 + 64 + lane] = (bf16)f2bf(xi); }
        }
        if (blk + 1 < 8) {
#pragma unroll
            for (int nt = 0; nt < 8; ++nt)
#pragma unroll
                for (int j = 0; j < 4; ++j) BU[(quad * 4 + j) * 132 + nt * 16 + l15] = accn[nt][j];
        }
        if (OUT) {
            f32x4 acc = {0.f, 0.f, 0.f, 0.f};
#pragma unroll
            for (int ks = 0; ks < 4; ++ks) { const bf16x8 xa = *(const LAS bf16x8*)(X + l15 * 136 + ks * 32 + quad * 8); acc = __builtin_amdgcn_mfma_f32_16x16x32_bf16(xa, cfr[ks], acc, 0, 0, 0); }
#pragma unroll
            for (int j = 0; j < 4; ++j) { const size_t row = row0 + quad * 4 + j;
                const float u = bf1(ue[j]);
                const float yg = gelu_tanh(acc[j] + dsk * u);
                ((bf16*)(a.ws + WS_YG))[row * 256 + g * 16 + l15] = (bf16)f2bf(yg);
                ((bf16*)(a.ws + WS_YGS))[row * 256 + g * 16 + l15] = (bf16)f2bf(yg * siluf(bf1(se[j]))); }
        }
    }
    LDS_WAIT();
    if (!OUT) { XL[c * 128 + lane] = xr; XL[c * 128 + 64 + lane] = xi; }
}


__device__ __forceinline__ void hgrn_scan(const PA& a, int task, int lane) {
    float* HU = (float*)(a.ws + WS_HU); const float* HA = (const float*)(a.ws + WS_HA);
    const int bh = task >> 6, r = task & 63, dk = 16 * (r >> 4) + 4 * (r & 3) + (lane & 3);
    float* up = HU + (size_t)(bh * 64) * 4096 + (size_t)r * 64 + lane; const float* ap = HA + (size_t)(bh * 64) * 64 + dk;
    float S = 0.f;
#pragma unroll 1
    for (int c0 = 0; c0 < 64; c0 += 32) {
        float u[32], av[32];
#pragma unroll
        for (int i = 0; i < 32; ++i) { u[i] = up[(size_t)(c0 + i) * 4096]; av[i] = ap[(size_t)(c0 + i) * 64]; }
#pragma unroll
        for (int i = 0; i < 32; ++i) { __hip_atomic_store(up + (size_t)(c0 + i) * 4096, S, __ATOMIC_RELAXED, __HIP_MEMORY_SCOPE_AGENT); S = av[i] * S + u[i]; }
    }
}
__device__ __forceinline__ void s5_scan(const PA& a, int layer, int task, int lane) {
    const int g = task & 15;
    const float* sa = (const float*)(a.ws + WS_S5A) + (size_t)(layer * 16 + g) * 256;
    float* XL = (float*)(a.ws + WS_XLOC) + (size_t)(task * 64) * 128;
    const float Lr = sa[128 + lane], Li = sa[192 + lane];
    float xr = 0.f, xi = 0.f;
#pragma unroll 1
    for (int c0 = 0; c0 < 64; c0 += 32) {
        float lr[32], li[32];
#pragma unroll
        for (int i = 0; i < 32; ++i) { lr[i] = XL[(c0 + i) * 128 + lane]; li[i] = XL[(c0 + i) * 128 + 64 + lane]; }
#pragma unroll
        for (int i = 0; i < 32; ++i) { __hip_atomic_store(XL + (c0 + i) * 128 + lane, xr, __ATOMIC_RELAXED, __HIP_MEMORY_SCOPE_AGENT); __hip_atomic_store(XL + (c0 + i) * 128 + 64 + lane, xi, __ATOMIC_RELAXED, __HIP_MEMORY_SCOPE_AGENT);
            const float nr = Lr * xr - Li * xi + lr[i], ni = Lr * xi + Li * xr + li[i]; xr = nr; xi = ni; }
    }
}
template <int NR> __device__ __forceinline__ void combine_rows(const PA& a, int layer, float lam, float post, size_t row0, size_t rstride, int lane) {
    const bf16* O = (const bf16*)(a.ws + WS_O); const bf16* PROJ = (const bf16*)(a.ws + WS_PROJ);
    const int h = lane >> 4, e0 = (lane & 15) * 8, j = e0 >> 6, d = e0 & 63;
    v4u o0[NR], o1[NR], gv[NR];
#pragma unroll
    for (int r = 0; r < NR; ++r) { const size_t row = row0 + r * rstride;
        o0[r] = *(const v4u*)(O + row * 1024 + (h * 4 + j) * 64 + d); o1[r] = *(const v4u*)(O + row * 1024 + (h * 4 + 2 + j) * 64 + d); gv[r] = *(const v4u*)(PROJ + row * DIN + 3072 + h * 128 + e0); }
    const f32x4 sw0 = *(const f32x4*)(a.in[20] + layer * 128 + e0), sw1 = *(const f32x4*)(a.in[20] + layer * 128 + e0 + 4);
    const float sw[8] = {sw0[0], sw0[1], sw0[2], sw0[3], sw1[0], sw1[1], sw1[2], sw1[3]};
#pragma unroll
    for (int r = 0; r < NR; ++r) { const size_t row = row0 + r * rstride;
        const unsigned a0[4] = {o0[r].x, o0[r].y, o0[r].z, o0[r].w}, a1[4] = {o1[r].x, o1[r].y, o1[r].z, o1[r].w}, ga[4] = {gv[r].x, gv[r].y, gv[r].z, gv[r].w};
        float v[8]; float ss = 0.f;
#pragma unroll
        for (int q = 0; q < 8; ++q) { const float x0 = (q & 1) ? bfhi(a0[q >> 1]) : bflo(a0[q >> 1]), x1 = (q & 1) ? bfhi(a1[q >> 1]) : bflo(a1[q >> 1]); v[q] = x0 - lam * x1; ss += v[q] * v[q]; }
        ss += __shfl_xor(ss, 1); ss += __shfl_xor(ss, 2); ss += __shfl_xor(ss, 4); ss += __shfl_xor(ss, 8);
        const float rs = post * __builtin_amdgcn_rsqf(ss * (1.f / 128.f) + EPS);
        float o[8];
#pragma unroll
        for (int q = 0; q < 8; ++q) { const float gq = (q & 1) ? bfhi(ga[q >> 1]) : bflo(ga[q >> 1]); o[q] = v[q] * rs * sw[q] * siluf(gq); }
        *(v4u*)((bf16*)(a.ws + WS_MIX) + row * 1024 + 512 + h * 128 + e0) = (v4u){pk2(o[0], o[1]), pk2(o[2], o[3]), pk2(o[4], o[5]), pk2(o[6], o[7])};
    }
}

__global__ void __launch_bounds__(NWAVES * 64, 2) hymba_fwd(Args args) {
    extern __shared__ __attribute__((aligned(16))) unsigned char lds_raw[];
    LAS unsigned char* lds = (LAS unsigned char*)lds_raw;
    cg::grid_group grid = cg::this_grid();
    int tid = threadIdx.x, lane = tid & 63, wave = __builtin_amdgcn_readfirstlane(tid >> 6);
#define RELAUNDER() do { int t_ = threadIdx.x; asm volatile("" : "+v"(t_)); tid = t_; lane = tid & 63; wave = __builtin_amdgcn_readfirstlane(tid >> 6); } while (0)
    const int G = gridDim.x, bx = blockIdx.x, vcu = (G % 8 == 0) ? (bx % 8) * (G / 8) + bx / 8 : bx;
    unsigned char* ws = args.ws;
    const int lo = args.ph_lo, hi = args.ph_hi;
    volatile LAS unsigned* MISC = (volatile LAS unsigned*)(lds + LDS_BYTES - 256);
    if (tid < 32) MISC[tid] = 0u;
    __syncthreads();
    unsigned* barw = (unsigned*)(ws + WS_CTL);
    XcdBarrier bar; bar.bar = barw; bar.x = 0; bar.st = MISC + 8;
    int ph = 0;
#ifndef MK_DIS
#define MK_DIS 0
#endif
#define EN(bit) (!((MK_DIS >> (bit)) & 1))
#ifndef MK_REP
#define MK_REP 0
#endif
#define REPS(bit) for (int rep_ = 0; rep_ < 1 + ((MK_REP >> (bit)) & 1); ++rep_)
#define IN(k) (lo <= (k) && (k) < hi)
#define SEAM() do { if (IN(ph) && IN(ph + 1)) { xcd_barrier(bar); if ((MK_REP >> 10) & 1) xcd_barrier(bar); } ++ph; RELAUNDER(); } while (0)
    bf16* PROJ = (bf16*)(ws + WS_PROJ); bf16* XN = (bf16*)(ws + WS_XN); bf16* MIX = (bf16*)(ws + WS_MIX);
    const int NGW = G * NWAVES;
#define gw (vcu * NWAVES + wave)

    const float** tabw = (const float**)(ws + WS_TAB);
    bar = xcd_barrier_post(barw, MISC + 8);
    if (IN(ph) && EN(0)) { if (bx == 0) {
            if (tid == 0) {
#pragma unroll
                for (int i = 0; i < 22; ++i) tabw[i] = args.in[i]; } }
        REPS(0) { __syncthreads(); prologue(args, lds, vcu, G, wave, lane); } }
    const PA pa{(const float* const*)tabw, args.out, ws};
    if (lo < 0) grid.sync();
    SEAM();
    for (int layer = 0; layer < DEPTH; ++layer) {
        if (IN(ph) && EN(1)) REPS(1) {
            pg8::Gemm g{(const bf16*)(ws + WS_HRES), (const bf16*)(ws + WS_WIN) + (size_t)layer * DIN * D, M, DIN, D}; pg8::StaticOrder S; S.init(M, DIN, G, bx);
            pg8::EpiInProj E{PROJ, (const float*)(ws + WS_ROPE), attn_body::C2, layer == 0 ? (const float*)(ws + WS_ROWSS0) : (const float*)(ws + WS_ROWSS), (unsigned*)(ws + WS_SUCNT) + layer * 64};
            pg8::gemm_phase<pg8::EpiInProj, pg8::StaticOrder, PG8_ALIGN, PG8_SP2>(lds, g, S, E);
            if (G == 256 && bx >= 128) {
                __syncthreads();
                if (wave == 0) { unsigned* sucnt = (unsigned*)(ws + WS_SUCNT) + layer * 64; unsigned spins = 0;
                    while ((unsigned)__builtin_amdgcn_readfirstlane(__hip_atomic_load(sucnt, __ATOMIC_RELAXED, __HIP_MEMORY_SCOPE_AGENT)) < 512u) { __builtin_amdgcn_s_sleep(4); if (++spins > (1u << 22)) break; }
                    __builtin_amdgcn_fence(__ATOMIC_ACQUIRE, "agent"); asm volatile("s_waitcnt vmcnt(0)" ::: "memory"); }
                __syncthreads();
                RELAUNDER();
                for (int it = (bx - 128) * NWAVES + wave; it < 2048; it += 128 * NWAVES) s5_item<false>(pa, lds, layer, it, wave, lane);
            }
        }
        SEAM();
        if (IN(ph)) {
            if (EN(2) && G != 256) REPS(2) for (int it = gw; it < 2048; it += NGW) s5_item<false>(pa, lds, layer, it, wave, lane);
            RELAUNDER();
            if (EN(3)) REPS(3) for (int v = vcu; v < 256; v += G) hgrn_pair<false>(pa, lds, layer, v >> 5, v & 31, wave, lane);
            xcd_barrier(bar);
            unsigned* scnt = (unsigned*)(ws + WS_SCNT) + layer * 64;
            { unsigned ndone = 0;
              if (wave < 2) { for (int t2 = wave * G + vcu; t2 < 512; t2 += 2 * G) { hgrn_scan(pa, t2, lane); ++ndone; } }
              else if (wave == 2) { for (int t2 = vcu; t2 < 32; t2 += G) { s5_scan(pa, layer, t2, lane); ++ndone; } }
              if (ndone) { asm volatile("s_waitcnt vmcnt(0)" ::: "memory"); if (lane == 0) (void)__hip_atomic_fetch_add(scnt, ndone, __ATOMIC_RELAXED, __HIP_MEMORY_SCOPE_AGENT); } }
            __syncthreads();
            const attn_body::AttnTensors AT{(const attn_body::bf16*)PROJ, (const attn_body::bf16*)PROJ, (const attn_body::bf16*)PROJ, (attn_body::bf16*)(ws + WS_O)};
            if (EN(4)) REPS(4) for (int v = vcu; v < 256; v += G) { const attn_body::StaticOrder S(v); attn_body::attn_phase<attn_body::StaticOrder>((char*)lds_raw, AT, S); }
        }
        ++ph; RELAUNDER();
        if (IN(ph)) {
            __syncthreads();
            if (wave == 0) { unsigned* scnt = (unsigned*)(ws + WS_SCNT) + layer * 64; unsigned spins = 0;
                while ((unsigned)__builtin_amdgcn_readfirstlane(__hip_atomic_load(scnt, __ATOMIC_RELAXED, __HIP_MEMORY_SCOPE_AGENT)) < 544u) { __builtin_amdgcn_s_sleep(4); if (++spins > (1u << 22)) break; }
                __builtin_amdgcn_fence(__ATOMIC_ACQUIRE, "agent"); asm volatile("s_waitcnt vmcnt(0)" ::: "memory"); }
            __syncthreads();
            if (EN(5)) REPS(5) for (int it = gw; it < 2048; it += NGW) s5_item<true>(pa, lds, layer, it, wave, lane);
            RELAUNDER();
            if (EN(6)) REPS(6) for (int v = vcu; v < 256; v += G) { const int bh = v >> 5, s = v & 31; const HRaw r1 = hgrn_load<true>(pa, bh, s, wave, lane), r2 = hgrn_load<true>(pa, bh, 63 - s, wave, lane); hgrn_item2<true>(pa, lds, layer, bh, s, wave, lane, r1); hgrn_item2<true>(pa, lds, layer, bh, 63 - s, wave, lane, r2); }
        }
        SEAM();
        const int cb0 = (G > 64) ? 64 : 0;
        if (IN(ph) && bx >= cb0) {
            const float l1 = wave_sum(pa.in[16][layer * 64 + lane] * pa.in[17][layer * 64 + lane]), l2 = wave_sum(pa.in[18][layer * 64 + lane] * pa.in[19][layer * 64 + lane]);
            const float linit = (layer == 0) ? 0.2f : 0.35550906759096934f;
            const float lam = __expf(l1) - __expf(l2) + linit;
            if (EN(7)) REPS(7) { const int nw_ = (G - cb0) * NWAVES; int m = (bx - cb0) * NWAVES + wave;
                for (; m + 3 * nw_ < M; m += 4 * nw_) combine_rows<4>(pa, layer, lam, 1.f - linit, (size_t)m, (size_t)nw_, lane);
                for (; m < M; m += nw_) combine_rows<1>(pa, layer, lam, 1.f - linit, (size_t)m, 0, lane); }
        }
        if (IN(ph) && EN(8) && (bx < 64 || G <= 64)) REPS(8) {
            __syncthreads();
            int kglu = 256; asm volatile("" : "+s"(kglu));
            pg8::Gemm g{(const bf16*)(ws + WS_YG), (const bf16*)(ws + WS_GLU) + (size_t)layer * 65536, M, 256, kglu}; pg8::StaticOrder S; S.init(M, 256, G, bx);
            pg8::EpiGlu E{(const bf16*)(ws + WS_YGS), pa.in[15] + layer * 256, MIX};
            pg8::gemm_phase<pg8::EpiGlu, pg8::StaticOrder, PG8_ALIGN, PG8_SP2>(lds, g, S, E);
        }
        SEAM();
        if (IN(ph) && EN(9)) for (int rep_ = 0; rep_ < 1 + (((MK_REP >> 9) & 1) && layer == 0); ++rep_) {
            pg8::Gemm g{MIX, (const bf16*)(ws + WS_WOUT) + (size_t)layer * D * D, M, D, D}; pg8::StaticOrder S; S.init(M, D, G, bx);
            if (layer + 1 < DEPTH) { pg8::EpiRes<true> E{nullptr, nullptr, (float*)(ws + WS_ROWSS), (const bf16*)(ws + WS_HRES), (bf16*)(ws + WS_HRES)};
                pg8::gemm_phase<pg8::EpiRes<true>, pg8::StaticOrder, PG8_ALIGN, PG8_SP2>(lds, g, S, E); }
            else if (G == 256) { pg8::EpiResFinal E{(const bf16*)(ws + WS_HRES), pa.out, (float*)(ws + WS_ROWSS2), (unsigned*)(ws + WS_PCNT), pa.in[21]};
                pg8::gemm_phase<pg8::EpiResFinal, pg8::StaticOrder, false, PG8_SP2>(lds, g, S, E); }
            else { pg8::EpiRes<false> E{nullptr, pa.out, nullptr, (const bf16*)(ws + WS_HRES), nullptr};
                pg8::gemm_phase<pg8::EpiRes<false>, pg8::StaticOrder, PG8_ALIGN, PG8_SP2>(lds, g, S, E); }
        }
        if (layer + 1 < DEPTH) { SEAM(); continue; }
        if (G == 256) break;
        SEAM();
        if (IN(ph)) {
            for (int m = gw; m < M; m += NGW) rms_row<true>(pa.out + (size_t)m * D, pa.in[21], nullptr, pa.out + (size_t)m * D, lane);
        }
    }
#undef IN
#undef SEAM
}
constexpr int N_PHASES = 1 + DEPTH * 5 + 1;

#ifndef MK_SPLIT
#define MK_SPLIT 0
#endif
extern "C" void kernel_launch(void* const* d_in, const int* in_sizes, int n_in, void* d_out, int out_size, void* d_ws, size_t ws_size, hipStream_t stream) {
    static int grid = 0;
    if (grid == 0) {
        if (n_in != 22 || in_sizes[0] != M * D || out_size != M * D || ws_size < WS_END) { fprintf(stderr, "kernel_launch: unexpected shapes (n_in %d, in0 %d, out %d, ws %zu)\n", n_in, n_in > 0 ? in_sizes[0] : -1, out_size, ws_size); grid = -1; return; }
        int dev = 0, cus = 0, per_cu = 0;
        hipGetDevice(&dev); hipDeviceGetAttribute(&cus, hipDeviceAttributeMultiprocessorCount, dev);
        hipFuncSetAttribute((const void*)hymba_fwd, hipFuncAttributeMaxDynamicSharedMemorySize, LDS_BYTES);
        hipOccupancyMaxActiveBlocksPerMultiprocessor(&per_cu, (const void*)hymba_fwd, NWAVES * 64, LDS_BYTES);
        (void)hipGetLastError();
        if (per_cu < 1) per_cu = 1;
        grid = cus * per_cu; if (grid > 256) grid = 256;
        fprintf(stderr, "kernel_launch: cus %d per_cu %d grid %d\n", cus, per_cu, grid);
    }
    if (grid < 0) return;
    Args a{};
    for (int i = 0; i < 22; ++i) a.in[i] = (const float*)d_in[i];
    a.out = (float*)d_out; a.ws = (unsigned char*)d_ws;
#if MK_SPLIT
    for (int p = 0; p < N_PHASES; ++p) { a.ph_lo = p; a.ph_hi = p + 1; hipLaunchKernelGGL(hymba_fwd, dim3(grid), dim3(NWAVES * 64), LDS_BYTES, stream, a); }
#else
    a.ph_lo = 0; a.ph_hi = N_PHASES;
    (void)hipMemsetAsync((char*)d_ws + WS_CTL, 0, 16384, stream);
    void* kargs[] = {&a};
    hipError_t e = hipLaunchCooperativeKernel((const void*)hymba_fwd, dim3(grid), dim3(NWAVES * 64), kargs, LDS_BYTES, stream);
    if (e != hipSuccess) fprintf(stderr, "cooperative launch failed: %s (grid %d)\n", hipGetErrorString(e), grid);
#endif
}
```

```cpp
#include <hip/hip_runtime.h>
#include <hip/hip_cooperative_groups.h>
#include <cstdio>
#include <cstdint>
namespace pg8 {
#define PG8_LAS __attribute__((address_space(3)))
typedef unsigned short bf16_t;
typedef short bf16x8 __attribute__((ext_vector_type(8)));
typedef float f32x4 __attribute__((ext_vector_type(4)));
typedef unsigned u32x4 __attribute__((ext_vector_type(4)));
constexpr int BM = 256, BK = 64, HALF = 128, HTB = HALF * BK * 2  , STAGE_BYTES = 8 * HTB, NXCD = 8, WGM = 8;

__host__ __device__ __forceinline__ int lds_byte(int r, int c) { const int st = (r >> 4) * 2 + (c >> 5), rr = r & 15, cc = c & 31, ob = rr * 64 + cc * 2; return st * 1024 + (ob ^ (((ob >> 9) & 1) << 5)); }
__host__ __device__ __forceinline__ void stage_rc(int b, int& R, int& C) { const int st = b / 1024, sb = b % 1024, swz = sb ^ (((sb >> 9) & 1) << 5); R = (st >> 1) * 16 + swz / 64; C = (st & 1) * 32 + (swz % 64) / 2; }
__host__ __device__ __forceinline__ int perm32(int rho) { const int n = rho >> 4, i = rho & 15; return 8 * (i >> 2) + 4 * n + (i & 3); }

struct Unit { int pm, pn; };
struct Gemm { const bf16_t* A; const bf16_t* Bt; int M, N, K; };

struct StaticOrder {
    int nM, nN, nwg, G, c;
    __host__ __device__ void init(int M, int N, int G_, int c_) { nM = M / BM; nN = N / BM; nwg = nM * nN; G = G_; c = c_; }
    __host__ __device__ bool next(int i, Unit& u) const {
        const long L = (long)i * G + c; if (L >= nwg) return false;
        int wgid = (int)L; { const int q = nwg / NXCD, r = nwg % NXCD, xcd = wgid % NXCD, off = wgid / NXCD; wgid = (xcd < r ? xcd * (q + 1) : r * (q + 1) + (xcd - r) * q) + off; }
        const int nig = WGM * nN, gid = wgid / nig, fm = gid * WGM, gsz = (nM - fm) < WGM ? (nM - fm) : WGM;
        u.pm = fm + ((wgid % nig) % gsz); u.pn = (wgid % nig) / gsz; return true;
    }
    __device__ __forceinline__ void a_ready(const Unit&) const {}
    __device__ __forceinline__ void done(const Unit&) const {}
};

__device__ __forceinline__ unsigned cvt_pk_bf16(float lo, float hi) { unsigned r; asm volatile("v_cvt_pk_bf16_f32 %0, %1, %2" : "=v"(r) : "v"(lo), "v"(hi)); return r; }
typedef float f32x2 __attribute__((ext_vector_type(2)));
__device__ __forceinline__ f32x2 gelu_pk(f32x2 v) {
    const f32x2 av = __builtin_elementwise_abs(v), d = av * 0.2316418882f + 1.0f;
    f32x2 t; t.x = __builtin_amdgcn_rcpf(d.x); t.y = __builtin_amdgcn_rcpf(d.y);
    f32x2 q = t * 0.5307027145f + (-0.7265760135f); q = q * t + 0.7107068705f; q = q * t + (-0.142248368f); q = q * t + 0.127414796f; q = q * t;
    const f32x2 s = (v * v) * (-0.72134752044f);
    f32x2 e; e.x = __builtin_amdgcn_exp2f(s.x); e.y = __builtin_amdgcn_exp2f(s.y);
    const f32x2 m = v * (q * e), r = v - m;
    f32x2 o; o.x = v.x < 0.f ? m.x : r.x; o.y = v.y < 0.f ? m.y : r.y; return o;
}

template <int ACT  > struct EpiBf16 {
    static constexpr bool PERM = true, AFTER_DRAIN = false; static_assert(ACT == 0 || ACT == 1, "EpiBf16: ACT is 0 (none) or 1 (gelu_pk)");
    bf16_t* O; int ldc; const float* bias; int split_cols; size_t split_stride; float scale0;
    __device__ __forceinline__ void operator()(const f32x4 (&acc)[2][2][4][2], const Unit& u, int wr, int wc, int fr, int fq) const {
        const int row0 = u.pm * BM + wr * 64 + fr; int colt = u.pn * BM; bf16_t* base = O;
        float sc = 1.f; if (split_cols) { const int t = colt / split_cols; base += (size_t)t * split_stride; colt -= t * split_cols; if (t == 0) sc = scale0; }
        const int col0 = colt + wc * 32 + 8 * fq, bcol0 = u.pn * BM + wc * 32 + 8 * fq;
        f32x4 bv[2][2];
#pragma unroll
        for (int bj = 0; bj < 2; ++bj)
#pragma unroll
            for (int n = 0; n < 2; ++n) bv[bj][n] = bias ? *(const f32x4*)(bias + bcol0 + bj * HALF + 4 * n) : (f32x4){0.f, 0.f, 0.f, 0.f};
#pragma unroll
        for (int ai = 0; ai < 2; ++ai)
#pragma unroll
            for (int m = 0; m < 4; ++m) { bf16_t* rowp = base + (size_t)(row0 + ai * HALF + m * 16) * ldc + col0;
#pragma unroll
                for (int bj = 0; bj < 2; ++bj) { f32x4 v0 = acc[ai][bj][m][0] + bv[bj][0], v1 = acc[ai][bj][m][1] + bv[bj][1];
                    if (ACT == 1) { f32x2 a = gelu_pk((f32x2){v0[0], v0[1]}), b = gelu_pk((f32x2){v0[2], v0[3]}), c = gelu_pk((f32x2){v1[0], v1[1]}), d = gelu_pk((f32x2){v1[2], v1[3]});
                        v0 = (f32x4){a.x, a.y, b.x, b.y}; v1 = (f32x4){c.x, c.y, d.x, d.y}; }
                    v0 = v0 * sc; v1 = v1 * sc; u32x4 w; w.x = cvt_pk_bf16(v0[0], v0[1]); w.y = cvt_pk_bf16(v0[2], v0[3]); w.z = cvt_pk_bf16(v1[0], v1[1]); w.w = cvt_pk_bf16(v1[2], v1[3]);
                    *(u32x4*)(rowp + bj * HALF) = w; } }
    }
};
__device__ __forceinline__ float bf2f(unsigned short h) { return __uint_as_float(((unsigned)h) << 16); }
#define WT_RSRC(base, bytes) __builtin_amdgcn_make_buffer_rsrc((void*)(base), 0, (int)(bytes), 0x00020000)
#define WT_ST16(rsrc, byteoff, v) __builtin_amdgcn_raw_buffer_store_b128((v), (rsrc), (unsigned)(byteoff), 0, 16)
__device__ __forceinline__ float sigm(float v) { return __builtin_amdgcn_rcpf(1.0f + __builtin_amdgcn_exp2f(-1.4426950408889634f * v)); }
struct EpiInProj {
    static constexpr bool PERM = true, AFTER_DRAIN = false;
    bf16_t* O; const float* rope; float qscale; const float* rowss; unsigned* sucnt;
    __device__ __forceinline__ void operator()(const f32x4 (&acc)[2][2][4][2], const Unit& u, int wr, int wc, int fr, int fq) const {
        const int row0 = u.pm * BM + wr * 64 + fr, col0 = u.pn * BM + wc * 32 + 8 * fq;
        const bool ropewave = (u.pn >= 6 && u.pn < 10) && ((wc & 1) == 0);
        const float sc = (u.pn == 6 || u.pn == 7) ? qscale : 1.f;
        const float sgn = (fq == 0) ? -1.f : 1.f;
        const bool pub = (u.pn == 4);
        const __amdgpu_buffer_rsrc_t orsrc = WT_RSRC(O, 16384u * 3584u * 2u);
        float rsv[2][4];
#pragma unroll
        for (int ai = 0; ai < 2; ++ai)
#pragma unroll
            for (int m = 0; m < 4; ++m) rsv[ai][m] = rowss ? rowss[row0 + ai * HALF + m * 16] : 0.f;
#pragma unroll
        for (int ai = 0; ai < 2; ++ai)
#pragma unroll
            for (int m = 0; m < 4; ++m) {
                const int row = row0 + ai * HALF + m * 16;
                bf16_t* rowp = O + (size_t)row * 3584 + col0;
                const float scr = rowss ? sc * __builtin_amdgcn_rsqf(rsv[ai][m] * (1.0f / 1024.0f) + 1e-6f) : sc;
                f32x4 cs[4];
                if (ropewave) { const float* rp = rope + (size_t)(row & 8191) * 16;
#pragma unroll
                    for (int k = 0; k < 4; ++k) cs[k] = *(const f32x4*)(rp + 4 * k); }
#pragma unroll
                for (int bj = 0; bj < 2; ++bj) {
                    f32x4 v0 = acc[ai][bj][m][0], v1 = acc[ai][bj][m][1];
                    if (ropewave) {
                        float v[8] = {v0[0], v0[1], v0[2], v0[3], v1[0], v1[1], v1[2], v1[3]};
#pragma unroll
                        for (int j = 0; j < 8; ++j) {
                            const float p = __shfl_xor(v[j], 16);
                            const float c = cs[j >> 1][(j & 1) * 2], s = cs[j >> 1][(j & 1) * 2 + 1];
                            const float nv = v[j] * c + sgn * p * s;
                            v[j] = (fq < 2) ? nv : v[j];
                        }
                        v0 = (f32x4){v[0], v[1], v[2], v[3]}; v1 = (f32x4){v[4], v[5], v[6], v[7]};
                    }
                    v0 = v0 * scr; v1 = v1 * scr;
                    u32x4 w; w.x = cvt_pk_bf16(v0[0], v0[1]); w.y = cvt_pk_bf16(v0[2], v0[3]); w.z = cvt_pk_bf16(v1[0], v1[1]); w.w = cvt_pk_bf16(v1[2], v1[3]);
                    if (pub) WT_ST16(orsrc, ((size_t)row * 3584 + col0 + bj * HALF) * 2, w); else *(u32x4*)(rowp + bj * HALF) = w;
                }
                asm volatile("" ::: "memory");
            }
        if (pub) { asm volatile("s_waitcnt vmcnt(0)" ::: "memory"); if (fr == 0 && fq == 0) (void)__hip_atomic_fetch_add(sucnt, 1u, __ATOMIC_RELAXED, __HIP_MEMORY_SCOPE_AGENT); }
    }
};
template <bool NEXT> struct EpiRes {
    static constexpr bool PERM = false, AFTER_DRAIN = false;
    const float* base; float* out; float* rowss; const bf16_t* baseh; bf16_t* XN;
    __device__ __forceinline__ void operator()(const f32x4 (&acc)[2][2][4][2], const Unit& u, int wr, int wc, int fr, int fq) const {
        typedef unsigned u32x2 __attribute__((ext_vector_type(2)));
        const int col0 = u.pn * BM + wc * 32 + 4 * fq;
#pragma unroll
        for (int ai = 0; ai < 2; ++ai)
#pragma unroll
            for (int m = 0; m < 4; ++m) {
                const int row = u.pm * BM + ai * HALF + wr * 64 + m * 16 + fr;
                const size_t off = (size_t)row * 1024 + col0;
                float ss = 0.f;
#pragma unroll
                for (int bj = 0; bj < 2; ++bj)
#pragma unroll
                    for (int n = 0; n < 2; ++n) {
                        f32x4 bs;
                        { const u32x2 hb = *(const u32x2*)(baseh + off + bj * HALF + n * 16); bs = (f32x4){__uint_as_float(hb.x << 16), __uint_as_float(hb.x & 0xffff0000u), __uint_as_float(hb.y << 16), __uint_as_float(hb.y & 0xffff0000u)}; }
                        const f32x4 o = bs + acc[ai][bj][m][n];
                        if (NEXT) { ss += (o[0] * o[0] + o[1] * o[1]) + (o[2] * o[2] + o[3] * o[3]);
                            u32x2 w; w.x = cvt_pk_bf16(o[0], o[1]); w.y = cvt_pk_bf16(o[2], o[3]); *(u32x2*)(XN + off + bj * HALF + n * 16) = w; }
                        else *(f32x4*)(out + off + bj * HALF + n * 16) = o;
                    }
                if (NEXT) { ss += __shfl_xor(ss, 16); ss += __shfl_xor(ss, 32); if (fq == 0) atomicAdd(rowss + row, ss); }
                if (m & 1) asm volatile("" ::: "memory");
            }
    }
};
struct EpiResFinal {
    static constexpr bool PERM = false, AFTER_DRAIN = true;
    const bf16_t* baseh; float* out; float* rowss2; unsigned* cnt; const float* fw;
    __device__ __forceinline__ void operator()(const f32x4 (&)[2][2][4][2], const Unit&, int, int, int, int) const {}
    __device__ __forceinline__ void fused(f32x4 (&acc)[2][2][4][2], const Unit& u, int wr, int wc, int fr, int fq, PG8_LAS unsigned char*, int wid, int lane) const {
        typedef unsigned u32x2 __attribute__((ext_vector_type(2)));
        const int col0 = u.pn * BM + wc * 32 + 4 * fq;
#pragma unroll
        for (int ai = 0; ai < 2; ++ai)
#pragma unroll
            for (int m = 0; m < 4; ++m) {
                const int row = u.pm * BM + ai * HALF + wr * 64 + m * 16 + fr;
                const size_t off = (size_t)row * 1024 + col0;
                float ss = 0.f;
#pragma unroll
                for (int bj = 0; bj < 2; ++bj)
#pragma unroll
                    for (int n = 0; n < 2; ++n) { const u32x2 hb = *(const u32x2*)(baseh + off + bj * HALF + n * 16);
                        const f32x4 o = (f32x4){__uint_as_float(hb.x << 16), __uint_as_float(hb.x & 0xffff0000u), __uint_as_float(hb.y << 16), __uint_as_float(hb.y & 0xffff0000u)} + acc[ai][bj][m][n]; acc[ai][bj][m][n] = o;
                        ss += (o[0] * o[0] + o[1] * o[1]) + (o[2] * o[2] + o[3] * o[3]); }
                ss += __shfl_xor(ss, 16); ss += __shfl_xor(ss, 32);
                if (fq == 0) (void)__hip_atomic_fetch_add(rowss2 + row, ss, __ATOMIC_RELAXED, __HIP_MEMORY_SCOPE_AGENT);
                if (m & 1) asm volatile("" ::: "memory");
            }
        asm volatile("s_waitcnt vmcnt(0)" ::: "memory");
        __builtin_amdgcn_s_barrier(); asm volatile("" ::: "memory");
        if (wid == 0) {
            if (lane == 0) (void)__hip_atomic_fetch_add(cnt + u.pm, 1u, __ATOMIC_RELAXED, __HIP_MEMORY_SCOPE_AGENT);
            unsigned spins = 0;
            while ((unsigned)__builtin_amdgcn_readfirstlane(__hip_atomic_load(cnt + u.pm, __ATOMIC_RELAXED, __HIP_MEMORY_SCOPE_AGENT)) < 4u) { __builtin_amdgcn_s_sleep(4); if (++spins > (1u << 20)) break; }
            __builtin_amdgcn_fence(__ATOMIC_ACQUIRE, "agent");
            asm volatile("s_waitcnt vmcnt(0)" ::: "memory");
        }
        __builtin_amdgcn_s_barrier(); asm volatile("" ::: "memory");
        f32x4 wv[2][2];
#pragma unroll
        for (int bj = 0; bj < 2; ++bj)
#pragma unroll
            for (int n = 0; n < 2; ++n) wv[bj][n] = *(const f32x4*)(fw + col0 + bj * HALF + n * 16);
#pragma unroll
        for (int ai = 0; ai < 2; ++ai)
#pragma unroll
            for (int m = 0; m < 4; ++m) {
                const int row = u.pm * BM + ai * HALF + wr * 64 + m * 16 + fr;
                const size_t off = (size_t)row * 1024 + col0;
                const float rs = __builtin_amdgcn_rsqf(__hip_atomic_load(rowss2 + row, __ATOMIC_RELAXED, __HIP_MEMORY_SCOPE_AGENT) * (1.0f / 1024.0f) + 1e-6f);
#pragma unroll
                for (int bj = 0; bj < 2; ++bj)
#pragma unroll
                    for (int n = 0; n < 2; ++n) *(f32x4*)(out + off + bj * HALF + n * 16) = acc[ai][bj][m][n] * rs * wv[bj][n];
            }
    }
};
struct EpiGlu {
    static constexpr bool PERM = true, AFTER_DRAIN = false;
    const bf16_t* YGS; const float* bias; bf16_t* MIX;
    __device__ __forceinline__ void operator()(const f32x4 (&acc)[2][2][4][2], const Unit& u, int wr, int wc, int fr, int fq) const {
        typedef unsigned u32x2 __attribute__((ext_vector_type(2)));
        const int row0 = u.pm * BM + wr * 64 + fr, col0 = wc * 32 + 8 * fq;
#pragma unroll
        for (int bj = 0; bj < 2; ++bj)
#pragma unroll
            for (int n = 0; n < 2; ++n) {
                const int c = col0 + bj * HALF + 4 * n;
                const f32x4 bv = *(const f32x4*)(bias + c);
#pragma unroll
                for (int ai = 0; ai < 2; ++ai)
#pragma unroll
                    for (int m = 0; m < 4; ++m) {
                        const size_t row = (size_t)(row0 + ai * HALF + m * 16);
                        const f32x4 v = acc[ai][bj][m][n] + bv;
                        const u32x2 yv = *(const u32x2*)(YGS + row * 256 + c);
                        const float y0 = __uint_as_float(yv.x << 16), y1 = __uint_as_float(yv.x & 0xffff0000u), y2 = __uint_as_float(yv.y << 16), y3 = __uint_as_float(yv.y & 0xffff0000u);
                        u32x2 w; w.x = cvt_pk_bf16(y0 * sigm(v[0]), y1 * sigm(v[1])); w.y = cvt_pk_bf16(y2 * sigm(v[2]), y3 * sigm(v[3]));
                        *(u32x2*)(MIX + row * 1024 + 256 + c) = w;
                        if (m & 1) asm volatile("" ::: "memory");
                    }
            }
    }
};
template <class Epi, class Sched, bool ALIGN_EPI = false, bool SP2 = false>
__device__ __forceinline__ void gemm_phase(PG8_LAS unsigned char* lds, const Gemm g, const Sched& S, const Epi& E) {
    int tid_l = threadIdx.x; asm volatile("" : "+v"(tid_l));
    const int tid = tid_l, wid = __builtin_amdgcn_readfirstlane(tid >> 6), lane = tid & 63, wr = wid >> 2, wc = wid & 3, fr = lane & 15, fq = lane >> 4;
    const int K = g.K, nt = K / BK;
    unsigned voffA[2], voffB[2];
#pragma unroll
    for (int i = 0; i < 2; ++i) { int R, C; stage_rc(tid * 16 + i * 8192, R, C); const int Rb = Epi::PERM ? ((R & ~31) + perm32(R & 31)) : R;
        voffA[i] = (unsigned)(R * K + C) * 2u; voffB[i] = (unsigned)(Rb * K + C) * 2u; }
    const size_t kstep = (size_t)(BK * 2);
    const size_t hstep = (size_t)HALF * K * 2;
    const size_t tstep = 2 * hstep;
    const unsigned ldsw = (unsigned)wid * 1024u;
    const int aoff = lds_byte(wr * 64 + fr, fq * 8), boff = lds_byte(wc * 32 + fr, fq * 8);
#define PG8_SA(b, h) (((b) * 2 + (h)) * HTB)
#define PG8_SB(b, h) ((4 + (b) * 2 + (h)) * HTB)
#define PG8_STAGE(bufoff, gbase, voff) do { _Pragma("unroll") for (int _i = 0; _i < 2; ++_i) \
        __builtin_amdgcn_global_load_lds((const unsigned*)((const char*)(gbase) + (voff)[_i]), (PG8_LAS unsigned*)(lds + (bufoff) + ldsw + _i * 8192), 16, 0, 0); } while (0)
#define PG8_LDA(dst, b, h) do { _Pragma("unroll") for (int m = 0; m < 4; ++m) _Pragma("unroll") for (int k = 0; k < 2; ++k) dst[m][k] = *(const PG8_LAS bf16x8*)(lds + PG8_SA(b, h) + aoff + m * 2048 + k * 1024); } while (0)
#define PG8_LDB(dst, b, h) do { _Pragma("unroll") for (int n = 0; n < 2; ++n) _Pragma("unroll") for (int k = 0; k < 2; ++k) dst[n][k] = *(const PG8_LAS bf16x8*)(lds + PG8_SB(b, h) + boff + n * 2048 + k * 1024); } while (0)
#define PG8_MMA(ai, bj, At, Bt) do { __builtin_amdgcn_s_setprio(1); _Pragma("unroll") for (int m = 0; m < 4; ++m) _Pragma("unroll") for (int n = 0; n < 2; ++n) _Pragma("unroll") for (int k = 0; k < 2; ++k) \
        acc[ai][bj][m][n] = __builtin_amdgcn_mfma_f32_16x16x32_bf16(Bt[n][k], At[m][k], acc[ai][bj][m][n], 0, 0, 0); __builtin_amdgcn_s_setprio(0); } while (0)
#define PG8_WAIT_V(n) asm volatile("s_waitcnt vmcnt(" #n ")" ::: "memory")
#define PG8_WAIT_L(n) asm volatile("s_waitcnt lgkmcnt(" #n ")" ::: "memory")
#define PG8_BAR __builtin_amdgcn_s_barrier()
#define PG8_SCHED __builtin_amdgcn_sched_barrier(0)
    Unit cur, nxt; int ui = 0;
    if (!S.next(0, cur)) return;
    f32x4 acc[2][2][4][2];
#pragma unroll
    for (int a = 0; a < 2; ++a)
#pragma unroll
        for (int b = 0; b < 2; ++b)
#pragma unroll
            for (int m = 0; m < 4; ++m)
#pragma unroll
                for (int n = 0; n < 2; ++n) acc[a][b][m][n] = (f32x4){0.f, 0.f, 0.f, 0.f};
    bf16x8 At[4][2], B0[2][2], B1[2][2];
    const char* cA = (const char*)g.A + (size_t)cur.pm * tstep; const char* cB = (const char*)g.Bt + (size_t)cur.pn * tstep;
    S.a_ready(cur);
    if constexpr (SP2) {
        PG8_STAGE(PG8_SB(0, 0), cB, voffB); PG8_STAGE(PG8_SB(0, 1), cB + hstep, voffB); PG8_STAGE(PG8_SA(0, 0), cA, voffA); PG8_STAGE(PG8_SA(0, 1), cA + hstep, voffA);
        if (wr == 1) PG8_BAR;
        PG8_WAIT_V(2); PG8_BAR;
        PG8_STAGE(PG8_SB(1, 0), cB + kstep, voffB); PG8_STAGE(PG8_SA(1, 0), cA + kstep, voffA); PG8_STAGE(PG8_SB(1, 1), cB + hstep + kstep, voffB);
        PG8_WAIT_V(6); PG8_BAR;
    } else {
        PG8_STAGE(PG8_SB(0, 0), cB, voffB); PG8_STAGE(PG8_SA(0, 0), cA, voffA); PG8_STAGE(PG8_SB(0, 1), cB + hstep, voffB); PG8_STAGE(PG8_SA(0, 1), cA + hstep, voffA);
        if (wr == 1) PG8_BAR;
        PG8_WAIT_V(4); PG8_BAR;
        PG8_STAGE(PG8_SB(1, 0), cB + kstep, voffB); PG8_STAGE(PG8_SA(1, 0), cA + kstep, voffA); PG8_STAGE(PG8_SB(1, 1), cB + hstep + kstep, voffB);
        PG8_WAIT_V(6); PG8_BAR;
    }
    for (;;) {
        const bool has_next = S.next(ui + 1, nxt);
        const char* nA = has_next ? (const char*)g.A + (size_t)nxt.pm * tstep : cA; const char* nB = has_next ? (const char*)g.Bt + (size_t)nxt.pn * tstep : cB;
        for (int t = 0; t < nt; t += 2) {
            const bool last = (t == nt - 2);
            const char* a1 = cA + (size_t)(t + 1) * kstep;
            const char* a2 = last ? nA : cA + (size_t)(t + 2) * kstep; const char* b2 = last ? nB : cB + (size_t)(t + 2) * kstep;
            const char* a3 = a2 + kstep; const char* b3 = b2 + kstep;
            if (last && has_next) S.a_ready(nxt);
            if constexpr (SP2) {
            PG8_LDB(B0, 0, 0); PG8_LDB(B1, 0, 1); PG8_SCHED; PG8_LDA(At, 0, 0); PG8_STAGE(PG8_SA(1, 1), a1 + hstep, voffA);
            PG8_WAIT_V(8); PG8_WAIT_L(0); PG8_BAR; PG8_MMA(0, 0, At, B0); PG8_MMA(0, 1, At, B1); PG8_BAR; PG8_SCHED;
            PG8_LDA(At, 0, 1); PG8_STAGE(PG8_SB(0, 0), b2, voffB); PG8_STAGE(PG8_SB(0, 1), b2 + hstep, voffB); PG8_STAGE(PG8_SA(0, 0), a2, voffA);
            PG8_WAIT_V(8); PG8_WAIT_L(0); PG8_BAR; PG8_MMA(1, 0, At, B0); PG8_MMA(1, 1, At, B1); PG8_BAR; PG8_SCHED;
            PG8_LDB(B0, 1, 0); PG8_LDB(B1, 1, 1); PG8_SCHED; PG8_LDA(At, 1, 0); PG8_STAGE(PG8_SA(0, 1), a2 + hstep, voffA);
            PG8_WAIT_V(8); PG8_WAIT_L(0); PG8_BAR; PG8_MMA(0, 0, At, B0); PG8_MMA(0, 1, At, B1); PG8_BAR; PG8_SCHED;
            PG8_LDA(At, 1, 1); PG8_STAGE(PG8_SB(1, 0), b3, voffB); PG8_STAGE(PG8_SB(1, 1), b3 + hstep, voffB); PG8_STAGE(PG8_SA(1, 0), a3, voffA);
            PG8_WAIT_V(8); PG8_WAIT_L(0); PG8_BAR; PG8_MMA(1, 0, At, B0); PG8_MMA(1, 1, At, B1); PG8_BAR; PG8_SCHED;
            } else {
            PG8_LDB(B0, 0, 0); PG8_SCHED; PG8_LDA(At, 0, 0); PG8_STAGE(PG8_SA(1, 1), a1 + hstep, voffA);
            PG8_WAIT_L(8); PG8_BAR; PG8_WAIT_L(0); PG8_MMA(0, 0, At, B0); PG8_BAR; PG8_SCHED;
            PG8_LDB(B1, 0, 1); PG8_STAGE(PG8_SB(0, 0), b2, voffB);
            PG8_BAR; PG8_WAIT_L(0); PG8_MMA(0, 1, At, B1); PG8_BAR;
            PG8_LDA(At, 0, 1); PG8_STAGE(PG8_SA(0, 0), a2, voffA);
            PG8_BAR; PG8_WAIT_L(0); PG8_MMA(1, 0, At, B0); PG8_BAR; PG8_SCHED;
            PG8_STAGE(PG8_SB(0, 1), b2 + hstep, voffB);
            PG8_WAIT_V(6); PG8_BAR; PG8_MMA(1, 1, At, B1); PG8_BAR;
            PG8_LDB(B0, 1, 0); PG8_SCHED; PG8_LDA(At, 1, 0); PG8_STAGE(PG8_SA(0, 1), a2 + hstep, voffA);
            PG8_WAIT_L(8); PG8_BAR; PG8_WAIT_L(0); PG8_MMA(0, 0, At, B0); PG8_BAR; PG8_SCHED;
            PG8_LDB(B1, 1, 1); PG8_STAGE(PG8_SB(1, 0), b3, voffB);
            PG8_BAR; PG8_WAIT_L(0); PG8_MMA(0, 1, At, B1); PG8_BAR;
            PG8_LDA(At, 1, 1); PG8_STAGE(PG8_SA(1, 0), a3, voffA);
            PG8_BAR; PG8_WAIT_L(0); PG8_MMA(1, 0, At, B0); PG8_BAR; PG8_SCHED;
            PG8_STAGE(PG8_SB(1, 1), b3 + hstep, voffB);
            PG8_WAIT_V(6); PG8_BAR; PG8_MMA(1, 1, At, B1); PG8_BAR;
            }
        }
        if constexpr (ALIGN_EPI) { if (wr == 0) PG8_BAR; }
        if constexpr (!Epi::AFTER_DRAIN) { E(acc, cur, wr, wc, fr, fq); S.done(cur); }
        if (!has_next) break;
#pragma unroll
        for (int a = 0; a < 2; ++a)
#pragma unroll
            for (int b = 0; b < 2; ++b)
#pragma unroll
                for (int m = 0; m < 4; ++m)
#pragma unroll
                    for (int n = 0; n < 2; ++n) acc[a][b][m][n] = (f32x4){0.f, 0.f, 0.f, 0.f};
        cur = nxt; cA = nA; cB = nB; ++ui;
        if constexpr (ALIGN_EPI) { if (wr == 1) PG8_BAR; }
    }
    PG8_WAIT_V(0);
    if constexpr (!ALIGN_EPI) { if (wr == 0) PG8_BAR; }
    PG8_BAR;
    if constexpr (Epi::AFTER_DRAIN) { E.fused(acc, cur, wr, wc, fr, fq, lds, wid, lane); S.done(cur); }
#undef PG8_SA
#undef PG8_SB
#undef PG8_STAGE
#undef PG8_LDA
#undef PG8_LDB
#undef PG8_MMA
#undef PG8_WAIT_V
#undef PG8_WAIT_L
#undef PG8_BAR
#undef PG8_SCHED
}
}

#ifndef PG8_SP2
#define PG8_SP2 true
#endif
#ifndef PG8_ALIGN
#define PG8_ALIGN true
#endif
#include <hip/hip_bf16.h>
#include <cmath>
namespace attn_body {
using bf16=__hip_bfloat16;
using bf16x8=__attribute__((ext_vector_type(8)))short;
using s16x4=__attribute__((ext_vector_type(4)))short;
using f32x16=__attribute__((ext_vector_type(16)))float;
using u32x4=__attribute__((ext_vector_type(4)))unsigned;
constexpr int BATCH=2,NHEAD=16,SEQ=8192,D=64,DM=NHEAD*D;
constexpr int NW=8,QBLK=32,QB=QBLK*NW,KVBLK=64,NQB=SEQ/QB;
constexpr int ATTN_PITCH=DM, ATTN_UNIT_ROWS=QB;
constexpr int PQ=3584,QCOL=1536,KCOL=2048,VCOL=2560;
__device__ __forceinline__ int crow(int r,int hi){return (r&3)+8*(r>>2)+4*hi;}
#define SBAR() __builtin_amdgcn_sched_barrier(0)
__device__ __forceinline__ void cmask(f32x16&p0,f32x16&p1,int jb,int qrel,int hi){
  const float NEG=-INFINITY; int kb=64*jb+4*hi;
  #pragma unroll
  for(int r=0;r<16;++r){int kv=kb+(r&3)+8*(r>>2); if(kv>qrel)p0[r]=NEG; if(kv+32>qrel)p1[r]=NEG;}
}

constexpr int NSLOT=3, SLOTB=8192;
constexpr int LDS_K=0, LDS_V=NSLOT*SLOTB, LDS_WS=3*NSLOT*SLOTB, LDS_OST=LDS_WS+NW*64*4, LDS_BYTES=LDS_OST+NW*4096;
constexpr float C2=0.125f*1.4426950408889634f;
__device__ __forceinline__ void glds16(const void*gsrc,unsigned lds_dst){unsigned keep;
  asm volatile("s_mov_b32 %0, m0\n\ts_mov_b32 m0, %2\n\ts_nop 0\n\tglobal_load_lds_dwordx4 %1, off\n\ts_mov_b32 m0, %0":"=&s"(keep):"v"(gsrc),"s"(lds_dst):"memory");}
__device__ __forceinline__ float max3f(float a,float b,float c){float r;asm("v_max3_f32 %0, %1, %2, %3":"=v"(r):"v"(a),"v"(b),"v"(c));return r;}
__device__ __forceinline__ float max2f(float a,float b){float r;asm("v_max_f32_e32 %0, %1, %2":"=v"(r):"v"(a),"v"(b));return r;}
__device__ __forceinline__ float fadd_s(float a,float b){float r;asm("v_add_f32_e32 %0, %1, %2":"=v"(r):"v"(a),"v"(b));return r;}
__device__ __forceinline__ float fsub_s(float a,float b){float r;asm("v_sub_f32_e32 %0, %1, %2":"=v"(r):"v"(a),"v"(b));return r;}
typedef float f32x2_t __attribute__((ext_vector_type(2))); typedef __bf16 bf16x2_t __attribute__((ext_vector_type(2)));
__device__ __forceinline__ unsigned cvtpk_s(float lo,float hi){f32x2_t v={lo,hi};bf16x2_t b=__builtin_convertvector(v,bf16x2_t);return __builtin_bit_cast(unsigned,b);}
#define WAIT_BAR(N) asm volatile("s_waitcnt vmcnt(" #N ") lgkmcnt(0)\n\ts_barrier":::"memory")

__device__ __forceinline__ void qkt(f32x16&p0,f32x16&p1,const char*Kslot,const bf16x8*qr,const f32x16&negm,int r32,int hi){
  const char*kb=Kslot+hi*1024+r32*16;
  #pragma unroll
  for(int d0=0;d0<4;++d0){
    const bf16x8 b0=*reinterpret_cast<const bf16x8*>(kb+d0*2048);
    const bf16x8 b1=*reinterpret_cast<const bf16x8*>(kb+d0*2048+512);
    if(d0==0){p0=__builtin_amdgcn_mfma_f32_32x32x16_bf16(b0,qr[0],negm,0,0,0);p1=__builtin_amdgcn_mfma_f32_32x32x16_bf16(b1,qr[0],negm,0,0,0);}
    else{p0=__builtin_amdgcn_mfma_f32_32x32x16_bf16(b0,qr[d0],p0,0,0,0);p1=__builtin_amdgcn_mfma_f32_32x32x16_bf16(b1,qr[d0],p1,0,0,0);}}
}
typedef __attribute__((address_space(3))) const char* lds_cptr;
typedef short v4i16_t __attribute__((ext_vector_type(4)));
__device__ __forceinline__ void kload8(bf16x8*kf,lds_cptr kp){
  kf[0]=*(const __attribute__((address_space(3))) bf16x8*)(kp);      kf[1]=*(const __attribute__((address_space(3))) bf16x8*)(kp+512);
  kf[2]=*(const __attribute__((address_space(3))) bf16x8*)(kp+2048); kf[3]=*(const __attribute__((address_space(3))) bf16x8*)(kp+2560);
  kf[4]=*(const __attribute__((address_space(3))) bf16x8*)(kp+4096); kf[5]=*(const __attribute__((address_space(3))) bf16x8*)(kp+4608);
  kf[6]=*(const __attribute__((address_space(3))) bf16x8*)(kp+6144); kf[7]=*(const __attribute__((address_space(3))) bf16x8*)(kp+6656);
}
__device__ __forceinline__ void kload2(bf16x8*kf,lds_cptr kp,int j){ kf[2*j]=*(const __attribute__((address_space(3))) bf16x8*)(kp+j*2048); kf[2*j+1]=*(const __attribute__((address_space(3))) bf16x8*)(kp+j*2048+512); }
__device__ __forceinline__ s16x4 vtr(lds_cptr p){ return __builtin_bit_cast(s16x4,__builtin_amdgcn_ds_read_tr16_b64_v4i16((__attribute__((address_space(3))) v4i16_t*)p)); }
__device__ __forceinline__ float rowmax(const f32x16&p0,const f32x16&p1){
  float a=max3f(p0[0],p0[1],p1[0]),b=max3f(p0[2],p0[3],p1[1]);a=max3f(a,p1[2],p1[3]);
  #pragma unroll
  for(int r=4;r<16;r+=4){a=max3f(a,p0[r],p0[r+1]);b=max3f(b,p0[r+2],p0[r+3]);a=max3f(a,p1[r],p1[r+1]);b=max3f(b,p1[r+2],p1[r+3]);}
  const float m=max2f(a,b);
  auto rr=__builtin_amdgcn_permlane32_swap(__float_as_uint(m),__float_as_uint(m),false,false);
  return max2f(__uint_as_float(rr[0]),__uint_as_float(rr[1]));
}
__device__ __forceinline__ void pv(f32x16*o,int vb,bf16x8 pa0,bf16x8 pa1,bf16x8 pa2,bf16x8 pa3){
  #pragma unroll
  for(int d0=0;d0<2;++d0){s16x4 lo[4],hi[4];
    #pragma unroll
    for(int ks=0;ks<4;++ks){
      asm volatile("ds_read_b64_tr_b16 %0,%1 offset:%c2":"=&v"(lo[ks]):"v"(vb),"i"(d0*4096+ks*1024):"memory");
      asm volatile("ds_read_b64_tr_b16 %0,%1 offset:%c2":"=&v"(hi[ks]):"v"(vb),"i"(d0*4096+ks*1024+512):"memory");}
    asm volatile("s_waitcnt lgkmcnt(0)":::"memory");SBAR();
    #define PK(k) (bf16x8){lo[k][0],lo[k][1],lo[k][2],lo[k][3],hi[k][0],hi[k][1],hi[k][2],hi[k][3]}
    o[d0]=__builtin_amdgcn_mfma_f32_32x32x16_bf16(pa0,PK(0),o[d0],0,0,0);
    o[d0]=__builtin_amdgcn_mfma_f32_32x32x16_bf16(pa1,PK(1),o[d0],0,0,0);
    o[d0]=__builtin_amdgcn_mfma_f32_32x32x16_bf16(pa2,PK(2),o[d0],0,0,0);
    o[d0]=__builtin_amdgcn_mfma_f32_32x32x16_bf16(pa3,PK(3),o[d0],0,0,0);
    #undef PK
  }
}

#ifndef ATTN_STORE16
#define ATTN_STORE16(p,v) (*(u32x4*)(p)=(v))
#endif
template<int THRL> __device__ __forceinline__ void attn_unit(int b,int h,int qb,const bf16*Q,const bf16*__restrict__ K,const bf16*__restrict__ V,bf16*O,char*shm){
  int tid_l=threadIdx.x; asm volatile("":"+v"(tid_l)); const int tid=tid_l,lane=tid&63,r32=lane&31,hi=lane>>5; const int wid=__builtin_amdgcn_readfirstlane(tid>>6);
  const long rowbase=(long)b*SEQ; const int q0=qb*QB;
  const int hh_=h>>1,mm_=h&1; const bf16*Qw=Q+(rowbase+q0+wid*QBLK)*PQ+QCOL+hh_*128+mm_*64;
  const bf16*Kh=K+rowbase*PQ+KCOL+hh_*128+mm_*64,*Vh=V+rowbase*PQ+VCOL+hh_*128;
  const unsigned lds0=(unsigned)(uintptr_t)shm;
  float*wsf=(float*)(shm+LDS_WS)+wid*64;
  const bf16*ksrc=Kh+(long)lane*PQ+wid*8;
  const bf16*vsrc=Vh+(long)(16*(wid&3)+(lane>>2))*PQ+(wid>>2)*32+(lane&3)*8;
  const unsigned kdst=lds0+LDS_K+wid*1024, vdst=lds0+LDS_V+wid*1024;
  #define DMA_K(t,slot) glds16(ksrc+(long)(t)*KVBLK*PQ,(unsigned)__builtin_amdgcn_readfirstlane(kdst+(slot)))
  #define DMA_V(t,slot) do{ glds16(vsrc+(long)(t)*KVBLK*PQ,(unsigned)__builtin_amdgcn_readfirstlane(vdst+2*(slot))); glds16(vsrc+(long)(t)*KVBLK*PQ+64,(unsigned)__builtin_amdgcn_readfirstlane(vdst+2*(slot)+8192)); }while(0)
  const int vb0=(int)(lds0+LDS_V)+((lane>>4)&1)*32+(lane&3)*8+(4*hi+((lane&15)>>2))*64;
  const char*Kbase=shm+LDS_K; bf16x8 kf[8];
  const lds_cptr shm3=(lds_cptr)shm; const lds_cptr kp0=shm3+LDS_K+hi*1024+r32*16; const lds_cptr vp0=shm3+LDS_V+((lane>>4)&1)*32+(lane&3)*8+(4*hi+((lane&15)>>2))*64;
  const int NT=(q0+QB)/KVBLK;
  DMA_K(0,0);DMA_V(0,0);DMA_K(1,SLOTB);
  bf16x8 qr[4];
  #pragma unroll
  for(int d0=0;d0<4;++d0)qr[d0]=*reinterpret_cast<const bf16x8*>(&Qw[(long)r32*PQ+d0*16+hi*8]);
  float mhat=0.f,l_reg=0.f;f32x16 o[4];o[0]=f32x16{};o[1]=f32x16{};o[2]=f32x16{};o[3]=f32x16{};f32x16 negm=f32x16{};asm volatile("":"+v"(negm));
  const int qrel=wid*QBLK+r32;
  #define CMASK(P0,P1,t) do{int jb_=(t)-(NT-4); if(jb_>=0)cmask(P0,P1,jb_,qrel,hi);}while(0)
  bool resc=false;
  #define START(P0,P1) do{ const float rm=rowmax(P0,P1); resc=false; \
    { const float dl=rm; mhat=fadd_s(mhat,dl); \
      _Pragma("unroll") for(int r=0;r<16;++r){P0[r]=fsub_s(P0[r],dl);P1[r]=fsub_s(P1[r],dl);} \
      _Pragma("unroll") for(int r=0;r<16;++r)negm[r]=-mhat; asm volatile("":"+v"(negm)); } \
    _Pragma("unroll") for(int r=0;r<16;++r)P0[r]=__builtin_amdgcn_exp2f(P0[r]); }while(0)
  #define RESC() do{ if(resc){ asm volatile("s_waitcnt lgkmcnt(0)":::"memory"); \
      _Pragma("unroll") for(int d_=0;d_<4;++d_) _Pragma("unroll") for(int r=0;r<16;++r)o[d_][r]*=wsf[crow(r,hi)]; } }while(0)
  f32x16 pA0,pA1,pB0,pB1;
  int sl_prev=0,sl_cur=0,sl_next=SLOTB;
  #define ROT() do{sl_prev=sl_cur;sl_cur=sl_next;sl_next=(sl_next==(NSLOT-1)*SLOTB)?0:sl_next+SLOTB;}while(0)
  DMA_K(2,2*SLOTB);
  WAIT_BAR(3);
  qkt(pA0,pA1,Kbase,qr,negm,r32,hi);asm volatile("s_nop 15\n\ts_nop 7":"+v"(pA0),"+v"(pA1));CMASK(pA0,pA1,0);
  START(pA0,pA1);
  _Pragma("unroll") for(int r=0;r<16;++r)pA1[r]=__builtin_amdgcn_exp2f(pA1[r]);
  WAIT_BAR(0);
  DMA_K(3,0);DMA_V(1,SLOTB);
  ROT();
  kload8(kf,kp0+sl_cur);
  WAIT_BAR(3);
  s16x4 vlo[8],vhi[8],wlo[8],whi[8]; u32x4 pw0,pw1,pw2,pw3;
  #define PKW(P,B) cvtpk_s(P[B],P[B+1])
  #define PAF(k) __builtin_bit_cast(bf16x8,pw##k)
  #define VFR(i) (bf16x8){vlo[i][0],vlo[i][1],vlo[i][2],vlo[i][3],vhi[i][0],vhi[i][1],vhi[i][2],vhi[i][3]}
  #define PIN(x) asm volatile("":"+v"(x))
  #define MX3(a,b,c) __builtin_fmaxf(__builtin_fmaxf((a),(b)),(c))
  #define GAPA(MF,A0,A1,A2,A3,W0,W1,PW) do{ MF; sacc+=A0; sacc+=A1; sacc+=A2; sacc+=A3; PIN(sacc); W0; W1; PIN(PW); SBAR(); }while(0)
  #define EX(v) __builtin_amdgcn_exp2f(v)
  #define GAPB(MF,X,B) do{ MF; X[B]=EX(X[B]); X[B+1]=EX(X[B+1]); PIN(X); SBAR(); }while(0)
  #define VRD(i) do{ vlo[i]=vtr(vp_+(((i)>>2)*4096+((i)&3)*1024)); vhi[i]=vtr(vp_+(((i)>>2)*4096+((i)&3)*1024+512)); }while(0)
  #define VRD2(i) do{ wlo[i]=vtr(vp_+(8192+((i)>>2)*4096+((i)&3)*1024)); whi[i]=vtr(vp_+(8192+((i)>>2)*4096+((i)&3)*1024+512)); SBAR(); }while(0)
  #define WFR(i) (bf16x8){wlo[i][0],wlo[i][1],wlo[i][2],wlo[i][3],whi[i][0],whi[i][1],whi[i][2],whi[i][3]}
  #define GAPC(MF,X,B) do{ MF; X[B]=EX(X[B]); X[B+1]=EX(X[B+1]); PIN(X); SBAR(); }while(0)
  #define KRD(G,j) do{ if(G){ kload2(kf,kp0+sl_next,j); SBAR(); } }while(0)
  #define STEP(C0,C1,P0,P1,t,GK,GV,GL) do{ SBAR(); \
    const lds_cptr vp_=vp0+2*sl_prev; \
    VRD(0); SBAR(); float sacc=(P0[0]+P0[1]); \
    GAPA(C0=__builtin_amdgcn_mfma_f32_32x32x16_bf16(kf[0],qr[0],negm,0,0,0), P0[2],P0[3],P0[4],P0[5],     pw0[0]=PKW(P0,0), pw0[1]=PKW(P0,2), pw0); \
    VRD(4); SBAR(); GAPA(C1=__builtin_amdgcn_mfma_f32_32x32x16_bf16(kf[1],qr[0],negm,0,0,0), P0[6],P0[7],P0[8],P0[9],     pw0[2]=PKW(P0,4), pw0[3]=PKW(P0,6), pw0); \
    VRD(1); SBAR(); GAPA(C0=__builtin_amdgcn_mfma_f32_32x32x16_bf16(kf[2],qr[1],C0,0,0,0),   P0[10],P0[11],P0[12],P0[13], pw1[0]=PKW(P0,8), pw1[1]=PKW(P0,10), pw1); \
    VRD(5); SBAR(); GAPA(C1=__builtin_amdgcn_mfma_f32_32x32x16_bf16(kf[3],qr[1],C1,0,0,0),   P0[14],P0[15],P1[0],P1[1],   pw1[2]=PKW(P0,12),pw1[3]=PKW(P0,14), pw1); \
    VRD(2); SBAR(); GAPA(C0=__builtin_amdgcn_mfma_f32_32x32x16_bf16(kf[4],qr[2],C0,0,0,0),   P1[2],P1[3],P1[4],P1[5],     pw2[0]=PKW(P1,0), pw2[1]=PKW(P1,2), pw2); \
    VRD(6); SBAR(); GAPA(C1=__builtin_amdgcn_mfma_f32_32x32x16_bf16(kf[5],qr[2],C1,0,0,0),   P1[6],P1[7],P1[8],P1[9],     pw2[2]=PKW(P1,4), pw2[3]=PKW(P1,6), pw2); \
    VRD(3); SBAR(); GAPA(C0=__builtin_amdgcn_mfma_f32_32x32x16_bf16(kf[6],qr[3],C0,0,0,0),   P1[10],P1[11],P1[12],P1[13], pw3[0]=PKW(P1,8), pw3[1]=PKW(P1,10), pw3); \
    VRD(7); SBAR(); GAPA(C1=__builtin_amdgcn_mfma_f32_32x32x16_bf16(kf[7],qr[3],C1,0,0,0),   P1[14],P1[15],0.f,0.f,       pw3[2]=PKW(P1,12),pw3[3]=PKW(P1,14), pw3); \
    l_reg+=sacc; \
    if(GK){DMA_K((t)+3,sl_cur);} if(GV){DMA_V((t)+1,sl_next);} \
    CMASK(C0,C1,t); \
    { float a=MX3(C0[0],C0[1],C1[0]),b=MX3(C0[2],C0[3],C1[1]); a=MX3(a,C1[2],C1[3]); \
      _Pragma("unroll") for(int r=4;r<16;r+=4){a=MX3(a,C0[r],C0[r+1]);b=MX3(b,C0[r+2],C0[r+3]);a=MX3(a,C1[r],C1[r+1]);b=MX3(b,C1[r+2],C1[r+3]);} \
      float rm=__builtin_fmaxf(a,b); { auto rr=__builtin_amdgcn_permlane32_swap(__float_as_uint(rm),__float_as_uint(rm),false,false); rm=__builtin_fmaxf(__uint_as_float(rr[0]),__uint_as_float(rr[1])); } \
      resc=false; \
      if(__builtin_expect(__any(rm>(float)THRL),0)){ const float dl=__builtin_fmaxf(rm,0.f); mhat+=dl; \
        _Pragma("unroll") for(int r=0;r<16;++r){C0[r]-=dl;C1[r]-=dl;} \
        _Pragma("unroll") for(int r=0;r<16;++r)negm[r]=-mhat; asm volatile("":"+v"(negm)); \
        const float f=__builtin_amdgcn_exp2f(-dl); l_reg*=f; if(hi==0)wsf[r32]=f; resc=true; } } \
    SBAR(); \
    GAPB(o[0]=__builtin_amdgcn_mfma_f32_32x32x16_bf16(PAF(0),VFR(0),o[0],0,0,0), C0,0); VRD2(0); \
    GAPB(o[1]=__builtin_amdgcn_mfma_f32_32x32x16_bf16(PAF(0),VFR(4),o[1],0,0,0), C0,2); VRD2(4); \
    KRD(GL,0); GAPB(o[0]=__builtin_amdgcn_mfma_f32_32x32x16_bf16(PAF(1),VFR(1),o[0],0,0,0), C0,4); VRD2(1); \
    KRD(GL,1); GAPB(o[1]=__builtin_amdgcn_mfma_f32_32x32x16_bf16(PAF(1),VFR(5),o[1],0,0,0), C0,6); VRD2(5); \
    KRD(GL,2); GAPB(o[0]=__builtin_amdgcn_mfma_f32_32x32x16_bf16(PAF(2),VFR(2),o[0],0,0,0), C0,8); VRD2(2); \
    KRD(GL,3); GAPB(o[1]=__builtin_amdgcn_mfma_f32_32x32x16_bf16(PAF(2),VFR(6),o[1],0,0,0), C0,10); VRD2(6); \
    GAPB(o[0]=__builtin_amdgcn_mfma_f32_32x32x16_bf16(PAF(3),VFR(3),o[0],0,0,0), C0,12); VRD2(3); \
    GAPB(o[1]=__builtin_amdgcn_mfma_f32_32x32x16_bf16(PAF(3),VFR(7),o[1],0,0,0), C0,14); VRD2(7); \
    GAPC(o[2]=__builtin_amdgcn_mfma_f32_32x32x16_bf16(PAF(0),WFR(0),o[2],0,0,0), C1,0); \
    GAPC(o[3]=__builtin_amdgcn_mfma_f32_32x32x16_bf16(PAF(0),WFR(4),o[3],0,0,0), C1,2); \
    GAPC(o[2]=__builtin_amdgcn_mfma_f32_32x32x16_bf16(PAF(1),WFR(1),o[2],0,0,0), C1,4); \
    GAPC(o[3]=__builtin_amdgcn_mfma_f32_32x32x16_bf16(PAF(1),WFR(5),o[3],0,0,0), C1,6); \
    GAPC(o[2]=__builtin_amdgcn_mfma_f32_32x32x16_bf16(PAF(2),WFR(2),o[2],0,0,0), C1,8); \
    GAPC(o[3]=__builtin_amdgcn_mfma_f32_32x32x16_bf16(PAF(2),WFR(6),o[3],0,0,0), C1,10); \
    GAPC(o[2]=__builtin_amdgcn_mfma_f32_32x32x16_bf16(PAF(3),WFR(3),o[2],0,0,0), C1,12); \
    GAPC(o[3]=__builtin_amdgcn_mfma_f32_32x32x16_bf16(PAF(3),WFR(7),o[3],0,0,0), C1,14); \
    }while(0)
  int t=1;
  #undef CMASK
  #define CMASK(P0,P1,t) do{}while(0)
  for(;t+5<NT;t+=2){
    STEP(pB0,pB1,pA0,pA1,t,true,true,true);     WAIT_BAR(3); RESC(); ROT();
    STEP(pA0,pA1,pB0,pB1,t+1,true,true,true);   WAIT_BAR(3); RESC(); ROT();
  }
  #undef CMASK
  #define CMASK(P0,P1,t) do{int jb_=(t)-(NT-4); if(jb_>=0)cmask(P0,P1,jb_,qrel,hi);}while(0)
  #define ENDW(tt) do{ if((tt)+3<NT){WAIT_BAR(3);} else if((tt)+2<NT){WAIT_BAR(2);} else {WAIT_BAR(0);} }while(0)
  for(;t+1<NT;t+=2){
    STEP(pB0,pB1,pA0,pA1,t,(t+3<NT),(t+1<NT),(t+1<NT));       ENDW(t);   RESC(); ROT();
    STEP(pA0,pA1,pB0,pB1,t+1,(t+4<NT),(t+2<NT),(t+2<NT));     ENDW(t+1); RESC(); ROT();
  }
  STEP(pB0,pB1,pA0,pA1,NT-1,false,false,false); RESC();
  { float sacc=pB0[0]+pB0[1]; _Pragma("unroll") for(int r=2;r<16;++r)sacc+=pB0[r]; _Pragma("unroll") for(int r=0;r<16;++r)sacc+=pB1[r]; l_reg+=sacc;
    pw0=(u32x4){PKW(pB0,0),PKW(pB0,2),PKW(pB0,4),PKW(pB0,6)};pw1=(u32x4){PKW(pB0,8),PKW(pB0,10),PKW(pB0,12),PKW(pB0,14)};pw2=(u32x4){PKW(pB1,0),PKW(pB1,2),PKW(pB1,4),PKW(pB1,6)};pw3=(u32x4){PKW(pB1,8),PKW(pB1,10),PKW(pB1,12),PKW(pB1,14)};
    SBAR(); pv(o,vb0+2*sl_cur,PAF(0),PAF(1),PAF(2),PAF(3)); pv(o+2,vb0+2*sl_cur+8192,PAF(0),PAF(1),PAF(2),PAF(3)); }
  #undef PKW
  #undef PAF
  #undef VFR
  #undef PIN
  #undef MX3
  #undef GAPA
  #undef GAPB
  #undef EX
  #undef VRD
  #undef VRD2
  #undef WFR
  #undef GAPC
  #undef KRD
  #undef STEP
  #undef ENDW
  {auto rr=__builtin_amdgcn_permlane32_swap(__float_as_uint(l_reg),__float_as_uint(l_reg),false,false);l_reg=__uint_as_float(rr[0])+__uint_as_float(rr[1]);}
  if(hi==0)wsf[32+r32]=l_reg;asm volatile("s_waitcnt lgkmcnt(0)":::"memory");
  float rli[16];
  #pragma unroll
  for(int r=0;r<16;++r)rli[r]=__builtin_amdgcn_rcpf(wsf[32+crow(r,hi)]);
  bf16*Ow=O+(rowbase+q0+wid*QBLK)*DM+hh_*256+mm_*128;
  #pragma unroll
  for(int half=0;half<2;++half)
  { bf16*stg=(bf16*)(shm+LDS_OST)+wid*2048;
    #pragma unroll
    for(int r=0;r<16;++r){const int orow=crow(r,hi);
      #pragma unroll
      for(int d0=0;d0<2;++d0)stg[orow*64+d0*32+r32]=__float2bfloat16(o[2*half+d0][r]*rli[r]);}
    asm volatile("s_waitcnt lgkmcnt(0)":::"memory");
    #pragma unroll
    for(int i=0;i<4;++i){const int row=i*8+(lane>>3),ch=lane&7; const u32x4 v=*(const u32x4*)(stg+row*64+ch*8); ATTN_STORE16(Ow+(long)row*DM+half*64+ch*8,v);}
    asm volatile("s_waitcnt lgkmcnt(0)":::"memory"); }
  asm volatile("s_waitcnt lgkmcnt(0)\n\ts_barrier":::"memory");
  #undef DMA_K
  #undef DMA_V
  #undef CMASK
  #undef START
  #undef RESC
  #undef ROT
}
constexpr int ATTN_LDS_BYTES=LDS_BYTES;
struct AttnTensors { const bf16* Q; const bf16* K; const bf16* V; bf16* O; };
struct AttnUnit { int bh; int qb; };
struct StaticOrder {
  int vcu;
  __device__ __forceinline__ explicit StaticOrder(int v):vcu(v){}
  __device__ __forceinline__ bool next(int i,AttnUnit&u)const{ if(i>=2)return false; const int s=vcu&15; u.bh=vcu>>4; u.qb=(i==0)?31-s:s; return true; }
  __device__ __forceinline__ void a_ready(const AttnUnit&)const{}
  __device__ __forceinline__ void done(const AttnUnit&)const{}
};
template<class Sched,int THRL=8> __device__ __forceinline__ void attn_phase(char*lds,const AttnTensors&T,const Sched&S){
  AttnUnit u;
  for(int i=0;S.next(i,u);++i){ S.a_ready(u); attn_unit<THRL>(u.bh>>3,u.bh&7,u.qb,T.Q,T.K,T.V,T.O,lds); S.done(u); }
}
#undef SBAR
#undef WAIT_BAR
}
namespace cg = cooperative_groups;
constexpr int NWAVES = 8;
constexpr int BATCH = 2, T = 8192, D = 1024, DIN = 3584, M = BATCH * T, DEPTH = 2;
constexpr float EPS = 1e-6f;
constexpr size_t MiB = 1u << 20;
constexpr size_t WS_CTL = 0;
constexpr size_t WS_TAB = 64 * 1024;
constexpr size_t WS_ROWSS = 128 * 1024;
constexpr size_t WS_ROWSS2 = 192 * 1024;
constexpr size_t WS_PCNT = 14336;
constexpr size_t WS_SUCNT = 15616;
constexpr size_t WS_SCNT = 14592;
constexpr size_t WS_ROWSS0 = 256 * 1024;
constexpr size_t WS_WIN = 2 * MiB;
constexpr size_t WS_WOUT = 16 * MiB;
constexpr size_t WS_GLU = 20 * MiB;
constexpr size_t WS_ROPE = 20 * MiB + 512 * 1024;
constexpr size_t WS_S5A = 21 * MiB;
constexpr size_t WS_S5B = 21 * MiB + 64 * 1024;
constexpr size_t WS_S5C = 21 * MiB + 256 * 1024;
constexpr size_t WS_HU = 22 * MiB;
constexpr size_t WS_HA = 30 * MiB;
constexpr size_t WS_XLOC = 31 * MiB;
constexpr size_t WS_XN = 32 * MiB;
constexpr size_t WS_O = WS_XN;
constexpr size_t WS_PROJ = 64 * MiB;
constexpr size_t WS_MIX = 176 * MiB;
constexpr size_t WS_YG = 208 * MiB;
constexpr size_t WS_YGS = 216 * MiB;
constexpr size_t WS_HRES = 224 * MiB;
constexpr size_t WS_END = 256 * MiB;
constexpr int LDS_BYTES = 147456, RING_BYTES = 131072;

#define GAS __attribute__((address_space(1)))
#define LAS __attribute__((address_space(3)))
typedef unsigned short bf16;
typedef unsigned v4u __attribute__((ext_vector_type(4)));
typedef unsigned v2u __attribute__((ext_vector_type(2)));
typedef float f32x4 __attribute__((ext_vector_type(4)));
typedef short bf16x8 __attribute__((ext_vector_type(8)));
#define LDS_WAIT() asm volatile("s_waitcnt lgkmcnt(0)" ::: "memory")
__device__ __forceinline__ unsigned f2bf(float f) { unsigned u = __builtin_bit_cast(unsigned, f); return (u + 0x7fffu + ((u >> 16) & 1u)) >> 16; }
__device__ __forceinline__ unsigned pk2(float lo, float hi) { return f2bf(lo) | (f2bf(hi) << 16); }
__device__ __forceinline__ float bflo(unsigned w) { return __uint_as_float(w << 16); }
__device__ __forceinline__ float bfhi(unsigned w) { return __uint_as_float(w & 0xffff0000u); }
__device__ __forceinline__ float bf1(bf16 h) { return __uint_as_float(((unsigned)h) << 16); }
__device__ __forceinline__ float sigmf(float v) { return __builtin_amdgcn_rcpf(1.0f + __builtin_amdgcn_exp2f(-1.4426950408889634f * v)); }
__device__ __forceinline__ float siluf(float v) { return v * sigmf(v); }
__device__ __forceinline__ float wave_sum(float v) {
#pragma unroll
    for (int o = 1; o < 64; o <<= 1) v += __shfl_xor(v, o);
    return v;
}
__device__ __forceinline__ void p0_transpose_item(const float* W, int K, int N, bf16* WT, LAS float* scr_f, int item, int lane, const float* kscale = nullptr) {
    LAS bf16* scr = (LAS bf16*)scr_f;
    const int nblk = N / 64, kb = item / nblk, nb = item % nblk, k0 = 64 * kb, n0 = 64 * nb;
    f32x4 v[16];
#pragma unroll
    for (int i = 0; i < 16; ++i) v[i] = __builtin_nontemporal_load((const f32x4*)(W + (size_t)(k0 + 4 * i + (lane >> 4)) * N + n0 + (lane & 15) * 4));
#pragma unroll
    for (int i = 0; i < 16; ++i) { const float sc = kscale ? kscale[k0 + 4 * i + (lane >> 4)] : 1.0f;
        *(LAS v2u*)(scr + (4 * i + (lane >> 4)) * 68 + (lane & 15) * 4) = (v2u){pk2(v[i].x * sc, v[i].y * sc), pk2(v[i].z * sc, v[i].w * sc)}; }
    LDS_WAIT(); asm volatile("" ::: "memory");
    const int c = lane & 7;
#pragma unroll
    for (int j = 0; j < 8; ++j) { const int n = (lane >> 3) + 8 * j; const LAS bf16* t = scr + (8 * c) * 68 + n;
        v4u o; o.x = (unsigned)t[0] | ((unsigned)t[68] << 16); o.y = (unsigned)t[2 * 68] | ((unsigned)t[3 * 68] << 16); o.z = (unsigned)t[4 * 68] | ((unsigned)t[5 * 68] << 16); o.w = (unsigned)t[6 * 68] | ((unsigned)t[7 * 68] << 16);
        *(v4u*)(WT + (size_t)(n0 + n) * K + k0 + 8 * c) = o; }
    LDS_WAIT(); asm volatile("" ::: "memory");
}
template <bool OUTF> __device__ __forceinline__ void rms_row(const float* xrow, const float* w, bf16* orow, float* frow, int lane) {
    const f32x4* xr = (const f32x4*)xrow + lane; const f32x4* wr = (const f32x4*)w + lane;
    f32x4 v[4]; float s = 0.f;
#pragma unroll
    for (int j = 0; j < 4; ++j) { v[j] = xr[64 * j]; s += (v[j].x * v[j].x + v[j].y * v[j].y) + (v[j].z * v[j].z + v[j].w * v[j].w); }
    const float rs = 1.0f / sqrtf(wave_sum(s) * (1.f / D) + EPS);
#pragma unroll
    for (int j = 0; j < 4; ++j) { const f32x4 ww = wr[64 * j]; const f32x4 o = v[j] * rs * ww;
        if (OUTF) ((f32x4*)frow + lane)[64 * j] = o;
        else ((v2u*)orow + lane)[64 * j] = (v2u){pk2(o.x, o.y), pk2(o.z, o.w)}; }
}

typedef GAS unsigned gu32;
#define RLX_AGENT __ATOMIC_RELAXED, __HIP_MEMORY_SCOPE_AGENT
#define XB_TMO      128
#define XB_XCNT(j)  (256  + 64 * (j))
#define XB_XSUB(j)  (1280 + 64 * (j))
#define XB_XGEN(j)  (2304 + 64 * (j))
#define XB_TOP      3328
#define XB_TOPGEN   3392
#define XCD_BAR_WORDS 3456
#define XB_SPIN_CAP (1u << 18)

__device__ __forceinline__ unsigned xb_ld(unsigned* p)              { return __hip_atomic_load(p, __ATOMIC_RELAXED, __HIP_MEMORY_SCOPE_AGENT); }
__device__ __forceinline__ unsigned xb_add(unsigned* p, unsigned v) { return __hip_atomic_fetch_add(p, v, __ATOMIC_RELAXED, __HIP_MEMORY_SCOPE_AGENT); }
__device__ __forceinline__ unsigned xb_xcc_id() { return (unsigned)__builtin_amdgcn_s_getreg((3 << 11) | 20) & 0xFu; }
#define XB_SPIN(cond, bar) do { unsigned _sp = 0; while (cond) { __builtin_amdgcn_s_sleep(1); \
    if ((++_sp & 255u) == 0u) { if (xb_ld(&(bar)[XB_TMO])) break; if (_sp > XB_SPIN_CAP) { atomicAdd(&(bar)[XB_TMO], 1u); break; } } } } while (0)

struct XcdBarrier {
    unsigned* bar; unsigned x;
    volatile LAS unsigned* st;
};

__device__ __forceinline__ XcdBarrier xcd_barrier_post(unsigned* bar, volatile LAS unsigned* st) {
    XcdBarrier b; b.bar = bar; b.x = xb_xcc_id(); b.st = st;
    if (threadIdx.x == 0) (void)xb_add(&bar[XB_XCNT(b.x)], 1u);
    return b;
}
__device__ __forceinline__ void xcd_barrier_complete(unsigned* bar, unsigned x, unsigned& nloc, unsigned& nx) {
    const unsigned G = gridDim.x * gridDim.y * gridDim.z;
    unsigned sum, cnt, mine, sp = 0u;
    for (;;) {
        sum = 0u; cnt = 0u; mine = 0u;
#pragma unroll
        for (unsigned j = 0; j < 16; ++j) { const unsigned c = xb_ld(&bar[XB_XCNT(j)]); sum += c; cnt += (c > 0u) ? 1u : 0u; mine = (j == x) ? c : mine; }
        if (sum == G) break;
        __builtin_amdgcn_s_sleep(1);
        if ((++sp & 255u) == 0u) { if (xb_ld(&bar[XB_TMO])) break; if (sp > XB_SPIN_CAP) { atomicAdd(&bar[XB_TMO], 1u); break; } }
    }
    nloc = mine > 0u ? mine : 1u; nx = cnt > 0u ? cnt : 1u;
}

__device__ __forceinline__ void xcd_barrier(const XcdBarrier& b) {
    asm volatile("s_waitcnt vmcnt(0)" ::: "memory");
    __syncthreads();
    if (threadIdx.x == 0) {
        unsigned* bar = b.bar;
        __builtin_amdgcn_s_waitcnt(0);
        unsigned nloc = b.st[0], nx = b.st[1];
        if (nloc == 0u) { xcd_barrier_complete(bar, b.x, nloc, nx); b.st[0] = nloc; b.st[1] = nx; }
        const unsigned old = xb_add(&bar[XB_XSUB(b.x)], 1u);
        const unsigned gen = old / nloc;
        if (old + 1u == (gen + 1u) * nloc) {
            __builtin_amdgcn_fence(__ATOMIC_RELEASE, "agent");
            asm volatile("s_waitcnt vmcnt(0)" ::: "memory");
            const unsigned og = xb_add(&bar[XB_TOP], 1u);
            const unsigned tg = og / nx;
            if (og + 1u == (tg + 1u) * nx) xb_add(&bar[XB_TOPGEN], 1u);
            else XB_SPIN(xb_ld(&bar[XB_TOPGEN]) == tg, bar);
            __builtin_amdgcn_fence(__ATOMIC_ACQUIRE, "agent");
            xb_add(&bar[XB_XGEN(b.x)], 1u);
            asm volatile("s_waitcnt vmcnt(0)" ::: "memory");
        } else {
            XB_SPIN(xb_ld(&bar[XB_XGEN(b.x)]) == gen, bar);
            __builtin_amdgcn_fence(__ATOMIC_ACQUIRE, "agent");
            asm volatile("s_waitcnt vmcnt(0)" ::: "memory");
        }
    }
    __syncthreads();
}
struct Args { const float* in[22]; float* out; unsigned char* ws; int ph_lo, ph_hi; };
struct PA { const float* const* in; float* out; unsigned char* ws; };

__device__ __forceinline__ void s5_prep(const float* const* in, unsigned char* ws, int t0, int nthreads) {
    const double TWO_PI = 6.283185307179586476925;
    for (int ec = t0; ec < DEPTH * 16 * 64 * 16; ec += nthreads) {
        const int e = ec >> 4, c = ec & 15;
        const int l = e >> 10, g = (e >> 6) & 15, p = e & 63;
        const double dt = (double)expf(in[12][l * 16 + g]);
        const double are = (double)in[6][e], aim = (double)in[7][e];
        const double mag = (double)expf((float)(dt * are));
        double tt = dt * aim * (1.0 / TWO_PI); tt -= __builtin_floor(tt);
        const float ang = (float)(tt * TWO_PI);
        const double abr = mag * (double)cosf(ang), abi = mag * (double)sinf(ang);
        const double den = are * are + aim * aim, nr = abr - 1.0, ni = abi;
        const double zr = (nr * are + ni * aim) / den, zi = (ni * are - nr * aim) / den;
        if (c == 0) {
            double pr = abr, pi = abi;
#pragma unroll
            for (int q = 0; q < 7; ++q) { const double r2 = pr * pr - pi * pi, i2 = 2.0 * pr * pi; pr = r2; pi = i2; }
            float* sa = (float*)(ws + WS_S5A) + (size_t)(l * 16 + g) * 256;
            sa[p] = (float)abr; sa[64 + p] = (float)abi; sa[128 + p] = (float)pr; sa[192 + p] = (float)pi;
        }
        bf16* bm = (bf16*)(ws + WS_S5B) + (size_t)(l * 16 + g) * 2048;
        const double br = in[8][(size_t)e * 16 + c], bi = in[9][(size_t)e * 16 + c];
        bm[p * 16 + c] = (bf16)f2bf((float)(zr * br - zi * bi)); bm[(64 + p) * 16 + c] = (bf16)f2bf((float)(zr * bi + zi * br));
        bf16* cm = (bf16*)(ws + WS_S5C) + (size_t)(l * 16 + g) * 2048;
        cm[c * 128 + p] = (bf16)f2bf(in[10][(size_t)(l * 16 + g) * 1024 + c * 64 + p]); cm[c * 128 + 64 + p] = (bf16)f2bf(-in[11][(size_t)(l * 16 + g) * 1024 + c * 64 + p]);
    }
}
__device__ __forceinline__ void prologue(const Args& a, LAS unsigned char* lds, int vcu, int G, int wave, int lane) {
    const bool defer_s5 = false;
    unsigned char* ws = a.ws;
    LAS float* scr = (LAS float*)(lds + wave * 16384);
    const int gw = vcu * NWAVES + wave, NGW = G * NWAVES;
    constexpr int I_IN = (D / 64) * (DIN / 64), I_OUT = (D / 64) * (D / 64), I_GLU = (256 / 64) * (256 / 64);
    constexpr int NITEMS = DEPTH * (I_IN + I_OUT + I_GLU);
    for (int it = gw; it < NITEMS; it += NGW) {
        int r = it; const int l = r / (I_IN + I_OUT + I_GLU); r -= l * (I_IN + I_OUT + I_GLU);
        if (r < I_IN) { p0_transpose_item(a.in[2] + (size_t)l * D * DIN, D, DIN, (bf16*)(ws + WS_WIN) + (size_t)l * DIN * D, scr, r, lane, a.in[1] + (size_t)l * D); continue; } r -= I_IN;
        if (r < I_OUT) { p0_transpose_item(a.in[3] + (size_t)l * D * D, D, D, (bf16*)(ws + WS_WOUT) + (size_t)l * D * D, scr, r, lane); continue; } r -= I_OUT;
        p0_transpose_item(a.in[14] + (size_t)l * 65536, 256, 256, (bf16*)(ws + WS_GLU) + (size_t)l * 65536, scr, r, lane);
    }
    for (int m = gw; m < M; m += 2 * NGW) {
        const int m2 = m + NGW; const bool has2 = m2 < M;
        const f32x4* x1 = (const f32x4*)(a.in[0] + (size_t)m * D) + lane; const f32x4* x2 = (const f32x4*)(a.in[0] + (size_t)(has2 ? m2 : m) * D) + lane;
        f32x4 v1[4], v2[4]; float s1 = 0.f, s2 = 0.f;
#pragma unroll
        for (int j = 0; j < 4; ++j) { v1[j] = __builtin_nontemporal_load(x1 + 64 * j); v2[j] = __builtin_nontemporal_load(x2 + 64 * j); }
#pragma unroll
        for (int j = 0; j < 4; ++j) { s1 += (v1[j].x * v1[j].x + v1[j].y * v1[j].y) + (v1[j].z * v1[j].z + v1[j].w * v1[j].w); s2 += (v2[j].x * v2[j].x + v2[j].y * v2[j].y) + (v2[j].z * v2[j].z + v2[j].w * v2[j].w);
            ((v2u*)((bf16*)(ws + WS_HRES) + (size_t)m * D) + lane)[64 * j] = (v2u){pk2(v1[j].x, v1[j].y), pk2(v1[j].z, v1[j].w)};
            if (has2) ((v2u*)((bf16*)(ws + WS_HRES) + (size_t)m2 * D) + lane)[64 * j] = (v2u){pk2(v2[j].x, v2[j].y), pk2(v2[j].z, v2[j].w)}; }
        s1 = wave_sum(s1); s2 = wave_sum(s2);
        if (lane == 0) { ((float*)(ws + WS_ROWSS0))[m] = s1; if (has2) ((float*)(ws + WS_ROWSS0))[m2] = s2; }
        if (lane == 0) { ((float*)(ws + WS_ROWSS))[m] = 0.f; ((float*)(ws + WS_ROWSS2))[m] = 0.f; if (has2) { ((float*)(ws + WS_ROWSS))[m2] = 0.f; ((float*)(ws + WS_ROWSS2))[m2] = 0.f; } }
    }
    const int gt = gw * 64 + lane, NGT = NGW * 64;
    const double TWO_PI = 6.283185307179586476925;
    for (int e = gt; e < 8192 * 8; e += NGT) {
        const int pos = e >> 3, i = e & 7;
        const double invf[8] = {1.0, 0.19392274474868576, 0.03760603093086393, 0.007292664737217109, 0.001414213562373095, 0.0002742481756762073, 5.318295896944988e-05, 1.031338537721246e-05};
        double inv = invf[0];
#pragma unroll
        for (int q = 1; q < 8; ++q) inv = (i == q) ? invf[q] : inv;
        double tt = (double)pos * inv * (1.0 / TWO_PI); tt -= __builtin_floor(tt);
        const float ang = (float)(tt * TWO_PI);
        float* rp = (float*)(ws + WS_ROPE) + (size_t)e * 2; rp[0] = cosf(ang); rp[1] = sinf(ang);
    }
    if (!defer_s5) s5_prep(a.in, ws, gt, NGT);
}

template <bool OUT> __device__ __forceinline__ void hgrn_item(const PA& a, LAS unsigned char* lds, int layer, int bh, int c, int tid, int wave, int lane) {
    const int b = bh >> 2, h = bh & 3;
    const bf16* PROJ = (const bf16*)(a.ws + WS_PROJ);
    float* HU = (float*)(a.ws + WS_HU); float* HA = (float*)(a.ws + WS_HA);
    LAS float* Fs = (LAS float*)lds; LAS float* Ks = Fs + 4096; LAS float* Vs = Ks + 4096; LAS float* Qs = Vs + 4096; LAS float* Ps = Qs + 4096;
    const size_t row0 = (size_t)b * T + (size_t)c * 128;
    float S[8];
#pragma unroll
    for (int j = 0; j < 8; ++j) S[j] = 0.f;
    if (OUT) {
        int cp = 0;
        for (; cp + 4 <= c; cp += 4) {
            float uu[4][8], aa[4][8];
#pragma unroll
            for (int q = 0; q < 4; ++q) {
                const float* U = HU + (size_t)(bh * 64 + cp + q) * 4096 + (size_t)(wave * 8) * 64 + lane; const float* A = HA + (size_t)(bh * 64 + cp + q) * 64 + wave * 8;
#pragma unroll
                for (int j = 0; j < 8; ++j) { uu[q][j] = U[j * 64]; aa[q][j] = A[j]; }
            }
#pragma unroll
            for (int q = 0; q < 4; ++q)
#pragma unroll
                for (int j = 0; j < 8; ++j) S[j] = aa[q][j] * S[j] + uu[q][j];
        }
        for (; cp < c; ++cp) {
            const float* U = HU + (size_t)(bh * 64 + cp) * 4096 + (size_t)(wave * 8) * 64 + lane; const float* A = HA + (size_t)(bh * 64 + cp) * 64 + wave * 8;
#pragma unroll
            for (int j = 0; j < 8; ++j) S[j] = A[j] * S[j] + U[j * 64];
        }
    }
    const int fcol = h * 64 + (tid & 7) * 8;
    float lb[8];
#pragma unroll
    for (int j = 0; j < 8; ++j) lb[j] = (layer == 0) ? 0.f : sigmf(a.in[4][256 + fcol + j] - a.in[4][fcol + j]);
    const float gnw = a.in[5][layer * 64 + lane];
    float aprod = 1.f;
    for (int sub = 0; sub < 2; ++sub) {
        __syncthreads();
        { const int t = tid >> 3; const bf16* pr = PROJ + (row0 + sub * 64 + t) * DIN + fcol;
          const v4u fw = *(const v4u*)(pr + 256), vw = *(const v4u*)(pr + 512);
          const unsigned fa[4] = {fw.x, fw.y, fw.z, fw.w}, va[4] = {vw.x, vw.y, vw.z, vw.w};
          float fo[8], ko[8], vo[8];
#pragma unroll
          for (int j = 0; j < 8; ++j) { const float x = (j & 1) ? bfhi(fa[j >> 1]) : bflo(fa[j >> 1]); const float sg = sigmf(x);
              fo[j] = lb[j] + (1.f - lb[j]) * sg; ko[j] = (1.f - lb[j]) * (1.f - sg); vo[j] = (j & 1) ? bfhi(va[j >> 1]) : bflo(va[j >> 1]); }
          LAS f32x4* d;
          d = (LAS f32x4*)(Fs + t * 64 + (tid & 7) * 8); d[0] = (f32x4){fo[0], fo[1], fo[2], fo[3]}; d[1] = (f32x4){fo[4], fo[5], fo[6], fo[7]};
          d = (LAS f32x4*)(Ks + t * 64 + (tid & 7) * 8); d[0] = (f32x4){ko[0], ko[1], ko[2], ko[3]}; d[1] = (f32x4){ko[4], ko[5], ko[6], ko[7]};
          d = (LAS f32x4*)(Vs + t * 64 + (tid & 7) * 8); d[0] = (f32x4){vo[0], vo[1], vo[2], vo[3]}; d[1] = (f32x4){vo[4], vo[5], vo[6], vo[7]};
          if (OUT) { const v4u qw = *(const v4u*)(pr); const unsigned qa[4] = {qw.x, qw.y, qw.z, qw.w}; float qo[8];
#pragma unroll
              for (int j = 0; j < 8; ++j) qo[j] = siluf((j & 1) ? bfhi(qa[j >> 1]) : bflo(qa[j >> 1]));
              d = (LAS f32x4*)(Qs + t * 64 + (tid & 7) * 8); d[0] = (f32x4){qo[0], qo[1], qo[2], qo[3]}; d[1] = (f32x4){qo[4], qo[5], qo[6], qo[7]}; }
        }
        __syncthreads();
        if (!OUT && tid < 64) { for (int t = 0; t < 64; ++t) aprod *= Fs[t * 64 + tid]; }
        for (int tb = 0; tb < 4; ++tb) {
#pragma unroll 4
            for (int tt = 0; tt < 16; ++tt) {
                const int t = tb * 16 + tt;
                const f32x4 f0 = *(const LAS f32x4*)(Fs + t * 64 + wave * 8), f1 = *(const LAS f32x4*)(Fs + t * 64 + wave * 8 + 4);
                const f32x4 k0 = *(const LAS f32x4*)(Ks + t * 64 + wave * 8), k1 = *(const LAS f32x4*)(Ks + t * 64 + wave * 8 + 4);
                const float v = Vs[t * 64 + lane];
                S[0] = f0[0] * S[0] + k0[0] * v; S[1] = f0[1] * S[1] + k0[1] * v; S[2] = f0[2] * S[2] + k0[2] * v; S[3] = f0[3] * S[3] + k0[3] * v;
                S[4] = f1[0] * S[4] + k1[0] * v; S[5] = f1[1] * S[5] + k1[1] * v; S[6] = f1[2] * S[6] + k1[2] * v; S[7] = f1[3] * S[7] + k1[3] * v;
                if (OUT) {
                    const f32x4 q0 = *(const LAS f32x4*)(Qs + t * 64 + wave * 8), q1 = *(const LAS f32x4*)(Qs + t * 64 + wave * 8 + 4);
                    const float p = ((q0[0] * S[0] + q0[1] * S[1]) + (q0[2] * S[2] + q0[3] * S[3])) + ((q1[0] * S[4] + q1[1] * S[5]) + (q1[2] * S[6] + q1[3] * S[7]));
                    Ps[(wave * 16 + tt) * 64 + lane] = p;
                }
            }
            if (OUT) {
                __syncthreads();
#pragma unroll
                for (int r = 0; r < 2; ++r) {
                    const int tt = wave + 8 * r; float o = 0.f;
#pragma unroll
                    for (int w2 = 0; w2 < 8; ++w2) o += Ps[(w2 * 16 + tt) * 64 + lane];
                    const float rs = 1.0f / sqrtf(wave_sum(o * o) * (1.f / 64.f) + EPS);
                    const size_t row = row0 + sub * 64 + tb * 16 + tt;
                    const float gt = siluf(bf1(PROJ[row * DIN + 768 + h * 64 + lane]));
                    ((bf16*)(a.ws + WS_MIX))[row * 1024 + h * 64 + lane] = (bf16)f2bf(o * rs * gnw * gt);
                }
                __syncthreads();
            }
        }
    }
    if (!OUT) {
        float* U = HU + (size_t)(bh * 64 + c) * 4096 + (size_t)(wave * 8) * 64 + lane;
#pragma unroll
        for (int j = 0; j < 8; ++j) U[j * 64] = S[j];
        if (tid < 64) HA[(size_t)(bh * 64 + c) * 64 + tid] = aprod;
    }
}

typedef unsigned short u16;
__device__ __forceinline__ bf16x8 pk8(const float* v) { v4u w = {pk2(v[0], v[1]), pk2(v[2], v[3]), pk2(v[4], v[5]), pk2(v[6], v[7])}; return __builtin_bit_cast(bf16x8, w); }
struct HRaw { v4u f[2], v[2], q[2], g[2]; };
template <bool OUT> __device__ __forceinline__ HRaw hgrn_load(const PA& a, int bh, int c, int wave, int lane) {
    const bf16* pr = (const bf16*)(a.ws + WS_PROJ) + ((size_t)(bh >> 2) * T + (size_t)c * 128 + wave * 16 + (lane >> 3)) * DIN + (bh & 3) * 64 + (lane & 7) * 8;
    HRaw r;
#pragma unroll
    for (int k = 0; k < 2; ++k) { r.f[k] = *(const v4u*)(pr + (size_t)(8 * k) * DIN + 256); r.v[k] = *(const v4u*)(pr + (size_t)(8 * k) * DIN + 512);
        if (OUT) { r.q[k] = *(const v4u*)(pr + (size_t)(8 * k) * DIN); r.g[k] = *(const v4u*)(pr + (size_t)(8 * k) * DIN + 768); } }
    return r;
}
template <bool OUT> __device__ __forceinline__ void hgrn_item2(const PA& a, LAS unsigned char* lds, int layer, int bh, int c, int wave, int lane, const HRaw& raw) {
    const int b = bh >> 2, h = bh & 3, item = bh * 64 + c;
    float* HU = (float*)(a.ws + WS_HU); float* HA = (float*)(a.ws + WS_HA);
    LAS unsigned char* wb = lds + wave * 12288;
    LAS bf16* QT = (LAS bf16*)wb; LAS bf16* KT = (LAS bf16*)(wb + 2304); LAS bf16* KHT = (LAS bf16*)(wb + 4608); LAS bf16* VT = (LAS bf16*)(wb + 7680); LAS bf16* P = (LAS bf16*)(wb + 10752);
    LAS float* DL = (LAS float*)(wb + 11520); LAS float* E7L = (LAS float*)(wb + 11776);
    LAS bf16* RF = (LAS bf16*)wb; LAS bf16* RV = (LAS bf16*)(wb + 2304); LAS bf16* RQ = (LAS bf16*)(wb + 4608);
    LAS bf16* GT = KHT; LAS bf16* OT = VT;
    LAS float* SBUF = (LAS float*)(lds + 98304); LAS float* DALL = (LAS float*)(lds + 114688);
    const int l15 = lane & 15, q = lane >> 4;
    const size_t row0 = (size_t)b * T + (size_t)c * 128 + wave * 16;
    const bf16x8 zero8 = {0, 0, 0, 0, 0, 0, 0, 0};
    const float lb = (layer == 0) ? 0.f : sigmf(a.in[4][256 + h * 64 + lane] - a.in[4][h * 64 + lane]);
    __syncthreads();
    {
        const int rr = lane >> 3, cc = (lane & 7) * 8;
#pragma unroll
        for (int k = 0; k < 2; ++k) { *(LAS v4u*)(RF + (rr + 8 * k) * 72 + cc) = raw.f[k]; *(LAS v4u*)(RV + (rr + 8 * k) * 72 + cc) = raw.v[k]; if (OUT) *(LAS v4u*)(RQ + (rr + 8 * k) * 72 + cc) = raw.q[k]; }
        LDS_WAIT();
        u16 fr[16], vr[16], qr[16];
#pragma unroll
        for (int t = 0; t < 16; ++t) { fr[t] = RF[t * 72 + lane]; vr[t] = RV[t * 72 + lane]; if (OUT) qr[t] = RQ[t * 72 + lane]; }
        LDS_WAIT();
        float cum[16], kk[16]; float run = 0.f;
#pragma unroll
        for (int t = 0; t < 16; ++t) { const float sg = sigmf(bf1(fr[t])); const float f = lb + (1.f - lb) * sg; kk[t] = (1.f - lb) * (1.f - sg); run += fmaxf(__logf(f), -69.f); cum[t] = run; }
        const float cl = cum[15], c7 = cum[7];
        DL[lane] = __expf(cl);
        if (OUT) E7L[lane] = __expf(c7); else DALL[wave * 64 + lane] = cl;
        float kh[16];
#pragma unroll
        for (int t = 0; t < 16; ++t) kh[t] = kk[t] * __expf(cl - cum[t]);
        *(LAS bf16x8*)(KHT + lane * 24) = pk8(kh); *(LAS bf16x8*)(KHT + lane * 24 + 8) = pk8(kh + 8);
        { v4u w0 = {(unsigned)vr[0] | ((unsigned)vr[1] << 16), (unsigned)vr[2] | ((unsigned)vr[3] << 16), (unsigned)vr[4] | ((unsigned)vr[5] << 16), (unsigned)vr[6] | ((unsigned)vr[7] << 16)};
          v4u w1 = {(unsigned)vr[8] | ((unsigned)vr[9] << 16), (unsigned)vr[10] | ((unsigned)vr[11] << 16), (unsigned)vr[12] | ((unsigned)vr[13] << 16), (unsigned)vr[14] | ((unsigned)vr[15] << 16)};
          *(LAS v4u*)(VT + lane * 24) = w0; *(LAS v4u*)(VT + lane * 24 + 8) = w1; }
        if (OUT) {
#pragma unroll
            for (int t = 0; t < 16; ++t) {
                QT[t * 72 + lane] = (bf16)f2bf(siluf(bf1(qr[t])) * __expf(fminf(cum[t] - c7, 60.f)));
                KT[t * 72 + lane] = (bf16)f2bf(kk[t] * __expf(fminf(c7 - cum[t], 60.f)));
            }
        }
    }
    LDS_WAIT();
    bf16x8 vfr[4];
#pragma unroll
    for (int nt = 0; nt < 4; ++nt) vfr[nt] = (q < 2) ? *(const LAS bf16x8*)(VT + (16 * nt + l15) * 24 + q * 8) : zero8;
    f32x4 U[4][4];
#pragma unroll
    for (int mt = 0; mt < 4; ++mt) { const bf16x8 afr = (q < 2) ? *(const LAS bf16x8*)(KHT + (16 * mt + l15) * 24 + q * 8) : zero8;
#pragma unroll
        for (int nt = 0; nt < 4; ++nt) U[mt][nt] = __builtin_amdgcn_mfma_f32_16x16x32_bf16(afr, vfr[nt], (f32x4){0.f, 0.f, 0.f, 0.f}, 0, 0, 0); }
    f32x4 o[4]; bf16x8 qf[2];
    if (OUT) {
        LDS_WAIT();
        { const int rr = lane >> 3, cc = (lane & 7) * 8; *(LAS v4u*)(GT + rr * 72 + cc) = raw.g[0]; *(LAS v4u*)(GT + (rr + 8) * 72 + cc) = raw.g[1]; }
        f32x4 sc = {0.f, 0.f, 0.f, 0.f};
#pragma unroll
        for (int ks = 0; ks < 2; ++ks) {
            const v2u qa = *(const LAS v2u*)(QT + l15 * 72 + 32 * ks + 4 * q), qb = *(const LAS v2u*)(QT + l15 * 72 + 32 * ks + 16 + 4 * q);
            const v2u ka = *(const LAS v2u*)(KT + l15 * 72 + 32 * ks + 4 * q), kb = *(const LAS v2u*)(KT + l15 * 72 + 32 * ks + 16 + 4 * q);
            qf[ks] = __builtin_bit_cast(bf16x8, (v4u){qa.x, qa.y, qb.x, qb.y});
            const bf16x8 kf = __builtin_bit_cast(bf16x8, (v4u){ka.x, ka.y, kb.x, kb.y});
            sc = __builtin_amdgcn_mfma_f32_16x16x32_bf16(qf[ks], kf, sc, 0, 0, 0);
        }
#pragma unroll
        for (int j = 0; j < 4; ++j) { const int t = 4 * q + j; P[t * 24 + l15] = (bf16)f2bf((l15 <= t) ? sc[j] : 0.f); }
        LDS_WAIT();
        const bf16x8 pf = (q < 2) ? *(const LAS bf16x8*)(P + l15 * 24 + q * 8) : zero8;
#pragma unroll
        for (int nt = 0; nt < 4; ++nt) o[nt] = __builtin_amdgcn_mfma_f32_16x16x32_bf16(pf, vfr[nt], (f32x4){0.f, 0.f, 0.f, 0.f}, 0, 0, 0);
    }
    {
        float S8[8];
#pragma unroll
        for (int i = 0; i < 8; ++i) S8[i] = 0.f;
        if (OUT) {
            const f32x4 h0 = *(const f32x4*)(HU + (size_t)item * 4096 + (size_t)((2 * wave) * 64 + lane) * 4), h1 = *(const f32x4*)(HU + (size_t)item * 4096 + (size_t)((2 * wave + 1) * 64 + lane) * 4);
            S8[0] = h0[0]; S8[1] = h0[1]; S8[2] = h0[2]; S8[3] = h0[3]; S8[4] = h1[0]; S8[5] = h1[1]; S8[6] = h1[2]; S8[7] = h1[3];
        }
        *(LAS f32x4*)(SBUF + ((2 * wave) * 64 + lane) * 4) = (f32x4){S8[0], S8[1], S8[2], S8[3]}; *(LAS f32x4*)(SBUF + ((2 * wave + 1) * 64 + lane) * 4) = (f32x4){S8[4], S8[5], S8[6], S8[7]};
    }
    __syncthreads();
    f32x4 Sp[4][4];
#pragma unroll 1
    for (int step = 0; step < 8; ++step) {
        if (wave == step) {
#pragma unroll
            for (int mt = 0; mt < 4; ++mt) { const f32x4 Dv = *(const LAS f32x4*)(DL + 16 * mt + 4 * q);
#pragma unroll
                for (int nt = 0; nt < 4; ++nt) {
                    Sp[mt][nt] = *(const LAS f32x4*)(SBUF + ((mt * 4 + nt) * 64 + lane) * 4);
                    U[mt][nt] = Dv * Sp[mt][nt] + U[mt][nt];
                    *(LAS f32x4*)(SBUF + ((mt * 4 + nt) * 64 + lane) * 4) = U[mt][nt];
                } }
        }
        __syncthreads();
    }
    if (OUT) {
#pragma unroll
        for (int mt = 0; mt < 4; ++mt) { const f32x4 Ev = *(const LAS f32x4*)(E7L + 16 * mt + 4 * q);
#pragma unroll
            for (int nt = 0; nt < 4; ++nt) Sp[mt][nt] = Sp[mt][nt] * Ev; }
#pragma unroll
        for (int nt = 0; nt < 4; ++nt)
#pragma unroll
            for (int ks = 0; ks < 2; ++ks) {
                const f32x4 s0 = Sp[2 * ks][nt], s1 = Sp[2 * ks + 1][nt];
                const bf16x8 bfrag = __builtin_bit_cast(bf16x8, (v4u){pk2(s0[0], s0[1]), pk2(s0[2], s0[3]), pk2(s1[0], s1[1]), pk2(s1[2], s1[3])});
                o[nt] = __builtin_amdgcn_mfma_f32_16x16x32_bf16(qf[ks], bfrag, o[nt], 0, 0, 0);
            }
        float gn[4];
#pragma unroll
        for (int nt = 0; nt < 4; ++nt) gn[nt] = a.in[5][layer * 64 + 16 * nt + l15];
#pragma unroll
        for (int j = 0; j < 4; ++j) {
            float ss = (o[0][j] * o[0][j] + o[1][j] * o[1][j]) + (o[2][j] * o[2][j] + o[3][j] * o[3][j]);
            ss += __shfl_xor(ss, 1); ss += __shfl_xor(ss, 2); ss += __shfl_xor(ss, 4); ss += __shfl_xor(ss, 8);
            const float rs = __builtin_amdgcn_rsqf(ss * (1.f / 64.f) + EPS);
#pragma unroll
            for (int nt = 0; nt < 4; ++nt) { const float gt = siluf(bf1(GT[(4 * q + j) * 72 + 16 * nt + l15]));
                OT[(4 * q + j) * 72 + 16 * nt + l15] = (bf16)f2bf(o[nt][j] * rs * gn[nt] * gt); }
        }
        LDS_WAIT();
        { const int rr = lane >> 3, cc = (lane & 7) * 8; bf16* mp = (bf16*)(a.ws + WS_MIX) + (row0 + rr) * 1024 + h * 64 + cc;
          *(v4u*)mp = *(const LAS v4u*)(OT + rr * 72 + cc); *(v4u*)(mp + 8 * 1024) = *(const LAS v4u*)(OT + (rr + 8) * 72 + cc); }
    } else {
        if (wave == 7) {
#pragma unroll
            for (int mt = 0; mt < 4; ++mt)
#pragma unroll
                for (int nt = 0; nt < 4; ++nt)
                    *(f32x4*)(HU + (size_t)item * 4096 + (size_t)((mt * 4 + nt) * 64 + lane) * 4) = U[mt][nt];
            float s = 0.f;
#pragma unroll
            for (int w2 = 0; w2 < 8; ++w2) s += DALL[w2 * 64 + lane];
            HA[(size_t)item * 64 + lane] = __expf(s);
        }
    }
}

template <bool OUT> __device__ __forceinline__ HRaw hgrn_loadc(const PA& a, int bh, int c, int chunk, int lane) {
    const bf16* pr = (const bf16*)(a.ws + WS_PROJ) + ((size_t)(bh >> 2) * T + (size_t)c * 128 + chunk * 16 + (lane >> 3)) * DIN + (bh & 3) * 64 + (lane & 7) * 8;
    HRaw r;
#pragma unroll
    for (int k = 0; k < 2; ++k) { r.f[k] = *(const v4u*)(pr + (size_t)(8 * k) * DIN + 256); r.v[k] = *(const v4u*)(pr + (size_t)(8 * k) * DIN + 512);
        if (OUT) { r.q[k] = *(const v4u*)(pr + (size_t)(8 * k) * DIN); } }
    return r;
}
template <bool OUT> __device__ __forceinline__ void hgrn_chunk(const PA& a, LAS unsigned char* wb, LAS float* DLk, LAS float* E7k, LAS float* DALLk, int layer, int h, int lane, const HRaw& raw,
                                                                f32x4 (&U)[4][4], f32x4 (&o)[4], bf16x8 (&qf)[2], float lb) {
    LAS bf16* QT = (LAS bf16*)wb; LAS bf16* KT = (LAS bf16*)(wb + 2304); LAS bf16* KHT = (LAS bf16*)(wb + 4608); LAS bf16* VT = (LAS bf16*)(wb + 7680); LAS bf16* P = (LAS bf16*)(wb + 10752);
    LAS bf16* RF = (LAS bf16*)wb; LAS bf16* RV = (LAS bf16*)(wb + 2304); LAS bf16* RQ = (LAS bf16*)(wb + 4608);
    const int l15 = lane & 15, q = lane >> 4;
    const bf16x8 zero8 = {0, 0, 0, 0, 0, 0, 0, 0};
    LDS_WAIT();
    {
        const int rr = lane >> 3, cc = (lane & 7) * 8;
#pragma unroll
        for (int k = 0; k < 2; ++k) { *(LAS v4u*)(RF + (rr + 8 * k) * 72 + cc) = raw.f[k]; *(LAS v4u*)(RV + (rr + 8 * k) * 72 + cc) = raw.v[k]; if (OUT) *(LAS v4u*)(RQ + (rr + 8 * k) * 72 + cc) = raw.q[k]; }
        LDS_WAIT();
        {
            u16 vr[16];
#pragma unroll
            for (int t = 0; t < 16; ++t) vr[t] = RV[t * 72 + lane];
            const v4u w0 = {(unsigned)vr[0] | ((unsigned)vr[1] << 16), (unsigned)vr[2] | ((unsigned)vr[3] << 16), (unsigned)vr[4] | ((unsigned)vr[5] << 16), (unsigned)vr[6] | ((unsigned)vr[7] << 16)};
            const v4u w1 = {(unsigned)vr[8] | ((unsigned)vr[9] << 16), (unsigned)vr[10] | ((unsigned)vr[11] << 16), (unsigned)vr[12] | ((unsigned)vr[13] << 16), (unsigned)vr[14] | ((unsigned)vr[15] << 16)};
            *(LAS v4u*)(VT + lane * 24) = w0; *(LAS v4u*)(VT + lane * 24 + 8) = w1;
        }
        float cum[16], kk[16]; float run = 0.f;
#pragma unroll
        for (int t = 0; t < 16; ++t) { const float sg = sigmf(bf1(RF[t * 72 + lane])); const float f = lb + (1.f - lb) * sg; kk[t] = (1.f - lb) * (1.f - sg); run += fmaxf(__logf(f), -69.f); cum[t] = run; }
        const float cl = cum[15], c7 = cum[7];
        DLk[lane] = __expf(cl);
        if (OUT) E7k[lane] = __expf(c7); else DALLk[lane] = cl;
        if (OUT) {
            float qv[16];
#pragma unroll
            for (int t = 0; t < 16; ++t) qv[t] = bf1(RQ[t * 72 + lane]);
            LDS_WAIT();
#pragma unroll
            for (int t = 0; t < 16; ++t) {
                QT[t * 72 + lane] = (bf16)f2bf(siluf(qv[t]) * __expf(fminf(cum[t] - c7, 60.f)));
                KT[t * 72 + lane] = (bf16)f2bf(kk[t] * __expf(fminf(c7 - cum[t], 60.f)));
            }
        }
        LDS_WAIT();
        float kh[16];
#pragma unroll
        for (int t = 0; t < 16; ++t) kh[t] = kk[t] * __expf(cl - cum[t]);
        *(LAS bf16x8*)(KHT + lane * 24) = pk8(kh); *(LAS bf16x8*)(KHT + lane * 24 + 8) = pk8(kh + 8);
    }
    LDS_WAIT();
    bf16x8 vfr[4];
#pragma unroll
    for (int nt = 0; nt < 4; ++nt) vfr[nt] = (q < 2) ? *(const LAS bf16x8*)(VT + (16 * nt + l15) * 24 + q * 8) : zero8;
#pragma unroll
    for (int mt = 0; mt < 4; ++mt) { const bf16x8 afr = (q < 2) ? *(const LAS bf16x8*)(KHT + (16 * mt + l15) * 24 + q * 8) : zero8;
#pragma unroll
        for (int nt = 0; nt < 4; ++nt) U[mt][nt] = __builtin_amdgcn_mfma_f32_16x16x32_bf16(afr, vfr[nt], (f32x4){0.f, 0.f, 0.f, 0.f}, 0, 0, 0); }
    if (OUT) {
        f32x4 sc = {0.f, 0.f, 0.f, 0.f};
#pragma unroll
        for (int ks = 0; ks < 2; ++ks) {
            const v2u qa = *(const LAS v2u*)(QT + l15 * 72 + 32 * ks + 4 * q), qb = *(const LAS v2u*)(QT + l15 * 72 + 32 * ks + 16 + 4 * q);
            const v2u ka = *(const LAS v2u*)(KT + l15 * 72 + 32 * ks + 4 * q), kb = *(const LAS v2u*)(KT + l15 * 72 + 32 * ks + 16 + 4 * q);
            qf[ks] = __builtin_bit_cast(bf16x8, (v4u){qa.x, qa.y, qb.x, qb.y});
            const bf16x8 kf = __builtin_bit_cast(bf16x8, (v4u){ka.x, ka.y, kb.x, kb.y});
            sc = __builtin_amdgcn_mfma_f32_16x16x32_bf16(qf[ks], kf, sc, 0, 0, 0);
        }
#pragma unroll
        for (int j = 0; j < 4; ++j) { const int t = 4 * q + j; P[t * 24 + l15] = (bf16)f2bf((l15 <= t) ? sc[j] : 0.f); }
        LDS_WAIT();
        const bf16x8 pf = (q < 2) ? *(const LAS bf16x8*)(P + l15 * 24 + q * 8) : zero8;
#pragma unroll
        for (int nt = 0; nt < 4; ++nt) o[nt] = __builtin_amdgcn_mfma_f32_16x16x32_bf16(pf, vfr[nt], (f32x4){0.f, 0.f, 0.f, 0.f}, 0, 0, 0);
    }
}
__device__ __forceinline__ void hgrn_ointer(f32x4 (&o)[4], const bf16x8 (&qf)[2], const f32x4 (&S)[4][4], const f32x4 (&sc)[4]) {
#pragma unroll
    for (int nt = 0; nt < 4; ++nt)
#pragma unroll
        for (int ks = 0; ks < 2; ++ks) {
            const f32x4 s0 = S[2 * ks][nt] * sc[2 * ks], s1 = S[2 * ks + 1][nt] * sc[2 * ks + 1];
            const bf16x8 bfrag = __builtin_bit_cast(bf16x8, (v4u){pk2(s0[0], s0[1]), pk2(s0[2], s0[3]), pk2(s1[0], s1[1]), pk2(s1[2], s1[3])});
            o[nt] = __builtin_amdgcn_mfma_f32_16x16x32_bf16(qf[ks], bfrag, o[nt], 0, 0, 0);
        }
}
#define HG_LAUNDER() do { asm volatile("" : "+v"(lane)); l15 = lane & 15; q = lane >> 4; } while (0)
template <bool OUT> __device__ __forceinline__ void hgrn_pair(const PA& a, LAS unsigned char* lds, int layer, int bh, int s, int wave, int lane) {
    const int half = wave >> 2, wl = wave & 3, c = half ? 63 - s : s, b = bh >> 2, h = bh & 3, item = bh * 64 + c;
    float* HU = (float*)(a.ws + WS_HU); float* HA = (float*)(a.ws + WS_HA);
    LAS unsigned char* wb = lds + wave * 12800;
    LAS float* DLs = (LAS float*)(wb + 11520);
    LAS float* SBUF = (LAS float*)(lds + 102400 + half * 16384);
    LAS float* DALL = (LAS float*)(lds + 135168 + half * 2048);
    int l15 = lane & 15, q = lane >> 4;
    const size_t rowc0 = (size_t)b * T + (size_t)c * 128 + (size_t)(2 * wl) * 16;
    const float lbp = (layer == 0) ? 0.f : sigmf(a.in[4][256 + h * 64 + lane] - a.in[4][h * 64 + lane]);
    __syncthreads();
    f32x4 U0[4][4], Up[4][4], o[2][4]; bf16x8 qf[2][2];
    { const HRaw r0 = hgrn_loadc<OUT>(a, bh, c, 2 * wl, lane); hgrn_chunk<OUT>(a, wb, DLs, DLs + 128, DALL + (2 * wl) * 64, layer, h, lane, r0, U0, o[0], qf[0], lbp); }
    asm volatile("" ::: "memory"); __builtin_amdgcn_sched_barrier(0); HG_LAUNDER();
    { const HRaw r1 = hgrn_loadc<OUT>(a, bh, c, 2 * wl + 1, lane); hgrn_chunk<OUT>(a, wb, DLs + 64, DLs + 192, DALL + (2 * wl + 1) * 64, layer, h, lane, r1, Up, o[1], qf[1], lbp); }
    asm volatile("" ::: "memory"); __builtin_amdgcn_sched_barrier(0); HG_LAUNDER();
    LDS_WAIT();
    if (OUT) { f32x4 E1[4];
#pragma unroll
        for (int mt = 0; mt < 4; ++mt) E1[mt] = *(const LAS f32x4*)(DLs + 192 + 16 * mt + 4 * q);
        hgrn_ointer(o[1], qf[1], U0, E1); }
#pragma unroll
    for (int mt = 0; mt < 4; ++mt) { const f32x4 D1 = *(const LAS f32x4*)(DLs + 64 + 16 * mt + 4 * q);
#pragma unroll
        for (int nt = 0; nt < 4; ++nt) Up[mt][nt] = D1 * U0[mt][nt] + Up[mt][nt]; }
    HG_LAUNDER();
#pragma unroll
    for (int i = 0; i < 4; ++i) { f32x4 hv = {0.f, 0.f, 0.f, 0.f};
        if (OUT) hv = *(const f32x4*)(HU + (size_t)item * 4096 + (size_t)((4 * wl + i) * 64 + lane) * 4);
        *(LAS f32x4*)(SBUF + ((4 * wl + i) * 64 + lane) * 4) = hv; }
    v4u gq[2][2];
    if (OUT) { const bf16* gp = (const bf16*)(a.ws + WS_PROJ) + (rowc0 + (lane >> 3)) * DIN + 768 + h * 64 + (lane & 7) * 8;
#pragma unroll
        for (int k = 0; k < 2; ++k) { gq[k][0] = *(const v4u*)(gp + (size_t)(16 * k) * DIN); gq[k][1] = *(const v4u*)(gp + (size_t)(16 * k + 8) * DIN); } }
    __syncthreads();
    HG_LAUNDER();
    f32x4 Sin[4][4];
#pragma unroll 1
    for (int step = 0; step < 4; ++step) {
        if (wl == step) {
#pragma unroll
            for (int mt = 0; mt < 4; ++mt) { const f32x4 Dp = *(const LAS f32x4*)(DLs + 16 * mt + 4 * q) * *(const LAS f32x4*)(DLs + 64 + 16 * mt + 4 * q);
#pragma unroll
                for (int nt = 0; nt < 4; ++nt) {
                    Sin[mt][nt] = *(const LAS f32x4*)(SBUF + ((mt * 4 + nt) * 64 + lane) * 4);
                    Up[mt][nt] = Dp * Sin[mt][nt] + Up[mt][nt];
                    *(LAS f32x4*)(SBUF + ((mt * 4 + nt) * 64 + lane) * 4) = Up[mt][nt];
                } }
        }
        __syncthreads();
    }
    HG_LAUNDER();
    if (OUT) {
        { f32x4 E0[4];
#pragma unroll
          for (int mt = 0; mt < 4; ++mt) E0[mt] = *(const LAS f32x4*)(DLs + 128 + 16 * mt + 4 * q);
          hgrn_ointer(o[0], qf[0], Sin, E0);
#pragma unroll
          for (int mt = 0; mt < 4; ++mt) E0[mt] = *(const LAS f32x4*)(DLs + 192 + 16 * mt + 4 * q) * *(const LAS f32x4*)(DLs + 16 * mt + 4 * q);
          hgrn_ointer(o[1], qf[1], Sin, E0); }
        HG_LAUNDER();
        LAS bf16* GT = (LAS bf16*)(wb + 4608); LAS bf16* OT = (LAS bf16*)(wb + 7680);
        float gn[4];
#pragma unroll
        for (int nt = 0; nt < 4; ++nt) gn[nt] = a.in[5][layer * 64 + 16 * nt + l15];
#pragma unroll
        for (int k = 0; k < 2; ++k) {
            const int rr = lane >> 3, cc = (lane & 7) * 8;
            LDS_WAIT();
            *(LAS v4u*)(GT + rr * 72 + cc) = gq[k][0]; *(LAS v4u*)(GT + (rr + 8) * 72 + cc) = gq[k][1];
            LDS_WAIT();
#pragma unroll
            for (int j = 0; j < 4; ++j) {
                float ss = (o[k][0][j] * o[k][0][j] + o[k][1][j] * o[k][1][j]) + (o[k][2][j] * o[k][2][j] + o[k][3][j] * o[k][3][j]);
                ss += __shfl_xor(ss, 1); ss += __shfl_xor(ss, 2); ss += __shfl_xor(ss, 4); ss += __shfl_xor(ss, 8);
                const float rs = __builtin_amdgcn_rsqf(ss * (1.f / 64.f) + EPS);
#pragma unroll
                for (int nt = 0; nt < 4; ++nt) { const float gt = siluf(bf1(GT[(4 * q + j) * 72 + 16 * nt + l15]));
                    OT[(4 * q + j) * 72 + 16 * nt + l15] = (bf16)f2bf(o[k][nt][j] * rs * gn[nt] * gt); }
            }
            LDS_WAIT();
            bf16* mp = (bf16*)(a.ws + WS_MIX) + (rowc0 + k * 16 + rr) * 1024 + h * 64 + cc;
            *(v4u*)mp = *(const LAS v4u*)(OT + rr * 72 + cc); *(v4u*)(mp + 8 * 1024) = *(const LAS v4u*)(OT + (rr + 8) * 72 + cc);
        }
    } else {
        if (wl == 3) {
#pragma unroll
            for (int mt = 0; mt < 4; ++mt)
#pragma unroll
                for (int nt = 0; nt < 4; ++nt)
                    *(f32x4*)(HU + (size_t)item * 4096 + (size_t)((mt * 4 + nt) * 64 + lane) * 4) = Up[mt][nt];
            float sm = 0.f;
#pragma unroll
            for (int w2 = 0; w2 < 8; ++w2) sm += DALL[w2 * 64 + lane];
            HA[(size_t)item * 64 + lane] = __expf(sm);
        }
    }
}

__device__ __forceinline__ float gelu_tanh(float y) { const float z = 0.7978845608028654f * (y + 0.044715f * y * y * y); return y * sigmf(2.f * z); }
template <bool OUT> __device__ __forceinline__ void s5_item(const PA& a, LAS unsigned char* lds, int layer, int item, int wave, int lane) {
    const int b = item >> 10, g = (item >> 6) & 15, c = item & 63, lg = layer * 16 + g;
    const bf16* PROJ = (const bf16*)(a.ws + WS_PROJ);
    const float* sa = (const float*)(a.ws + WS_S5A) + (size_t)lg * 256;
    float* XL = (float*)(a.ws + WS_XLOC) + (size_t)((b * 16 + g) * 64) * 128;
    const float ar = sa[lane], ai = sa[64 + lane];
    float xr = 0.f, xi = 0.f;
    if (OUT) { xr = XL[c * 128 + lane]; xi = XL[c * 128 + 64 + lane]; }
    const int l15 = lane & 15, quad = lane >> 4;
    const bf16x8 zero8 = {0, 0, 0, 0, 0, 0, 0, 0};
    bf16x8 bfr[8];
#pragma unroll
    for (int nt = 0; nt < 8; ++nt) bfr[nt] = (quad < 2) ? *(const bf16x8*)((const bf16*)(a.ws + WS_S5B) + (size_t)lg * 2048 + (nt * 16 + l15) * 16 + quad * 8) : zero8;
    bf16x8 cfr[4];
    if (OUT) {
#pragma unroll
        for (int ks = 0; ks < 4; ++ks) cfr[ks] = *(const bf16x8*)((const bf16*)(a.ws + WS_S5C) + (size_t)lg * 2048 + l15 * 128 + ks * 32 + quad * 8);
    }
    const float dsk = a.in[13][layer * 256 + g * 16 + l15];
    LAS float* BU = (LAS float*)(lds + wave * 12800);
    LAS bf16* X = (LAS bf16*)(lds + wave * 12800 + 8448);
    const size_t rowb = (size_t)b * T + (size_t)c * 128;
    bf16x8 afr_n = (quad < 2) ? *(const bf16x8*)(PROJ + (rowb + l15) * DIN + 1024 + g * 16 + quad * 8) : zero8;
    bf16 ue_n[4] = {0, 0, 0, 0}, se_n[4] = {0, 0, 0, 0};
    if (OUT) {
#pragma unroll
        for (int j = 0; j < 4; ++j) { ue_n[j] = PROJ[(rowb + quad * 4 + j) * DIN + 1024 + g * 16 + l15]; se_n[j] = PROJ[(rowb + quad * 4 + j) * DIN + 1280 + g * 16 + l15]; }
    }
    f32x4 accn[8];
#pragma unroll
    for (int nt = 0; nt < 8; ++nt) accn[nt] = __builtin_amdgcn_mfma_f32_16x16x32_bf16(afr_n, bfr[nt], (f32x4){0.f, 0.f, 0.f, 0.f}, 0, 0, 0);
#pragma unroll
    for (int nt = 0; nt < 8; ++nt)
#pragma unroll
        for (int j = 0; j < 4; ++j) BU[(quad * 4 + j) * 132 + nt * 16 + l15] = accn[nt][j];
    afr_n = (quad < 2) ? *(const bf16x8*)(PROJ + (rowb + 16 + l15) * DIN + 1024 + g * 16 + quad * 8) : zero8;
    for (int blk = 0; blk < 8; ++blk) {
        const size_t row0 = rowb + blk * 16;
        bf16 ue[4], se[4];
#pragma unroll
        for (int j = 0; j < 4; ++j) { ue[j] = ue_n[j]; se[j] = se_n[j]; }
        if (blk + 1 < 8) {
#pragma unroll
            for (int nt = 0; nt < 8; ++nt) accn[nt] = __builtin_amdgcn_mfma_f32_16x16x32_bf16(afr_n, bfr[nt], (f32x4){0.f, 0.f, 0.f, 0.f}, 0, 0, 0);
            if (blk + 2 < 8) afr_n = (quad < 2) ? *(const bf16x8*)(PROJ + (row0 + 32 + l15) * DIN + 1024 + g * 16 + quad * 8) : zero8;
            if (OUT) {
#pragma unroll
                for (int j = 0; j < 4; ++j) { ue_n[j] = PROJ[(row0 + 16 + quad * 4 + j) * DIN + 1024 + g * 16 + l15]; se_n[j] = PROJ[(row0 + 16 + quad * 4 + j) * DIN + 1280 + g * 16 + l15]; }
            }
        }
#pragma unroll
        for (int t = 0; t < 16; ++t) {
            const float br = BU[t * 132 + lane], bi = BU[t * 132 + 64 + lane];
            const float nr = ar * xr - ai * xi + br, ni = ar * xi + ai * xr + bi; xr = nr; xi = ni;
            if (OUT) { X[t * 136 + lane] = (bf16)f2bf(xr); X[t * 136 + 64 + lane] = (bf16)f2bf(xi); }
        }
        if (blk + 1 < 8) {
#pragma unroll
            for (int nt = 0; nt < 8; ++nt)
#pragma unroll
                for (int j = 0; j < 4; ++j) BU[(quad * 4 + j) * 132 + nt * 16 + l15] = accn[nt][j];
        }
        if (OUT) {
            f32x4 acc = {0.f, 0.f, 0.f, 0.f};
#pragma unroll
            for (int ks = 0; ks < 4; ++ks) { const bf16x8 xa = *(const LAS bf16x8*)(X + l15 * 136 + ks * 32 + quad * 8); acc = __builtin_amdgcn_mfma_f32_16x16x32_bf16(xa, cfr[ks], acc, 0, 0, 0); }
#pragma unroll
            for (int j = 0; j < 4; ++j) { const size_t row = row0 + quad * 4 + j;
                const float u = bf1(ue[j]);
                const float yg = gelu_tanh(acc[j] + dsk * u);
                ((bf16*)(a.ws + WS_YG))[row * 256 + g * 16 + l15] = (bf16)f2bf(yg);
                ((bf16*)(a.ws + WS_YGS))[row * 256 + g * 16 + l15] = (bf16)f2bf(yg * siluf(bf1(se[j]))); }
        }
    }
    LDS_WAIT();
    if (!OUT) { XL[c * 128 + lane] = xr; XL[c * 128 + 64 + lane] = xi; }
}


__device__ __forceinline__ void hgrn_scan(const PA& a, int task, int lane) {
    float* HU = (float*)(a.ws + WS_HU); const float* HA = (const float*)(a.ws + WS_HA);
    const int bh = task >> 6, r = task & 63, dk = 16 * (r >> 4) + 4 * (r & 3) + (lane & 3);
    float* up = HU + (size_t)(bh * 64) * 4096 + (size_t)r * 64 + lane; const float* ap = HA + (size_t)(bh * 64) * 64 + dk;
    float S = 0.f;
#pragma unroll 1
    for (int c0 = 0; c0 < 64; c0 += 32) {
        float u[32], av[32];
#pragma unroll
        for (int i = 0; i < 32; ++i) { u[i] = up[(size_t)(c0 + i) * 4096]; av[i] = ap[(size_t)(c0 + i) * 64]; }
#pragma unroll
        for (int i = 0; i < 32; ++i) { __hip_atomic_store(up + (size_t)(c0 + i) * 4096, S, __ATOMIC_RELAXED, __HIP_MEMORY_SCOPE_AGENT); S = av[i] * S + u[i]; }
    }
}
__device__ __forceinline__ void s5_scan(const PA& a, int layer, int task, int lane) {
    const int g = task & 15;
    const float* sa = (const float*)(a.ws + WS_S5A) + (size_t)(layer * 16 + g) * 256;
    float* XL = (float*)(a.ws + WS_XLOC) + (size_t)(task * 64) * 128;
    const float Lr = sa[128 + lane], Li = sa[192 + lane];
    float xr = 0.f, xi = 0.f;
#pragma unroll 1
    for (int c0 = 0; c0 < 64; c0 += 32) {
        float lr[32], li[32];
#pragma unroll
        for (int i = 0; i < 32; ++i) { lr[i] = XL[(c0 + i) * 128 + lane]; li[i] = XL[(c0 + i) * 128 + 64 + lane]; }
#pragma unroll
        for (int i = 0; i < 32; ++i) { __hip_atomic_store(XL + (c0 + i) * 128 + lane, xr, __ATOMIC_RELAXED, __HIP_MEMORY_SCOPE_AGENT); __hip_atomic_store(XL + (c0 + i) * 128 + 64 + lane, xi, __ATOMIC_RELAXED, __HIP_MEMORY_SCOPE_AGENT);
            const float nr = Lr * xr - Li * xi + lr[i], ni = Lr * xi + Li * xr + li[i]; xr = nr; xi = ni; }
    }
}
template <int NR> __device__ __forceinline__ void combine_rows(const PA& a, int layer, float lam, float post, size_t row0, size_t rstride, int lane) {
    const bf16* O = (const bf16*)(a.ws + WS_O); const bf16* PROJ = (const bf16*)(a.ws + WS_PROJ);
    const int h = lane >> 4, e0 = (lane & 15) * 8, j = e0 >> 6, d = e0 & 63;
    v4u o0[NR], o1[NR], gv[NR];
#pragma unroll
    for (int r = 0; r < NR; ++r) { const size_t row = row0 + r * rstride;
        o0[r] = *(const v4u*)(O + row * 1024 + (h * 4 + j) * 64 + d); o1[r] = *(const v4u*)(O + row * 1024 + (h * 4 + 2 + j) * 64 + d); gv[r] = *(const v4u*)(PROJ + row * DIN + 3072 + h * 128 + e0); }
    const f32x4 sw0 = *(const f32x4*)(a.in[20] + layer * 128 + e0), sw1 = *(const f32x4*)(a.in[20] + layer * 128 + e0 + 4);
    const float sw[8] = {sw0[0], sw0[1], sw0[2], sw0[3], sw1[0], sw1[1], sw1[2], sw1[3]};
#pragma unroll
    for (int r = 0; r < NR; ++r) { const size_t row = row0 + r * rstride;
        const unsigned a0[4] = {o0[r].x, o0[r].y, o0[r].z, o0[r].w}, a1[4] = {o1[r].x, o1[r].y, o1[r].z, o1[r].w}, ga[4] = {gv[r].x, gv[r].y, gv[r].z, gv[r].w};
        float v[8]; float ss = 0.f;
#pragma unroll
        for (int q = 0; q < 8; ++q) { const float x0 = (q & 1) ? bfhi(a0[q >> 1]) : bflo(a0[q >> 1]), x1 = (q & 1) ? bfhi(a1[q >> 1]) : bflo(a1[q >> 1]); v[q] = x0 - lam * x1; ss += v[q] * v[q]; }
        ss += __shfl_xor(ss, 1); ss += __shfl_xor(ss, 2); ss += __shfl_xor(ss, 4); ss += __shfl_xor(ss, 8);
        const float rs = post * __builtin_amdgcn_rsqf(ss * (1.f / 128.f) + EPS);
        float o[8];
#pragma unroll
        for (int q = 0; q < 8; ++q) { const float gq = (q & 1) ? bfhi(ga[q >> 1]) : bflo(ga[q >> 1]); o[q] = v[q] * rs * sw[q] * siluf(gq); }
        *(v4u*)((bf16*)(a.ws + WS_MIX) + row * 1024 + 512 + h * 128 + e0) = (v4u){pk2(o[0], o[1]), pk2(o[2], o[3]), pk2(o[4], o[5]), pk2(o[6], o[7])};
    }
}

__global__ void __launch_bounds__(NWAVES * 64, 2) hymba_fwd(Args args) {
    extern __shared__ __attribute__((aligned(16))) unsigned char lds_raw[];
    LAS unsigned char* lds = (LAS unsigned char*)lds_raw;
    cg::grid_group grid = cg::this_grid();
    int tid = threadIdx.x, lane = tid & 63, wave = __builtin_amdgcn_readfirstlane(tid >> 6);
#define RELAUNDER() do { int t_ = threadIdx.x; asm volatile("" : "+v"(t_)); tid = t_; lane = tid & 63; wave = __builtin_amdgcn_readfirstlane(tid >> 6); } while (0)
    const int G = gridDim.x, bx = blockIdx.x, vcu = (G % 8 == 0) ? (bx % 8) * (G / 8) + bx / 8 : bx;
    unsigned char* ws = args.ws;
    const int lo = args.ph_lo, hi = args.ph_hi;
    volatile LAS unsigned* MISC = (volatile LAS unsigned*)(lds + LDS_BYTES - 256);
    if (tid < 32) MISC[tid] = 0u;
    __syncthreads();
    unsigned* barw = (unsigned*)(ws + WS_CTL);
    XcdBarrier bar; bar.bar = barw; bar.x = 0; bar.st = MISC + 8;
    int ph = 0;
#ifndef MK_DIS
#define MK_DIS 0
#endif
#define EN(bit) (!((MK_DIS >> (bit)) & 1))
#ifndef MK_REP
#define MK_REP 0
#endif
#define REPS(bit) for (int rep_ = 0; rep_ < 1 + ((MK_REP >> (bit)) & 1); ++rep_)
#define IN(k) (lo <= (k) && (k) < hi)
#define SEAM() do { if (IN(ph) && IN(ph + 1)) { xcd_barrier(bar); if ((MK_REP >> 10) & 1) xcd_barrier(bar); } ++ph; RELAUNDER(); } while (0)
    bf16* PROJ = (bf16*)(ws + WS_PROJ); bf16* XN = (bf16*)(ws + WS_XN); bf16* MIX = (bf16*)(ws + WS_MIX);
    const int NGW = G * NWAVES;
#define gw (vcu * NWAVES + wave)

    const float** tabw = (const float**)(ws + WS_TAB);
    bar = xcd_barrier_post(barw, MISC + 8);
    if (IN(ph) && EN(0)) { if (bx == 0) {
            if (tid == 0) {
#pragma unroll
                for (int i = 0; i < 22; ++i) tabw[i] = args.in[i]; } }
        REPS(0) { __syncthreads(); prologue(args, lds, vcu, G, wave, lane); } }
    const PA pa{(const float* const*)tabw, args.out, ws};
    if (lo < 0) grid.sync();
    SEAM();
    for (int layer = 0; layer < DEPTH; ++layer) {
        if (IN(ph) && EN(1)) REPS(1) {
            pg8::Gemm g{(const bf16*)(ws + WS_HRES), (const bf16*)(ws + WS_WIN) + (size_t)layer * DIN * D, M, DIN, D}; pg8::StaticOrder S; S.init(M, DIN, G, bx);
            pg8::EpiInProj E{PROJ, (const float*)(ws + WS_ROPE), attn_body::C2, layer == 0 ? (const float*)(ws + WS_ROWSS0) : (const float*)(ws + WS_ROWSS), (unsigned*)(ws + WS_SUCNT) + layer * 64};
            pg8::gemm_phase<pg8::EpiInProj, pg8::StaticOrder, PG8_ALIGN, PG8_SP2>(lds, g, S, E);
            if (G == 256 && bx >= 128) {
                __syncthreads();
                if (wave == 0) { unsigned* sucnt = (unsigned*)(ws + WS_SUCNT) + layer * 64; unsigned spins = 0;
                    while ((unsigned)__builtin_amdgcn_readfirstlane(__hip_atomic_load(sucnt, __ATOMIC_RELAXED, __HIP_MEMORY_SCOPE_AGENT)) < 512u) { __builtin_amdgcn_s_sleep(4); if (++spins > (1u << 22)) break; }
                    __builtin_amdgcn_fence(__ATOMIC_ACQUIRE, "agent"); asm volatile("s_waitcnt vmcnt(0)" ::: "memory"); }
                __syncthreads();
                RELAUNDER();
                for (int it = (bx - 128) * NWAVES + wave; it < 2048; it += 128 * NWAVES) s5_item<false>(pa, lds, layer, it, wave, lane);
            }
        }
        SEAM();
        if (IN(ph)) {
            if (EN(2) && G != 256) REPS(2) for (int it = gw; it < 2048; it += NGW) s5_item<false>(pa, lds, layer, it, wave, lane);
            RELAUNDER();
            if (EN(3)) REPS(3) for (int v = vcu; v < 256; v += G) hgrn_pair<false>(pa, lds, layer, v >> 5, v & 31, wave, lane);
            xcd_barrier(bar);
            unsigned* scnt = (unsigned*)(ws + WS_SCNT) + layer * 64;
            { unsigned ndone = 0;
              if (wave < 2) { for (int t2 = wave * G + vcu; t2 < 512; t2 += 2 * G) { hgrn_scan(pa, t2, lane); ++ndone; } }
              else if (wave == 2) { for (int t2 = vcu; t2 < 32; t2 += G) { s5_scan(pa, layer, t2, lane); ++ndone; } }
              if (ndone) { asm volatile("s_waitcnt vmcnt(0)" ::: "memory"); if (lane == 0) (void)__hip_atomic_fetch_add(scnt, ndone, __ATOMIC_RELAXED, __HIP_MEMORY_SCOPE_AGENT); } }
            __syncthreads();
            const attn_body::AttnTensors AT{(const attn_body::bf16*)PROJ, (const attn_body::bf16*)PROJ, (const attn_body::bf16*)PROJ, (attn_body::bf16*)(ws + WS_O)};
            if (EN(4)) REPS(4) for (int v = vcu; v < 256; v += G) { const attn_body::StaticOrder S(v); attn_body::attn_phase<attn_body::StaticOrder>((char*)lds_raw, AT, S); }
        }
        ++ph; RELAUNDER();
        if (IN(ph)) {
            __syncthreads();
            if (wave == 0) { unsigned* scnt = (unsigned*)(ws + WS_SCNT) + layer * 64; unsigned spins = 0;
                while ((unsigned)__builtin_amdgcn_readfirstlane(__hip_atomic_load(scnt, __ATOMIC_RELAXED, __HIP_MEMORY_SCOPE_AGENT)) < 544u) { __builtin_amdgcn_s_sleep(4); if (++spins > (1u << 22)) break; }
                __builtin_amdgcn_fence(__ATOMIC_ACQUIRE, "agent"); asm volatile("s_waitcnt vmcnt(0)" ::: "memory"); }
            __syncthreads();
            if (EN(5)) REPS(5) for (int it = gw; it < 2048; it += NGW) s5_item<true>(pa, lds, layer, it, wave, lane);
            RELAUNDER();
            if (EN(6)) REPS(6) for (int v = vcu; v < 256; v += G) { const int bh = v >> 5, s = v & 31; const HRaw r1 = hgrn_load<true>(pa, bh, s, wave, lane), r2 = hgrn_load<true>(pa, bh, 63 - s, wave, lane); hgrn_item2<true>(pa, lds, layer, bh, s, wave, lane, r1); hgrn_item2<true>(pa, lds, layer, bh, 63 - s, wave, lane, r2); }
        }
        SEAM();
        const int cb0 = (G > 64) ? 64 : 0;
        if (IN(ph) && bx >= cb0) {
            const float l1 = wave_sum(pa.in[16][layer * 64 + lane] * pa.in[17][layer * 64 + lane]), l2 = wave_sum(pa.in[18][layer * 64 + lane] * pa.in[19][layer * 64 + lane]);
            const float linit = (layer == 0) ? 0.2f : 0.35550906759096934f;
            const float lam = __expf(l1) - __expf(l2) + linit;
            if (EN(7)) REPS(7) { const int nw_ = (G - cb0) * NWAVES; int m = (bx - cb0) * NWAVES + wave;
                for (; m + 3 * nw_ < M; m += 4 * nw_) combine_rows<4>(pa, layer, lam, 1.f - linit, (size_t)m, (size_t)nw_, lane);
                for (; m < M; m += nw_) combine_rows<1>(pa, layer, lam, 1.f - linit, (size_t)m, 0, lane); }
        }
        if (IN(ph) && EN(8) && (bx < 64 || G <= 64)) REPS(8) {
            __syncthreads();
            int kglu = 256; asm volatile("" : "+s"(kglu));
            pg8::Gemm g{(const bf16*)(ws + WS_YG), (const bf16*)(ws + WS_GLU) + (size_t)layer * 65536, M, 256, kglu}; pg8::StaticOrder S; S.init(M, 256, G, bx);
            pg8::EpiGlu E{(const bf16*)(ws + WS_YGS), pa.in[15] + layer * 256, MIX};
            pg8::gemm_phase<pg8::EpiGlu, pg8::StaticOrder, PG8_ALIGN, PG8_SP2>(lds, g, S, E);
        }
        SEAM();
        if (IN(ph) && EN(9)) for (int rep_ = 0; rep_ < 1 + (((MK_REP >> 9) & 1) && layer == 0); ++rep_) {
            pg8::Gemm g{MIX, (const bf16*)(ws + WS_WOUT) + (size_t)layer * D * D, M, D, D}; pg8::StaticOrder S; S.init(M, D, G, bx);
            if (layer + 1 < DEPTH) { pg8::EpiRes<true> E{nullptr, nullptr, (float*)(ws + WS_ROWSS), (const bf16*)(ws + WS_HRES), (bf16*)(ws + WS_HRES)};
                pg8::gemm_phase<pg8::EpiRes<true>, pg8::StaticOrder, PG8_ALIGN, PG8_SP2>(lds, g, S, E); }
            else if (G == 256) { pg8::EpiResFinal E{(const bf16*)(ws + WS_HRES), pa.out, (float*)(ws + WS_ROWSS2), (unsigned*)(ws + WS_PCNT), pa.in[21]};
                pg8::gemm_phase<pg8::EpiResFinal, pg8::StaticOrder, false, PG8_SP2>(lds, g, S, E); }
            else { pg8::EpiRes<false> E{nullptr, pa.out, nullptr, (const bf16*)(ws + WS_HRES), nullptr};
                pg8::gemm_phase<pg8::EpiRes<false>, pg8::StaticOrder, PG8_ALIGN, PG8_SP2>(lds, g, S, E); }
        }
        if (layer + 1 < DEPTH) { SEAM(); continue; }
        if (G == 256) break;
        SEAM();
        if (IN(ph)) {
            for (int m = gw; m < M; m += NGW) rms_row<true>(pa.out + (size_t)m * D, pa.in[21], nullptr, pa.out + (size_t)m * D, lane);
        }
    }
#undef IN
#undef SEAM
}
constexpr int N_PHASES = 1 + DEPTH * 5 + 1;

#ifndef MK_SPLIT
#define MK_SPLIT 0
#endif
extern "C" void kernel_launch(void* const* d_in, const int* in_sizes, int n_in, void* d_out, int out_size, void* d_ws, size_t ws_size, hipStream_t stream) {
    static int grid = 0;
    if (grid == 0) {
        if (n_in != 22 || in_sizes[0] != M * D || out_size != M * D || ws_size < WS_END) { fprintf(stderr, "kernel_launch: unexpected shapes (n_in %d, in0 %d, out %d, ws %zu)\n", n_in, n_in > 0 ? in_sizes[0] : -1, out_size, ws_size); grid = -1; return; }
        int dev = 0, cus = 0, per_cu = 0;
        hipGetDevice(&dev); hipDeviceGetAttribute(&cus, hipDeviceAttributeMultiprocessorCount, dev);
        hipFuncSetAttribute((const void*)hymba_fwd, hipFuncAttributeMaxDynamicSharedMemorySize, LDS_BYTES);
        hipOccupancyMaxActiveBlocksPerMultiprocessor(&per_cu, (const void*)hymba_fwd, NWAVES * 64, LDS_BYTES);
        (void)hipGetLastError();
        if (per_cu < 1) per_cu = 1;
        grid = cus * per_cu; if (grid > 256) grid = 256;
        fprintf(stderr, "kernel_launch: cus %d per_cu %d grid %d\n", cus, per_cu, grid);
    }
    if (grid < 0) return;
    Args a{};
    for (int i = 0; i < 22; ++i) a.in[i] = (const float*)d_in[i];
    a.out = (float*)d_out; a.ws = (unsigned char*)d_ws;
#if MK_SPLIT
    for (int p = 0; p < N_PHASES; ++p) { a.ph_lo = p; a.ph_hi = p + 1; hipLaunchKernelGGL(hymba_fwd, dim3(grid), dim3(NWAVES * 64), LDS_BYTES, stream, a); }
#else
    a.ph_lo = 0; a.ph_hi = N_PHASES;
    (void)hipMemsetAsync((char*)d_ws + WS_CTL, 0, 16384, stream);
    void* kargs[] = {&a};
    hipError_t e = hipLaunchCooperativeKernel((const void*)hymba_fwd, dim3(grid), dim3(NWAVES * 64), kargs, LDS_BYTES, stream);
    if (e != hipSuccess) fprintf(stderr, "cooperative launch failed: %s (grid %d)\n", hipGetErrorString(e), grid);
#endif
}
```
